# Optimizing an MI355X kernel written in HIP

```python
import jax, jax.numpy as jnp
from jax import lax
import numpy as np

D_MODEL = 2048
BATCH = 2
SEQ = 4096
DEPTH = 1

CONV_CH = D_MODEL // 2
CONV_K = 31
HEAD_DIM = 128
HEADS_PER_GROUP = 4
DILATED_GROUPS = ((128, 1), (512, 4), (2048, 16))
N_GROUPS = len(DILATED_GROUPS)
N_ATTN_HEADS = HEADS_PER_GROUP * N_GROUPS
ATTN_WIDTH = N_ATTN_HEADS * HEAD_DIM
ATTN_OUT_WIDTH = HEADS_PER_GROUP * HEAD_DIM
BAND_BLOCK = 128
OFF_Q = 2 * CONV_CH
OFF_K = OFF_Q + ATTN_WIDTH
OFF_V = OFF_K + ATTN_WIDTH
OFF_G = OFF_V + ATTN_WIDTH
IN_COLS = OFF_G + 2 * D_MODEL
PEER_HEADS = 8
PEER_NKEYS = 128
PEER_EXPERTS = PEER_NKEYS * PEER_NKEYS
PEER_TOPK = 16
PEER_QDIM = 256
PEER_HALF = PEER_QDIM // 2
PEER_CHUNK = 128
EPS = 1e-6

kernel_name = "hybrid_conv_dilatedattn_peer_adaln"


def rmsnorm(x, g):
    xf = x.astype(jnp.float32)
    y = xf * lax.rsqrt(jnp.mean(xf * xf, axis=-1, keepdims=True) + EPS)
    return (y * g.astype(jnp.float32)).astype(x.dtype)


def layernorm(x, g, b):
    xf = x.astype(jnp.float32)
    mu = jnp.mean(xf, axis=-1, keepdims=True)
    var = jnp.mean(jnp.square(xf - mu), axis=-1, keepdims=True)
    y = (xf - mu) * lax.rsqrt(var + EPS) * g.astype(jnp.float32) + b.astype(jnp.float32)
    return y.astype(x.dtype)


def dilated_group_attention(q, k, v, window, dil):
    B, S, Hg, E = q.shape
    w_sub = window // dil
    blk = BAND_BLOCK
    assert w_sub <= blk
    L = S // dil
    nb = -(-L // blk)
    Lp = nb * blk

    def split(t):
        t = t.reshape(B, L, dil, Hg, E)
        return jnp.pad(t, ((0, 0), (0, Lp - L), (0, 0), (0, 0), (0, 0)))

    def band(t):
        t = jnp.pad(split(t), ((0, 0), (blk, 0), (0, 0), (0, 0), (0, 0)))
        t = t.reshape(B, nb + 1, blk, dil, Hg, E)
        return jnp.concatenate([t[:, :-1], t[:, 1:]], axis=2)

    qs = split(q).reshape(B, nb, blk, dil, Hg, E)
    kb, vb = band(k), band(v)
    s = jnp.einsum('bnqrhe,bnkrhe->bnrhqk', qs, kb) * (E ** -0.5)
    qi = jnp.arange(blk)[:, None]
    ki = jnp.arange(2 * blk)[None, :]
    dist = qi + blk - ki
    key_pos = jnp.arange(nb)[:, None, None] * blk + ki[None] - blk
    valid = (dist >= 0)[None] & (dist <= w_sub)[None] & (key_pos >= 0)
    s = jnp.where(valid[None, :, None, None], s, -jnp.inf)
    m = jnp.max(s, axis=-1, keepdims=True)
    p = jnp.exp(s - m)
    den = jnp.sum(p, axis=-1, keepdims=True)
    o = jnp.einsum('bnrhqk,bnkrhe->bnqrhe', p / den, vb)
    lse = (m + jnp.log(den))[..., 0]
    o = o.reshape(B, Lp, dil, Hg, E)[:, :L].reshape(B, S, Hg, E)
    lse = lse.transpose(0, 1, 4, 2, 3).reshape(B, Lp, dil, Hg)[:, :L].reshape(B, S, Hg)
    return o, lse


def token_mixer(h, w_in, conv_dw, conv_db, conv_ln_g, conv_ln_b, w_conv_out, b_conv_out,
                q_norm_g, k_norm_g, w_attn_o, w_out):
    B, S, D = h.shape
    z = h @ w_in
    glu = z[..., :OFF_Q]
    u = glu[..., :CONV_CH] * jax.nn.sigmoid(glu[..., CONV_CH:])
    u = lax.conv_general_dilated(u, conv_dw[:, None, :].astype(u.dtype), window_strides=(1,),
                                 padding=[(CONV_K - 1, 0)], dimension_numbers=('NWC', 'WIO', 'NWC'),
                                 feature_group_count=CONV_CH) + conv_db
    u = jax.nn.silu(layernorm(u, conv_ln_g, conv_ln_b))
    y_conv = u @ w_conv_out + b_conv_out
    def heads(t, g):
        t = t.reshape(B, S, N_ATTN_HEADS, HEAD_DIM).astype(jnp.float32)
        if g is None:
            return t
        return t * lax.rsqrt(jnp.mean(t * t, axis=-1, keepdims=True) + EPS) * g.astype(jnp.float32)
    q = heads(z[..., OFF_Q:OFF_K], q_norm_g)
    k = heads(z[..., OFF_K:OFF_V], k_norm_g)
    v = heads(z[..., OFF_V:OFF_G], None)
    outs, lses = [], []
    for gi, (window, dil) in enumerate(DILATED_GROUPS):
        hs = slice(gi * HEADS_PER_GROUP, (gi + 1) * HEADS_PER_GROUP)
        o, l = dilated_group_attention(q[:, :, hs], k[:, :, hs], v[:, :, hs], window, dil)
        outs.append(o)
        lses.append(l)
    wts = jax.nn.softmax(jnp.stack(lses, axis=0), axis=0)
    o = jnp.sum(wts[..., None] * jnp.stack(outs, axis=0), axis=0)
    y_attn = o.reshape(B, S, ATTN_OUT_WIDTH).astype(h.dtype) @ w_attn_o
    gates = jax.nn.sigmoid(z[..., OFF_G:])
    merged = gates[..., :D] * y_conv + gates[..., D:] * y_attn
    return merged @ w_out


def peer(h, w_q, sub_keys, w_up, w_down):
    B, S, D = h.shape
    qp = (h @ w_q).reshape(B, S, PEER_HEADS, 2, PEER_HALF).astype(jnp.float32)
    s = jnp.einsum('bshpe,hpne->bshpn', qp, sub_keys.astype(jnp.float32))
    v1, i1 = lax.top_k(s[..., 0, :], PEER_TOPK)
    v2, i2 = lax.top_k(s[..., 1, :], PEER_TOPK)
    cand = (v1[..., :, None] + v2[..., None, :]).reshape(B, S, PEER_HEADS, PEER_TOPK * PEER_TOPK)
    top, ci = lax.top_k(cand, PEER_TOPK)
    e1 = jnp.take_along_axis(i1, ci // PEER_TOPK, axis=-1)
    e2 = jnp.take_along_axis(i2, ci % PEER_TOPK, axis=-1)
    idx = e1 * PEER_NKEYS + e2
    g = jax.nn.softmax(top, axis=-1).astype(h.dtype)
    nc = (B * S) // PEER_CHUNK
    hk = PEER_HEADS * PEER_TOPK
    xs = (h.reshape(nc, PEER_CHUNK, D), idx.reshape(nc, PEER_CHUNK, hk), g.reshape(nc, PEER_CHUNK, hk))

    def chunk(args):
        xc, ic, gc = args
        u = jnp.take(w_up, ic, axis=0)
        a = jax.nn.gelu(jnp.einsum('td,tkd->tk', xc, u), approximate=False)
        return jnp.einsum('tk,tkd->td', gc * a, jnp.take(w_down, ic, axis=0))

    return lax.map(chunk, xs).reshape(B, S, D)


def setup_inputs(seed: int = 0) -> dict:
    key = jax.random.key(seed)
    ks = jax.random.split(key, 24)
    D, L = D_MODEL, DEPTH
    nrm = lambda k, shape, s: jax.random.normal(k, shape, jnp.float32) * s
    return {
        "x": nrm(ks[0], (BATCH, SEQ, D), 1.0),
        "c": nrm(ks[1], (BATCH, D), 1.0),
        "norm1_g": 1.0 + nrm(ks[2], (L, D), 0.02),
        "norm2_g": 1.0 + nrm(ks[3], (L, D), 0.02),
        "w_ada": nrm(ks[4], (L, D, 6 * D), 0.5 * D ** -0.5),
        "b_ada": nrm(ks[5], (L, 6 * D), 0.01),
        "w_in": nrm(ks[6], (L, D, IN_COLS), D ** -0.5),
        "conv_dw": nrm(ks[7], (L, CONV_K, CONV_CH), CONV_K ** -0.5),
        "conv_db": nrm(ks[8], (L, CONV_CH), 0.01),
        "conv_ln_g": 1.0 + nrm(ks[9], (L, CONV_CH), 0.02),
        "conv_ln_b": nrm(ks[10], (L, CONV_CH), 0.01),
        "w_conv_out": nrm(ks[11], (L, CONV_CH, D), CONV_CH ** -0.5),
        "b_conv_out": nrm(ks[12], (L, D), 0.01),
        "q_norm_g": 1.0 + nrm(ks[13], (L, N_ATTN_HEADS, HEAD_DIM), 0.02),
        "k_norm_g": 1.0 + nrm(ks[14], (L, N_ATTN_HEADS, HEAD_DIM), 0.02),
        "w_attn_o": nrm(ks[15], (L, ATTN_OUT_WIDTH, D), ATTN_OUT_WIDTH ** -0.5),
        "w_out": nrm(ks[16], (L, D, D), D ** -0.5),
        "peer_w_q": nrm(ks[17], (L, D, PEER_HEADS * PEER_QDIM), D ** -0.5),
        "peer_sub_keys": nrm(ks[18], (L, PEER_HEADS, 2, PEER_NKEYS, PEER_HALF), PEER_HALF ** -0.5),
        "peer_w_up": nrm(ks[19], (L, PEER_EXPERTS, D), D ** -0.5),
        "peer_w_down": nrm(ks[20], (L, PEER_EXPERTS, D), PEER_HEADS ** -0.5),
    }


def reference(x, c, norm1_g, norm2_g, w_ada, b_ada, w_in, conv_dw, conv_db, conv_ln_g, conv_ln_b,
              w_conv_out, b_conv_out, q_norm_g, k_norm_g, w_attn_o, w_out,
              peer_w_q, peer_sub_keys, peer_w_up, peer_w_down):
    B, S, D = x.shape
    for l in range(DEPTH):
        mod = (jax.nn.silu(c) @ w_ada[l] + b_ada[l]).reshape(B, 6, D)
        shift1, scale1, gate1 = mod[:, 0, None], mod[:, 1, None], mod[:, 2, None]
        shift2, scale2, gate2 = mod[:, 3, None], mod[:, 4, None], mod[:, 5, None]
        h = rmsnorm(x, norm1_g[l]) * (1.0 + scale1) + shift1
        x = x + gate1 * token_mixer(h, w_in[l], conv_dw[l], conv_db[l], conv_ln_g[l], conv_ln_b[l],
                                    w_conv_out[l], b_conv_out[l], q_norm_g[l], k_norm_g[l],
                                    w_attn_o[l], w_out[l])
        h = rmsnorm(x, norm2_g[l]) * (1.0 + scale2) + shift2
        x = x + gate2 * peer(h, peer_w_q[l], peer_sub_keys[l], peer_w_up[l], peer_w_down[l])
    return x
```

```cpp
#include <hip/hip_runtime.h>
#include <cstdio>
#include <cstdint>
#include <cmath>

constexpr int BATCH = 2, SEQ = 4096, D = 2048, T = BATCH * SEQ;
constexpr int CONV_CH = 1024, CONV_K = 31;
constexpr int HD = 128, NHEADS = 12, AW = 1536, AOW = 512;
constexpr int OFF_Q = 2048, OFF_G = OFF_Q + 3 * AW, IN_COLS = OFF_G + 2 * D;
constexpr int QKVW = 3 * AW;
constexpr int PEER_H = 8, PEER_NK = 128, PEER_TOPK = 16, PEER_HK = PEER_H * PEER_TOPK;
constexpr int PEER_E = PEER_NK * PEER_NK;
constexpr int MODW = 6 * D;
constexpr float EPS = 1e-6f;
constexpr int NWAVES = 8, NTHREADS = NWAVES * 64;
#ifndef N_LAUNCH_MODE
#define N_LAUNCH_MODE 0
#endif
constexpr int NPHASES = 11;

constexpr size_t MiB = 1u << 20;
constexpr size_t WS_CTL = 0, CTL_ZERO_BYTES = 1 * MiB;
constexpr size_t WS_MOD = 1 * MiB;
constexpr size_t WS_SK = 1 * MiB + 512 * 1024;
constexpr size_t WS_WIN = 2 * MiB;
constexpr size_t WS_WCO = 44 * MiB;
constexpr size_t WS_WAO = 48 * MiB;
constexpr size_t WS_WOUT = 50 * MiB;
constexpr size_t WS_WQ = 58 * MiB;
constexpr size_t WS_WUP = 66 * MiB;
constexpr size_t WS_WDN = 130 * MiB;
constexpr size_t WS_H = 194 * MiB;
constexpr size_t WS_U = 226 * MiB;
constexpr size_t WS_QKV = 242 * MiB;
constexpr size_t WS_G = 314 * MiB;
constexpr size_t WS_UCV = 378 * MiB;
constexpr size_t WS_ON = 394 * MiB;
constexpr size_t WS_DEN = 418 * MiB;
constexpr size_t WS_O = 419 * MiB;
constexpr size_t WS_MERGED = 427 * MiB;
constexpr size_t WS_QP = 459 * MiB;
constexpr size_t WS_IDX = 491 * MiB;
constexpr size_t WS_GW = 495 * MiB;
constexpr size_t WS_END = 500 * MiB;
constexpr int CW_BAR = 4096;

constexpr int LDS_BYTES = 147456;
constexpr int RING_BYTES = 131072, MISC_OFF = RING_BYTES + 320;

#define GAS __attribute__((address_space(1)))
#define LAS __attribute__((address_space(3)))
typedef unsigned short bf16;
typedef unsigned v4u __attribute__((ext_vector_type(4)));
typedef unsigned v2u __attribute__((ext_vector_type(2)));
typedef float f32x4 __attribute__((ext_vector_type(4)));
#define RLX_AGENT __ATOMIC_RELAXED, __HIP_MEMORY_SCOPE_AGENT

__device__ __forceinline__ unsigned f2bf(float f) { unsigned u = __builtin_bit_cast(unsigned, f); return (u + 0x7fffu + ((u >> 16) & 1u)) >> 16; }
__device__ __forceinline__ unsigned pk2(float lo, float hi) { return f2bf(lo) | (f2bf(hi) << 16); }
__device__ __forceinline__ float bf2f(unsigned b) { return __builtin_bit_cast(float, b << 16); }
__device__ __forceinline__ float bflo(unsigned w) { return __builtin_bit_cast(float, w << 16); }
__device__ __forceinline__ float bfhi(unsigned w) { return __builtin_bit_cast(float, w & 0xffff0000u); }
__device__ __forceinline__ float wave_sum(float v) {
#pragma unroll
    for (int o = 1; o < 64; o <<= 1) v += __shfl_xor(v, o);
    return v;
}
__device__ __forceinline__ float sigmoidf_(float x) { return 1.0f / (1.0f + __expf(-x)); }
__device__ __forceinline__ float siluf_(float x) { return x / (1.0f + __expf(-x)); }
__device__ __forceinline__ float gelu_erf(float x) { return 0.5f * x * (1.0f + erff(x * 0.70710678118654752f)); }

#define XB_TMO      128
#define XB_XCNT(j)  (256  + 64 * (j))
#define XB_XSUB(j)  (1280 + 64 * (j))
#define XB_XGEN(j)  (2304 + 64 * (j))
#define XB_TOP      3328
#define XB_TOPGEN   3392
#define XCD_BAR_WORDS 3456
#define XB_SPIN_CAP (1u << 22)
__device__ __forceinline__ unsigned xb_ld(unsigned* p)              { return __hip_atomic_load(p, __ATOMIC_RELAXED, __HIP_MEMORY_SCOPE_AGENT); }
__device__ __forceinline__ unsigned xb_add(unsigned* p, unsigned v) { return __hip_atomic_fetch_add(p, v, __ATOMIC_RELAXED, __HIP_MEMORY_SCOPE_AGENT); }
__device__ __forceinline__ unsigned xb_xcc_id() { return (unsigned)__builtin_amdgcn_s_getreg((3 << 11) | 20) & 0xFu; }
#define XB_SPIN(cond, bar) do { unsigned _sp = 0; while (cond) { __builtin_amdgcn_s_sleep(1); \
    if ((++_sp & 255u) == 0u) { if (xb_ld(&(bar)[XB_TMO])) break; if (_sp > XB_SPIN_CAP) { atomicAdd(&(bar)[XB_TMO], 1u); break; } } } } while (0)
struct XcdBarrier { unsigned* bar; unsigned x; volatile LAS unsigned* st; };
__device__ __forceinline__ XcdBarrier xcd_barrier_post(unsigned* bar, volatile LAS unsigned* st) {
    XcdBarrier b; b.bar = bar; b.x = xb_xcc_id(); b.st = st;
    if (threadIdx.x == 0) (void)xb_add(&bar[XB_XCNT(b.x)], 1u);
    return b;
}
__device__ __forceinline__ void xcd_barrier_complete(unsigned* bar, unsigned x, unsigned& nloc, unsigned& nx) {
    const unsigned G = gridDim.x * gridDim.y * gridDim.z;
    unsigned sum, cnt, mine, sp = 0u;
    for (;;) {
        sum = 0u; cnt = 0u; mine = 0u;
#pragma unroll
        for (unsigned j = 0; j < 16; ++j) { const unsigned c = xb_ld(&bar[XB_XCNT(j)]); sum += c; cnt += (c > 0u) ? 1u : 0u; mine = (j == x) ? c : mine; }
        if (sum == G) break;
        __builtin_amdgcn_s_sleep(1);
        if ((++sp & 255u) == 0u) { if (xb_ld(&bar[XB_TMO])) break; if (sp > XB_SPIN_CAP) { atomicAdd(&bar[XB_TMO], 1u); break; } }
    }
    nloc = mine > 0u ? mine : 1u; nx = cnt > 0u ? cnt : 1u;
}
__device__ __forceinline__ void xcd_barrier(const XcdBarrier& b) {
    asm volatile("s_waitcnt vmcnt(0)" ::: "memory");
    __syncthreads();
    if (threadIdx.x == 0) {
        unsigned* bar = b.bar;
        __builtin_amdgcn_s_waitcnt(0);
        unsigned nloc = b.st[0], nx = b.st[1];
        if (nloc == 0u) { xcd_barrier_complete(bar, b.x, nloc, nx); b.st[0] = nloc; b.st[1] = nx; }
        const unsigned old = xb_add(&bar[XB_XSUB(b.x)], 1u);
        const unsigned gen = old / nloc;
        if (old + 1u == (gen + 1u) * nloc) {
            __builtin_amdgcn_fence(__ATOMIC_RELEASE, "agent");
            asm volatile("s_waitcnt vmcnt(0)" ::: "memory");
            const unsigned og = xb_add(&bar[XB_TOP], 1u);
            const unsigned tg = og / nx;
            if (og + 1u == (tg + 1u) * nx) xb_add(&bar[XB_TOPGEN], 1u);
            else XB_SPIN(xb_ld(&bar[XB_TOPGEN]) == tg, bar);
            __builtin_amdgcn_fence(__ATOMIC_ACQUIRE, "agent");
            xb_add(&bar[XB_XGEN(b.x)], 1u);
            asm volatile("s_waitcnt vmcnt(0)" ::: "memory");
        } else {
            XB_SPIN(xb_ld(&bar[XB_XGEN(b.x)]) == gen, bar);
            __builtin_amdgcn_fence(__ATOMIC_ACQUIRE, "agent");
            asm volatile("s_waitcnt vmcnt(0)" ::: "memory");
        }
    }
    __syncthreads();
}

struct Args { const float* in[21]; float* out; unsigned char* ws; int ph_lo, ph_hi; };
enum { I_X = 0, I_C, I_N1G, I_N2G, I_WADA, I_BADA, I_WIN, I_CDW, I_CDB, I_CLNG, I_CLNB, I_WCO, I_BCO, I_QNG, I_KNG, I_WAO, I_WOUT, I_PWQ, I_PSK, I_PWUP, I_PWDN };

struct Ctx {
    int tid, lane, wave, bid, nb, gw, ngw;
    unsigned char* lds;
};

__device__ __forceinline__ int win_row(int n) {
    if (n < 1024) return (n >> 7) * 256 + (n & 127);
    if (n < 2048) { const int m = n - 1024; return (m >> 7) * 256 + 128 + (m & 127); }
    return n;
}
__device__ __forceinline__ void p0_transpose_item(const float* W, int K, int N, bf16* WT, bool perm, float* scr, int item, int lane) {
    const int nblk = N / 32, kb = item / nblk, nbi = item % nblk, k0 = 64 * kb, n0 = 32 * nbi;
#pragma unroll 8
    for (int i = 0; i < 32; ++i) { const int kk = 2 * i + (lane >> 5); scr[kk * 33 + (lane & 31)] = W[(size_t)(k0 + kk) * N + n0 + (lane & 31)]; }
    asm volatile("s_waitcnt lgkmcnt(0)" ::: "memory");
    const int c = lane & 7;
    const int r0 = perm ? win_row(n0) : n0;
#pragma unroll
    for (int j = 0; j < 4; ++j) { const int n = (lane >> 3) + 8 * j; const float* s = scr + (8 * c) * 33 + n;
        v4u o; o.x = pk2(s[0 * 33], s[1 * 33]); o.y = pk2(s[2 * 33], s[3 * 33]); o.z = pk2(s[4 * 33], s[5 * 33]); o.w = pk2(s[6 * 33], s[7 * 33]);
        *(v4u*)(WT + (size_t)(r0 + n) * K + k0 + 8 * c) = o; }
    asm volatile("s_waitcnt lgkmcnt(0)" ::: "memory");
}
__device__ __forceinline__ void cvt_stream(const float* src, bf16* dst, size_t n, const Ctx& C) {
    const size_t nv = n / 8;
    for (size_t i = (size_t)C.gw * 64 + C.lane; i < nv; i += (size_t)C.ngw * 64) {
        const f32x4 a = *(const f32x4*)(src + i * 8), b = *(const f32x4*)(src + i * 8 + 4);
        v4u o; o.x = pk2(a.x, a.y); o.y = pk2(a.z, a.w); o.z = pk2(b.x, b.y); o.w = pk2(b.z, b.w);
        *(v4u*)(dst + i * 8) = o;
    }
}
__device__ __forceinline__ void phase_prologue(const Args& A, const Ctx& C) {
    unsigned char* ws = A.ws;
    float* mod = (float*)(ws + WS_MOD);
    {
        float* red = (float*)C.lds;
        const float* w_ada = A.in[I_WADA]; const float* cv = A.in[I_C];
        for (int it = C.bid; it < MODW / 48; it += C.nb) {
            const int c4 = C.tid % 12, kg = C.tid / 12;
            f32x4 a0 = {0.f, 0.f, 0.f, 0.f}, a1 = {0.f, 0.f, 0.f, 0.f};
            if (C.tid < 504) {
                for (int k = kg; k < D; k += 42) {
                    const f32x4 w = *(const f32x4*)(w_ada + (size_t)k * MODW + 48 * it + 4 * c4);
                    const float s0 = siluf_(cv[k]), s1 = siluf_(cv[D + k]);
                    a0 += w * s0; a1 += w * s1;
                }
                float* r = red + kg * 96 + c4 * 4;
                r[0] = a0.x; r[1] = a0.y; r[2] = a0.z; r[3] = a0.w;
                r[48 + 0] = a1.x; r[48 + 1] = a1.y; r[48 + 2] = a1.z; r[48 + 3] = a1.w;
            }
            __syncthreads();
            if (C.tid < 96) {
                float s = 0.f;
                for (int g = 0; g < 42; ++g) s += red[g * 96 + C.tid];
                const int b = C.tid / 48, col = 48 * it + (C.tid % 48);
                mod[b * MODW + col] = s + A.in[I_BADA][col];
            }
            __syncthreads();
        }
    }
    {
        float* scr = (float*)(C.lds + C.wave * 16384);
        constexpr int I_IN = (D / 64) * (IN_COLS / 32), I_CO = (CONV_CH / 64) * (D / 32), I_AO = (AOW / 64) * (D / 32), I_OUT = (D / 64) * (D / 32), I_Q = I_OUT;
        constexpr int NITEMS = I_IN + I_CO + I_AO + I_OUT + I_Q;
        for (int it = C.gw; it < NITEMS; it += C.ngw) {
            int r = it;
            if (r < I_IN) { p0_transpose_item(A.in[I_WIN], D, IN_COLS, (bf16*)(ws + WS_WIN), true, scr, r, C.lane); continue; } r -= I_IN;
            if (r < I_CO) { p0_transpose_item(A.in[I_WCO], CONV_CH, D, (bf16*)(ws + WS_WCO), false, scr, r, C.lane); continue; } r -= I_CO;
            if (r < I_AO) { p0_transpose_item(A.in[I_WAO], AOW, D, (bf16*)(ws + WS_WAO), false, scr, r, C.lane); continue; } r -= I_AO;
            if (r < I_OUT) { p0_transpose_item(A.in[I_WOUT], D, D, (bf16*)(ws + WS_WOUT), false, scr, r, C.lane); continue; } r -= I_OUT;
            p0_transpose_item(A.in[I_PWQ], D, D, (bf16*)(ws + WS_WQ), false, scr, r, C.lane);
        }
    }
    cvt_stream(A.in[I_PSK], (bf16*)(ws + WS_SK), (size_t)16 * 128 * 128, C);
    cvt_stream(A.in[I_PWUP], (bf16*)(ws + WS_WUP), (size_t)PEER_E * D, C);
    cvt_stream(A.in[I_PWDN], (bf16*)(ws + WS_WDN), (size_t)PEER_E * D, C);
}

__device__ __forceinline__ void phase_norm_mod(const float* xin, const float* gn, const float* mod, int shift_i, int scale_i, bf16* hout, const Ctx& C) {
    for (int m = C.gw; m < T; m += C.ngw) {
        const f32x4* xr = (const f32x4*)(xin + (size_t)m * D);
        f32x4 v[8]; float ss = 0.f;
#pragma unroll
        for (int j = 0; j < 8; ++j) { v[j] = xr[C.lane + 64 * j]; ss += (v[j].x * v[j].x + v[j].y * v[j].y) + (v[j].z * v[j].z + v[j].w * v[j].w); }
        ss = wave_sum(ss);
        const float rstd = 1.0f / sqrtf(ss * (1.0f / D) + EPS);
        const int b = m / SEQ;
        const f32x4* gp = (const f32x4*)gn; const f32x4* sc = (const f32x4*)(mod + b * MODW + scale_i * D); const f32x4* sh = (const f32x4*)(mod + b * MODW + shift_i * D);
        v2u* o = (v2u*)(hout + (size_t)m * D);
#pragma unroll
        for (int j = 0; j < 8; ++j) { const int q = C.lane + 64 * j; const f32x4 g = gp[q], s = sc[q], h = sh[q];
            const f32x4 y = v[j] * rstd * g * (s + 1.0f) + h;
            v2u w; w.x = pk2(y.x, y.y); w.y = pk2(y.z, y.w); o[q] = w; }
    }
}

template <class Epi>
__device__ __forceinline__ void ngemm_phase(const bf16* Am, const bf16* Bt, int M, int N, int K, int lda, const Epi& E, const Ctx& C) {
    float* As = (float*)C.lds;
    float* Bs = As + 64 * 33;
    const int tid = C.tid, ty = tid >> 5, tx = tid & 31;
    const int ntm = M / 64, ntn = N / 256;
    for (int it = C.bid; it < ntm * ntn; it += C.nb) {
        const int pm = it / ntn, pn = it % ntn;
        float acc[4][8];
#pragma unroll
        for (int i = 0; i < 4; ++i)
#pragma unroll
            for (int j = 0; j < 8; ++j) acc[i][j] = 0.f;
        for (int k0 = 0; k0 < K; k0 += 32) {
            { const int r = tid >> 3, c = (tid & 7) * 4; const v2u v = *(const v2u*)(Am + (size_t)(pm * 64 + r) * lda + k0 + c);
              float* d = As + r * 33 + c; d[0] = bflo(v.x); d[1] = bfhi(v.x); d[2] = bflo(v.y); d[3] = bfhi(v.y); }
#pragma unroll
            for (int i = 0; i < 4; ++i) { const int idx = tid + 512 * i, r = idx >> 3, c = (idx & 7) * 4; const v2u v = *(const v2u*)(Bt + (size_t)(pn * 256 + r) * K + k0 + c);
              float* d = Bs + r * 33 + c; d[0] = bflo(v.x); d[1] = bfhi(v.x); d[2] = bflo(v.y); d[3] = bfhi(v.y); }
            __syncthreads();
#pragma unroll 4
            for (int k = 0; k < 32; ++k) {
                float a[4], b[8];
#pragma unroll
                for (int i = 0; i < 4; ++i) a[i] = As[(ty + 16 * i) * 33 + k];
#pragma unroll
                for (int j = 0; j < 8; ++j) b[j] = Bs[(tx + 32 * j) * 33 + k];
#pragma unroll
                for (int i = 0; i < 4; ++i)
#pragma unroll
                    for (int j = 0; j < 8; ++j) acc[i][j] += a[i] * b[j];
            }
            __syncthreads();
        }
        E(pm * 64 + ty, pn, tx, acc);
    }
}
struct NEpiIn {
    bf16 *U, *QKV, *G;
    __device__ __forceinline__ void operator()(int r0, int pn, int tx, const float (&acc)[4][8]) const {
#pragma unroll
        for (int i = 0; i < 4; ++i) { const size_t row = r0 + 16 * i;
            if (pn < 8) {
#pragma unroll
                for (int j = 0; j < 4; ++j) U[row * CONV_CH + 128 * pn + tx + 32 * j] = (bf16)f2bf(acc[i][j] * sigmoidf_(acc[i][j + 4]));
            } else if (pn < 26) {
#pragma unroll
                for (int j = 0; j < 8; ++j) QKV[row * QKVW + (pn - 8) * 256 + tx + 32 * j] = (bf16)f2bf(acc[i][j]);
            } else {
#pragma unroll
                for (int j = 0; j < 8; ++j) G[row * (2 * D) + (pn - 26) * 256 + tx + 32 * j] = (bf16)f2bf(sigmoidf_(acc[i][j]));
            } }
    }
};
struct NEpiYattn {
    const bf16* G; bf16* MG;
    __device__ __forceinline__ void operator()(int r0, int pn, int tx, const float (&acc)[4][8]) const {
#pragma unroll
        for (int i = 0; i < 4; ++i) { const size_t row = r0 + 16 * i;
#pragma unroll
            for (int j = 0; j < 8; ++j) { const int col = pn * 256 + tx + 32 * j; MG[row * D + col] = (bf16)f2bf(bf2f(G[row * (2 * D) + D + col]) * acc[i][j]); } }
    }
};
struct NEpiYconv {
    const bf16* G; bf16* MG; const float* bias;
    __device__ __forceinline__ void operator()(int r0, int pn, int tx, const float (&acc)[4][8]) const {
#pragma unroll
        for (int i = 0; i < 4; ++i) { const size_t row = r0 + 16 * i;
#pragma unroll
            for (int j = 0; j < 8; ++j) { const int col = pn * 256 + tx + 32 * j;
                MG[row * D + col] = (bf16)f2bf(bf2f(MG[row * D + col]) + bf2f(G[row * (2 * D) + col]) * (acc[i][j] + bias[col])); } }
    }
};
struct NEpiOut {
    const float* x; const float* mod; float* out;
    __device__ __forceinline__ void operator()(int r0, int pn, int tx, const float (&acc)[4][8]) const {
#pragma unroll
        for (int i = 0; i < 4; ++i) { const size_t row = r0 + 16 * i; const int b = (int)(row / SEQ);
#pragma unroll
            for (int j = 0; j < 8; ++j) { const int col = pn * 256 + tx + 32 * j; out[row * D + col] = x[row * D + col] + mod[b * MODW + 2 * D + col] * acc[i][j]; } }
    }
};
struct NEpiBf16 {
    bf16* O; int ldc;
    __device__ __forceinline__ void operator()(int r0, int pn, int tx, const float (&acc)[4][8]) const {
#pragma unroll
        for (int i = 0; i < 4; ++i) { const size_t row = r0 + 16 * i;
#pragma unroll
            for (int j = 0; j < 8; ++j) O[row * ldc + pn * 256 + tx + 32 * j] = (bf16)f2bf(acc[i][j]); }
    }
};

__device__ __forceinline__ float block_sum(float v, float* red, const Ctx& C) {
    v = wave_sum(v);
    __syncthreads();
    if (C.lane == 0) red[C.wave] = v;
    __syncthreads();
    float s = 0.f;
#pragma unroll
    for (int i = 0; i < NWAVES; ++i) s += red[i];
    return s;
}
__device__ __forceinline__ void phase_conv_naive(const Args& A, const Ctx& C) {
    const bf16* U = (const bf16*)(A.ws + WS_U); bf16* UCV = (bf16*)(A.ws + WS_UCV);
    const float* dw = A.in[I_CDW]; const float* db = A.in[I_CDB]; const float* lg = A.in[I_CLNG]; const float* lb = A.in[I_CLNB];
    float* red = (float*)C.lds;
    const int c0 = 2 * C.tid;
    for (int t = C.bid; t < T; t += C.nb) {
        const int s = t % SEQ;
        float a0 = db[c0], a1 = db[c0 + 1];
        for (int j = 0; j < CONV_K; ++j) { const int sp = s - (CONV_K - 1) + j; if (sp < 0) continue;
            const unsigned w = *(const unsigned*)(U + (size_t)(t - (CONV_K - 1) + j) * CONV_CH + c0);
            a0 += dw[j * CONV_CH + c0] * bflo(w); a1 += dw[j * CONV_CH + c0 + 1] * bfhi(w); }
        const float mean = block_sum(a0 + a1, red, C) * (1.0f / CONV_CH);
        const float d0 = a0 - mean, d1 = a1 - mean;
        const float var = block_sum(d0 * d0 + d1 * d1, red, C) * (1.0f / CONV_CH);
        const float rstd = 1.0f / sqrtf(var + EPS);
        const float y0 = d0 * rstd * lg[c0] + lb[c0], y1 = d1 * rstd * lg[c0 + 1] + lb[c0 + 1];
        *(unsigned*)(UCV + (size_t)t * CONV_CH + c0) = pk2(siluf_(y0), siluf_(y1));
    }
}
__device__ __forceinline__ void phase_attn_naive(const Args& A, const Ctx& C) {
    const bf16* QKV = (const bf16*)(A.ws + WS_QKV); bf16* O = (bf16*)(A.ws + WS_O);
    const float* qg = A.in[I_QNG]; const float* kg = A.in[I_KNG];
    const int lane = C.lane;
    for (int it = C.gw; it < T * 4; it += C.ngw) {
        const int t = it >> 2, hh = it & 3, b = t / SEQ, s = t % SEQ;
        float m = -INFINITY, l = 0.f, o0 = 0.f, o1 = 0.f;
        for (int g = 0; g < 3; ++g) {
            const int dil = (g == 0) ? 1 : (g == 1) ? 4 : 16; const int head = g * 4 + hh;
            const unsigned qw = *(const unsigned*)(QKV + (size_t)t * QKVW + head * HD + 2 * lane);
            const float q0 = bflo(qw), q1 = bfhi(qw);
            const float rq = 1.0f / sqrtf(wave_sum(q0 * q0 + q1 * q1) * (1.0f / HD) + EPS);
            const float qq0 = q0 * rq * qg[head * HD + 2 * lane] * kg[head * HD + 2 * lane], qq1 = q1 * rq * qg[head * HD + 2 * lane + 1] * kg[head * HD + 2 * lane + 1];
            for (int dist = 0; dist <= 128; ++dist) {
                const int sk = s - dist * dil; if (sk < 0) break;
                const size_t tk = (size_t)b * SEQ + sk;
                const unsigned kw = *(const unsigned*)(QKV + tk * QKVW + AW + head * HD + 2 * lane);
                const unsigned vw = *(const unsigned*)(QKV + tk * QKVW + 2 * AW + head * HD + 2 * lane);
                const float k0 = bflo(kw), k1 = bfhi(kw);
                float dot = qq0 * k0 + qq1 * k1, kss = k0 * k0 + k1 * k1;
#pragma unroll
                for (int o = 1; o < 64; o <<= 1) { dot += __shfl_xor(dot, o); kss += __shfl_xor(kss, o); }
                const float sc = dot * (1.0f / sqrtf(kss * (1.0f / HD) + EPS)) * 0.08838834764831845f;
                const float mn = fmaxf(m, sc), corr = __expf(m - mn), p = __expf(sc - mn);
                l = l * corr + p; o0 = o0 * corr + p * bflo(vw); o1 = o1 * corr + p * bfhi(vw); m = mn;
            }
        }
        const float il = 1.0f / l;
        *(unsigned*)(O + (size_t)t * AOW + hh * HD + 2 * lane) = pk2(o0 * il, o1 * il);
    }
}

__device__ __forceinline__ void wave_argmax(float& v, int& i) {
#pragma unroll
    for (int o = 32; o >= 1; o >>= 1) { const float ov = __shfl_xor(v, o); const int oi = __shfl_xor(i, o);
        if (ov > v || (ov == v && oi < i)) { v = ov; i = oi; } }
}
__device__ __forceinline__ void phase_topk_naive(const Args& A, const Ctx& C) {
    const bf16* QP = (const bf16*)(A.ws + WS_QP); const bf16* SK = (const bf16*)(A.ws + WS_SK);
    int* IDX = (int*)(A.ws + WS_IDX); float* GW = (float*)(A.ws + WS_GW);
    const int lane = C.lane;
    for (int it = C.gw; it < T * PEER_H; it += C.ngw) {
        const int t = it >> 3, h = it & 7;
        const bf16* qrow = QP + (size_t)t * D + h * 256;
        float topv[2]; int topi[2];
#pragma unroll
        for (int p = 0; p < 2; ++p) {
            float s0 = 0.f, s1 = 0.f;
            const bf16* k0r = SK + ((size_t)(h * 2 + p) * 128 + lane) * 128; const bf16* k1r = k0r + 64 * 128;
            for (int e = 0; e < 128; e += 8) {
                const v4u qv = *(const v4u*)(qrow + p * 128 + e), a = *(const v4u*)(k0r + e), bq = *(const v4u*)(k1r + e);
                s0 += bflo(qv.x) * bflo(a.x) + bfhi(qv.x) * bfhi(a.x) + bflo(qv.y) * bflo(a.y) + bfhi(qv.y) * bfhi(a.y) + bflo(qv.z) * bflo(a.z) + bfhi(qv.z) * bfhi(a.z) + bflo(qv.w) * bflo(a.w) + bfhi(qv.w) * bfhi(a.w);
                s1 += bflo(qv.x) * bflo(bq.x) + bfhi(qv.x) * bfhi(bq.x) + bflo(qv.y) * bflo(bq.y) + bfhi(qv.y) * bfhi(bq.y) + bflo(qv.z) * bflo(bq.z) + bfhi(qv.z) * bfhi(bq.z) + bflo(qv.w) * bflo(bq.w) + bfhi(qv.w) * bfhi(bq.w);
            }
            float tv = 0.f; int ti = 0;
            for (int k = 0; k < PEER_TOPK; ++k) {
                float v; int i;
                if (s0 >= s1) { v = s0; i = lane; } else { v = s1; i = lane + 64; }
                wave_argmax(v, i);
                if (i == lane) s0 = -INFINITY; else if (i == lane + 64) s1 = -INFINITY;
                if (lane == k) { tv = v; ti = i; }
            }
            topv[p] = tv; topi[p] = ti;
        }
        float cv[4];
        const float v1 = __shfl(topv[0], lane >> 2);
#pragma unroll
        for (int u = 0; u < 4; ++u) cv[u] = v1 + __shfl(topv[1], 4 * (lane & 3) + u);
        float wv = -INFINITY; int wc = 0;
        for (int k = 0; k < PEER_TOPK; ++k) {
            float v = cv[0]; int i = 4 * lane;
#pragma unroll
            for (int u = 1; u < 4; ++u) if (cv[u] > v) { v = cv[u]; i = 4 * lane + u; }
            wave_argmax(v, i);
            if ((i >> 2) == lane) {
#pragma unroll
                for (int u = 0; u < 4; ++u) if ((i & 3) == u) cv[u] = -INFINITY;
            }
            if (lane == k) { wv = v; wc = i; }
        }
        const float mx = __shfl(wv, 0);
        const float e = (lane < PEER_TOPK) ? __expf(wv - mx) : 0.f;
        const float sum = wave_sum(e);
        const int e1 = __shfl(topi[0], wc >> 4), e2 = __shfl(topi[1], wc & 15);
        if (lane < PEER_TOPK) { IDX[(size_t)t * PEER_HK + h * PEER_TOPK + lane] = e1 * PEER_NK + e2; GW[(size_t)t * PEER_HK + h * PEER_TOPK + lane] = e / sum; }
    }
}
__device__ __forceinline__ void phase_experts_naive(const Args& A, const Ctx& C) {
    const bf16* H2 = (const bf16*)(A.ws + WS_H); const bf16* WUP = (const bf16*)(A.ws + WS_WUP); const bf16* WDN = (const bf16*)(A.ws + WS_WDN);
    const int* IDX = (const int*)(A.ws + WS_IDX); const float* GW = (const float*)(A.ws + WS_GW); const float* mod = (const float*)(A.ws + WS_MOD);
    float* hs = (float*)C.lds;
    float* coef = hs + D;
    int* eidx = (int*)(coef + PEER_HK);
    for (int t = C.bid; t < T; t += C.nb) {
        { const v2u v = *(const v2u*)(H2 + (size_t)t * D + 4 * C.tid); float* d = hs + 4 * C.tid; d[0] = bflo(v.x); d[1] = bfhi(v.x); d[2] = bflo(v.y); d[3] = bfhi(v.y); }
        if (C.tid < PEER_HK) eidx[C.tid] = IDX[(size_t)t * PEER_HK + C.tid];
        __syncthreads();
        for (int i = 0; i < 16; ++i) {
            const int k = C.wave * 16 + i; const bf16* wr = WUP + (size_t)eidx[k] * D;
            float dot = 0.f;
#pragma unroll
            for (int j = 0; j < 4; ++j) { const int e0 = C.lane * 8 + 512 * j; const v4u w = *(const v4u*)(wr + e0); const float* hp = hs + e0;
                dot += hp[0] * bflo(w.x) + hp[1] * bfhi(w.x) + hp[2] * bflo(w.y) + hp[3] * bfhi(w.y) + hp[4] * bflo(w.z) + hp[5] * bfhi(w.z) + hp[6] * bflo(w.w) + hp[7] * bfhi(w.w); }
            dot = wave_sum(dot);
            if (C.lane == 0) coef[k] = GW[(size_t)t * PEER_HK + k] * gelu_erf(dot);
        }
        __syncthreads();
        float a0 = 0.f, a1 = 0.f, a2 = 0.f, a3 = 0.f;
        for (int k = 0; k < PEER_HK; ++k) { const float c = coef[k]; const v2u w = *(const v2u*)(WDN + (size_t)eidx[k] * D + 4 * C.tid);
            a0 += c * bflo(w.x); a1 += c * bfhi(w.x); a2 += c * bflo(w.y); a3 += c * bfhi(w.y); }
        const int b = t / SEQ; const f32x4 g2 = *(const f32x4*)(mod + b * MODW + 5 * D + 4 * C.tid);
        f32x4* op = (f32x4*)(A.out + (size_t)t * D + 4 * C.tid);
        f32x4 x1 = *op; x1.x += g2.x * a0; x1.y += g2.y * a1; x1.z += g2.z * a2; x1.w += g2.w * a3; *op = x1;
        __syncthreads();
    }
}

__global__ void __launch_bounds__(NTHREADS, 2) mk_fwd(Args args) {
    extern __shared__ __attribute__((aligned(16))) unsigned char lds[];
    Ctx C;
    C.tid = threadIdx.x; C.lane = C.tid & 63; C.wave = __builtin_amdgcn_readfirstlane(C.tid >> 6);
    C.bid = blockIdx.x; C.nb = gridDim.x; C.gw = C.bid * NWAVES + C.wave; C.ngw = C.nb * NWAVES; C.lds = lds;
    volatile LAS unsigned* MISC = (volatile LAS unsigned*)((LAS unsigned char*)lds + MISC_OFF);
    if (C.tid < 32) MISC[C.tid] = 0u;
    __syncthreads();
    unsigned* ctl = (unsigned*)(args.ws + WS_CTL);
    XcdBarrier bar; bar.bar = ctl + CW_BAR; bar.x = 0; bar.st = nullptr;
    const int lo = args.ph_lo, hi = args.ph_hi;
    if (hi - lo > 1) bar = xcd_barrier_post(ctl + CW_BAR, MISC + 8);
#define IN(k) (lo <= (k) && (k) < hi)
#define SEAM(k) do { if (IN(k) && IN((k) + 1)) xcd_barrier(bar); } while (0)
    unsigned char* ws = args.ws;
    const float* mod = (const float*)(ws + WS_MOD);
    if (IN(0)) { phase_prologue(args, C); } SEAM(0);
    if (IN(1)) { phase_norm_mod(args.in[I_X], args.in[I_N1G], mod, 0, 1, (bf16*)(ws + WS_H), C); } SEAM(1);
    if (IN(2)) { NEpiIn E{(bf16*)(ws + WS_U), (bf16*)(ws + WS_QKV), (bf16*)(ws + WS_G)};
                 ngemm_phase((const bf16*)(ws + WS_H), (const bf16*)(ws + WS_WIN), T, IN_COLS, D, D, E, C); } SEAM(2);
    if (IN(3)) { phase_conv_naive(args, C); phase_attn_naive(args, C); } SEAM(3);
    if (IN(4)) { NEpiYattn E{(const bf16*)(ws + WS_G), (bf16*)(ws + WS_MERGED)};
                 ngemm_phase((const bf16*)(ws + WS_O), (const bf16*)(ws + WS_WAO), T, D, AOW, AOW, E, C); } SEAM(4);
    if (IN(5)) { NEpiYconv E{(const bf16*)(ws + WS_G), (bf16*)(ws + WS_MERGED), args.in[I_BCO]};
                 ngemm_phase((const bf16*)(ws + WS_UCV), (const bf16*)(ws + WS_WCO), T, D, CONV_CH, CONV_CH, E, C); } SEAM(5);
    if (IN(6)) { NEpiOut E{args.in[I_X], mod, args.out};
                 ngemm_phase((const bf16*)(ws + WS_MERGED), (const bf16*)(ws + WS_WOUT), T, D, D, D, E, C); } SEAM(6);
    if (IN(7)) { phase_norm_mod(args.out, args.in[I_N2G], mod, 3, 4, (bf16*)(ws + WS_H), C); } SEAM(7);
    if (IN(8)) { NEpiBf16 E{(bf16*)(ws + WS_QP), D};
                 ngemm_phase((const bf16*)(ws + WS_H), (const bf16*)(ws + WS_WQ), T, D, D, D, E, C); } SEAM(8);
    if (IN(9)) { phase_topk_naive(args, C); } SEAM(9);
    if (IN(10)) { phase_experts_naive(args, C); }
#undef IN
#undef SEAM
}

extern "C" void kernel_launch(void* const* d_in, const int* in_sizes, int n_in, void* d_out, int out_size, void* d_ws, size_t ws_size, hipStream_t stream) {
    static int grid = 0;
    if (grid == 0) {
        if (n_in != 21 || in_sizes[0] != T * D || out_size != T * D || ws_size < WS_END) {
            fprintf(stderr, "kernel_launch: unexpected shapes: n_in %d in0 %d out %d ws %zu (need %zu)\n", n_in, n_in > 0 ? in_sizes[0] : -1, out_size, ws_size, (size_t)WS_END); grid = -1; return; }
        int dev = 0, cus = 0, per_cu = 0;
        if (hipGetDevice(&dev) != hipSuccess || hipDeviceGetAttribute(&cus, hipDeviceAttributeMultiprocessorCount, dev) != hipSuccess) { grid = -1; return; }
        if (hipFuncSetAttribute((const void*)mk_fwd, hipFuncAttributeMaxDynamicSharedMemorySize, LDS_BYTES) != hipSuccess) { fprintf(stderr, "kernel_launch: hipFuncSetAttribute failed\n"); grid = -1; return; }
        if (hipOccupancyMaxActiveBlocksPerMultiprocessor(&per_cu, (const void*)mk_fwd, NTHREADS, LDS_BYTES) != hipSuccess || per_cu < 1)
            fprintf(stderr, "kernel_launch: note: occupancy query reports %d\n", per_cu);
        (void)hipGetLastError();
        grid = cus;
    }
    if (grid < 0) return;
    (void)hipMemsetAsync((char*)d_ws + WS_CTL, 0, CTL_ZERO_BYTES, stream);
    Args a{};
    for (int i = 0; i < 21; ++i) a.in[i] = (const float*)d_in[i];
    a.out = (float*)d_out; a.ws = (unsigned char*)d_ws;
#if N_LAUNCH_MODE == 1
    a.ph_lo = 0; a.ph_hi = NPHASES;
    hipLaunchKernelGGL(mk_fwd, dim3(grid), dim3(NTHREADS), LDS_BYTES, stream, a);
#else
    for (int p = 0; p < NPHASES; ++p) { a.ph_lo = p; a.ph_hi = p + 1; hipLaunchKernelGGL(mk_fwd, dim3(grid), dim3(NTHREADS), LDS_BYTES, stream, a); }
#endif
}
```

```cpp
#include <hip/hip_runtime.h>
#include <cstdio>
#include <cstdint>
#include <cmath>

constexpr int BATCH = 2, SEQ = 4096, D = 2048, T = BATCH * SEQ;
constexpr int CONV_CH = 1024, CONV_K = 31;
constexpr int HD = 128, NHEADS = 12, AW = 1536, AOW = 512;
constexpr int OFF_Q = 2048, OFF_G = OFF_Q + 3 * AW, IN_COLS = OFF_G + 2 * D;
constexpr int QKVW = 3 * AW;
constexpr int PEER_H = 8, PEER_NK = 128, PEER_TOPK = 16, PEER_HK = PEER_H * PEER_TOPK;
constexpr int PEER_E = PEER_NK * PEER_NK;
constexpr int MODW = 6 * D;
constexpr float EPS = 1e-6f;
constexpr int NWAVES = 8, NTHREADS = NWAVES * 64;
#ifndef N_LAUNCH_MODE
#define N_LAUNCH_MODE 1
#endif
constexpr int NPHASES = 11;
#ifndef PROBE_EMASK
#define PROBE_EMASK 0xFFFFFFFFu
#endif
#ifndef PROBE_DUP
#define PROBE_DUP (-1)
#endif
#ifndef MFMA_MASK
#define MFMA_MASK 31
#endif
#ifndef P2_SPLIT
#define P2_SPLIT 0
#endif

constexpr size_t MiB = 1u << 20;
constexpr size_t WS_CTL = 0, CTL_ZERO_BYTES = 1 * MiB;
constexpr size_t WS_MOD = 1 * MiB;
constexpr size_t WS_SK = 1 * MiB + 512 * 1024;
constexpr size_t WS_WIN = 2 * MiB;
constexpr size_t WS_WCO = 44 * MiB;
constexpr size_t WS_WAO = 48 * MiB;
constexpr size_t WS_WOUT = 50 * MiB;
constexpr size_t WS_WQ = 58 * MiB;
constexpr size_t WS_WUP = 66 * MiB;
constexpr size_t WS_WDN = 130 * MiB;
constexpr size_t WS_SUP = 98 * MiB, WS_SDN = 98 * MiB + 65536;
constexpr size_t WS_H = 194 * MiB;
constexpr size_t WS_U = 226 * MiB;
constexpr size_t WS_QKV = 242 * MiB;
constexpr size_t WS_G = 314 * MiB;
constexpr size_t WS_UCV = 378 * MiB;
constexpr size_t WS_ON = 394 * MiB;
constexpr size_t WS_DEN = 418 * MiB;
constexpr size_t WS_O = 419 * MiB;
constexpr size_t WS_MERGED = 427 * MiB;
constexpr size_t WS_QP = 459 * MiB;
constexpr size_t WS_IDX = 491 * MiB;
constexpr size_t WS_GW = 495 * MiB;
constexpr size_t WS_END = 500 * MiB;
constexpr int CW_BAR = 4096;
constexpr int TK_W = 4;
constexpr int UP_TAIL_ROWS = 4096;
constexpr float MG_SCALE = 16.0f;
constexpr float WIN_SCALE = 256.0f;

constexpr int LDS_BYTES = 147456 + 512;
constexpr int RING_BYTES = 131072, MISC_OFF = 147456 + 64;

#define GAS __attribute__((address_space(1)))
#define LAS __attribute__((address_space(3)))
typedef unsigned short bf16;
typedef unsigned v4u __attribute__((ext_vector_type(4)));
typedef unsigned v2u __attribute__((ext_vector_type(2)));
typedef float f32x4 __attribute__((ext_vector_type(4)));
#define RLX_AGENT __ATOMIC_RELAXED, __HIP_MEMORY_SCOPE_AGENT

__device__ __forceinline__ unsigned f2bf(float f) { unsigned u = __builtin_bit_cast(unsigned, f); return (u + 0x7fffu + ((u >> 16) & 1u)) >> 16; }
__device__ __forceinline__ unsigned pk2(float lo, float hi) { return f2bf(lo) | (f2bf(hi) << 16); }
__device__ __forceinline__ float bf2f(unsigned b) { return __builtin_bit_cast(float, b << 16); }
__device__ __forceinline__ float bflo(unsigned w) { return __builtin_bit_cast(float, w << 16); }
__device__ __forceinline__ float bfhi(unsigned w) { return __builtin_bit_cast(float, w & 0xffff0000u); }
__device__ __forceinline__ float wave_sum(float v) {
#pragma unroll
    for (int o = 1; o < 64; o <<= 1) v += __shfl_xor(v, o);
    return v;
}
__device__ __forceinline__ float sigmoidf_(float x) { return 1.0f / (1.0f + __expf(-x)); }
__device__ __forceinline__ float siluf_(float x) { return x / (1.0f + __expf(-x)); }
__device__ __forceinline__ float gelu_erf(float x) { return 0.5f * x * (1.0f + erff(x * 0.70710678118654752f)); }

__device__ __forceinline__ int lane_id() { return (int)__builtin_amdgcn_mbcnt_hi(~0u, __builtin_amdgcn_mbcnt_lo(~0u, 0u)); }
#define XB_TMO      128
#define XB_XCNT(j)  (256  + 64 * (j))
#define XB_XSUB(j)  (1280 + 64 * (j))
#define XB_XGEN(j)  (2304 + 64 * (j))
#define XB_TOP      3328
#define XB_TOPGEN   3392
#define XCD_BAR_WORDS 3456
#define XB_SPIN_CAP (1u << 22)
__device__ __forceinline__ unsigned xb_ld(unsigned* p)              { return __hip_atomic_load(p, __ATOMIC_RELAXED, __HIP_MEMORY_SCOPE_AGENT); }
__device__ __forceinline__ unsigned xb_add(unsigned* p, unsigned v) { return __hip_atomic_fetch_add(p, v, __ATOMIC_RELAXED, __HIP_MEMORY_SCOPE_AGENT); }
__device__ __forceinline__ unsigned xb_xcc_id() { return (unsigned)__builtin_amdgcn_s_getreg((3 << 11) | 20) & 0xFu; }
#define XB_SPIN(cond, bar) do { unsigned _sp = 0; while (cond) { __builtin_amdgcn_s_sleep(1); \
    if ((++_sp & 255u) == 0u) { if (xb_ld(&(bar)[XB_TMO])) break; if (_sp > XB_SPIN_CAP) { atomicAdd(&(bar)[XB_TMO], 1u); break; } } } } while (0)
struct XcdBarrier { unsigned* bar; unsigned x; volatile LAS unsigned* st; int wave; };
__device__ __forceinline__ XcdBarrier xcd_barrier_post(unsigned* bar, volatile LAS unsigned* st) {
    XcdBarrier b; b.bar = bar; b.x = xb_xcc_id(); b.st = st; b.wave = 0;
    if (threadIdx.x == 0) (void)xb_add(&bar[XB_XCNT(b.x)], 1u);
    return b;
}
__device__ __forceinline__ void xcd_barrier_complete(unsigned* bar, unsigned x, unsigned& nloc, unsigned& nx) {
    const unsigned G = gridDim.x * gridDim.y * gridDim.z;
    unsigned sum, cnt, mine, sp = 0u;
    for (;;) {
        sum = 0u; cnt = 0u; mine = 0u;
#pragma unroll
        for (unsigned j = 0; j < 16; ++j) { const unsigned c = xb_ld(&bar[XB_XCNT(j)]); sum += c; cnt += (c > 0u) ? 1u : 0u; mine = (j == x) ? c : mine; }
        if (sum == G) break;
        __builtin_amdgcn_s_sleep(1);
        if ((++sp & 255u) == 0u) { if (xb_ld(&bar[XB_TMO])) break; if (sp > XB_SPIN_CAP) { atomicAdd(&bar[XB_TMO], 1u); break; } }
    }
    nloc = mine > 0u ? mine : 1u; nx = cnt > 0u ? cnt : 1u;
}
__device__ __forceinline__ void xcd_barrier(const XcdBarrier& b) {
    asm volatile("s_waitcnt vmcnt(0)" ::: "memory");
    __syncthreads();
    if (b.wave == 0 && lane_id() == 0) {
        unsigned* bar = b.bar;
        __builtin_amdgcn_s_waitcnt(0);
        unsigned nloc = b.st[0], nx = b.st[1];
        if (nloc == 0u) { xcd_barrier_complete(bar, b.x, nloc, nx); b.st[0] = nloc; b.st[1] = nx; }
        const unsigned old = xb_add(&bar[XB_XSUB(b.x)], 1u);
        const unsigned gen = old / nloc;
        if (old + 1u == (gen + 1u) * nloc) {
            __builtin_amdgcn_fence(__ATOMIC_RELEASE, "agent");
            asm volatile("s_waitcnt vmcnt(0)" ::: "memory");
            const unsigned og = xb_add(&bar[XB_TOP], 1u);
            const unsigned tg = og / nx;
            if (og + 1u == (tg + 1u) * nx) xb_add(&bar[XB_TOPGEN], 1u);
            else XB_SPIN(xb_ld(&bar[XB_TOPGEN]) == tg, bar);
            __builtin_amdgcn_fence(__ATOMIC_ACQUIRE, "agent");
            xb_add(&bar[XB_XGEN(b.x)], 1u);
            asm volatile("s_waitcnt vmcnt(0)" ::: "memory");
        } else {
            XB_SPIN(xb_ld(&bar[XB_XGEN(b.x)]) == gen, bar);
            __builtin_amdgcn_fence(__ATOMIC_ACQUIRE, "agent");
            asm volatile("s_waitcnt vmcnt(0)" ::: "memory");
        }
    }
    __syncthreads();
}

namespace pg8 {
#define PG8_LAS __attribute__((address_space(3)))
typedef unsigned short bf16_t;
typedef short bf16x8 __attribute__((ext_vector_type(8)));
typedef float f32x4 __attribute__((ext_vector_type(4)));
typedef unsigned u32x4 __attribute__((ext_vector_type(4)));
constexpr int BM = 256, BK = 64, HALF = 128, HTB = HALF * BK * 2  , STAGE_BYTES = 8 * HTB, NXCD = 8, WGM = 16;

__host__ __device__ __forceinline__ int lds_byte(int r, int c) { const int st = (r >> 4) * 2 + (c >> 5), rr = r & 15, cc = c & 31, ob = rr * 64 + cc * 2; return st * 1024 + (ob ^ (((ob >> 9) & 1) << 5)); }
__host__ __device__ __forceinline__ void stage_rc(int b, int& R, int& C) { const int st = b / 1024, sb = b % 1024, swz = sb ^ (((sb >> 9) & 1) << 5); R = (st >> 1) * 16 + swz / 64; C = (st & 1) * 32 + (swz % 64) / 2; }
__host__ __device__ __forceinline__ int perm32(int rho) { const int n = rho >> 4, i = rho & 15; return 8 * (i >> 2) + 4 * n + (i & 3); }

struct Unit { int pm, pn; };
struct Gemm { const bf16_t* A; const bf16_t* Bt; int M, N, K; };

struct StaticOrder {
    int nM, nN, nwg, G, c;
    __host__ __device__ void init(int M, int N, int G_, int c_) { nM = M / BM; nN = N / BM; nwg = nM * nN; G = G_; c = c_; }
    __host__ __device__ bool next(int i, Unit& u) const {
        const long L = (long)i * G + c; if (L >= nwg) return false;
        int wgid = (int)L; { const int q = nwg / NXCD, r = nwg % NXCD, xcd = wgid % NXCD, off = wgid / NXCD; wgid = (xcd < r ? xcd * (q + 1) : r * (q + 1) + (xcd - r) * q) + off; }
        const int nig = WGM * nN, gid = wgid / nig, fm = gid * WGM, gsz = (nM - fm) < WGM ? (nM - fm) : WGM;
        u.pm = fm + ((wgid % nig) % gsz); u.pn = (wgid % nig) / gsz; return true;
    }
    __device__ __forceinline__ void a_ready(const Unit&) const {}
    __device__ __forceinline__ void done(const Unit&) const {}
};

typedef float f32x2_t __attribute__((ext_vector_type(2))); typedef __bf16 bf16x2_t __attribute__((ext_vector_type(2)));
__device__ __forceinline__ unsigned cvt_pk_bf16(float lo, float hi) { f32x2_t v = {lo, hi}; bf16x2_t b = __builtin_convertvector(v, bf16x2_t); return __builtin_bit_cast(unsigned, b); }
typedef float f32x2 __attribute__((ext_vector_type(2)));
typedef int v8i_t __attribute__((ext_vector_type(8)));
struct Frag32 { bf16x8 lo, hi; };
template <class Epi, class Sched, bool ALIGN_EPI = false, bool SP2 = false, bool FP8 = false>
__device__ __forceinline__ void gemm_phase(PG8_LAS unsigned char* lds, const Gemm g, const Sched& S, const Epi& E, int wave_idx) {
    const int wid = wave_idx, lane = lane_id(), tid = wid * 64 + lane, wr = wid >> 2, wc = wid & 3, fr = lane & 15, fq = lane >> 4;
    const int K = g.K, nt = K / BK;
    unsigned voffA[2], voffB[2];
#pragma unroll
    for (int i = 0; i < 2; ++i) { int R, C; stage_rc(tid * 16 + i * 8192, R, C); const int Rb = Epi::PERM ? ((R & ~31) + perm32(R & 31)) : R;
        voffA[i] = (unsigned)(R * K + C) * 2u; voffB[i] = (unsigned)(Rb * K + C) * 2u; }
    const size_t kstep = (size_t)(BK * 2);
    const size_t hstep = (size_t)HALF * K * 2;
    const size_t tstep = 2 * hstep;
    const unsigned ldsw = (unsigned)wid * 1024u;
    const int aoff = lds_byte(wr * 64 + fr, fq * 8), boff = lds_byte(wc * 32 + fr, fq * 8);
#define PG8_SA(b, h) (((b) * 2 + (h)) * HTB)
#define PG8_SB(b, h) ((4 + (b) * 2 + (h)) * HTB)
#define PG8_STAGE(bufoff, gbase, voff) do { _Pragma("unroll") for (int _i = 0; _i < 2; ++_i) { unsigned vo_ = (voff)[_i]; asm volatile("" : "+v"(vo_));     \
        __builtin_amdgcn_global_load_lds((const unsigned*)((const char*)(gbase) + vo_), (PG8_LAS unsigned*)(lds + (bufoff) + ldsw + _i * 8192), 16, 0, 0); } } while (0)
#define PG8_LDA(dst, b, h) do { _Pragma("unroll") for (int m = 0; m < 4; ++m) { const bf16x8 lo_ = *(const PG8_LAS bf16x8*)(lds + PG8_SA(b, h) + aoff + m * 2048), hi_ = *(const PG8_LAS bf16x8*)(lds + PG8_SA(b, h) + aoff + m * 2048 + 1024); dst[m] = __builtin_bit_cast(v8i_t, (Frag32){lo_, hi_}); } } while (0)
#define PG8_LDB(dst, b, h) do { _Pragma("unroll") for (int n = 0; n < 2; ++n) { const bf16x8 lo_ = *(const PG8_LAS bf16x8*)(lds + PG8_SB(b, h) + boff + n * 2048), hi_ = *(const PG8_LAS bf16x8*)(lds + PG8_SB(b, h) + boff + n * 2048 + 1024); dst[n] = __builtin_bit_cast(v8i_t, (Frag32){lo_, hi_}); } } while (0)
#define PG8_MMA(ai, bj, At, Bt) do { __builtin_amdgcn_s_setprio(1); \
        if constexpr (FP8) { _Pragma("unroll") for (int m = 0; m < 4; ++m) _Pragma("unroll") for (int n = 0; n < 2; ++n) \
            acc[ai][bj][m][n] = __builtin_amdgcn_mfma_scale_f32_16x16x128_f8f6f4(Bt[n], At[m], acc[ai][bj][m][n], 0, 0, 0, 0x7F7F7F7F, 0, 0x7F7F7F7F); } \
        else { _Pragma("unroll") for (int m = 0; m < 4; ++m) _Pragma("unroll") for (int n = 0; n < 2; ++n) { const Frag32 fa_ = __builtin_bit_cast(Frag32, At[m]), fb_ = __builtin_bit_cast(Frag32, Bt[n]); \
            acc[ai][bj][m][n] = __builtin_amdgcn_mfma_f32_16x16x32_bf16(fb_.lo, fa_.lo, acc[ai][bj][m][n], 0, 0, 0); acc[ai][bj][m][n] = __builtin_amdgcn_mfma_f32_16x16x32_bf16(fb_.hi, fa_.hi, acc[ai][bj][m][n], 0, 0, 0); } } \
        __builtin_amdgcn_s_setprio(0); } while (0)
#define PG8_WAIT_V(n) asm volatile("s_waitcnt vmcnt(" #n ")" ::: "memory")
#define PG8_WAIT_L(n) asm volatile("s_waitcnt lgkmcnt(" #n ")" ::: "memory")
#define PG8_BAR __builtin_amdgcn_s_barrier()
#define PG8_SCHED __builtin_amdgcn_sched_barrier(0)
    Unit cur, nxt; int ui = 0;
    if (!S.next(0, cur)) return;
    f32x4 acc[2][2][4][2];
#pragma unroll
    for (int a = 0; a < 2; ++a)
#pragma unroll
        for (int b = 0; b < 2; ++b)
#pragma unroll
            for (int m = 0; m < 4; ++m)
#pragma unroll
                for (int n = 0; n < 2; ++n) acc[a][b][m][n] = (f32x4){0.f, 0.f, 0.f, 0.f};
    v8i_t At[4], B0[2], B1[2];
    const char* cA = (const char*)g.A + (size_t)cur.pm * tstep; const char* cB = (const char*)g.Bt + (size_t)cur.pn * tstep;
    S.a_ready(cur);
    if constexpr (SP2) {
        PG8_STAGE(PG8_SB(0, 0), cB, voffB); PG8_STAGE(PG8_SB(0, 1), cB + hstep, voffB); PG8_STAGE(PG8_SA(0, 0), cA, voffA); PG8_STAGE(PG8_SA(0, 1), cA + hstep, voffA);
        if (wr == 1) PG8_BAR;
        PG8_WAIT_V(2); PG8_BAR;
        PG8_STAGE(PG8_SB(1, 0), cB + kstep, voffB); PG8_STAGE(PG8_SA(1, 0), cA + kstep, voffA); PG8_STAGE(PG8_SB(1, 1), cB + hstep + kstep, voffB);
        PG8_WAIT_V(6); PG8_BAR;
    } else {
        PG8_STAGE(PG8_SB(0, 0), cB, voffB); PG8_STAGE(PG8_SA(0, 0), cA, voffA); PG8_STAGE(PG8_SB(0, 1), cB + hstep, voffB); PG8_STAGE(PG8_SA(0, 1), cA + hstep, voffA);
        if (wr == 1) PG8_BAR;
        PG8_WAIT_V(4); PG8_BAR;
        PG8_STAGE(PG8_SB(1, 0), cB + kstep, voffB); PG8_STAGE(PG8_SA(1, 0), cA + kstep, voffA); PG8_STAGE(PG8_SB(1, 1), cB + hstep + kstep, voffB);
        PG8_WAIT_V(6); PG8_BAR;
    }
    for (;;) {
        const bool has_next = S.next(ui + 1, nxt);
        const char* nA = has_next ? (const char*)g.A + (size_t)nxt.pm * tstep : cA; const char* nB = has_next ? (const char*)g.Bt + (size_t)nxt.pn * tstep : cB;
        for (int t = 0; t < nt; t += 2) {
            const bool last = (t == nt - 2);
            const char* a1 = cA + (size_t)(t + 1) * kstep;
            const char* a2 = last ? nA : cA + (size_t)(t + 2) * kstep; const char* b2 = last ? nB : cB + (size_t)(t + 2) * kstep;
            const char* a3 = a2 + kstep; const char* b3 = b2 + kstep;
            if (last && has_next) S.a_ready(nxt);
            if constexpr (SP2) {
            PG8_LDB(B0, 0, 0); PG8_LDB(B1, 0, 1); PG8_SCHED; PG8_LDA(At, 0, 0); PG8_STAGE(PG8_SA(1, 1), a1 + hstep, voffA);
            PG8_WAIT_V(8); PG8_WAIT_L(0); PG8_BAR; PG8_MMA(0, 0, At, B0); PG8_MMA(0, 1, At, B1); PG8_BAR; PG8_SCHED;
            PG8_LDA(At, 0, 1); PG8_STAGE(PG8_SB(0, 0), b2, voffB); PG8_STAGE(PG8_SB(0, 1), b2 + hstep, voffB); PG8_STAGE(PG8_SA(0, 0), a2, voffA);
            PG8_WAIT_V(8); PG8_WAIT_L(0); PG8_BAR; PG8_MMA(1, 0, At, B0); PG8_MMA(1, 1, At, B1); PG8_BAR; PG8_SCHED;
            PG8_LDB(B0, 1, 0); PG8_LDB(B1, 1, 1); PG8_SCHED; PG8_LDA(At, 1, 0); PG8_STAGE(PG8_SA(0, 1), a2 + hstep, voffA);
            PG8_WAIT_V(8); PG8_WAIT_L(0); PG8_BAR; PG8_MMA(0, 0, At, B0); PG8_MMA(0, 1, At, B1); PG8_BAR; PG8_SCHED;
            PG8_LDA(At, 1, 1); PG8_STAGE(PG8_SB(1, 0), b3, voffB); PG8_STAGE(PG8_SB(1, 1), b3 + hstep, voffB); PG8_STAGE(PG8_SA(1, 0), a3, voffA);
            PG8_WAIT_V(8); PG8_WAIT_L(0); PG8_BAR; PG8_MMA(1, 0, At, B0); PG8_MMA(1, 1, At, B1); PG8_BAR; PG8_SCHED;
            } else {
            PG8_LDB(B0, 0, 0); PG8_SCHED; PG8_LDA(At, 0, 0); PG8_STAGE(PG8_SA(1, 1), a1 + hstep, voffA);
            PG8_WAIT_L(8); PG8_BAR; PG8_WAIT_L(0); PG8_MMA(0, 0, At, B0); PG8_BAR; PG8_SCHED;
            PG8_LDB(B1, 0, 1); PG8_STAGE(PG8_SB(0, 0), b2, voffB);
            PG8_BAR; PG8_WAIT_L(0); PG8_MMA(0, 1, At, B1); PG8_BAR;
            PG8_LDA(At, 0, 1); PG8_STAGE(PG8_SA(0, 0), a2, voffA);
            PG8_BAR; PG8_WAIT_L(0); PG8_MMA(1, 0, At, B0); PG8_BAR; PG8_SCHED;
            PG8_STAGE(PG8_SB(0, 1), b2 + hstep, voffB);
            PG8_WAIT_V(6); PG8_BAR; PG8_MMA(1, 1, At, B1); PG8_BAR;
            PG8_LDB(B0, 1, 0); PG8_SCHED; PG8_LDA(At, 1, 0); PG8_STAGE(PG8_SA(0, 1), a2 + hstep, voffA);
            PG8_WAIT_L(8); PG8_BAR; PG8_WAIT_L(0); PG8_MMA(0, 0, At, B0); PG8_BAR; PG8_SCHED;
            PG8_LDB(B1, 1, 1); PG8_STAGE(PG8_SB(1, 0), b3, voffB);
            PG8_BAR; PG8_WAIT_L(0); PG8_MMA(0, 1, At, B1); PG8_BAR;
            PG8_LDA(At, 1, 1); PG8_STAGE(PG8_SA(1, 0), a3, voffA);
            PG8_BAR; PG8_WAIT_L(0); PG8_MMA(1, 0, At, B0); PG8_BAR; PG8_SCHED;
            PG8_STAGE(PG8_SB(1, 1), b3 + hstep, voffB);
            PG8_WAIT_V(6); PG8_BAR; PG8_MMA(1, 1, At, B1); PG8_BAR;
            }
        }
        if constexpr (ALIGN_EPI) { if (wr == 0) PG8_BAR; }
        if constexpr (!Epi::AFTER_DRAIN) { E(acc, cur, wr, wc, fr, fq); S.done(cur); }
        if (!has_next) break;
#pragma unroll
        for (int a = 0; a < 2; ++a)
#pragma unroll
            for (int b = 0; b < 2; ++b)
#pragma unroll
                for (int m = 0; m < 4; ++m)
#pragma unroll
                    for (int n = 0; n < 2; ++n) acc[a][b][m][n] = (f32x4){0.f, 0.f, 0.f, 0.f};
        cur = nxt; cA = nA; cB = nB; ++ui;
        if constexpr (ALIGN_EPI) { if (wr == 1) PG8_BAR; }
    }
    PG8_WAIT_V(0);
    if constexpr (!ALIGN_EPI) { if (wr == 0) PG8_BAR; }
    PG8_BAR;
    if constexpr (Epi::AFTER_DRAIN) { E.fused(acc, cur, wr, wc, fr, fq, lds, wid, lane); S.done(cur); }
#undef PG8_SA
#undef PG8_SB
#undef PG8_STAGE
#undef PG8_LDA
#undef PG8_LDB
#undef PG8_MMA
#undef PG8_WAIT_V
#undef PG8_WAIT_L
#undef PG8_BAR
#undef PG8_SCHED
}
}

namespace pg8 {
__device__ __forceinline__ float fsig(float x) { return __builtin_amdgcn_rcpf(1.0f + __expf(-x)); }
__device__ __forceinline__ u32x4 pack8(const f32x4& v0, const f32x4& v1) { u32x4 w; w.x = cvt_pk_bf16(v0[0], v0[1]); w.y = cvt_pk_bf16(v0[2], v0[3]); w.z = cvt_pk_bf16(v1[0], v1[1]); w.w = cvt_pk_bf16(v1[2], v1[3]); return w; }
__device__ __forceinline__ float blo(unsigned w) { return __builtin_bit_cast(float, w << 16); }
__device__ __forceinline__ float bhi(unsigned w) { return __builtin_bit_cast(float, w & 0xffff0000u); }
struct EpiIn {
    static constexpr bool PERM = true, AFTER_DRAIN = false;
    bf16_t *U, *QKV, *G; int pn0; float osc;
    __device__ __forceinline__ void operator()(const f32x4 (&acc)[2][2][4][2], const Unit& u0, int wr, int wc, int fr, int fq) const {
        Unit u; u.pm = u0.pm; u.pn = u0.pn + pn0;
        const int row0 = u.pm * BM + wr * 64 + fr, cw = wc * 32 + 8 * fq;
        if (u.pn < 8) {
#pragma unroll
            for (int ai = 0; ai < 2; ++ai)
#pragma unroll
                for (int m = 0; m < 4; ++m) { const size_t row = row0 + ai * HALF + m * 16;
                    f32x4 v0 = acc[ai][0][m][0] * osc, v1 = acc[ai][0][m][1] * osc; const f32x4 g0 = acc[ai][1][m][0] * osc, g1 = acc[ai][1][m][1] * osc;
#pragma unroll
                    for (int e = 0; e < 4; ++e) { v0[e] *= fsig(g0[e]); v1[e] *= fsig(g1[e]); }
                    *(u32x4*)(U + row * 1024 + 128 * u.pn + cw) = pack8(v0, v1); }
        } else if (u.pn < 26) {
#pragma unroll
            for (int ai = 0; ai < 2; ++ai)
#pragma unroll
                for (int m = 0; m < 4; ++m) { const size_t row = row0 + ai * HALF + m * 16;
#pragma unroll
                    for (int bj = 0; bj < 2; ++bj) *(u32x4*)(QKV + row * 4608 + (u.pn - 8) * 256 + bj * HALF + cw) = pack8(acc[ai][bj][m][0] * osc, acc[ai][bj][m][1] * osc); }
        } else {
#pragma unroll
            for (int ai = 0; ai < 2; ++ai)
#pragma unroll
                for (int m = 0; m < 4; ++m) { const size_t row = row0 + ai * HALF + m * 16;
#pragma unroll
                    for (int bj = 0; bj < 2; ++bj) { f32x4 v0 = acc[ai][bj][m][0] * osc, v1 = acc[ai][bj][m][1] * osc;
#pragma unroll
                        for (int e = 0; e < 4; ++e) { v0[e] = fsig(v0[e]); v1[e] = fsig(v1[e]); }
                        *(u32x4*)(G + row * 4096 + (u.pn - 26) * 256 + bj * HALF + cw) = pack8(v0, v1); } }
        }
    }
};
struct EpiYconv {
    static constexpr bool PERM = true, AFTER_DRAIN = false;
    const bf16_t* G; bf16_t* MG; const float* bias;
    __device__ __forceinline__ void operator()(const f32x4 (&acc)[2][2][4][2], const Unit& u, int wr, int wc, int fr, int fq) const {
        const int row0 = u.pm * BM + wr * 64 + fr, cw = wc * 32 + 8 * fq;
#pragma unroll
        for (int bj = 0; bj < 2; ++bj) { const int col = u.pn * 256 + bj * HALF + cw; const f32x4 b0 = *(const f32x4*)(bias + col), b1 = *(const f32x4*)(bias + col + 4);
#pragma unroll
            for (int ai = 0; ai < 2; ++ai)
#pragma unroll
                for (int m = 0; m < 4; ++m) { const size_t row = row0 + ai * HALF + m * 16;
                    const u32x4 g = *(const u32x4*)(G + row * 4096 + col);
                    f32x4 v0 = acc[ai][bj][m][0] + b0, v1 = acc[ai][bj][m][1] + b1;
                    v0[0] *= blo(g.x); v0[1] *= bhi(g.x); v0[2] *= blo(g.y); v0[3] *= bhi(g.y); v1[0] *= blo(g.z); v1[1] *= bhi(g.z); v1[2] *= blo(g.w); v1[3] *= bhi(g.w);
                    *(u32x4*)(MG + row * 2048 + col) = pack8(v0, v1); } }
    }
};
struct EpiYattn {
    static constexpr bool PERM = true, AFTER_DRAIN = false;
    const bf16_t* G; const bf16_t* MG; unsigned char* MG8; float msc;
    __device__ __forceinline__ void operator()(const f32x4 (&acc)[2][2][4][2], const Unit& u, int wr, int wc, int fr, int fq) const {
        const int row0 = u.pm * BM + wr * 64 + fr, cw = wc * 32 + 8 * fq;
#pragma unroll
        for (int ai = 0; ai < 2; ++ai)
#pragma unroll
            for (int m = 0; m < 4; ++m) { const size_t row = row0 + ai * HALF + m * 16;
#pragma unroll
                for (int bj = 0; bj < 2; ++bj) { const int col = u.pn * 256 + bj * HALF + cw; const u32x4 g = *(const u32x4*)(G + row * 4096 + 2048 + col); const u32x4 p = *(const u32x4*)(MG + row * 2048 + col);
                    f32x4 v0 = acc[ai][bj][m][0], v1 = acc[ai][bj][m][1];
                    v0[0] = (blo(p.x) + v0[0] * blo(g.x)) * msc; v0[1] = (bhi(p.x) + v0[1] * bhi(g.x)) * msc; v0[2] = (blo(p.y) + v0[2] * blo(g.y)) * msc; v0[3] = (bhi(p.y) + v0[3] * bhi(g.y)) * msc;
                    v1[0] = (blo(p.z) + v1[0] * blo(g.z)) * msc; v1[1] = (bhi(p.z) + v1[1] * bhi(g.z)) * msc; v1[2] = (blo(p.w) + v1[2] * blo(g.w)) * msc; v1[3] = (bhi(p.w) + v1[3] * bhi(g.w)) * msc;
                    int p0 = __builtin_amdgcn_cvt_pk_fp8_f32(v0[0], v0[1], 0, false); p0 = __builtin_amdgcn_cvt_pk_fp8_f32(v0[2], v0[3], p0, true);
                    int p1 = __builtin_amdgcn_cvt_pk_fp8_f32(v1[0], v1[1], 0, false); p1 = __builtin_amdgcn_cvt_pk_fp8_f32(v1[2], v1[3], p1, true);
                    typedef unsigned u32x2_ __attribute__((ext_vector_type(2))); *(u32x2_*)(MG8 + row * 2048 + col) = (u32x2_){(unsigned)p0, (unsigned)p1}; } }
    }
};
struct EpiOut {
    static constexpr bool PERM = false, AFTER_DRAIN = false;
    const float* x; const float* mod; float* out; float osc;
    __device__ __forceinline__ void operator()(const f32x4 (&acc)[2][2][4][2], const Unit& u, int wr, int wc, int fr, int fq) const {
        const int row0 = u.pm * BM + wr * 64 + fr, col0 = u.pn * BM + wc * 32 + 4 * fq; const int b = (u.pm * BM) / 4096;
#pragma unroll
        for (int bj = 0; bj < 2; ++bj)
#pragma unroll
            for (int n = 0; n < 2; ++n) { const int col = col0 + bj * HALF + n * 16; const f32x4 gt = *(const f32x4*)(mod + b * 12288 + 2 * 2048 + col) * osc;
#pragma unroll
                for (int ai = 0; ai < 2; ++ai)
#pragma unroll
                    for (int m = 0; m < 4; ++m) { const size_t off = (size_t)(row0 + ai * HALF + m * 16) * 2048 + col;
                        *(f32x4*)(out + off) = *(const f32x4*)(x + off) + gt * acc[ai][bj][m][n]; } }
    }
};
struct EpiPlain {
    static constexpr bool PERM = true, AFTER_DRAIN = false;
    bf16_t* O; int ldc;
    __device__ __forceinline__ void operator()(const f32x4 (&acc)[2][2][4][2], const Unit& u, int wr, int wc, int fr, int fq) const {
        const int row0 = u.pm * BM + wr * 64 + fr, cw = u.pn * BM + wc * 32 + 8 * fq;
#pragma unroll
        for (int ai = 0; ai < 2; ++ai)
#pragma unroll
            for (int m = 0; m < 4; ++m) { const size_t row = row0 + ai * HALF + m * 16;
#pragma unroll
                for (int bj = 0; bj < 2; ++bj) *(u32x4*)(O + row * ldc + bj * HALF + cw) = pack8(acc[ai][bj][m][0], acc[ai][bj][m][1]); }
    }
};
}

struct Args { const float* in[21]; float* out; unsigned char* ws; int ph_lo, ph_hi; };
enum { I_X = 0, I_C, I_N1G, I_N2G, I_WADA, I_BADA, I_WIN, I_CDW, I_CDB, I_CLNG, I_CLNB, I_WCO, I_BCO, I_QNG, I_KNG, I_WAO, I_WOUT, I_PWQ, I_PSK, I_PWUP, I_PWDN };

struct Ctx {
    int tid, lane, wave, bid, nb, gw, ngw;
    unsigned char* lds;
};

__device__ __forceinline__ int win_row(int n) {
    if (n < 1024) return (n >> 7) * 256 + (n & 127);
    if (n < 2048) { const int m = n - 1024; return (m >> 7) * 256 + 128 + (m & 127); }
    return n;
}
__device__ __forceinline__ void p0_transpose_item(const float* W, int K, int N, bf16* WT, bool perm, float* scr, int item, int lane) {
    const int nblk = N / 32, kb = item / nblk, nbi = item % nblk, k0 = 64 * kb, n0 = 32 * nbi;
#pragma unroll 8
    for (int i = 0; i < 32; ++i) { const int kk = 2 * i + (lane >> 5); scr[kk * 33 + (lane & 31)] = W[(size_t)(k0 + kk) * N + n0 + (lane & 31)]; }
    asm volatile("s_waitcnt lgkmcnt(0)" ::: "memory");
    const int c = lane & 7;
    const int r0 = perm ? win_row(n0) : n0;
#pragma unroll
    for (int j = 0; j < 4; ++j) { const int n = (lane >> 3) + 8 * j; const float* s = scr + (8 * c) * 33 + n;
        v4u o; o.x = pk2(s[0 * 33], s[1 * 33]); o.y = pk2(s[2 * 33], s[3 * 33]); o.z = pk2(s[4 * 33], s[5 * 33]); o.w = pk2(s[6 * 33], s[7 * 33]);
        *(v4u*)(WT + (size_t)(r0 + n) * K + k0 + 8 * c) = o; }
    asm volatile("s_waitcnt lgkmcnt(0)" ::: "memory");
}

__device__ __forceinline__ void p0_transpose_item_fp8(const float* W, int K, int N, unsigned char* WT, bool perm, float* scr, int item, int lane, float wsc) {
    const int nblk = N / 32, kb = item / nblk, nbi = item % nblk, k0 = 64 * kb, n0 = 32 * nbi;
#pragma unroll 8
    for (int i = 0; i < 32; ++i) { const int kk = 2 * i + (lane >> 5); scr[kk * 33 + (lane & 31)] = W[(size_t)(k0 + kk) * N + n0 + (lane & 31)] * wsc; }
    asm volatile("s_waitcnt lgkmcnt(0)" ::: "memory");
    const int c = lane & 3;
    const int r0 = perm ? win_row(n0) : n0;
#pragma unroll
    for (int j = 0; j < 2; ++j) { const int n = (lane >> 2) + 16 * j; const float* s = scr + (16 * c) * 33 + n; v4u o; unsigned* op = (unsigned*)&o;
#pragma unroll
        for (int q = 0; q < 4; ++q) { int p = __builtin_amdgcn_cvt_pk_fp8_f32(s[(4 * q) * 33], s[(4 * q + 1) * 33], 0, false);
            p = __builtin_amdgcn_cvt_pk_fp8_f32(s[(4 * q + 2) * 33], s[(4 * q + 3) * 33], p, true); op[q] = (unsigned)p; }
        *(v4u*)(WT + (size_t)(r0 + n) * K + k0 + 16 * c) = o; }
    asm volatile("s_waitcnt lgkmcnt(0)" ::: "memory");
}
__device__ __forceinline__ void cvt_stream(const float* src, bf16* dst, size_t n, const Ctx& C) {
    const size_t nv = n / 8;
    for (size_t i = (size_t)C.gw * 64 + C.lane; i < nv; i += (size_t)C.ngw * 64) {
        const f32x4 a = *(const f32x4*)(src + i * 8), b = *(const f32x4*)(src + i * 8 + 4);
        v4u o; o.x = pk2(a.x, a.y); o.y = pk2(a.z, a.w); o.z = pk2(b.x, b.y); o.w = pk2(b.z, b.w);
        *(v4u*)(dst + i * 8) = o;
    }
}

typedef float f2v __attribute__((ext_vector_type(2)));
__device__ __forceinline__ void cvt_rows_fp8(const float* src, unsigned char* dst, float* inv, int rows, const Ctx& C) {
    for (int r = C.gw; r < rows; r += C.ngw) {
        const float* sp = src + (size_t)r * D + 16 * C.lane;
        f32x4 v[2][4]; float am = 0.f;
#pragma unroll
        for (int j = 0; j < 2; ++j)
#pragma unroll
            for (int q = 0; q < 4; ++q) { v[j][q] = *(const f32x4*)(sp + 1024 * j + 4 * q);
                am = fmaxf(am, fmaxf(fmaxf(fabsf(v[j][q].x), fabsf(v[j][q].y)), fmaxf(fabsf(v[j][q].z), fabsf(v[j][q].w)))); }
#pragma unroll
        for (int o = 1; o < 64; o <<= 1) am = fmaxf(am, __shfl_xor(am, o));
        const int ex = (int)((__builtin_bit_cast(unsigned, am) >> 23) & 255u);
        const float sc = (ex == 0) ? 1.0f : __builtin_bit_cast(float, (unsigned)(127 + 7 + 127 - ex) << 23);
        const float isc = (ex == 0) ? 1.0f : __builtin_bit_cast(float, (unsigned)(ex - 7) << 23);
#pragma unroll
        for (int j = 0; j < 2; ++j) { v4u o; unsigned* op = (unsigned*)&o;
#pragma unroll
            for (int q = 0; q < 4; ++q) { int p = __builtin_amdgcn_cvt_pk_fp8_f32(v[j][q].x * sc, v[j][q].y * sc, 0, false);
                p = __builtin_amdgcn_cvt_pk_fp8_f32(v[j][q].z * sc, v[j][q].w * sc, p, true); op[q] = (unsigned)p; }
            *(v4u*)(dst + (size_t)r * D + 16 * C.lane + 1024 * j) = o; }
        if (C.lane == 0) inv[r] = isc;
    }
}

__device__ __forceinline__ unsigned pack_i8x4(float a, float b, float c, float d) {
    const int ia = (int)rintf(a), ib = (int)rintf(b), ic = (int)rintf(c), id = (int)rintf(d);
    return ((unsigned)ia & 255u) | (((unsigned)ib & 255u) << 8) | (((unsigned)ic & 255u) << 16) | ((unsigned)id << 24);
}
__device__ __forceinline__ void cvt_rows_i8(const float* src, unsigned char* dst, float* inv, int rows, const Ctx& C) {
    for (int r = C.gw; r < rows; r += C.ngw) {
        const float* sp = src + (size_t)r * D + 16 * C.lane;
        f32x4 v[2][4]; float am = 0.f;
#pragma unroll
        for (int j = 0; j < 2; ++j)
#pragma unroll
            for (int q = 0; q < 4; ++q) { v[j][q] = *(const f32x4*)(sp + 1024 * j + 4 * q);
                am = fmaxf(am, fmaxf(fmaxf(fabsf(v[j][q].x), fabsf(v[j][q].y)), fmaxf(fabsf(v[j][q].z), fabsf(v[j][q].w)))); }
#pragma unroll
        for (int o = 1; o < 64; o <<= 1) am = fmaxf(am, __shfl_xor(am, o));
        const float sc = (am > 0.f) ? 127.0f / am : 0.f;
#pragma unroll
        for (int j = 0; j < 2; ++j) { v4u o;
            o.x = pack_i8x4(v[j][0].x * sc, v[j][0].y * sc, v[j][0].z * sc, v[j][0].w * sc); o.y = pack_i8x4(v[j][1].x * sc, v[j][1].y * sc, v[j][1].z * sc, v[j][1].w * sc);
            o.z = pack_i8x4(v[j][2].x * sc, v[j][2].y * sc, v[j][2].z * sc, v[j][2].w * sc); o.w = pack_i8x4(v[j][3].x * sc, v[j][3].y * sc, v[j][3].z * sc, v[j][3].w * sc);
            *(v4u*)(dst + (size_t)r * D + 16 * C.lane + 1024 * j) = o; }
        if (C.lane == 0) inv[r] = am * (1.0f / 127.0f);
    }
}

struct RowCvt { f32x4 v[2][4]; };
__device__ __forceinline__ void rc_issue(RowCvt& rc, const float* src, int row, int lane) {
    const float* sp = src + (size_t)row * D + 16 * lane;
#pragma unroll
    for (int j = 0; j < 2; ++j)
#pragma unroll
        for (int q = 0; q < 4; ++q) rc.v[j][q] = *(const f32x4*)(sp + 1024 * j + 4 * q);
}
__device__ __forceinline__ float rc_amax(const RowCvt& rc) {
    float am = 0.f;
#pragma unroll
    for (int j = 0; j < 2; ++j)
#pragma unroll
        for (int q = 0; q < 4; ++q) am = fmaxf(am, fmaxf(fmaxf(fabsf(rc.v[j][q].x), fabsf(rc.v[j][q].y)), fmaxf(fabsf(rc.v[j][q].z), fabsf(rc.v[j][q].w))));
#pragma unroll
    for (int o = 1; o < 64; o <<= 1) am = fmaxf(am, __shfl_xor(am, o));
    return am;
}
__device__ __forceinline__ void rc_finish_fp8(const RowCvt& rc, unsigned char* dst, float* inv, int row, int lane) {
    const float am = rc_amax(rc);
    const int ex = (int)((__builtin_bit_cast(unsigned, am) >> 23) & 255u);
    const float sc = (ex == 0) ? 1.0f : __builtin_bit_cast(float, (unsigned)(127 + 7 + 127 - ex) << 23);
    const float isc = (ex == 0) ? 1.0f : __builtin_bit_cast(float, (unsigned)(ex - 7) << 23);
#pragma unroll
    for (int j = 0; j < 2; ++j) { v4u o; unsigned* op = (unsigned*)&o;
#pragma unroll
        for (int q = 0; q < 4; ++q) { int p = __builtin_amdgcn_cvt_pk_fp8_f32(rc.v[j][q].x * sc, rc.v[j][q].y * sc, 0, false);
            p = __builtin_amdgcn_cvt_pk_fp8_f32(rc.v[j][q].z * sc, rc.v[j][q].w * sc, p, true); op[q] = (unsigned)p; }
        *(v4u*)(dst + (size_t)row * D + 16 * lane + 1024 * j) = o; }
    if (lane == 0) inv[row] = isc;
}
__device__ __forceinline__ void rc_finish_i8(const RowCvt& rc, unsigned char* dst, float* inv, int row, int lane) {
    const float am = rc_amax(rc);
    const float sc = (am > 0.f) ? 127.0f / am : 0.f;
#pragma unroll
    for (int j = 0; j < 2; ++j) { v4u o;
        o.x = pack_i8x4(rc.v[j][0].x * sc, rc.v[j][0].y * sc, rc.v[j][0].z * sc, rc.v[j][0].w * sc); o.y = pack_i8x4(rc.v[j][1].x * sc, rc.v[j][1].y * sc, rc.v[j][1].z * sc, rc.v[j][1].w * sc);
        o.z = pack_i8x4(rc.v[j][2].x * sc, rc.v[j][2].y * sc, rc.v[j][2].z * sc, rc.v[j][2].w * sc); o.w = pack_i8x4(rc.v[j][3].x * sc, rc.v[j][3].y * sc, rc.v[j][3].z * sc, rc.v[j][3].w * sc);
        *(v4u*)(dst + (size_t)row * D + 16 * lane + 1024 * j) = o; }
    if (lane == 0) inv[row] = am * (1.0f / 127.0f);
}
__device__ __forceinline__ void phase_prologue(const Args& A, const Ctx& C) {
    unsigned char* ws = A.ws;
    float* mod = (float*)(ws + WS_MOD);
    {
        float* red = (float*)C.lds;
        const float* w_ada = A.in[I_WADA]; const float* cv = A.in[I_C];
        for (int it = C.bid; it < MODW / 48; it += C.nb) {
            const int c4 = C.tid % 12, kg = C.tid / 12;
            f32x4 a0 = {0.f, 0.f, 0.f, 0.f}, a1 = {0.f, 0.f, 0.f, 0.f};
            if (C.tid < 504) {
                for (int k = kg; k < D; k += 42) {
                    const f32x4 w = *(const f32x4*)(w_ada + (size_t)k * MODW + 48 * it + 4 * c4);
                    const float s0 = siluf_(cv[k]), s1 = siluf_(cv[D + k]);
                    a0 += w * s0; a1 += w * s1;
                }
                float* r = red + kg * 96 + c4 * 4;
                r[0] = a0.x; r[1] = a0.y; r[2] = a0.z; r[3] = a0.w;
                r[48 + 0] = a1.x; r[48 + 1] = a1.y; r[48 + 2] = a1.z; r[48 + 3] = a1.w;
            }
            __syncthreads();
            if (C.tid < 96) {
                float s = 0.f;
                for (int g = 0; g < 42; ++g) s += red[g * 96 + C.tid];
                const int b = C.tid / 48, col = 48 * it + (C.tid % 48);
                mod[b * MODW + col] = s + A.in[I_BADA][col];
            }
            __syncthreads();
        }
    }
    {
        float* scr = (float*)(C.lds + C.wave * 16384);
        constexpr int I_IN = (D / 64) * (IN_COLS / 32);
        for (int it = C.gw; it < I_IN; it += C.ngw) p0_transpose_item_fp8(A.in[I_WIN], D, IN_COLS, ws + WS_WIN, true, scr, it, C.lane, WIN_SCALE);
    }
    cvt_stream(A.in[I_PSK], (bf16*)(ws + WS_SK), (size_t)16 * 128 * 128, C);
}


__device__ __forceinline__ void late_transposes(const Args& A, const Ctx& C, unsigned char* ldsbase, int w0, int nw) {
    unsigned char* ws = A.ws;
    float* scr = (float*)(ldsbase + C.wave * 16384);
    int lane = lane_id(); asm volatile("" : "+v"(lane));
    constexpr int I_CO = (CONV_CH / 64) * (D / 32), I_AO = (AOW / 64) * (D / 32), I_OUT = (D / 64) * (D / 32), I_Q = I_OUT;
    constexpr int NITEMS = I_CO + I_AO + I_OUT + I_Q;
    for (int it = w0; it < NITEMS; it += nw) {
        int r = it;
        if (r < I_CO) { p0_transpose_item(A.in[I_WCO], CONV_CH, D, (bf16*)(ws + WS_WCO), false, scr, r, lane); continue; } r -= I_CO;
        if (r < I_AO) { p0_transpose_item(A.in[I_WAO], AOW, D, (bf16*)(ws + WS_WAO), false, scr, r, lane); continue; } r -= I_AO;
        if (r < I_OUT) { p0_transpose_item_fp8(A.in[I_WOUT], D, D, ws + WS_WOUT, false, scr, r, lane, WIN_SCALE); continue; } r -= I_OUT;
        p0_transpose_item(A.in[I_PWQ], D, D, (bf16*)(ws + WS_WQ), false, scr, r, lane);
    }
    { RowCvt rc; for (int row = w0; row < UP_TAIL_ROWS; row += nw) { rc_issue(rc, A.in[I_PWUP], row, lane); rc_finish_i8(rc, ws + WS_WUP, (float*)(ws + WS_SUP), row, lane); } }
}
template <bool FP8OUT>
__device__ __forceinline__ void norm_mod_store(const f32x4 (&v)[8], float ss, int m, const float* gn, const float* mod, int shift_i, int scale_i, bf16* hout, int lane) {
    const float rstd = 1.0f / sqrtf(ss * (1.0f / D) + EPS);
    const int b = m / SEQ;
    const f32x4* gp = (const f32x4*)gn; const f32x4* sc = (const f32x4*)(mod + b * MODW + scale_i * D); const f32x4* sh = (const f32x4*)(mod + b * MODW + shift_i * D);
    v2u* o = (v2u*)(hout + (size_t)m * D); unsigned* o8 = (unsigned*)((unsigned char*)hout + (size_t)m * D);
#pragma unroll
    for (int j = 0; j < 8; ++j) { const int q = lane + 64 * j; const f32x4 g = gp[q], s = sc[q], h = sh[q];
        const f32x4 y = v[j] * rstd * g * (s + 1.0f) + h;
        if constexpr (FP8OUT) { int p = __builtin_amdgcn_cvt_pk_fp8_f32(y.x, y.y, 0, false); p = __builtin_amdgcn_cvt_pk_fp8_f32(y.z, y.w, p, true); o8[q] = (unsigned)p; }
        else { v2u w; w.x = pk2(y.x, y.y); w.y = pk2(y.z, y.w); o[q] = w; } }
}
template <bool FP8OUT>
__device__ __forceinline__ void phase_norm_mod(const float* xin, const float* gn, const float* mod, int shift_i, int scale_i, bf16* hout, const Ctx& C) {
    for (int m = C.gw; m < T; m += 2 * C.ngw) {
        const int m2 = m + C.ngw; const bool has2 = m2 < T;
        const f32x4* xr = (const f32x4*)(xin + (size_t)m * D); const f32x4* xr2 = (const f32x4*)(xin + (size_t)(has2 ? m2 : m) * D);
        f32x4 v[8], v2[8]; float ss = 0.f, ss2 = 0.f;
#pragma unroll
        for (int j = 0; j < 8; ++j) v[j] = xr[C.lane + 64 * j];
#pragma unroll
        for (int j = 0; j < 8; ++j) v2[j] = xr2[C.lane + 64 * j];
#pragma unroll
        for (int j = 0; j < 8; ++j) { ss += (v[j].x * v[j].x + v[j].y * v[j].y) + (v[j].z * v[j].z + v[j].w * v[j].w); ss2 += (v2[j].x * v2[j].x + v2[j].y * v2[j].y) + (v2[j].z * v2[j].z + v2[j].w * v2[j].w); }
#pragma unroll
        for (int o = 1; o < 64; o <<= 1) { ss += __shfl_xor(ss, o); ss2 += __shfl_xor(ss2, o); }
        norm_mod_store<FP8OUT>(v, ss, m, gn, mod, shift_i, scale_i, hout, C.lane);
        if (has2) norm_mod_store<FP8OUT>(v2, ss2, m2, gn, mod, shift_i, scale_i, hout, C.lane);
    }
}

template <class Epi>
__device__ __forceinline__ void ngemm_phase(const bf16* Am, const bf16* Bt, int M, int N, int K, int lda, const Epi& E, const Ctx& C) {
    float* As = (float*)C.lds;
    float* Bs = As + 64 * 33;
    const int tid = C.tid, ty = tid >> 5, tx = tid & 31;
    const int ntm = M / 64, ntn = N / 256;
    for (int it = C.bid; it < ntm * ntn; it += C.nb) {
        const int pm = it / ntn, pn = it % ntn;
        float acc[4][8];
#pragma unroll
        for (int i = 0; i < 4; ++i)
#pragma unroll
            for (int j = 0; j < 8; ++j) acc[i][j] = 0.f;
        for (int k0 = 0; k0 < K; k0 += 32) {
            { const int r = tid >> 3, c = (tid & 7) * 4; const v2u v = *(const v2u*)(Am + (size_t)(pm * 64 + r) * lda + k0 + c);
              float* d = As + r * 33 + c; d[0] = bflo(v.x); d[1] = bfhi(v.x); d[2] = bflo(v.y); d[3] = bfhi(v.y); }
#pragma unroll
            for (int i = 0; i < 4; ++i) { const int idx = tid + 512 * i, r = idx >> 3, c = (idx & 7) * 4; const v2u v = *(const v2u*)(Bt + (size_t)(pn * 256 + r) * K + k0 + c);
              float* d = Bs + r * 33 + c; d[0] = bflo(v.x); d[1] = bfhi(v.x); d[2] = bflo(v.y); d[3] = bfhi(v.y); }
            __syncthreads();
#pragma unroll 4
            for (int k = 0; k < 32; ++k) {
                float a[4], b[8];
#pragma unroll
                for (int i = 0; i < 4; ++i) a[i] = As[(ty + 16 * i) * 33 + k];
#pragma unroll
                for (int j = 0; j < 8; ++j) b[j] = Bs[(tx + 32 * j) * 33 + k];
#pragma unroll
                for (int i = 0; i < 4; ++i)
#pragma unroll
                    for (int j = 0; j < 8; ++j) acc[i][j] += a[i] * b[j];
            }
            __syncthreads();
        }
        E(pm * 64 + ty, pn, tx, acc);
    }
}
struct NEpiIn {
    bf16 *U, *QKV, *G;
    __device__ __forceinline__ void operator()(int r0, int pn, int tx, const float (&acc)[4][8]) const {
#pragma unroll
        for (int i = 0; i < 4; ++i) { const size_t row = r0 + 16 * i;
            if (pn < 8) {
#pragma unroll
                for (int j = 0; j < 4; ++j) U[row * CONV_CH + 128 * pn + tx + 32 * j] = (bf16)f2bf(acc[i][j] * sigmoidf_(acc[i][j + 4]));
            } else if (pn < 26) {
#pragma unroll
                for (int j = 0; j < 8; ++j) QKV[row * QKVW + (pn - 8) * 256 + tx + 32 * j] = (bf16)f2bf(acc[i][j]);
            } else {
#pragma unroll
                for (int j = 0; j < 8; ++j) G[row * (2 * D) + (pn - 26) * 256 + tx + 32 * j] = (bf16)f2bf(sigmoidf_(acc[i][j]));
            } }
    }
};
struct NEpiYattn {
    const bf16* G; bf16* MG;
    __device__ __forceinline__ void operator()(int r0, int pn, int tx, const float (&acc)[4][8]) const {
#pragma unroll
        for (int i = 0; i < 4; ++i) { const size_t row = r0 + 16 * i;
#pragma unroll
            for (int j = 0; j < 8; ++j) { const int col = pn * 256 + tx + 32 * j; MG[row * D + col] = (bf16)f2bf(bf2f(G[row * (2 * D) + D + col]) * acc[i][j]); } }
    }
};
struct NEpiYconv {
    const bf16* G; bf16* MG; const float* bias;
    __device__ __forceinline__ void operator()(int r0, int pn, int tx, const float (&acc)[4][8]) const {
#pragma unroll
        for (int i = 0; i < 4; ++i) { const size_t row = r0 + 16 * i;
#pragma unroll
            for (int j = 0; j < 8; ++j) { const int col = pn * 256 + tx + 32 * j;
                MG[row * D + col] = (bf16)f2bf(bf2f(MG[row * D + col]) + bf2f(G[row * (2 * D) + col]) * (acc[i][j] + bias[col])); } }
    }
};
struct NEpiOut {
    const float* x; const float* mod; float* out;
    __device__ __forceinline__ void operator()(int r0, int pn, int tx, const float (&acc)[4][8]) const {
#pragma unroll
        for (int i = 0; i < 4; ++i) { const size_t row = r0 + 16 * i; const int b = (int)(row / SEQ);
#pragma unroll
            for (int j = 0; j < 8; ++j) { const int col = pn * 256 + tx + 32 * j; out[row * D + col] = x[row * D + col] + mod[b * MODW + 2 * D + col] * acc[i][j]; } }
    }
};
struct NEpiBf16 {
    bf16* O; int ldc;
    __device__ __forceinline__ void operator()(int r0, int pn, int tx, const float (&acc)[4][8]) const {
#pragma unroll
        for (int i = 0; i < 4; ++i) { const size_t row = r0 + 16 * i;
#pragma unroll
            for (int j = 0; j < 8; ++j) O[row * ldc + pn * 256 + tx + 32 * j] = (bf16)f2bf(acc[i][j]); }
    }
};

__device__ __forceinline__ float block_sum(float v, float* red, const Ctx& C) {
    v = wave_sum(v);
    __syncthreads();
    if (C.lane == 0) red[C.wave] = v;
    __syncthreads();
    float s = 0.f;
#pragma unroll
    for (int i = 0; i < NWAVES; ++i) s += red[i];
    return s;
}
__device__ __forceinline__ void phase_conv_naive(const Args& A, const Ctx& C) {
    const bf16* U = (const bf16*)(A.ws + WS_U); bf16* UCV = (bf16*)(A.ws + WS_UCV);
    const float* dw = A.in[I_CDW]; const float* db = A.in[I_CDB]; const float* lg = A.in[I_CLNG]; const float* lb = A.in[I_CLNB];
    float* red = (float*)C.lds;
    const int c0 = 2 * C.tid;
    for (int t = C.bid; t < T; t += C.nb) {
        const int s = t % SEQ;
        float a0 = db[c0], a1 = db[c0 + 1];
        for (int j = 0; j < CONV_K; ++j) { const int sp = s - (CONV_K - 1) + j; if (sp < 0) continue;
            const unsigned w = *(const unsigned*)(U + (size_t)(t - (CONV_K - 1) + j) * CONV_CH + c0);
            a0 += dw[j * CONV_CH + c0] * bflo(w); a1 += dw[j * CONV_CH + c0 + 1] * bfhi(w); }
        const float mean = block_sum(a0 + a1, red, C) * (1.0f / CONV_CH);
        const float d0 = a0 - mean, d1 = a1 - mean;
        const float var = block_sum(d0 * d0 + d1 * d1, red, C) * (1.0f / CONV_CH);
        const float rstd = 1.0f / sqrtf(var + EPS);
        const float y0 = d0 * rstd * lg[c0] + lb[c0], y1 = d1 * rstd * lg[c0 + 1] + lb[c0 + 1];
        *(unsigned*)(UCV + (size_t)t * CONV_CH + c0) = pk2(siluf_(y0), siluf_(y1));
    }
}
__device__ __forceinline__ void phase_attn_naive(const Args& A, const Ctx& C) {
    const bf16* QKV = (const bf16*)(A.ws + WS_QKV); bf16* O = (bf16*)(A.ws + WS_O);
    const float* qg = A.in[I_QNG]; const float* kg = A.in[I_KNG];
    const int lane = C.lane;
    for (int it = C.gw; it < T * 4; it += C.ngw) {
        const int t = it >> 2, hh = it & 3, b = t / SEQ, s = t % SEQ;
        float m = -INFINITY, l = 0.f, o0 = 0.f, o1 = 0.f;
        for (int g = 0; g < 3; ++g) {
            const int dil = (g == 0) ? 1 : (g == 1) ? 4 : 16; const int head = g * 4 + hh;
            const unsigned qw = *(const unsigned*)(QKV + (size_t)t * QKVW + head * HD + 2 * lane);
            const float q0 = bflo(qw), q1 = bfhi(qw);
            const float rq = 1.0f / sqrtf(wave_sum(q0 * q0 + q1 * q1) * (1.0f / HD) + EPS);
            const float qq0 = q0 * rq * qg[head * HD + 2 * lane] * kg[head * HD + 2 * lane], qq1 = q1 * rq * qg[head * HD + 2 * lane + 1] * kg[head * HD + 2 * lane + 1];
            for (int dist = 0; dist <= 128; ++dist) {
                const int sk = s - dist * dil; if (sk < 0) break;
                const size_t tk = (size_t)b * SEQ + sk;
                const unsigned kw = *(const unsigned*)(QKV + tk * QKVW + AW + head * HD + 2 * lane);
                const unsigned vw = *(const unsigned*)(QKV + tk * QKVW + 2 * AW + head * HD + 2 * lane);
                const float k0 = bflo(kw), k1 = bfhi(kw);
                float dot = qq0 * k0 + qq1 * k1, kss = k0 * k0 + k1 * k1;
#pragma unroll
                for (int o = 1; o < 64; o <<= 1) { dot += __shfl_xor(dot, o); kss += __shfl_xor(kss, o); }
                const float sc = dot * (1.0f / sqrtf(kss * (1.0f / HD) + EPS)) * 0.08838834764831845f;
                const float mn = fmaxf(m, sc), corr = __expf(m - mn), p = __expf(sc - mn);
                l = l * corr + p; o0 = o0 * corr + p * bflo(vw); o1 = o1 * corr + p * bfhi(vw); m = mn;
            }
        }
        const float il = 1.0f / l;
        *(unsigned*)(O + (size_t)t * AOW + hh * HD + 2 * lane) = pk2(o0 * il, o1 * il);
    }
}

__device__ __forceinline__ void wave_argmax(float& v, int& i) {
#pragma unroll
    for (int o = 32; o >= 1; o >>= 1) { const float ov = __shfl_xor(v, o); const int oi = __shfl_xor(i, o);
        if (ov > v || (ov == v && oi < i)) { v = ov; i = oi; } }
}
__device__ __forceinline__ void phase_topk_naive(const Args& A, const Ctx& C) {
    const bf16* QP = (const bf16*)(A.ws + WS_QP); const bf16* SK = (const bf16*)(A.ws + WS_SK);
    int* IDX = (int*)(A.ws + WS_IDX); float* GW = (float*)(A.ws + WS_GW);
    const int lane = C.lane;
    for (int it = C.gw; it < T * PEER_H; it += C.ngw) {
        const int t = it >> 3, h = it & 7;
        const bf16* qrow = QP + (size_t)t * D + h * 256;
        float topv[2]; int topi[2];
#pragma unroll
        for (int p = 0; p < 2; ++p) {
            float s0 = 0.f, s1 = 0.f;
            const bf16* k0r = SK + ((size_t)(h * 2 + p) * 128 + lane) * 128; const bf16* k1r = k0r + 64 * 128;
            for (int e = 0; e < 128; e += 8) {
                const v4u qv = *(const v4u*)(qrow + p * 128 + e), a = *(const v4u*)(k0r + e), bq = *(const v4u*)(k1r + e);
                s0 += bflo(qv.x) * bflo(a.x) + bfhi(qv.x) * bfhi(a.x) + bflo(qv.y) * bflo(a.y) + bfhi(qv.y) * bfhi(a.y) + bflo(qv.z) * bflo(a.z) + bfhi(qv.z) * bfhi(a.z) + bflo(qv.w) * bflo(a.w) + bfhi(qv.w) * bfhi(a.w);
                s1 += bflo(qv.x) * bflo(bq.x) + bfhi(qv.x) * bfhi(bq.x) + bflo(qv.y) * bflo(bq.y) + bfhi(qv.y) * bfhi(bq.y) + bflo(qv.z) * bflo(bq.z) + bfhi(qv.z) * bfhi(bq.z) + bflo(qv.w) * bflo(bq.w) + bfhi(qv.w) * bfhi(bq.w);
            }
            float tv = 0.f; int ti = 0;
            for (int k = 0; k < PEER_TOPK; ++k) {
                float v; int i;
                if (s0 >= s1) { v = s0; i = lane; } else { v = s1; i = lane + 64; }
                wave_argmax(v, i);
                if (i == lane) s0 = -INFINITY; else if (i == lane + 64) s1 = -INFINITY;
                if (lane == k) { tv = v; ti = i; }
            }
            topv[p] = tv; topi[p] = ti;
        }
        float cv[4];
        const float v1 = __shfl(topv[0], lane >> 2);
#pragma unroll
        for (int u = 0; u < 4; ++u) cv[u] = v1 + __shfl(topv[1], 4 * (lane & 3) + u);
        float wv = -INFINITY; int wc = 0;
        for (int k = 0; k < PEER_TOPK; ++k) {
            float v = cv[0]; int i = 4 * lane;
#pragma unroll
            for (int u = 1; u < 4; ++u) if (cv[u] > v) { v = cv[u]; i = 4 * lane + u; }
            wave_argmax(v, i);
            if ((i >> 2) == lane) {
#pragma unroll
                for (int u = 0; u < 4; ++u) if ((i & 3) == u) cv[u] = -INFINITY;
            }
            if (lane == k) { wv = v; wc = i; }
        }
        const float mx = __shfl(wv, 0);
        const float e = (lane < PEER_TOPK) ? __expf(wv - mx) : 0.f;
        const float sum = wave_sum(e);
        const int e1 = __shfl(topi[0], wc >> 4), e2 = __shfl(topi[1], wc & 15);
        if (lane < PEER_TOPK) { IDX[(size_t)t * PEER_HK + h * PEER_TOPK + lane] = e1 * PEER_NK + e2; GW[(size_t)t * PEER_HK + h * PEER_TOPK + lane] = e / sum; }
    }
}
__device__ __forceinline__ void phase_experts_naive(const Args& A, const Ctx& C) {
    const bf16* H2 = (const bf16*)(A.ws + WS_H); const bf16* WUP = (const bf16*)(A.ws + WS_WUP); const bf16* WDN = (const bf16*)(A.ws + WS_WDN);
    const int* IDX = (const int*)(A.ws + WS_IDX); const float* GW = (const float*)(A.ws + WS_GW); const float* mod = (const float*)(A.ws + WS_MOD);
    float* hs = (float*)C.lds;
    float* coef = hs + D;
    int* eidx = (int*)(coef + PEER_HK);
    for (int t = C.bid; t < T; t += C.nb) {
        { const v2u v = *(const v2u*)(H2 + (size_t)t * D + 4 * C.tid); float* d = hs + 4 * C.tid; d[0] = bflo(v.x); d[1] = bfhi(v.x); d[2] = bflo(v.y); d[3] = bfhi(v.y); }
        if (C.tid < PEER_HK) eidx[C.tid] = IDX[(size_t)t * PEER_HK + C.tid];
        __syncthreads();
        for (int i = 0; i < 16; ++i) {
            const int k = C.wave * 16 + i; const bf16* wr = WUP + (size_t)eidx[k] * D;
            float dot = 0.f;
#pragma unroll
            for (int j = 0; j < 4; ++j) { const int e0 = C.lane * 8 + 512 * j; const v4u w = *(const v4u*)(wr + e0); const float* hp = hs + e0;
                dot += hp[0] * bflo(w.x) + hp[1] * bfhi(w.x) + hp[2] * bflo(w.y) + hp[3] * bfhi(w.y) + hp[4] * bflo(w.z) + hp[5] * bfhi(w.z) + hp[6] * bflo(w.w) + hp[7] * bfhi(w.w); }
            dot = wave_sum(dot);
            if (C.lane == 0) coef[k] = GW[(size_t)t * PEER_HK + k] * gelu_erf(dot);
        }
        __syncthreads();
        float a0 = 0.f, a1 = 0.f, a2 = 0.f, a3 = 0.f;
        for (int k = 0; k < PEER_HK; ++k) { const float c = coef[k]; const v2u w = *(const v2u*)(WDN + (size_t)eidx[k] * D + 4 * C.tid);
            a0 += c * bflo(w.x); a1 += c * bfhi(w.x); a2 += c * bflo(w.y); a3 += c * bfhi(w.y); }
        const int b = t / SEQ; const f32x4 g2 = *(const f32x4*)(mod + b * MODW + 5 * D + 4 * C.tid);
        f32x4* op = (f32x4*)(A.out + (size_t)t * D + 4 * C.tid);
        f32x4 x1 = *op; x1.x += g2.x * a0; x1.y += g2.y * a1; x1.z += g2.z * a2; x1.w += g2.w * a3; *op = x1;
        __syncthreads();
    }
}


__device__ __forceinline__ unsigned f2ord(float f) { const unsigned u = __builtin_bit_cast(unsigned, f); return u ^ ((u >> 31) ? 0xFFFFFFFFu : 0x80000000u); }
__device__ __forceinline__ float ord2f(unsigned u) { return __builtin_bit_cast(float, (u & 0x80000000u) ? (u ^ 0x80000000u) : ~u); }
template <int CTRL> __device__ __forceinline__ unsigned dpp_u(unsigned x) { return (unsigned)__builtin_amdgcn_update_dpp(0, (int)x, CTRL, 0xF, 0xF, false); }
__device__ __forceinline__ unsigned rowmax_u(unsigned x) {
    x = max(x, dpp_u<0x128>(x)); x = max(x, dpp_u<0x124>(x)); x = max(x, dpp_u<0x122>(x)); x = max(x, dpp_u<0x121>(x)); return x; }
__device__ __forceinline__ float rowsum_f(float x) {
    x += __builtin_bit_cast(float, dpp_u<0x128>(__builtin_bit_cast(unsigned, x))); x += __builtin_bit_cast(float, dpp_u<0x124>(__builtin_bit_cast(unsigned, x)));
    x += __builtin_bit_cast(float, dpp_u<0x122>(__builtin_bit_cast(unsigned, x))); x += __builtin_bit_cast(float, dpp_u<0x121>(__builtin_bit_cast(unsigned, x))); return x; }
#define CE_DESC(a, b) do { const unsigned _hi = max(a, b), _lo = min(a, b); a = _hi; b = _lo; } while (0)
__device__ __forceinline__ void phase_topk(const Args& A, const Ctx& C) {
    const bf16* QP = (const bf16*)(A.ws + WS_QP); const bf16* SK = (const bf16*)(A.ws + WS_SK);
    int* IDX = (int*)(A.ws + WS_IDX); float* GW = (float*)(A.ws + WS_GW);
    const int lane = C.lane, i = lane & 15, g = lane >> 4;
    if (C.wave >= TK_W) {
        const int cw = C.bid * (NWAVES - TK_W) + (C.wave - TK_W), ncw = C.nb * (NWAVES - TK_W); RowCvt ra, rb;
        for (int row = UP_TAIL_ROWS + cw; row < 2 * PEER_E; row += 2 * ncw) {
            const int row2 = row + ncw; const bool has2 = row2 < 2 * PEER_E;
            rc_issue(ra, row < PEER_E ? A.in[I_PWUP] : A.in[I_PWDN], row < PEER_E ? row : row - PEER_E, lane);
            if (has2) rc_issue(rb, row2 < PEER_E ? A.in[I_PWUP] : A.in[I_PWDN], row2 < PEER_E ? row2 : row2 - PEER_E, lane);
            if (row < PEER_E) rc_finish_i8(ra, A.ws + WS_WUP, (float*)(A.ws + WS_SUP), row, lane); else rc_finish_fp8(ra, A.ws + WS_WDN, (float*)(A.ws + WS_SDN), row - PEER_E, lane);
            if (has2) { if (row2 < PEER_E) rc_finish_i8(rb, A.ws + WS_WUP, (float*)(A.ws + WS_SUP), row2, lane); else rc_finish_fp8(rb, A.ws + WS_WDN, (float*)(A.ws + WS_SDN), row2 - PEER_E, lane); }
        }
        return;
    }
    int crow = 2 * PEER_E; RowCvt rc;
#define CV_ISSUE() do { asm volatile("" ::: "memory"); if (crow < 2 * PEER_E) rc_issue(rc, crow < PEER_E ? A.in[I_PWUP] : A.in[I_PWDN], crow < PEER_E ? crow : crow - PEER_E, lane); } while (0)
#define CV_FINISH() do { if (crow < 2 * PEER_E) { if (crow < PEER_E) rc_finish_i8(rc, A.ws + WS_WUP, (float*)(A.ws + WS_SUP), crow, lane); \
        else rc_finish_fp8(rc, A.ws + WS_WDN, (float*)(A.ws + WS_SDN), crow - PEER_E, lane); crow += C.ngw; } asm volatile("" ::: "memory"); } while (0)
    for (int it = C.bid * TK_W + C.wave; it < (T / 16) * PEER_H; it += C.nb * TK_W) {
        const int tile = it >> 3, t0 = tile * 16; int h = it & 7; asm volatile("" : "+s"(h));
        unsigned win[2][4];
#pragma unroll
        for (int p = 0; p < 2; ++p) {
            const int slot = 2 * h + p;
            pg8::bf16x8 aq[4];
#pragma unroll
            for (int ks = 0; ks < 4; ++ks) aq[ks] = *(const pg8::bf16x8*)(QP + (size_t)(t0 + i) * D + slot * 128 + 32 * ks + 8 * g);
            unsigned K[4][8];
#pragma unroll
            for (int nt = 0; nt < 8; ++nt) {
                f32x4 acc = {0.f, 0.f, 0.f, 0.f};
                const bf16* kr = SK + ((size_t)slot * 128 + 16 * nt + i) * 128 + 8 * g;
#pragma unroll
                for (int ks = 0; ks < 4; ++ks) acc = __builtin_amdgcn_mfma_f32_16x16x32_bf16(aq[ks], *(const pg8::bf16x8*)(kr + 32 * ks), acc, 0, 0, 0);
#pragma unroll
                for (int r = 0; r < 4; ++r) K[r][nt] = (f2ord(acc[r]) & ~127u) | (unsigned)(127 - (16 * nt + i));
            }
#pragma unroll
            for (int r = 0; r < 4; ++r) {
                CV_ISSUE();
                unsigned* k = K[r];
                CE_DESC(k[0], k[1]); CE_DESC(k[2], k[3]); CE_DESC(k[4], k[5]); CE_DESC(k[6], k[7]);
                CE_DESC(k[0], k[2]); CE_DESC(k[1], k[3]); CE_DESC(k[4], k[6]); CE_DESC(k[5], k[7]);
                CE_DESC(k[1], k[2]); CE_DESC(k[5], k[6]);
                CE_DESC(k[0], k[4]); CE_DESC(k[1], k[5]); CE_DESC(k[2], k[6]); CE_DESC(k[3], k[7]);
                CE_DESC(k[2], k[4]); CE_DESC(k[3], k[5]);
                CE_DESC(k[1], k[2]); CE_DESC(k[3], k[4]); CE_DESC(k[5], k[6]);
                unsigned w = 0u;
#pragma unroll
                for (int kk = 0; kk < PEER_TOPK; ++kk) {
                    const unsigned M = rowmax_u(k[0]);
                    const bool pop = (k[0] == M);
#pragma unroll
                    for (int q = 0; q < 7; ++q) k[q] = pop ? k[q + 1] : k[q];
                    k[7] = pop ? 0u : k[7];
                    w = (i == kk) ? M : w;
                }
                win[p][r] = w;
                CV_FINISH();
            }
        }
#pragma unroll
        for (int r = 0; r < 4; ++r) {
            CV_ISSUE();
            const float v1 = ord2f(win[0][r] & ~127u), v2 = ord2f(win[1][r] & ~127u);
            int j = 0;
            float nv = __builtin_bit_cast(float, __builtin_amdgcn_ds_bpermute(4 * (16 * g), __builtin_bit_cast(int, v2)));
            unsigned key = (f2ord(v1 + nv) & ~255u) | (unsigned)(255 - 16 * i);
            unsigned w = 0u; float mx = 0.f;
#pragma unroll
            for (int kk = 0; kk < PEER_TOPK; ++kk) {
                const unsigned M = rowmax_u(key);
                if (kk == 0) mx = ord2f(M & ~255u);
                const bool pop = (key == M);
                j += pop ? 1 : 0;
                const int jj = j < 15 ? j : 15;
                nv = __builtin_bit_cast(float, __builtin_amdgcn_ds_bpermute(4 * (16 * g + jj), __builtin_bit_cast(int, v2)));
                const unsigned nk = (j < 16) ? ((f2ord(v1 + nv) & ~255u) | (unsigned)(255 - (16 * i + jj))) : 0u;
                key = pop ? nk : key;
                w = (i == kk) ? M : w;
            }
            const int ci = 255 - (int)(w & 255u);
            const int n1 = 127 - (int)(win[0][r] & 127u), n2 = 127 - (int)(win[1][r] & 127u);
            const int e1 = __builtin_amdgcn_ds_bpermute(4 * (16 * g + (ci >> 4)), n1), e2 = __builtin_amdgcn_ds_bpermute(4 * (16 * g + (ci & 15)), n2);
            const float ex = __expf(ord2f(w & ~255u) - mx);
            const float sum = rowsum_f(ex);
            const size_t o = (size_t)(t0 + 4 * g + r) * PEER_HK + h * PEER_TOPK + i;
            IDX[o] = e1 * PEER_NK + e2; GW[o] = ex / sum;
            CV_FINISH();
        }
    }
    while (crow < 2 * PEER_E) { CV_ISSUE(); CV_FINISH(); }
#undef CV_ISSUE
#undef CV_FINISH
}

typedef __bf16 bf16x2v __attribute__((ext_vector_type(2)));
__device__ __forceinline__ float dot2bf(unsigned w, unsigned x, float acc) { return __builtin_amdgcn_fdot2_f32_bf16(__builtin_bit_cast(bf16x2v, w), __builtin_bit_cast(bf16x2v, x), acc, false); }
__device__ __forceinline__ f2v fp8lo(unsigned w) { return __builtin_amdgcn_cvt_pk_f32_fp8((int)w, false); }
__device__ __forceinline__ f2v fp8hi(unsigned w) { return __builtin_amdgcn_cvt_pk_f32_fp8((int)w, true); }
constexpr int EXB = 8;
__device__ __forceinline__ void phase_experts(const Args& A, const Ctx& C, float* dst) {
    const bf16* H2 = (const bf16*)(A.ws + WS_H); const unsigned char* WUP = A.ws + WS_WUP; const unsigned char* WDN = A.ws + WS_WDN;
    const float* SUP = (const float*)(A.ws + WS_SUP); const float* SDN = (const float*)(A.ws + WS_SDN);
    const int* IDX = (const int*)(A.ws + WS_IDX); const float* GW = (const float*)(A.ws + WS_GW); const float* mod = (const float*)(A.ws + WS_MOD);
    LAS unsigned* skey = (LAS unsigned*)((LAS unsigned char*)C.lds + C.wave * 2048);
    LAS float* sg = (LAS float*)(skey + 128);
    LAS float* ssup = sg + 128;
    const int lane = C.lane;
    for (int t = C.gw; t < T; t += C.ngw) {
        const int e0 = IDX[(size_t)t * PEER_HK + lane], e1 = IDX[(size_t)t * PEER_HK + 64 + lane];
        unsigned k0 = ((unsigned)e0 << 7) | (unsigned)lane, k1 = ((unsigned)e1 << 7) | (unsigned)(64 + lane);
        sg[lane] = GW[(size_t)t * PEER_HK + lane] * SDN[e0]; sg[64 + lane] = GW[(size_t)t * PEER_HK + 64 + lane] * SDN[e1];
        ssup[lane] = SUP[e0]; ssup[64 + lane] = SUP[e1];
#pragma unroll
        for (int k = 2; k <= 128; k <<= 1) {
#pragma unroll
            for (int j = k >> 1; j >= 1; j >>= 1) {
                if (j == 64) { const unsigned a = min(k0, k1), b = max(k0, k1); k0 = a; k1 = b; }
                else {
                    const unsigned o0 = __shfl_xor(k0, j), o1 = __shfl_xor(k1, j);
                    const bool lower = (lane & j) == 0;
                    const bool up0 = (lane & k) == 0, up1 = ((lane + 64) & k) == 0;
                    k0 = (up0 == lower) ? min(k0, o0) : max(k0, o0);
                    k1 = (up1 == lower) ? min(k1, o1) : max(k1, o1);
                }
            }
        }
        skey[lane] = k0; skey[64 + lane] = k1;
        f2v hv[2][8], acc[2][8];
#pragma unroll
        for (int j = 0; j < 2; ++j) { const v4u a = *(const v4u*)(H2 + (size_t)t * D + 16 * lane + 1024 * j), b = *(const v4u*)(H2 + (size_t)t * D + 16 * lane + 1024 * j + 8);
            hv[j][0] = (f2v){bflo(a.x), bfhi(a.x)}; hv[j][1] = (f2v){bflo(a.y), bfhi(a.y)}; hv[j][2] = (f2v){bflo(a.z), bfhi(a.z)}; hv[j][3] = (f2v){bflo(a.w), bfhi(a.w)};
            hv[j][4] = (f2v){bflo(b.x), bfhi(b.x)}; hv[j][5] = (f2v){bflo(b.y), bfhi(b.y)}; hv[j][6] = (f2v){bflo(b.z), bfhi(b.z)}; hv[j][7] = (f2v){bflo(b.w), bfhi(b.w)};
#pragma unroll
            for (int q = 0; q < 8; ++q) acc[j][q] = (f2v){0.f, 0.f}; }
        asm volatile("s_waitcnt lgkmcnt(0)" ::: "memory");
        v4u bu[EXB][2], bd[EXB][2];
#pragma unroll
        for (int i = 0; i < EXB; ++i) { const unsigned e = __builtin_amdgcn_readfirstlane(skey[i]) >> 7; const unsigned char* r = WUP + (size_t)e * D + 16 * lane;
            bu[i][0] = *(const v4u*)r; bu[i][1] = *(const v4u*)(r + 1024); }
        for (int b = 0; b < PEER_HK / EXB; ++b) {
#pragma unroll
            for (int i = 0; i < EXB; ++i) { const unsigned e = __builtin_amdgcn_readfirstlane(skey[EXB * b + i]) >> 7; const unsigned char* r = WDN + (size_t)e * D + 16 * lane;
                bd[i][0] = *(const v4u*)r; bd[i][1] = *(const v4u*)(r + 1024); }
            float p[EXB];
#pragma unroll
            for (int i = 0; i < EXB; ++i) { f2v s0 = {0.f, 0.f}, s1 = {0.f, 0.f};
#pragma unroll
                for (int j = 0; j < 2; ++j) { const v4u w = bu[i][j];
                    s0 = __builtin_elementwise_fma(fp8lo(w.x), hv[j][0], s0); s1 = __builtin_elementwise_fma(fp8hi(w.x), hv[j][1], s1);
                    s0 = __builtin_elementwise_fma(fp8lo(w.y), hv[j][2], s0); s1 = __builtin_elementwise_fma(fp8hi(w.y), hv[j][3], s1);
                    s0 = __builtin_elementwise_fma(fp8lo(w.z), hv[j][4], s0); s1 = __builtin_elementwise_fma(fp8hi(w.z), hv[j][5], s1);
                    s0 = __builtin_elementwise_fma(fp8lo(w.w), hv[j][6], s0); s1 = __builtin_elementwise_fma(fp8hi(w.w), hv[j][7], s1); }
                p[i] = (s0.x + s0.y) + (s1.x + s1.y); }
            const bool b5 = (lane & 32) != 0, b4 = (lane & 16) != 0, b3 = (lane & 8) != 0;
#pragma unroll
            for (int k = 0; k < 4; ++k) { const float keep = b5 ? p[k + 4] : p[k], send = b5 ? p[k] : p[k + 4]; p[k] = keep + __shfl_xor(send, 32); }
#pragma unroll
            for (int k = 0; k < 2; ++k) { const float keep = b4 ? p[k + 2] : p[k], send = b4 ? p[k] : p[k + 2]; p[k] = keep + __shfl_xor(send, 16); }
            float d; { const float keep = b3 ? p[1] : p[0], send = b3 ? p[0] : p[1]; d = keep + __shfl_xor(send, 8); }
            d += __shfl_xor(d, 4); d += __shfl_xor(d, 2); d += __shfl_xor(d, 1);
            const unsigned myk = skey[EXB * b + (lane >> 3)];
            const float cf = gelu_erf(d * ssup[myk & 127u]) * sg[myk & 127u];
            float c[EXB];
#pragma unroll
            for (int i = 0; i < EXB; ++i) c[i] = __builtin_bit_cast(float, __builtin_amdgcn_readlane(__builtin_bit_cast(int, cf), 8 * i));
            if (b + 1 < PEER_HK / EXB) {
#pragma unroll
                for (int i = 0; i < EXB; ++i) { const unsigned e = __builtin_amdgcn_readfirstlane(skey[EXB * b + EXB + i]) >> 7; const unsigned char* r = WUP + (size_t)e * D + 16 * lane;
                    bu[i][0] = *(const v4u*)r; bu[i][1] = *(const v4u*)(r + 1024); }
            }
#pragma unroll
            for (int i = 0; i < EXB; ++i) { const f2v cc = {c[i], c[i]};
#pragma unroll
                for (int j = 0; j < 2; ++j) { const v4u w = bd[i][j];
                    acc[j][0] = __builtin_elementwise_fma(fp8lo(w.x), cc, acc[j][0]); acc[j][1] = __builtin_elementwise_fma(fp8hi(w.x), cc, acc[j][1]);
                    acc[j][2] = __builtin_elementwise_fma(fp8lo(w.y), cc, acc[j][2]); acc[j][3] = __builtin_elementwise_fma(fp8hi(w.y), cc, acc[j][3]);
                    acc[j][4] = __builtin_elementwise_fma(fp8lo(w.z), cc, acc[j][4]); acc[j][5] = __builtin_elementwise_fma(fp8hi(w.z), cc, acc[j][5]);
                    acc[j][6] = __builtin_elementwise_fma(fp8lo(w.w), cc, acc[j][6]); acc[j][7] = __builtin_elementwise_fma(fp8hi(w.w), cc, acc[j][7]); } }
        }
        const int bb = t / SEQ;
#pragma unroll
        for (int j = 0; j < 2; ++j)
#pragma unroll
            for (int q = 0; q < 4; ++q) { const int col = 16 * lane + 1024 * j + 4 * q; const f32x4 g = *(const f32x4*)(mod + bb * MODW + 5 * D + col);
                f32x4 x = *(const f32x4*)(A.out + (size_t)t * D + col);
                x.x += g.x * acc[j][2 * q].x; x.y += g.y * acc[j][2 * q].y; x.z += g.z * acc[j][2 * q + 1].x; x.w += g.w * acc[j][2 * q + 1].y; *(f32x4*)(dst + (size_t)t * D + col) = x; }
        asm volatile("s_waitcnt lgkmcnt(0)" ::: "memory");
    }
}


constexpr int EX_LDS_WAVE = 4 * 4096 + 2048;
typedef __bf16 bf16x2w __attribute__((ext_vector_type(2)));
__device__ __forceinline__ float gelu_as(float v) {
    const float av = fabsf(v), t = __builtin_amdgcn_rcpf(av * 0.2316419f + 1.0f);
    float q = t * 0.5307027145f + (-0.7265760135f); q = q * t + 0.7107068705f; q = q * t + (-0.142248368f); q = q * t + 0.127414796f; q = q * t;
    const float e = __builtin_amdgcn_exp2f((v * v) * (-0.72134752044f));
    const float m = v * (q * e);
    return v < 0.f ? m : v - m;
}
__device__ __forceinline__ v4u ldrow16(const unsigned char* sbase, unsigned voff) { return *(const v4u*)(sbase + voff); }
__device__ __forceinline__ v2u ldrow8(const unsigned char* sbase, unsigned voff) { return *(const v2u*)(sbase + voff); }
__device__ __forceinline__ int dot16_i8(const v4u w0, const v4u h0) {
    int s0 = __builtin_amdgcn_sdot4((int)w0.x, (int)h0.x, 0, false), s1 = __builtin_amdgcn_sdot4((int)w0.y, (int)h0.y, 0, false);
    s0 = __builtin_amdgcn_sdot4((int)w0.z, (int)h0.z, s0, false); s1 = __builtin_amdgcn_sdot4((int)w0.w, (int)h0.w, s1, false);
    return s0 + s1;
}
__device__ __forceinline__ int dot32_i8(const v4u w0, const v4u h0, const v4u w1, const v4u h1) {
    int s0 = __builtin_amdgcn_sdot4((int)w0.x, (int)h0.x, 0, false), s1 = __builtin_amdgcn_sdot4((int)w0.y, (int)h0.y, 0, false);
    s0 = __builtin_amdgcn_sdot4((int)w0.z, (int)h0.z, s0, false); s1 = __builtin_amdgcn_sdot4((int)w0.w, (int)h0.w, s1, false);
    s0 = __builtin_amdgcn_sdot4((int)w1.x, (int)h1.x, s0, false); s1 = __builtin_amdgcn_sdot4((int)w1.y, (int)h1.y, s1, false);
    s0 = __builtin_amdgcn_sdot4((int)w1.z, (int)h1.z, s0, false); s1 = __builtin_amdgcn_sdot4((int)w1.w, (int)h1.w, s1, false);
    return s0 + s1;
}
__device__ __forceinline__ float dot2_f2v_bf16(f2v a, unsigned h, float s) { return __builtin_amdgcn_fdot2_f32_bf16(__builtin_convertvector(a, bf16x2w), __builtin_bit_cast(bf16x2w, h), s, false); }
__device__ __forceinline__ float dot16_fp8_bf16(const v4u w, const v4u ha, const v4u hb, float s) {
#define D2(W, HI, H) s = dot2_f2v_bf16((HI) ? fp8hi(W) : fp8lo(W), H, s)
    D2(w.x, 0, ha.x); D2(w.x, 1, ha.y); D2(w.y, 0, ha.z); D2(w.y, 1, ha.w); D2(w.z, 0, hb.x); D2(w.z, 1, hb.y); D2(w.w, 0, hb.z); D2(w.w, 1, hb.w);
#undef D2
    return s;
}
#define EX_AXPY(ACC, W0, W1, CC) do { \
    ACC[0][0] = __builtin_elementwise_fma(fp8lo((W0).x), CC, ACC[0][0]); ACC[0][1] = __builtin_elementwise_fma(fp8hi((W0).x), CC, ACC[0][1]); \
    ACC[0][2] = __builtin_elementwise_fma(fp8lo((W0).y), CC, ACC[0][2]); ACC[0][3] = __builtin_elementwise_fma(fp8hi((W0).y), CC, ACC[0][3]); \
    ACC[0][4] = __builtin_elementwise_fma(fp8lo((W0).z), CC, ACC[0][4]); ACC[0][5] = __builtin_elementwise_fma(fp8hi((W0).z), CC, ACC[0][5]); \
    ACC[0][6] = __builtin_elementwise_fma(fp8lo((W0).w), CC, ACC[0][6]); ACC[0][7] = __builtin_elementwise_fma(fp8hi((W0).w), CC, ACC[0][7]); \
    ACC[1][0] = __builtin_elementwise_fma(fp8lo((W1).x), CC, ACC[1][0]); ACC[1][1] = __builtin_elementwise_fma(fp8hi((W1).x), CC, ACC[1][1]); \
    ACC[1][2] = __builtin_elementwise_fma(fp8lo((W1).y), CC, ACC[1][2]); ACC[1][3] = __builtin_elementwise_fma(fp8hi((W1).y), CC, ACC[1][3]); \
    ACC[1][4] = __builtin_elementwise_fma(fp8lo((W1).z), CC, ACC[1][4]); ACC[1][5] = __builtin_elementwise_fma(fp8hi((W1).z), CC, ACC[1][5]); \
    ACC[1][6] = __builtin_elementwise_fma(fp8lo((W1).w), CC, ACC[1][6]); ACC[1][7] = __builtin_elementwise_fma(fp8hi((W1).w), CC, ACC[1][7]); } while (0)
__device__ __forceinline__ void phase_experts3(const Args& A, const Ctx& C, float* dst, unsigned emask) {
    const bf16* H2 = (const bf16*)(A.ws + WS_H); const unsigned char* WUP = A.ws + WS_WUP; const unsigned char* WDN = A.ws + WS_WDN;
    const float* SUP = (const float*)(A.ws + WS_SUP); const float* SDN = (const float*)(A.ws + WS_SDN);
    const int* IDX = (const int*)(A.ws + WS_IDX); const float* GW = (const float*)(A.ws + WS_GW); const float* mod = (const float*)(A.ws + WS_MOD);
    LAS unsigned char* hb = (LAS unsigned char*)C.lds + C.wave * EX_LDS_WAVE;
    LAS unsigned* keys = (LAS unsigned*)(hb + 8192);
    for (int tg = C.gw; tg < T / 4; tg += C.ngw) {
        unsigned z_ = 0u; asm volatile("" : "+v"(z_));
        int lane = (int)__builtin_amdgcn_mbcnt_hi(~0u, __builtin_amdgcn_mbcnt_lo(~0u, z_));
        const int t0 = 4 * tg;
        float hs4[4];
        {
#pragma unroll
          for (int tk = 0; tk < 4; ++tk) {
              float hv[2][16]; float am = 0.f;
#pragma unroll
              for (int j = 0; j < 2; ++j) { const v4u a = *(const v4u*)(H2 + (size_t)(t0 + tk) * D + 16 * lane + 1024 * j), b = *(const v4u*)(H2 + (size_t)(t0 + tk) * D + 16 * lane + 1024 * j + 8);
                  hv[j][0] = bflo(a.x); hv[j][1] = bfhi(a.x); hv[j][2] = bflo(a.y); hv[j][3] = bfhi(a.y); hv[j][4] = bflo(a.z); hv[j][5] = bfhi(a.z); hv[j][6] = bflo(a.w); hv[j][7] = bfhi(a.w);
                  hv[j][8] = bflo(b.x); hv[j][9] = bfhi(b.x); hv[j][10] = bflo(b.y); hv[j][11] = bfhi(b.y); hv[j][12] = bflo(b.z); hv[j][13] = bfhi(b.z); hv[j][14] = bflo(b.w); hv[j][15] = bfhi(b.w);
#pragma unroll
                  for (int q = 0; q < 16; ++q) am = fmaxf(am, fabsf(hv[j][q])); }
#pragma unroll
              for (int o = 1; o < 64; o <<= 1) am = fmaxf(am, __shfl_xor(am, o));
              const float sc = (am > 0.f) ? 127.0f / am : 0.f; hs4[tk] = am * (1.0f / 127.0f);
#pragma unroll
              for (int j = 0; j < 2; ++j) { v4u o;
                  o.x = pack_i8x4(hv[j][0] * sc, hv[j][1] * sc, hv[j][2] * sc, hv[j][3] * sc); o.y = pack_i8x4(hv[j][4] * sc, hv[j][5] * sc, hv[j][6] * sc, hv[j][7] * sc);
                  o.z = pack_i8x4(hv[j][8] * sc, hv[j][9] * sc, hv[j][10] * sc, hv[j][11] * sc); o.w = pack_i8x4(hv[j][12] * sc, hv[j][13] * sc, hv[j][14] * sc, hv[j][15] * sc);
                  *(LAS v4u*)(hb + tk * 2048 + 16 * lane + 1024 * j) = o; } }
        }
        LAS unsigned* keysM = keys + 512;
        LAS float* cfl = (LAS float*)(keys + 1024);
        unsigned K[8];
#pragma unroll
        for (int s = 0; s < 8; ++s) { const int tk = s >> 1, slot = lane + 64 * (s & 1); const unsigned e = (unsigned)IDX[(size_t)(t0 + tk) * PEER_HK + slot];
            K[s] = ((unsigned)tk << 21) | (e << 7) | (unsigned)slot; }
#define EX_SORT512(KK) do { _Pragma("unroll") for (int k = 2; k <= 512; k <<= 1) { _Pragma("unroll") for (int j = k >> 1; j >= 1; j >>= 1) { \
            if (j >= 64) { const int ds = j >> 6; _Pragma("unroll") for (int s = 0; s < 8; ++s) if ((s & ds) == 0) { const bool up = ((64 * s) & k) == 0; \
                    const unsigned a_ = min(KK[s], KK[s | ds]), b_ = max(KK[s], KK[s | ds]); KK[s] = up ? a_ : b_; KK[s | ds] = up ? b_ : a_; } } \
            else { const bool lower = (lane & j) == 0; _Pragma("unroll") for (int s = 0; s < 8; ++s) { const unsigned o = __shfl_xor(KK[s], j); const bool up = ((lane + 64 * s) & k) == 0; \
                    KK[s] = (up == lower) ? min(KK[s], o) : max(KK[s], o); } } } } } while (0)
        EX_SORT512(K);
#pragma unroll
        for (int s = 0; s < 8; ++s) { const int p = lane + 64 * s; keys[(p & 127) * 4 + (p >> 7)] = K[s]; }
        asm volatile("" : "+v"(lane));
#pragma unroll
        for (int s = 0; s < 8; ++s) { const int tk = s >> 1, slot = lane + 64 * (s & 1); const unsigned e = (unsigned)IDX[(size_t)(t0 + tk) * PEER_HK + slot];
            K[s] = (e << 9) | ((unsigned)tk << 7) | (unsigned)slot; }
        EX_SORT512(K);
#pragma unroll
        for (int s = 0; s < 8; ++s) keysM[lane + 64 * s] = K[s];
#undef EX_SORT512
        asm volatile("s_waitcnt lgkmcnt(0)" ::: "memory");
        asm volatile("" : "+v"(lane));
        constexpr int EX_NB = 128;
        {
            const int gq_ = lane >> 4, li_ = lane & 15;
            v4u bw[2][8]; unsigned kcur = keysM[gq_];
#define EX_UP_LD(KW, BUF) do { const unsigned char* r_ = WUP + (size_t)(((KW) >> 9) & emask) * D + 16 * li_; \
            _Pragma("unroll") for (int q_ = 0; q_ < 8; ++q_) bw[BUF][q_] = *(const v4u*)(r_ + 256 * q_); } while (0)
#define EX_UP_STEP(B, CUR) do { \
            const unsigned knext = keysM[4 * (((B) + 1 < EX_NB) ? (B) + 1 : (B)) + gq_]; \
            EX_UP_LD(knext, (CUR) ^ 1); \
            const unsigned me = kcur >> 9, mtok = (kcur >> 7) & 3u, mslot = kcur & 127u; \
            const float gg = GW[(size_t)(t0 + (int)mtok) * PEER_HK + mslot], su = SUP[me], sd = SDN[me]; \
            LAS unsigned char* hr = hb + mtok * 2048 + 16 * li_; int s0_ = 0, s1_ = 0; \
            _Pragma("unroll") for (int q_ = 0; q_ < 8; q_ += 2) { const v4u h0 = *(LAS v4u*)(hr + 256 * q_), h1 = *(LAS v4u*)(hr + 256 * q_ + 256); \
                s0_ += dot16_i8(bw[CUR][q_], h0); s1_ += dot16_i8(bw[CUR][q_ + 1], h1); } \
            unsigned s_ = (unsigned)(s0_ + s1_); \
            s_ += dpp_u<0x128>(s_); s_ += dpp_u<0x124>(s_); s_ += dpp_u<0x122>(s_); s_ += dpp_u<0x121>(s_);            \
            const float hs_ = (mtok == 0u) ? hs4[0] : (mtok == 1u) ? hs4[1] : (mtok == 2u) ? hs4[2] : hs4[3]; \
            cfl[mtok * 128u + mslot] = gg * sd * gelu_as((float)(int)s_ * su * hs_); \
            kcur = knext; } while (0)
            EX_UP_LD(kcur, 0);
            for (int b = 0; b < EX_NB; b += 2) { EX_UP_STEP(b, 0); EX_UP_STEP(b + 1, 1); }
#undef EX_UP_LD
#undef EX_UP_STEP
        }
        asm volatile("s_waitcnt lgkmcnt(0)" ::: "memory");
        asm volatile("" : "+v"(lane));
        const int bb = t0 / SEQ;
        constexpr int EX_DB = 2;
        LAS unsigned* rowT = keys + 1536;
        LAS float* cfT = (LAS float*)(keys + 2048);
#pragma unroll
        for (int s = 0; s < 8; ++s) { const int q_ = lane + 64 * s; const unsigned kk_ = keys[q_]; const unsigned e_ = ((kk_ >> 7) & 16383u) & emask;
            rowT[q_] = e_ * (unsigned)D; cfT[q_] = cfl[(q_ & 3) * 128 + (int)(kk_ & 127u)]; }
        asm volatile("s_waitcnt lgkmcnt(0)" ::: "memory");
#define EX_AXPY1(ACC, W0, CC) do { \
    ACC[0] = __builtin_elementwise_fma(fp8lo((W0).x), CC, ACC[0]); ACC[1] = __builtin_elementwise_fma(fp8hi((W0).x), CC, ACC[1]); \
    ACC[2] = __builtin_elementwise_fma(fp8lo((W0).y), CC, ACC[2]); ACC[3] = __builtin_elementwise_fma(fp8hi((W0).y), CC, ACC[3]); } while (0)
#define EX_RO(W) ((unsigned)__builtin_amdgcn_readfirstlane((int)(W)))
#define EX_DN_LD(J, BQ, BUF) do { _Pragma("unroll") for (int bb_ = 0; bb_ < EX_DB; ++bb_) { const v4u rv = *(LAS v4u*)(rowT + 4 * ((BQ) + bb_)); \
            bd[BUF][bb_][0] = ldrow8(WDN + EX_RO(rv.x), voff_ + 512u * (J)); bd[BUF][bb_][1] = ldrow8(WDN + EX_RO(rv.y), voff_ + 512u * (J)); \
            bd[BUF][bb_][2] = ldrow8(WDN + EX_RO(rv.z), voff_ + 512u * (J)); bd[BUF][bb_][3] = ldrow8(WDN + EX_RO(rv.w), voff_ + 512u * (J)); } } while (0)
#define EX_DN_STEP(J, B, CUR) do { \
            EX_DN_LD(J, (((B) + EX_DB < EX_NB) ? (B) + EX_DB : (B)), (CUR) ^ 1); \
            _Pragma("unroll") for (int bb_ = 0; bb_ < EX_DB; ++bb_) { const f32x4 cv = *(LAS f32x4*)(cfT + 4 * ((B) + bb_)); \
                { const f2v cc = {cv.x, cv.x}; EX_AXPY1(a0, bd[CUR][bb_][0], cc); } \
                { const f2v cc = {cv.y, cv.y}; EX_AXPY1(a1, bd[CUR][bb_][1], cc); } \
                { const f2v cc = {cv.z, cv.z}; EX_AXPY1(a2, bd[CUR][bb_][2], cc); } \
                { const f2v cc = {cv.w, cv.w}; EX_AXPY1(a3, bd[CUR][bb_][3], cc); } } } while (0)
#define EX_OUT1(TK, ACC, J) do { _Pragma("unroll") for (int q = 0; q < 2; ++q) { const int col = 8 * lane + 512 * (J) + 4 * q; \
            const f32x4 g = *(const f32x4*)(mod + bb * MODW + 5 * D + col); f32x4 x = *(const f32x4*)(A.out + (size_t)(t0 + TK) * D + col); \
            x.x += g.x * ACC[2 * q].x; x.y += g.y * ACC[2 * q].y; x.z += g.z * ACC[2 * q + 1].x; x.w += g.w * ACC[2 * q + 1].y; *(f32x4*)(dst + (size_t)(t0 + TK) * D + col) = x; } } while (0)
#define EX_DN_PASS(J) do { v2u bd[2][EX_DB][4]; const unsigned voff_ = 8u * (unsigned)lane; f2v a0[4], a1[4], a2[4], a3[4]; \
            _Pragma("unroll") for (int q = 0; q < 4; ++q) { a0[q] = (f2v){0.f, 0.f}; a1[q] = (f2v){0.f, 0.f}; a2[q] = (f2v){0.f, 0.f}; a3[q] = (f2v){0.f, 0.f}; } \
            EX_DN_LD(J, 0, 0); \
            for (int b = 0; b < EX_NB; b += 2 * EX_DB) { EX_DN_STEP(J, b, 0); EX_DN_STEP(J, b + EX_DB, 1); } \
            EX_OUT1(0, a0, J); EX_OUT1(1, a1, J); EX_OUT1(2, a2, J); EX_OUT1(3, a3, J); } while (0)
        EX_DN_PASS(0);
        asm volatile("" : "+v"(lane));
        EX_DN_PASS(1);
        asm volatile("" : "+v"(lane));
        EX_DN_PASS(2);
        asm volatile("" : "+v"(lane));
        EX_DN_PASS(3);
#undef EX_DN_PASS
#undef EX_DN_LD
#undef EX_RO
#undef EX_DN_STEP
#undef EX_AXPY1
#undef EX_OUT1
        asm volatile("s_waitcnt lgkmcnt(0)" ::: "memory");
    }
}

constexpr int CONV_TT = 16;
__device__ __forceinline__ void wave_reduce16(float (&v)[16], int lane) {
    const bool b5 = lane & 32, b4 = lane & 16, b3 = lane & 8, b2 = lane & 4;
#pragma unroll
    for (int k = 0; k < 8; ++k) { const float keep = b5 ? v[k + 8] : v[k], send = b5 ? v[k] : v[k + 8]; v[k] = keep + __shfl_xor(send, 32); }
#pragma unroll
    for (int k = 0; k < 4; ++k) { const float keep = b4 ? v[k + 4] : v[k], send = b4 ? v[k] : v[k + 4]; v[k] = keep + __shfl_xor(send, 16); }
#pragma unroll
    for (int k = 0; k < 2; ++k) { const float keep = b3 ? v[k + 2] : v[k], send = b3 ? v[k] : v[k + 2]; v[k] = keep + __shfl_xor(send, 8); }
    { const float keep = b2 ? v[1] : v[0], send = b2 ? v[0] : v[1]; v[0] = keep + __shfl_xor(send, 4); }
    v[0] += __shfl_xor(v[0], 2); v[0] += __shfl_xor(v[0], 1);
}
__device__ __forceinline__ void phase_conv(const Args& A, const Ctx& C) {
    const bf16* U = (const bf16*)(A.ws + WS_U); bf16* UCV = (bf16*)(A.ws + WS_UCV);
    const float* dw = A.in[I_CDW]; const float* db = A.in[I_CDB]; const float* lg = A.in[I_CLNG]; const float* lb = A.in[I_CLNB];
    LAS float* red = (LAS float*)((LAS unsigned char*)C.lds);
    const int c0 = 2 * C.tid, lane = C.lane;
    float w0[CONV_K], w1[CONV_K];
#pragma unroll
    for (int j = 0; j < CONV_K; ++j) { const float2 w = *(const float2*)(dw + j * CONV_CH + c0); w0[j] = w.x; w1[j] = w.y; }
    const float2 bias = *(const float2*)(db + c0), gam = *(const float2*)(lg + c0), bet = *(const float2*)(lb + c0);
    const int tsel = ((lane >> 5) & 1) * 8 + ((lane >> 4) & 1) * 4 + ((lane >> 3) & 1) * 2 + ((lane >> 2) & 1);
    for (int it = C.bid; it < T / CONV_TT; it += C.nb) {
        const int t0 = it * CONV_TT, s0 = t0 % SEQ;
        unsigned in[CONV_TT + CONV_K - 1];
#pragma unroll
        for (int q = 0; q < CONV_TT + CONV_K - 1; ++q) { const int sp = s0 - (CONV_K - 1) + q;
            in[q] = (sp >= 0) ? *(const unsigned*)(U + (size_t)(t0 - (CONV_K - 1) + q) * CONV_CH + c0) : 0u; }
        float a0[CONV_TT], a1[CONV_TT];
#pragma unroll
        for (int k = 0; k < CONV_TT; ++k) { float x0 = bias.x, x1 = bias.y;
#pragma unroll
            for (int j = 0; j < CONV_K; ++j) { x0 += w0[j] * bflo(in[k + j]); x1 += w1[j] * bfhi(in[k + j]); }
            a0[k] = x0; a1[k] = x1; }
        float v[16];
#pragma unroll
        for (int k = 0; k < 16; ++k) v[k] = a0[k] + a1[k];
        wave_reduce16(v, lane);
        __syncthreads();
        if ((lane & 3) == 0) red[C.wave * 16 + tsel] = v[0];
        __syncthreads();
        float mean[16];
#pragma unroll
        for (int k = 0; k < 16; ++k) { float s = 0.f;
#pragma unroll
            for (int wv = 0; wv < NWAVES; ++wv) s += red[wv * 16 + k];
            mean[k] = s * (1.0f / CONV_CH); }
#pragma unroll
        for (int k = 0; k < 16; ++k) { a0[k] -= mean[k]; a1[k] -= mean[k]; v[k] = a0[k] * a0[k] + a1[k] * a1[k]; }
        wave_reduce16(v, lane);
        __syncthreads();
        if ((lane & 3) == 0) red[C.wave * 16 + tsel] = v[0];
        __syncthreads();
#pragma unroll
        for (int k = 0; k < 16; ++k) { float s = 0.f;
#pragma unroll
            for (int wv = 0; wv < NWAVES; ++wv) s += red[wv * 16 + k];
            const float rstd = 1.0f / sqrtf(s * (1.0f / CONV_CH) + EPS);
            const float y0 = a0[k] * rstd * gam.x + bet.x, y1 = a1[k] * rstd * gam.y + bet.y;
            *(unsigned*)(UCV + (size_t)(t0 + k) * CONV_CH + c0) = pk2(siluf_(y0), siluf_(y1)); }
    }
    __syncthreads();
}

typedef short v4i16_t __attribute__((ext_vector_type(4)));
constexpr int VROW = 288;
constexpr int ATT_V_BYTES = 256 * VROW;
constexpr int KROW = 272;
constexpr int ATT_K_OFF = ATT_V_BYTES;
constexpr int ATT_SCR_OFF = ATT_V_BYTES + 256 * KROW;
__device__ __forceinline__ void phase_attn(const Args& A, const Ctx& C) {
    const bf16* QKV = (const bf16*)(A.ws + WS_QKV); bf16* ON = (bf16*)(A.ws + WS_ON); float* DEN = (float*)(A.ws + WS_DEN);
    const float* qg = A.in[I_QNG]; const float* kg = A.in[I_KNG];
    LAS unsigned char* Vb = (LAS unsigned char*)C.lds;
    LAS unsigned char* Kb = Vb + ATT_K_OFF;
    LAS float* scr = (LAS float*)(Vb + ATT_SCR_OFF + C.wave * 256);
    unsigned z0_ = 0u; asm volatile("" : "+v"(z0_));
    const int lane = (int)__builtin_amdgcn_mbcnt_hi(~0u, __builtin_amdgcn_mbcnt_lo(~0u, z0_)), c = lane & 15, kq = lane >> 4, w = C.wave, i0 = 16 * w;
    constexpr float C2 = 0.08838834764831845f * 1.4426950408889634f;
#define ATT_DECODE(U, B_, GI_, HH_, R_, N_, DIL_) const int B_ = (U) / 384, GI_ = ((U) % 384) >> 7; const int DIL_ = (GI_ == 0) ? 1 : (GI_ == 1) ? 4 : 16; \
        const int nbk##B_ = (GI_ == 0) ? 32 : (GI_ == 1) ? 8 : 2; const int rem2##B_ = ((U) % 384) & 127; const int HH_ = rem2##B_ / (DIL_ * nbk##B_), r2##B_ = rem2##B_ % (DIL_ * nbk##B_), R_ = r2##B_ / nbk##B_, N_ = r2##B_ % nbk##B_;
#define ATT_LOAD(KD, VD, QD, RB_, N_, DIL_, HEAD_) do { unsigned zz_ = 0u; asm volatile("" : "+v"(zz_)); const int tid_ = C.wave * 64 + (int)__builtin_amdgcn_mbcnt_hi(~0u, __builtin_amdgcn_mbcnt_lo(~0u, zz_)); const int lb_ = 128 * (N_) - 128; \
        _Pragma("unroll") for (int k_ = 0; k_ < 8; ++k_) { const int idx_ = tid_ + NTHREADS * k_; int l_ = lb_ + (idx_ >> 4); l_ = l_ < 0 ? 0 : l_; \
            const bf16* rp_ = QKV + ((RB_) + (size_t)l_ * (DIL_)) * QKVW + (HEAD_) * HD + (idx_ & 15) * 8; KD[k_] = *(const v4u*)(rp_ + AW); VD[k_] = *(const v4u*)(rp_ + 2 * AW); } \
        { const bf16* qrow_ = QKV + ((RB_) + (size_t)(128 * (N_) + i0 + (tid_ & 15)) * (DIL_)) * QKVW + (HEAD_) * HD + 8 * ((tid_ & 63) >> 4); \
          _Pragma("unroll") for (int ks_ = 0; ks_ < 4; ++ks_) QD[ks_] = *(const v4u*)(qrow_ + 32 * ks_); } } while (0)
#define ATT_STORE(KD, VD) do { unsigned zz_ = 0u; asm volatile("" : "+v"(zz_)); const int tid_ = C.wave * 64 + (int)__builtin_amdgcn_mbcnt_hi(~0u, __builtin_amdgcn_mbcnt_lo(~0u, zz_)); _Pragma("unroll") for (int k_ = 0; k_ < 8; ++k_) { const int idx_ = tid_ + NTHREADS * k_; \
            *(LAS v4u*)(Kb + (idx_ >> 4) * KROW + (idx_ & 15) * 16) = KD[k_]; *(LAS v4u*)(Vb + (idx_ >> 4) * VROW + (idx_ & 15) * 16) = VD[k_]; } } while (0)
    v4u knext[8], vnext[8], qnext[4], qraw[4];
    if (C.bid < 768) { ATT_DECODE(C.bid, b0_, gi0_, hh0_, r0_, n0_, dil0_); ATT_LOAD(knext, vnext, qraw, (size_t)b0_ * SEQ + r0_, n0_, dil0_, gi0_ * 4 + hh0_); ATT_STORE(knext, vnext); }
    for (int u = C.bid; u < 768; u += C.nb) {
        ATT_DECODE(u, b, gi, hh, r, n, dil);
        const int head = gi * 4 + hh;
        const size_t rowbase = (size_t)b * SEQ + r;
        const int lb = 128 * n - 128;
        __syncthreads();
        const int un = u + C.nb; const bool hasn = un < 768;
        if (hasn) { ATT_DECODE(un, bn_, gin_, hhn_, rn_, nn_, diln_); ATT_LOAD(knext, vnext, qnext, (size_t)bn_ * SEQ + rn_, nn_, diln_, gin_ * 4 + hhn_); }
        pg8::bf16x8 qf[4];
        { float ss = 0.f;
#pragma unroll
          for (int ks = 0; ks < 4; ++ks) { const v4u rw = qraw[ks];
              const float a0 = bflo(rw.x), a1 = bfhi(rw.x), a2 = bflo(rw.y), a3 = bfhi(rw.y), a4 = bflo(rw.z), a5 = bfhi(rw.z), a6 = bflo(rw.w), a7 = bfhi(rw.w);
              ss += (a0 * a0 + a1 * a1) + (a2 * a2 + a3 * a3) + (a4 * a4 + a5 * a5) + (a6 * a6 + a7 * a7); }
          ss += __shfl_xor(ss, 16); ss += __shfl_xor(ss, 32);
          const float rq = 1.0f / sqrtf(ss * (1.0f / HD) + EPS);
#pragma unroll
          for (int ks = 0; ks < 4; ++ks) { const int d0 = head * HD + 32 * ks + 8 * kq; const v4u rw = qraw[ks];
              const f32x4 g0 = *(const f32x4*)(qg + d0) * *(const f32x4*)(kg + d0), g1 = *(const f32x4*)(qg + d0 + 4) * *(const f32x4*)(kg + d0 + 4);
              pg8::u32x4 pk;
              pk.x = pg8::cvt_pk_bf16(bflo(rw.x) * rq * g0.x, bfhi(rw.x) * rq * g0.y); pk.y = pg8::cvt_pk_bf16(bflo(rw.y) * rq * g0.z, bfhi(rw.y) * rq * g0.w);
              pk.z = pg8::cvt_pk_bf16(bflo(rw.z) * rq * g1.x, bfhi(rw.z) * rq * g1.y); pk.w = pg8::cvt_pk_bf16(bflo(rw.w) * rq * g1.z, bfhi(rw.w) * rq * g1.w);
              qf[ks] = __builtin_bit_cast(pg8::bf16x8, pk); } }
        unsigned Pk[10][2]; float dsum = 0.f;
#pragma unroll
        for (int kb = 0; kb < 9; ++kb) {
            const int j0 = i0 + 16 * kb;
            v4u kr[4];
#pragma unroll
            for (int ks = 0; ks < 4; ++ks) kr[ks] = *(const LAS v4u*)(Kb + (j0 + c) * KROW + 64 * ks + 16 * kq);
            float ss = 0.f;
#pragma unroll
            for (int ks = 0; ks < 4; ++ks) { const v4u k4 = kr[ks];
                const float a0 = bflo(k4.x), a1 = bfhi(k4.x), a2 = bflo(k4.y), a3 = bfhi(k4.y), a4 = bflo(k4.z), a5 = bfhi(k4.z), a6 = bflo(k4.w), a7 = bfhi(k4.w);
                ss += (a0 * a0 + a1 * a1) + (a2 * a2 + a3 * a3) + (a4 * a4 + a5 * a5) + (a6 * a6 + a7 * a7); }
            ss += __shfl_xor(ss, 16); ss += __shfl_xor(ss, 32);
            const float rk = C2 / sqrtf(ss * (1.0f / HD) + EPS);
            if (kq == 0) scr[(kb & 1) * 16 + c] = rk;
            const f32x4 rk4 = *(const LAS f32x4*)(scr + (kb & 1) * 16 + 4 * kq);
            f32x4 acc = {0.f, 0.f, 0.f, 0.f};
#pragma unroll
            for (int ks = 0; ks < 4; ++ks) acc = __builtin_amdgcn_mfma_f32_16x16x32_bf16(__builtin_bit_cast(pg8::bf16x8, kr[ks]), qf[ks], acc, 0, 0, 0);
#pragma unroll
            for (int e = 0; e < 4; ++e) { const int j = j0 + 4 * kq + e; const int dist = 128 + i0 + c - j;
                const bool valid = (dist >= 0) && (dist <= 128) && (lb + j >= 0);
                const float pv = __builtin_amdgcn_exp2f(acc[e] * rk4[e]);
                acc[e] = valid ? pv : 0.f; dsum += acc[e]; }
            Pk[kb][0] = pg8::cvt_pk_bf16(acc[0], acc[1]); Pk[kb][1] = pg8::cvt_pk_bf16(acc[2], acc[3]);
        }
        Pk[9][0] = 0u; Pk[9][1] = 0u;
        dsum += __shfl_xor(dsum, 16); dsum += __shfl_xor(dsum, 32);
        if (kq == 0) scr[32 + c] = dsum;
        const f32x4 dq = *(const LAS f32x4*)(scr + 32 + 4 * kq);
        f32x4 O[8];
#pragma unroll
        for (int dt = 0; dt < 8; ++dt) O[dt] = (f32x4){0.f, 0.f, 0.f, 0.f};
#pragma unroll
        for (int s = 0; s < 5; ++s) {
            pg8::u32x4 pk; pk.x = Pk[2 * s][0]; pk.y = Pk[2 * s][1]; pk.z = Pk[2 * s + 1][0]; pk.w = Pk[2 * s + 1][1];
            const pg8::bf16x8 pf = __builtin_bit_cast(pg8::bf16x8, pk);
            const int kb1 = (2 * s + 1 < 9) ? 2 * s + 1 : 8;
            const int rowA = i0 + 32 * s + 4 * kq + (c >> 2), rowB = i0 + 16 * kb1 + 4 * kq + (c >> 2);
            LAS unsigned char* pa = Vb + rowA * VROW + (c & 3) * 8; LAS unsigned char* pb = Vb + rowB * VROW + (c & 3) * 8;
#pragma unroll
            for (int dt = 0; dt < 8; ++dt) {
                const v4i16_t lo = __builtin_amdgcn_ds_read_tr16_b64_v4i16((LAS v4i16_t*)(pa + dt * 32));
                const v4i16_t hi = __builtin_amdgcn_ds_read_tr16_b64_v4i16((LAS v4i16_t*)(pb + dt * 32));
                const pg8::bf16x8 vf = {lo[0], lo[1], lo[2], lo[3], hi[0], hi[1], hi[2], hi[3]};
                O[dt] = __builtin_amdgcn_mfma_f32_16x16x32_bf16(pf, vf, O[dt], 0, 0, 0);
            }
        }
        { float inv[4];
#pragma unroll
          for (int e = 0; e < 4; ++e) inv[e] = 1.0f / dq[e];
#pragma unroll
          for (int e = 0; e < 4; ++e) { const size_t trow = rowbase + (size_t)(128 * n + i0 + 4 * kq + e) * dil;
              bf16* op = ON + ((size_t)gi * T + trow) * AOW + hh * HD + c;
#pragma unroll
              for (int dt = 0; dt < 8; ++dt) op[16 * dt] = (bf16)f2bf(O[dt][e] * inv[e]); }
          { unsigned zq_ = 0u; asm volatile("" : "+v"(zq_)); const int l2_ = (int)__builtin_amdgcn_mbcnt_hi(~0u, __builtin_amdgcn_mbcnt_lo(~0u, zq_));
            if ((l2_ >> 4) == 0) DEN[((size_t)gi * T + rowbase + (size_t)(128 * n + 16 * C.wave + (l2_ & 15)) * dil) * 4 + hh] = dsum; } }
        __syncthreads();
        if (hasn) { ATT_STORE(knext, vnext);
#pragma unroll
            for (int ks = 0; ks < 4; ++ks) qraw[ks] = qnext[ks]; }
    }
#undef ATT_DECODE
#undef ATT_LOAD
#undef ATT_STORE
}
__device__ __forceinline__ void phase_attn_combine(const Args& A, const Ctx& C) {
    const bf16* ON = (const bf16*)(A.ws + WS_ON); const float* DEN = (const float*)(A.ws + WS_DEN); bf16* O = (bf16*)(A.ws + WS_O);
    const int gt = C.bid * NTHREADS + C.tid, ngt = C.nb * NTHREADS;
    for (int i = gt; i < T * (AOW / 8); i += ngt) {
        const int t = i >> 6, ch = i & 63, hh = ch >> 4;
        const float d0 = DEN[((size_t)0 * T + t) * 4 + hh], d1 = DEN[((size_t)1 * T + t) * 4 + hh], d2 = DEN[((size_t)2 * T + t) * 4 + hh];
        const float inv = 1.0f / (d0 + d1 + d2); const float w0 = d0 * inv, w1 = d1 * inv, w2 = d2 * inv;
        const v4u a = *(const v4u*)(ON + ((size_t)0 * T + t) * AOW + ch * 8), bq = *(const v4u*)(ON + ((size_t)1 * T + t) * AOW + ch * 8), cq = *(const v4u*)(ON + ((size_t)2 * T + t) * AOW + ch * 8);
        v4u o;
        o.x = pk2(w0 * bflo(a.x) + w1 * bflo(bq.x) + w2 * bflo(cq.x), w0 * bfhi(a.x) + w1 * bfhi(bq.x) + w2 * bfhi(cq.x));
        o.y = pk2(w0 * bflo(a.y) + w1 * bflo(bq.y) + w2 * bflo(cq.y), w0 * bfhi(a.y) + w1 * bfhi(bq.y) + w2 * bfhi(cq.y));
        o.z = pk2(w0 * bflo(a.z) + w1 * bflo(bq.z) + w2 * bflo(cq.z), w0 * bfhi(a.z) + w1 * bfhi(bq.z) + w2 * bfhi(cq.z));
        o.w = pk2(w0 * bflo(a.w) + w1 * bflo(bq.w) + w2 * bflo(cq.w), w0 * bfhi(a.w) + w1 * bfhi(bq.w) + w2 * bfhi(cq.w));
        *(v4u*)(O + (size_t)t * AOW + ch * 8) = o;
    }
}

__global__ void __launch_bounds__(NTHREADS, 2) mk_fwd(Args args) {
    extern __shared__ __attribute__((aligned(16))) unsigned char lds[];
    Ctx C;
    C.tid = threadIdx.x; C.lane = C.tid & 63; C.wave = __builtin_amdgcn_readfirstlane(C.tid >> 6);
    C.bid = blockIdx.x; C.nb = gridDim.x; C.gw = C.bid * NWAVES + C.wave; C.ngw = C.nb * NWAVES; C.lds = lds;
    volatile LAS unsigned* MISC = (volatile LAS unsigned*)((LAS unsigned char*)lds + MISC_OFF);
    if (C.tid < 32) MISC[C.tid] = 0u;
    __syncthreads();
    unsigned* ctl = (unsigned*)(args.ws + WS_CTL);
    XcdBarrier bar; bar.bar = ctl + CW_BAR; bar.x = 0; bar.st = nullptr;
    const int lo = args.ph_lo, hi = args.ph_hi;
    if (hi - lo > 1) bar = xcd_barrier_post(ctl + CW_BAR, MISC + 8);
    bar.wave = C.wave;
#define IN(k) (lo <= (k) && (k) < hi)
#define SEAM(k) do { if (IN(k) && IN((k) + 1)) xcd_barrier(bar); } while (0)
    unsigned char* ws = args.ws;
    const float* mod = (const float*)(ws + WS_MOD);
#define REP(k) for (int rep_ = 0; rep_ < ((PROBE_DUP == (k)) ? 2 : 1); ++rep_)
#define FRESH_CTX() do { unsigned z_ = 0u; asm volatile("" : "+v"(z_)); C.lane = (int)__builtin_amdgcn_mbcnt_hi(~0u, __builtin_amdgcn_mbcnt_lo(~0u, z_)); C.tid = C.wave * 64 + C.lane; } while (0)
    if (IN(0)) { FRESH_CTX(); REP(0) phase_prologue(args, C); } SEAM(0);
    if (IN(1)) { FRESH_CTX(); REP(1) phase_norm_mod<true>(args.in[I_X], args.in[I_N1G], mod, 0, 1, (bf16*)(ws + WS_H), C); } SEAM(1);
    LAS unsigned char* ldsl = (LAS unsigned char*)lds;
    if (IN(2)) { FRESH_CTX(); REP(2) { pg8::Gemm g{(const bf16*)(ws + WS_H), (const bf16*)(ws + WS_WIN), T, IN_COLS, D / 2}; pg8::StaticOrder S; S.init(T, IN_COLS, C.nb, C.bid);
                 pg8::EpiIn E{(bf16*)(ws + WS_U), (bf16*)(ws + WS_QKV), (bf16*)(ws + WS_G), 0, 1.0f / WIN_SCALE};
                 pg8::gemm_phase<pg8::EpiIn, pg8::StaticOrder, false, true, true>(ldsl, g, S, E, C.wave); }
                 { constexpr int NT6 = (T / 256) * (IN_COLS / 256) % 256;
                   if (C.nb == 256 && NT6 > 0) { if (C.bid >= NT6) late_transposes(args, C, lds, (C.bid - NT6) * NWAVES + C.wave, (256 - NT6) * NWAVES); }
                   else late_transposes(args, C, lds, C.gw, C.ngw); } } SEAM(2);
    if (IN(3)) { FRESH_CTX(); REP(3) { phase_conv(args, C); phase_attn(args, C); } } SEAM(3);
    if (IN(4)) { FRESH_CTX(); phase_attn_combine(args, C);
                 pg8::Gemm g{(const bf16*)(ws + WS_UCV), (const bf16*)(ws + WS_WCO), T, D, CONV_CH}; pg8::StaticOrder S; S.init(T, D, C.nb, C.bid);
                 pg8::EpiYconv E{(const bf16*)(ws + WS_G), (bf16*)(ws + WS_MERGED), args.in[I_BCO]};
                 pg8::gemm_phase<pg8::EpiYconv, pg8::StaticOrder, true, true>(ldsl, g, S, E, C.wave); } SEAM(4);
    if (IN(5)) { FRESH_CTX(); REP(5) { pg8::Gemm g{(const bf16*)(ws + WS_O), (const bf16*)(ws + WS_WAO), T, D, AOW}; pg8::StaticOrder S; S.init(T, D, C.nb, C.bid);
                 pg8::EpiYattn E{(const bf16*)(ws + WS_G), (const bf16*)(ws + WS_MERGED), ws + WS_QP, MG_SCALE};
                 pg8::gemm_phase<pg8::EpiYattn, pg8::StaticOrder, true, true>(ldsl, g, S, E, C.wave); } } SEAM(5);
    if (IN(6)) { FRESH_CTX(); REP(6) { pg8::Gemm g{(const bf16*)(ws + WS_QP), (const bf16*)(ws + WS_WOUT), T, D, D / 2}; pg8::StaticOrder S; S.init(T, D, C.nb, C.bid);
                 pg8::EpiOut E{args.in[I_X], mod, args.out, 1.0f / (MG_SCALE * WIN_SCALE)};
                 pg8::gemm_phase<pg8::EpiOut, pg8::StaticOrder, true, true, true>(ldsl, g, S, E, C.wave); } } SEAM(6);
    if (IN(7)) { FRESH_CTX(); REP(7) phase_norm_mod<false>(args.out, args.in[I_N2G], mod, 3, 4, (bf16*)(ws + WS_H), C); } SEAM(7);
    if (IN(8)) { FRESH_CTX(); REP(8) { pg8::Gemm g{(const bf16*)(ws + WS_H), (const bf16*)(ws + WS_WQ), T, D, D}; pg8::StaticOrder S; S.init(T, D, C.nb, C.bid);
                 pg8::EpiPlain E{(bf16*)(ws + WS_QP), D};
                 pg8::gemm_phase<pg8::EpiPlain, pg8::StaticOrder, true, true>(ldsl, g, S, E, C.wave); } } SEAM(8);
    if (IN(9)) { FRESH_CTX(); REP(9) phase_topk(args, C); } SEAM(9);
    if (IN(10)) { FRESH_CTX(); for (int rep_ = (PROBE_DUP == 10) ? 0 : 1; rep_ < 2; ++rep_) phase_experts3(args, C, rep_ ? args.out : (float*)(ws + WS_MERGED), rep_ ? 0xFFFFFFFFu : PROBE_EMASK); }
#undef REP
#undef IN
#undef SEAM
}

extern "C" void kernel_launch(void* const* d_in, const int* in_sizes, int n_in, void* d_out, int out_size, void* d_ws, size_t ws_size, hipStream_t stream) {
    static int grid = 0;
    if (grid == 0) {
        if (n_in != 21 || in_sizes[0] != T * D || out_size != T * D || ws_size < WS_END) {
            fprintf(stderr, "kernel_launch: unexpected shapes: n_in %d in0 %d out %d ws %zu (need %zu)\n", n_in, n_in > 0 ? in_sizes[0] : -1, out_size, ws_size, (size_t)WS_END); grid = -1; return; }
        int dev = 0, cus = 0, per_cu = 0;
        if (hipGetDevice(&dev) != hipSuccess || hipDeviceGetAttribute(&cus, hipDeviceAttributeMultiprocessorCount, dev) != hipSuccess) { grid = -1; return; }
        if (hipFuncSetAttribute((const void*)mk_fwd, hipFuncAttributeMaxDynamicSharedMemorySize, LDS_BYTES) != hipSuccess) { fprintf(stderr, "kernel_launch: hipFuncSetAttribute failed\n"); grid = -1; return; }
        if (hipOccupancyMaxActiveBlocksPerMultiprocessor(&per_cu, (const void*)mk_fwd, NTHREADS, LDS_BYTES) != hipSuccess || per_cu < 1)
            fprintf(stderr, "kernel_launch: note: occupancy query reports %d\n", per_cu);
        (void)hipGetLastError();
        grid = cus;
    }
    if (grid < 0) return;
    (void)hipMemsetAsync((char*)d_ws + WS_CTL, 0, CTL_ZERO_BYTES, stream);
    Args a{};
    for (int i = 0; i < 21; ++i) a.in[i] = (const float*)d_in[i];
    a.out = (float*)d_out; a.ws = (unsigned char*)d_ws;
#if N_LAUNCH_MODE == 1
    a.ph_lo = 0; a.ph_hi = NPHASES;
    hipLaunchKernelGGL(mk_fwd, dim3(grid), dim3(NTHREADS), LDS_BYTES, stream, a);
#else
    for (int p = 0; p < NPHASES; ++p) { a.ph_lo = p; a.ph_hi = p + 1; hipLaunchKernelGGL(mk_fwd, dim3(grid), dim3(NTHREADS), LDS_BYTES, stream, a); }
#endif
}
```

```cpp
#include <hip/hip_runtime.h>
#include <cstdio>
#include <cstdint>
#include <cmath>

constexpr int BATCH = 2, SEQ = 4096, D = 2048, T = BATCH * SEQ;
constexpr int CONV_CH = 1024, CONV_K = 31;
constexpr int HD = 128, NHEADS = 12, AW = 1536, AOW = 512;
constexpr int OFF_Q = 2048, OFF_G = OFF_Q + 3 * AW, IN_COLS = OFF_G + 2 * D;
constexpr int QKVW = 3 * AW;
constexpr int PEER_H = 8, PEER_NK = 128, PEER_TOPK = 16, PEER_HK = PEER_H * PEER_TOPK;
constexpr int PEER_E = PEER_NK * PEER_NK;
constexpr int MODW = 6 * D;
constexpr float EPS = 1e-6f;
constexpr int NWAVES = 8, NTHREADS = NWAVES * 64;
#ifndef N_LAUNCH_MODE
#define N_LAUNCH_MODE 1
#endif
constexpr int NPHASES = 11;
#ifndef PROBE_EMASK
#define PROBE_EMASK 0xFFFFFFFFu
#endif
#ifndef PROBE_DUP
#define PROBE_DUP (-1)
#endif
#ifndef MFMA_MASK
#define MFMA_MASK 31
#endif
#ifndef P2_SPLIT
#define P2_SPLIT 0
#endif

constexpr size_t MiB = 1u << 20;
constexpr size_t WS_CTL = 0, CTL_ZERO_BYTES = 64 * 1024;
constexpr size_t WS_MOD = 1 * MiB;
constexpr size_t WS_SK = 1 * MiB + 512 * 1024;
constexpr size_t WS_WIN = 2 * MiB;
constexpr size_t WS_WCO = 44 * MiB;
constexpr size_t WS_WAO = 48 * MiB;
constexpr size_t WS_WOUT = 50 * MiB;
constexpr size_t WS_WQ = 58 * MiB;
constexpr size_t WS_WUP = 66 * MiB;
constexpr size_t WS_WDN = 130 * MiB;
constexpr size_t WS_SUP = 98 * MiB, WS_SDN = 98 * MiB + 65536;
constexpr size_t WS_H = 194 * MiB;
constexpr size_t WS_U = 226 * MiB;
constexpr size_t WS_QKV = 242 * MiB;
constexpr size_t WS_G = 314 * MiB;
constexpr size_t WS_UCV = 378 * MiB;
constexpr size_t WS_ON = 394 * MiB;
constexpr size_t WS_DEN = 418 * MiB;
constexpr size_t WS_O = 419 * MiB;
constexpr size_t WS_MERGED = 427 * MiB;
constexpr size_t WS_QP = 459 * MiB;
constexpr size_t WS_IDX = 491 * MiB;
constexpr size_t WS_GW = 495 * MiB;
constexpr size_t WS_END = 500 * MiB;
constexpr int CW_BAR = 4096;
constexpr int TK_W = 4;
constexpr int UP_TAIL_ROWS = 4096;
constexpr float MG_SCALE = 16.0f;
constexpr float WIN_SCALE = 256.0f;

constexpr int LDS_BYTES = 147456 + 512;
constexpr int RING_BYTES = 131072, MISC_OFF = 147456 + 64;

#define GAS __attribute__((address_space(1)))
#define LAS __attribute__((address_space(3)))
typedef unsigned short bf16;
typedef unsigned v4u __attribute__((ext_vector_type(4)));
typedef unsigned v2u __attribute__((ext_vector_type(2)));
typedef float f32x4 __attribute__((ext_vector_type(4)));
#define RLX_AGENT __ATOMIC_RELAXED, __HIP_MEMORY_SCOPE_AGENT

__device__ __forceinline__ unsigned f2bf(float f) { unsigned u = __builtin_bit_cast(unsigned, f); return (u + 0x7fffu + ((u >> 16) & 1u)) >> 16; }
__device__ __forceinline__ unsigned pk2(float lo, float hi) { return f2bf(lo) | (f2bf(hi) << 16); }
__device__ __forceinline__ float bf2f(unsigned b) { return __builtin_bit_cast(float, b << 16); }
__device__ __forceinline__ float bflo(unsigned w) { return __builtin_bit_cast(float, w << 16); }
__device__ __forceinline__ float bfhi(unsigned w) { return __builtin_bit_cast(float, w & 0xffff0000u); }
__device__ __forceinline__ float wave_sum(float v) {
#pragma unroll
    for (int o = 1; o < 64; o <<= 1) v += __shfl_xor(v, o);
    return v;
}
__device__ __forceinline__ float sigmoidf_(float x) { return 1.0f / (1.0f + __expf(-x)); }
__device__ __forceinline__ float siluf_(float x) { return x / (1.0f + __expf(-x)); }
__device__ __forceinline__ float gelu_erf(float x) { return 0.5f * x * (1.0f + erff(x * 0.70710678118654752f)); }

__device__ __forceinline__ int lane_id() { return (int)__builtin_amdgcn_mbcnt_hi(~0u, __builtin_amdgcn_mbcnt_lo(~0u, 0u)); }
#define XB_TMO      128
#define XB_XCNT(j)  (256  + 64 * (j))
#define XB_XSUB(j)  (1280 + 64 * (j))
#define XB_XGEN(j)  (2304 + 64 * (j))
#define XB_TOP      3328
#define XB_TOPGEN   3392
#define XCD_BAR_WORDS 3456
#define XB_SPIN_CAP (1u << 22)
__device__ __forceinline__ unsigned xb_ld(unsigned* p)              { return __hip_atomic_load(p, __ATOMIC_RELAXED, __HIP_MEMORY_SCOPE_AGENT); }
__device__ __forceinline__ unsigned xb_add(unsigned* p, unsigned v) { return __hip_atomic_fetch_add(p, v, __ATOMIC_RELAXED, __HIP_MEMORY_SCOPE_AGENT); }
__device__ __forceinline__ unsigned xb_xcc_id() { return (unsigned)__builtin_amdgcn_s_getreg((3 << 11) | 20) & 0xFu; }
#define XB_SPIN(cond, bar) do { unsigned _sp = 0; while (cond) { __builtin_amdgcn_s_sleep(1); \
    if ((++_sp & 255u) == 0u) { if (xb_ld(&(bar)[XB_TMO])) break; if (_sp > XB_SPIN_CAP) { atomicAdd(&(bar)[XB_TMO], 1u); break; } } } } while (0)
struct XcdBarrier { unsigned* bar; unsigned x; volatile LAS unsigned* st; int wave; };
__device__ __forceinline__ XcdBarrier xcd_barrier_post(unsigned* bar, volatile LAS unsigned* st) {
    XcdBarrier b; b.bar = bar; b.x = xb_xcc_id(); b.st = st; b.wave = 0;
    if (threadIdx.x == 0) (void)xb_add(&bar[XB_XCNT(b.x)], 1u);
    return b;
}
__device__ __forceinline__ void xcd_barrier_complete(unsigned* bar, unsigned x, unsigned& nloc, unsigned& nx) {
    const unsigned G = gridDim.x * gridDim.y * gridDim.z;
    unsigned sum, cnt, mine, sp = 0u;
    for (;;) {
        sum = 0u; cnt = 0u; mine = 0u;
#pragma unroll
        for (unsigned j = 0; j < 16; ++j) { const unsigned c = xb_ld(&bar[XB_XCNT(j)]); sum += c; cnt += (c > 0u) ? 1u : 0u; mine = (j == x) ? c : mine; }
        if (sum == G) break;
        __builtin_amdgcn_s_sleep(1);
        if ((++sp & 255u) == 0u) { if (xb_ld(&bar[XB_TMO])) break; if (sp > XB_SPIN_CAP) { atomicAdd(&bar[XB_TMO], 1u); break; } }
    }
    nloc = mine > 0u ? mine : 1u; nx = cnt > 0u ? cnt : 1u;
}
__device__ __forceinline__ void xcd_barrier(const XcdBarrier& b) {
    asm volatile("s_waitcnt vmcnt(0)" ::: "memory");
    __syncthreads();
    if (b.wave == 0 && lane_id() == 0) {
        unsigned* bar = b.bar;
        __builtin_amdgcn_s_waitcnt(0);
        unsigned nloc = b.st[0], nx = b.st[1];
        if (nloc == 0u) { xcd_barrier_complete(bar, b.x, nloc, nx); b.st[0] = nloc; b.st[1] = nx; }
        const unsigned old = xb_add(&bar[XB_XSUB(b.x)], 1u);
        const unsigned gen = old / nloc;
        if (old + 1u == (gen + 1u) * nloc) {
            __builtin_amdgcn_fence(__ATOMIC_RELEASE, "agent");
            asm volatile("s_waitcnt vmcnt(0)" ::: "memory");
            const unsigned og = xb_add(&bar[XB_TOP], 1u);
            const unsigned tg = og / nx;
            if (og + 1u == (tg + 1u) * nx) xb_add(&bar[XB_TOPGEN], 1u);
            else XB_SPIN(xb_ld(&bar[XB_TOPGEN]) == tg, bar);
            __builtin_amdgcn_fence(__ATOMIC_ACQUIRE, "agent");
            xb_add(&bar[XB_XGEN(b.x)], 1u);
            asm volatile("s_waitcnt vmcnt(0)" ::: "memory");
        } else {
            XB_SPIN(xb_ld(&bar[XB_XGEN(b.x)]) == gen, bar);
            __builtin_amdgcn_fence(__ATOMIC_ACQUIRE, "agent");
            asm volatile("s_waitcnt vmcnt(0)" ::: "memory");
        }
    }
    __syncthreads();
}

namespace pg8 {
#define PG8_LAS __attribute__((address_space(3)))
typedef unsigned short bf16_t;
typedef short bf16x8 __attribute__((ext_vector_type(8)));
typedef float f32x4 __attribute__((ext_vector_type(4)));
typedef unsigned u32x4 __attribute__((ext_vector_type(4)));
constexpr int BM = 256, BK = 64, HALF = 128, HTB = HALF * BK * 2  , STAGE_BYTES = 8 * HTB, NXCD = 8, WGM = 16;

__host__ __device__ __forceinline__ int lds_byte(int r, int c) { const int st = (r >> 4) * 2 + (c >> 5), rr = r & 15, cc = c & 31, ob = rr * 64 + cc * 2; return st * 1024 + (ob ^ (((ob >> 9) & 1) << 5)); }
__host__ __device__ __forceinline__ void stage_rc(int b, int& R, int& C) { const int st = b / 1024, sb = b % 1024, swz = sb ^ (((sb >> 9) & 1) << 5); R = (st >> 1) * 16 + swz / 64; C = (st & 1) * 32 + (swz % 64) / 2; }
__host__ __device__ __forceinline__ int perm32(int rho) { const int n = rho >> 4, i = rho & 15; return 8 * (i >> 2) + 4 * n + (i & 3); }

struct Unit { int pm, pn; };
struct Gemm { const bf16_t* A; const bf16_t* Bt; int M, N, K; };

struct StaticOrder {
    int nM, nN, nwg, G, c;
    __host__ __device__ void init(int M, int N, int G_, int c_) { nM = M / BM; nN = N / BM; nwg = nM * nN; G = G_; c = c_; }
    __host__ __device__ bool next(int i, Unit& u) const {
        const long L = (long)i * G + c; if (L >= nwg) return false;
        int wgid = (int)L; { const int q = nwg / NXCD, r = nwg % NXCD, xcd = wgid % NXCD, off = wgid / NXCD; wgid = (xcd < r ? xcd * (q + 1) : r * (q + 1) + (xcd - r) * q) + off; }
        const int nig = WGM * nN, gid = wgid / nig, fm = gid * WGM, gsz = (nM - fm) < WGM ? (nM - fm) : WGM;
        u.pm = fm + ((wgid % nig) % gsz); u.pn = (wgid % nig) / gsz; return true;
    }
    __device__ __forceinline__ void a_ready(const Unit&) const {}
    __device__ __forceinline__ void done(const Unit&) const {}
};

typedef float f32x2_t __attribute__((ext_vector_type(2))); typedef __bf16 bf16x2_t __attribute__((ext_vector_type(2)));
__device__ __forceinline__ unsigned cvt_pk_bf16(float lo, float hi) { f32x2_t v = {lo, hi}; bf16x2_t b = __builtin_convertvector(v, bf16x2_t); return __builtin_bit_cast(unsigned, b); }
typedef float f32x2 __attribute__((ext_vector_type(2)));
typedef int v8i_t __attribute__((ext_vector_type(8)));
struct Frag32 { bf16x8 lo, hi; };
template <class Epi, class Sched, bool ALIGN_EPI = false, bool SP2 = false, bool FP8 = false>
__device__ __forceinline__ void gemm_phase(PG8_LAS unsigned char* lds, const Gemm g, const Sched& S, const Epi& E, int wave_idx) {
    const int wid = wave_idx, lane = lane_id(), tid = wid * 64 + lane, wr = wid >> 2, wc = wid & 3, fr = lane & 15, fq = lane >> 4;
    const int K = g.K, nt = K / BK;
    unsigned voffA[2], voffB[2];
#pragma unroll
    for (int i = 0; i < 2; ++i) { int R, C; stage_rc(tid * 16 + i * 8192, R, C); const int Rb = Epi::PERM ? ((R & ~31) + perm32(R & 31)) : R;
        voffA[i] = (unsigned)(R * K + C) * 2u; voffB[i] = (unsigned)(Rb * K + C) * 2u; }
    const size_t kstep = (size_t)(BK * 2);
    const size_t hstep = (size_t)HALF * K * 2;
    const size_t tstep = 2 * hstep;
    const unsigned ldsw = (unsigned)wid * 1024u;
    const int aoff = lds_byte(wr * 64 + fr, fq * 8), boff = lds_byte(wc * 32 + fr, fq * 8);
#define PG8_SA(b, h) (((b) * 2 + (h)) * HTB)
#define PG8_SB(b, h) ((4 + (b) * 2 + (h)) * HTB)
#define PG8_STAGE(bufoff, gbase, voff) do { _Pragma("unroll") for (int _i = 0; _i < 2; ++_i) { unsigned vo_ = (voff)[_i]; asm volatile("" : "+v"(vo_));     \
        __builtin_amdgcn_global_load_lds((const unsigned*)((const char*)(gbase) + vo_), (PG8_LAS unsigned*)(lds + (bufoff) + ldsw + _i * 8192), 16, 0, 0); } } while (0)
#define PG8_LDA(dst, b, h) do { _Pragma("unroll") for (int m = 0; m < 4; ++m) { const bf16x8 lo_ = *(const PG8_LAS bf16x8*)(lds + PG8_SA(b, h) + aoff + m * 2048), hi_ = *(const PG8_LAS bf16x8*)(lds + PG8_SA(b, h) + aoff + m * 2048 + 1024); dst[m] = __builtin_bit_cast(v8i_t, (Frag32){lo_, hi_}); } } while (0)
#define PG8_LDB(dst, b, h) do { _Pragma("unroll") for (int n = 0; n < 2; ++n) { const bf16x8 lo_ = *(const PG8_LAS bf16x8*)(lds + PG8_SB(b, h) + boff + n * 2048), hi_ = *(const PG8_LAS bf16x8*)(lds + PG8_SB(b, h) + boff + n * 2048 + 1024); dst[n] = __builtin_bit_cast(v8i_t, (Frag32){lo_, hi_}); } } while (0)
#define PG8_MMA(ai, bj, At, Bt) do { __builtin_amdgcn_s_setprio(1); \
        if constexpr (FP8) { _Pragma("unroll") for (int m = 0; m < 4; ++m) _Pragma("unroll") for (int n = 0; n < 2; ++n) \
            acc[ai][bj][m][n] = __builtin_amdgcn_mfma_scale_f32_16x16x128_f8f6f4(Bt[n], At[m], acc[ai][bj][m][n], 0, 0, 0, 0x7F7F7F7F, 0, 0x7F7F7F7F); } \
        else { _Pragma("unroll") for (int m = 0; m < 4; ++m) _Pragma("unroll") for (int n = 0; n < 2; ++n) { const Frag32 fa_ = __builtin_bit_cast(Frag32, At[m]), fb_ = __builtin_bit_cast(Frag32, Bt[n]); \
            acc[ai][bj][m][n] = __builtin_amdgcn_mfma_f32_16x16x32_bf16(fb_.lo, fa_.lo, acc[ai][bj][m][n], 0, 0, 0); acc[ai][bj][m][n] = __builtin_amdgcn_mfma_f32_16x16x32_bf16(fb_.hi, fa_.hi, acc[ai][bj][m][n], 0, 0, 0); } } \
        __builtin_amdgcn_s_setprio(0); } while (0)
#define PG8_WAIT_V(n) asm volatile("s_waitcnt vmcnt(" #n ")" ::: "memory")
#define PG8_WAIT_L(n) asm volatile("s_waitcnt lgkmcnt(" #n ")" ::: "memory")
#define PG8_BAR __builtin_amdgcn_s_barrier()
#define PG8_SCHED __builtin_amdgcn_sched_barrier(0)
    Unit cur, nxt; int ui = 0;
    if (!S.next(0, cur)) return;
    f32x4 acc[2][2][4][2];
#pragma unroll
    for (int a = 0; a < 2; ++a)
#pragma unroll
        for (int b = 0; b < 2; ++b)
#pragma unroll
            for (int m = 0; m < 4; ++m)
#pragma unroll
                for (int n = 0; n < 2; ++n) acc[a][b][m][n] = (f32x4){0.f, 0.f, 0.f, 0.f};
    v8i_t At[4], B0[2], B1[2];
    const char* cA = (const char*)g.A + (size_t)cur.pm * tstep; const char* cB = (const char*)g.Bt + (size_t)cur.pn * tstep;
    S.a_ready(cur);
    if constexpr (SP2) {
        PG8_STAGE(PG8_SB(0, 0), cB, voffB); PG8_STAGE(PG8_SB(0, 1), cB + hstep, voffB); PG8_STAGE(PG8_SA(0, 0), cA, voffA); PG8_STAGE(PG8_SA(0, 1), cA + hstep, voffA);
        if (wr == 1) PG8_BAR;
        PG8_WAIT_V(2); PG8_BAR;
        PG8_STAGE(PG8_SB(1, 0), cB + kstep, voffB); PG8_STAGE(PG8_SA(1, 0), cA + kstep, voffA); PG8_STAGE(PG8_SB(1, 1), cB + hstep + kstep, voffB);
        PG8_WAIT_V(6); PG8_BAR;
    } else {
        PG8_STAGE(PG8_SB(0, 0), cB, voffB); PG8_STAGE(PG8_SA(0, 0), cA, voffA); PG8_STAGE(PG8_SB(0, 1), cB + hstep, voffB); PG8_STAGE(PG8_SA(0, 1), cA + hstep, voffA);
        if (wr == 1) PG8_BAR;
        PG8_WAIT_V(4); PG8_BAR;
        PG8_STAGE(PG8_SB(1, 0), cB + kstep, voffB); PG8_STAGE(PG8_SA(1, 0), cA + kstep, voffA); PG8_STAGE(PG8_SB(1, 1), cB + hstep + kstep, voffB);
        PG8_WAIT_V(6); PG8_BAR;
    }
    for (;;) {
        const bool has_next = S.next(ui + 1, nxt);
        const char* nA = has_next ? (const char*)g.A + (size_t)nxt.pm * tstep : cA; const char* nB = has_next ? (const char*)g.Bt + (size_t)nxt.pn * tstep : cB;
        for (int t = 0; t < nt; t += 2) {
            const bool last = (t == nt - 2);
            const char* a1 = cA + (size_t)(t + 1) * kstep;
            const char* a2 = last ? nA : cA + (size_t)(t + 2) * kstep; const char* b2 = last ? nB : cB + (size_t)(t + 2) * kstep;
            const char* a3 = a2 + kstep; const char* b3 = b2 + kstep;
            if (last && has_next) S.a_ready(nxt);
            if constexpr (SP2) {
            PG8_LDB(B0, 0, 0); PG8_LDB(B1, 0, 1); PG8_SCHED; PG8_LDA(At, 0, 0); PG8_STAGE(PG8_SA(1, 1), a1 + hstep, voffA);
            PG8_WAIT_V(8); PG8_WAIT_L(0); PG8_BAR; PG8_MMA(0, 0, At, B0); PG8_MMA(0, 1, At, B1); PG8_BAR; PG8_SCHED;
            PG8_LDA(At, 0, 1); PG8_STAGE(PG8_SB(0, 0), b2, voffB); PG8_STAGE(PG8_SB(0, 1), b2 + hstep, voffB); PG8_STAGE(PG8_SA(0, 0), a2, voffA);
            PG8_WAIT_V(8); PG8_WAIT_L(0); PG8_BAR; PG8_MMA(1, 0, At, B0); PG8_MMA(1, 1, At, B1); PG8_BAR; PG8_SCHED;
            PG8_LDB(B0, 1, 0); PG8_LDB(B1, 1, 1); PG8_SCHED; PG8_LDA(At, 1, 0); PG8_STAGE(PG8_SA(0, 1), a2 + hstep, voffA);
            PG8_WAIT_V(8); PG8_WAIT_L(0); PG8_BAR; PG8_MMA(0, 0, At, B0); PG8_MMA(0, 1, At, B1); PG8_BAR; PG8_SCHED;
            PG8_LDA(At, 1, 1); PG8_STAGE(PG8_SB(1, 0), b3, voffB); PG8_STAGE(PG8_SB(1, 1), b3 + hstep, voffB); PG8_STAGE(PG8_SA(1, 0), a3, voffA);
            PG8_WAIT_V(8); PG8_WAIT_L(0); PG8_BAR; PG8_MMA(1, 0, At, B0); PG8_MMA(1, 1, At, B1); PG8_BAR; PG8_SCHED;
            } else {
            PG8_LDB(B0, 0, 0); PG8_SCHED; PG8_LDA(At, 0, 0); PG8_STAGE(PG8_SA(1, 1), a1 + hstep, voffA);
            PG8_WAIT_L(8); PG8_BAR; PG8_WAIT_L(0); PG8_MMA(0, 0, At, B0); PG8_BAR; PG8_SCHED;
            PG8_LDB(B1, 0, 1); PG8_STAGE(PG8_SB(0, 0), b2, voffB);
            PG8_BAR; PG8_WAIT_L(0); PG8_MMA(0, 1, At, B1); PG8_BAR;
            PG8_LDA(At, 0, 1); PG8_STAGE(PG8_SA(0, 0), a2, voffA);
            PG8_BAR; PG8_WAIT_L(0); PG8_MMA(1, 0, At, B0); PG8_BAR; PG8_SCHED;
            PG8_STAGE(PG8_SB(0, 1), b2 + hstep, voffB);
            PG8_WAIT_V(6); PG8_BAR; PG8_MMA(1, 1, At, B1); PG8_BAR;
            PG8_LDB(B0, 1, 0); PG8_SCHED; PG8_LDA(At, 1, 0); PG8_STAGE(PG8_SA(0, 1), a2 + hstep, voffA);
            PG8_WAIT_L(8); PG8_BAR; PG8_WAIT_L(0); PG8_MMA(0, 0, At, B0); PG8_BAR; PG8_SCHED;
            PG8_LDB(B1, 1, 1); PG8_STAGE(PG8_SB(1, 0), b3, voffB);
            PG8_BAR; PG8_WAIT_L(0); PG8_MMA(0, 1, At, B1); PG8_BAR;
            PG8_LDA(At, 1, 1); PG8_STAGE(PG8_SA(1, 0), a3, voffA);
            PG8_BAR; PG8_WAIT_L(0); PG8_MMA(1, 0, At, B0); PG8_BAR; PG8_SCHED;
            PG8_STAGE(PG8_SB(1, 1), b3 + hstep, voffB);
            PG8_WAIT_V(6); PG8_BAR; PG8_MMA(1, 1, At, B1); PG8_BAR;
            }
        }
        if constexpr (ALIGN_EPI) { if (wr == 0) PG8_BAR; }
        if constexpr (!Epi::AFTER_DRAIN) { E(acc, cur, wr, wc, fr, fq); S.done(cur); }
        if (!has_next) break;
#pragma unroll
        for (int a = 0; a < 2; ++a)
#pragma unroll
            for (int b = 0; b < 2; ++b)
#pragma unroll
                for (int m = 0; m < 4; ++m)
#pragma unroll
                    for (int n = 0; n < 2; ++n) acc[a][b][m][n] = (f32x4){0.f, 0.f, 0.f, 0.f};
        cur = nxt; cA = nA; cB = nB; ++ui;
        if constexpr (ALIGN_EPI) { if (wr == 1) PG8_BAR; }
    }
    PG8_WAIT_V(0);
    if constexpr (!ALIGN_EPI) { if (wr == 0) PG8_BAR; }
    PG8_BAR;
    if constexpr (Epi::AFTER_DRAIN) { E.fused(acc, cur, wr, wc, fr, fq, lds, wid, lane); S.done(cur); }
#undef PG8_SA
#undef PG8_SB
#undef PG8_STAGE
#undef PG8_LDA
#undef PG8_LDB
#undef PG8_MMA
#undef PG8_WAIT_V
#undef PG8_WAIT_L
#undef PG8_BAR
#undef PG8_SCHED
}
}

namespace pg8 {
__device__ __forceinline__ float fsig(float x) { return __builtin_amdgcn_rcpf(1.0f + __expf(-x)); }
__device__ __forceinline__ u32x4 pack8(const f32x4& v0, const f32x4& v1) { u32x4 w; w.x = cvt_pk_bf16(v0[0], v0[1]); w.y = cvt_pk_bf16(v0[2], v0[3]); w.z = cvt_pk_bf16(v1[0], v1[1]); w.w = cvt_pk_bf16(v1[2], v1[3]); return w; }
__device__ __forceinline__ float blo(unsigned w) { return __builtin_bit_cast(float, w << 16); }
__device__ __forceinline__ float bhi(unsigned w) { return __builtin_bit_cast(float, w & 0xffff0000u); }
struct EpiIn {
    static constexpr bool PERM = true, AFTER_DRAIN = false;
    bf16_t *U, *QKV, *G; int pn0; float osc;
    __device__ __forceinline__ void operator()(const f32x4 (&acc)[2][2][4][2], const Unit& u0, int wr, int wc, int fr, int fq) const {
        Unit u; u.pm = u0.pm; u.pn = u0.pn + pn0;
        const int row0 = u.pm * BM + wr * 64 + fr, cw = wc * 32 + 8 * fq;
        if (u.pn < 8) {
#pragma unroll
            for (int ai = 0; ai < 2; ++ai)
#pragma unroll
                for (int m = 0; m < 4; ++m) { const size_t row = row0 + ai * HALF + m * 16;
                    f32x4 v0 = acc[ai][0][m][0] * osc, v1 = acc[ai][0][m][1] * osc; const f32x4 g0 = acc[ai][1][m][0] * osc, g1 = acc[ai][1][m][1] * osc;
#pragma unroll
                    for (int e = 0; e < 4; ++e) { v0[e] *= fsig(g0[e]); v1[e] *= fsig(g1[e]); }
                    *(u32x4*)(U + row * 1024 + 128 * u.pn + cw) = pack8(v0, v1); }
        } else if (u.pn < 26) {
#pragma unroll
            for (int ai = 0; ai < 2; ++ai)
#pragma unroll
                for (int m = 0; m < 4; ++m) { const size_t row = row0 + ai * HALF + m * 16;
#pragma unroll
                    for (int bj = 0; bj < 2; ++bj) *(u32x4*)(QKV + row * 4608 + (u.pn - 8) * 256 + bj * HALF + cw) = pack8(acc[ai][bj][m][0] * osc, acc[ai][bj][m][1] * osc); }
        } else {
#pragma unroll
            for (int ai = 0; ai < 2; ++ai)
#pragma unroll
                for (int m = 0; m < 4; ++m) { const size_t row = row0 + ai * HALF + m * 16;
#pragma unroll
                    for (int bj = 0; bj < 2; ++bj) { f32x4 v0 = acc[ai][bj][m][0] * osc, v1 = acc[ai][bj][m][1] * osc;
#pragma unroll
                        for (int e = 0; e < 4; ++e) { v0[e] = fsig(v0[e]); v1[e] = fsig(v1[e]); }
                        *(u32x4*)(G + row * 4096 + (u.pn - 26) * 256 + bj * HALF + cw) = pack8(v0, v1); } }
        }
    }
};
struct EpiYconv {
    static constexpr bool PERM = true, AFTER_DRAIN = false;
    const bf16_t* G; bf16_t* MG; const float* bias;
    __device__ __forceinline__ void operator()(const f32x4 (&acc)[2][2][4][2], const Unit& u, int wr, int wc, int fr, int fq) const {
        const int row0 = u.pm * BM + wr * 64 + fr, cw = wc * 32 + 8 * fq;
#pragma unroll
        for (int bj = 0; bj < 2; ++bj) { const int col = u.pn * 256 + bj * HALF + cw; const f32x4 b0 = *(const f32x4*)(bias + col), b1 = *(const f32x4*)(bias + col + 4);
#pragma unroll
            for (int ai = 0; ai < 2; ++ai)
#pragma unroll
                for (int m = 0; m < 4; ++m) { const size_t row = row0 + ai * HALF + m * 16;
                    const u32x4 g = *(const u32x4*)(G + row * 4096 + col);
                    f32x4 v0 = acc[ai][bj][m][0] + b0, v1 = acc[ai][bj][m][1] + b1;
                    v0[0] *= blo(g.x); v0[1] *= bhi(g.x); v0[2] *= blo(g.y); v0[3] *= bhi(g.y); v1[0] *= blo(g.z); v1[1] *= bhi(g.z); v1[2] *= blo(g.w); v1[3] *= bhi(g.w);
                    *(u32x4*)(MG + row * 2048 + col) = pack8(v0, v1); } }
    }
};
struct EpiYattn {
    static constexpr bool PERM = true, AFTER_DRAIN = false;
    const bf16_t* G; const bf16_t* MG; unsigned char* MG8; float msc;
    __device__ __forceinline__ void operator()(const f32x4 (&acc)[2][2][4][2], const Unit& u, int wr, int wc, int fr, int fq) const {
        const int row0 = u.pm * BM + wr * 64 + fr, cw = wc * 32 + 8 * fq;
#pragma unroll
        for (int ai = 0; ai < 2; ++ai)
#pragma unroll
            for (int m = 0; m < 4; ++m) { const size_t row = row0 + ai * HALF + m * 16;
#pragma unroll
                for (int bj = 0; bj < 2; ++bj) { const int col = u.pn * 256 + bj * HALF + cw; const u32x4 g = *(const u32x4*)(G + row * 4096 + 2048 + col); const u32x4 p = *(const u32x4*)(MG + row * 2048 + col);
                    f32x4 v0 = acc[ai][bj][m][0], v1 = acc[ai][bj][m][1];
                    v0[0] = (blo(p.x) + v0[0] * blo(g.x)) * msc; v0[1] = (bhi(p.x) + v0[1] * bhi(g.x)) * msc; v0[2] = (blo(p.y) + v0[2] * blo(g.y)) * msc; v0[3] = (bhi(p.y) + v0[3] * bhi(g.y)) * msc;
                    v1[0] = (blo(p.z) + v1[0] * blo(g.z)) * msc; v1[1] = (bhi(p.z) + v1[1] * bhi(g.z)) * msc; v1[2] = (blo(p.w) + v1[2] * blo(g.w)) * msc; v1[3] = (bhi(p.w) + v1[3] * bhi(g.w)) * msc;
                    int p0 = __builtin_amdgcn_cvt_pk_fp8_f32(v0[0], v0[1], 0, false); p0 = __builtin_amdgcn_cvt_pk_fp8_f32(v0[2], v0[3], p0, true);
                    int p1 = __builtin_amdgcn_cvt_pk_fp8_f32(v1[0], v1[1], 0, false); p1 = __builtin_amdgcn_cvt_pk_fp8_f32(v1[2], v1[3], p1, true);
                    typedef unsigned u32x2_ __attribute__((ext_vector_type(2))); *(u32x2_*)(MG8 + row * 2048 + col) = (u32x2_){(unsigned)p0, (unsigned)p1}; } }
    }
};
struct EpiOut {
    static constexpr bool PERM = false, AFTER_DRAIN = false;
    const float* x; const float* mod; float* out; float osc;
    __device__ __forceinline__ void operator()(const f32x4 (&acc)[2][2][4][2], const Unit& u, int wr, int wc, int fr, int fq) const {
        const int row0 = u.pm * BM + wr * 64 + fr, col0 = u.pn * BM + wc * 32 + 4 * fq; const int b = (u.pm * BM) / 4096;
#pragma unroll
        for (int bj = 0; bj < 2; ++bj)
#pragma unroll
            for (int n = 0; n < 2; ++n) { const int col = col0 + bj * HALF + n * 16; const f32x4 gt = *(const f32x4*)(mod + b * 12288 + 2 * 2048 + col) * osc;
#pragma unroll
                for (int ai = 0; ai < 2; ++ai)
#pragma unroll
                    for (int m = 0; m < 4; ++m) { const size_t off = (size_t)(row0 + ai * HALF + m * 16) * 2048 + col;
                        *(f32x4*)(out + off) = *(const f32x4*)(x + off) + gt * acc[ai][bj][m][n]; } }
    }
};
struct EpiPlain {
    static constexpr bool PERM = true, AFTER_DRAIN = false;
    bf16_t* O; int ldc;
    __device__ __forceinline__ void operator()(const f32x4 (&acc)[2][2][4][2], const Unit& u, int wr, int wc, int fr, int fq) const {
        const int row0 = u.pm * BM + wr * 64 + fr, cw = u.pn * BM + wc * 32 + 8 * fq;
#pragma unroll
        for (int ai = 0; ai < 2; ++ai)
#pragma unroll
            for (int m = 0; m < 4; ++m) { const size_t row = row0 + ai * HALF + m * 16;
#pragma unroll
                for (int bj = 0; bj < 2; ++bj) *(u32x4*)(O + row * ldc + bj * HALF + cw) = pack8(acc[ai][bj][m][0], acc[ai][bj][m][1]); }
    }
};
}

struct Args { const float* in[21]; float* out; unsigned char* ws; int ph_lo, ph_hi; };
enum { I_X = 0, I_C, I_N1G, I_N2G, I_WADA, I_BADA, I_WIN, I_CDW, I_CDB, I_CLNG, I_CLNB, I_WCO, I_BCO, I_QNG, I_KNG, I_WAO, I_WOUT, I_PWQ, I_PSK, I_PWUP, I_PWDN };

struct Ctx {
    int tid, lane, wave, bid, nb, gw, ngw;
    unsigned char* lds;
};

__device__ __forceinline__ int win_row(int n) {
    if (n < 1024) return (n >> 7) * 256 + (n & 127);
    if (n < 2048) { const int m = n - 1024; return (m >> 7) * 256 + 128 + (m & 127); }
    return n;
}
__device__ __forceinline__ void p0_transpose_item(const float* W, int K, int N, bf16* WT, bool perm, float* scr, int item, int lane) {
    const int nblk = N / 32, kb = item / nblk, nbi = item % nblk, k0 = 64 * kb, n0 = 32 * nbi;
#pragma unroll 8
    for (int i = 0; i < 32; ++i) { const int kk = 2 * i + (lane >> 5); scr[kk * 33 + (lane & 31)] = W[(size_t)(k0 + kk) * N + n0 + (lane & 31)]; }
    asm volatile("s_waitcnt lgkmcnt(0)" ::: "memory");
    const int c = lane & 7;
    const int r0 = perm ? win_row(n0) : n0;
#pragma unroll
    for (int j = 0; j < 4; ++j) { const int n = (lane >> 3) + 8 * j; const float* s = scr + (8 * c) * 33 + n;
        v4u o; o.x = pk2(s[0 * 33], s[1 * 33]); o.y = pk2(s[2 * 33], s[3 * 33]); o.z = pk2(s[4 * 33], s[5 * 33]); o.w = pk2(s[6 * 33], s[7 * 33]);
        *(v4u*)(WT + (size_t)(r0 + n) * K + k0 + 8 * c) = o; }
    asm volatile("s_waitcnt lgkmcnt(0)" ::: "memory");
}

__device__ __forceinline__ void p0_transpose_item_fp8(const float* W, int K, int N, unsigned char* WT, bool perm, float* scr, int item, int lane, float wsc) {
    const int nblk = N / 32, kb = item / nblk, nbi = item % nblk, k0 = 64 * kb, n0 = 32 * nbi;
#pragma unroll 8
    for (int i = 0; i < 32; ++i) { const int kk = 2 * i + (lane >> 5); scr[kk * 33 + (lane & 31)] = W[(size_t)(k0 + kk) * N + n0 + (lane & 31)] * wsc; }
    asm volatile("s_waitcnt lgkmcnt(0)" ::: "memory");
    const int c = lane & 3;
    const int r0 = perm ? win_row(n0) : n0;
#pragma unroll
    for (int j = 0; j < 2; ++j) { const int n = (lane >> 2) + 16 * j; const float* s = scr + (16 * c) * 33 + n; v4u o; unsigned* op = (unsigned*)&o;
#pragma unroll
        for (int q = 0; q < 4; ++q) { int p = __builtin_amdgcn_cvt_pk_fp8_f32(s[(4 * q) * 33], s[(4 * q + 1) * 33], 0, false);
            p = __builtin_amdgcn_cvt_pk_fp8_f32(s[(4 * q + 2) * 33], s[(4 * q + 3) * 33], p, true); op[q] = (unsigned)p; }
        *(v4u*)(WT + (size_t)(r0 + n) * K + k0 + 16 * c) = o; }
    asm volatile("s_waitcnt lgkmcnt(0)" ::: "memory");
}
__device__ __forceinline__ void cvt_stream(const float* src, bf16* dst, size_t n, const Ctx& C) {
    const size_t nv = n / 8;
    for (size_t i = (size_t)C.gw * 64 + C.lane; i < nv; i += (size_t)C.ngw * 64) {
        const f32x4 a = *(const f32x4*)(src + i * 8), b = *(const f32x4*)(src + i * 8 + 4);
        v4u o; o.x = pk2(a.x, a.y); o.y = pk2(a.z, a.w); o.z = pk2(b.x, b.y); o.w = pk2(b.z, b.w);
        *(v4u*)(dst + i * 8) = o;
    }
}

typedef float f2v __attribute__((ext_vector_type(2)));
__device__ __forceinline__ void cvt_rows_fp8(const float* src, unsigned char* dst, float* inv, int rows, const Ctx& C) {
    for (int r = C.gw; r < rows; r += C.ngw) {
        const float* sp = src + (size_t)r * D + 16 * C.lane;
        f32x4 v[2][4]; float am = 0.f;
#pragma unroll
        for (int j = 0; j < 2; ++j)
#pragma unroll
            for (int q = 0; q < 4; ++q) { v[j][q] = *(const f32x4*)(sp + 1024 * j + 4 * q);
                am = fmaxf(am, fmaxf(fmaxf(fabsf(v[j][q].x), fabsf(v[j][q].y)), fmaxf(fabsf(v[j][q].z), fabsf(v[j][q].w)))); }
#pragma unroll
        for (int o = 1; o < 64; o <<= 1) am = fmaxf(am, __shfl_xor(am, o));
        const int ex = (int)((__builtin_bit_cast(unsigned, am) >> 23) & 255u);
        const float sc = (ex == 0) ? 1.0f : __builtin_bit_cast(float, (unsigned)(127 + 7 + 127 - ex) << 23);
        const float isc = (ex == 0) ? 1.0f : __builtin_bit_cast(float, (unsigned)(ex - 7) << 23);
#pragma unroll
        for (int j = 0; j < 2; ++j) { v4u o; unsigned* op = (unsigned*)&o;
#pragma unroll
            for (int q = 0; q < 4; ++q) { int p = __builtin_amdgcn_cvt_pk_fp8_f32(v[j][q].x * sc, v[j][q].y * sc, 0, false);
                p = __builtin_amdgcn_cvt_pk_fp8_f32(v[j][q].z * sc, v[j][q].w * sc, p, true); op[q] = (unsigned)p; }
            *(v4u*)(dst + (size_t)r * D + 16 * C.lane + 1024 * j) = o; }
        if (C.lane == 0) inv[r] = isc;
    }
}

__device__ __forceinline__ unsigned pack_i8x4(float a, float b, float c, float d) {
    const int ia = (int)rintf(a), ib = (int)rintf(b), ic = (int)rintf(c), id = (int)rintf(d);
    return ((unsigned)ia & 255u) | (((unsigned)ib & 255u) << 8) | (((unsigned)ic & 255u) << 16) | ((unsigned)id << 24);
}
__device__ __forceinline__ void cvt_rows_i8(const float* src, unsigned char* dst, float* inv, int rows, const Ctx& C) {
    for (int r = C.gw; r < rows; r += C.ngw) {
        const float* sp = src + (size_t)r * D + 16 * C.lane;
        f32x4 v[2][4]; float am = 0.f;
#pragma unroll
        for (int j = 0; j < 2; ++j)
#pragma unroll
            for (int q = 0; q < 4; ++q) { v[j][q] = *(const f32x4*)(sp + 1024 * j + 4 * q);
                am = fmaxf(am, fmaxf(fmaxf(fabsf(v[j][q].x), fabsf(v[j][q].y)), fmaxf(fabsf(v[j][q].z), fabsf(v[j][q].w)))); }
#pragma unroll
        for (int o = 1; o < 64; o <<= 1) am = fmaxf(am, __shfl_xor(am, o));
        const float sc = (am > 0.f) ? 127.0f / am : 0.f;
#pragma unroll
        for (int j = 0; j < 2; ++j) { v4u o;
            o.x = pack_i8x4(v[j][0].x * sc, v[j][0].y * sc, v[j][0].z * sc, v[j][0].w * sc); o.y = pack_i8x4(v[j][1].x * sc, v[j][1].y * sc, v[j][1].z * sc, v[j][1].w * sc);
            o.z = pack_i8x4(v[j][2].x * sc, v[j][2].y * sc, v[j][2].z * sc, v[j][2].w * sc); o.w = pack_i8x4(v[j][3].x * sc, v[j][3].y * sc, v[j][3].z * sc, v[j][3].w * sc);
            *(v4u*)(dst + (size_t)r * D + 16 * C.lane + 1024 * j) = o; }
        if (C.lane == 0) inv[r] = am * (1.0f / 127.0f);
    }
}

struct RowCvt { f32x4 v[2][4]; };
__device__ __forceinline__ void rc_issue(RowCvt& rc, const float* src, int row, int lane) {
    const float* sp = src + (size_t)row * D + 16 * lane;
#pragma unroll
    for (int j = 0; j < 2; ++j)
#pragma unroll
        for (int q = 0; q < 4; ++q) rc.v[j][q] = *(const f32x4*)(sp + 1024 * j + 4 * q);
}
__device__ __forceinline__ float rc_amax(const RowCvt& rc) {
    float am = 0.f;
#pragma unroll
    for (int j = 0; j < 2; ++j)
#pragma unroll
        for (int q = 0; q < 4; ++q) am = fmaxf(am, fmaxf(fmaxf(fabsf(rc.v[j][q].x), fabsf(rc.v[j][q].y)), fmaxf(fabsf(rc.v[j][q].z), fabsf(rc.v[j][q].w))));
#pragma unroll
    for (int o = 1; o < 64; o <<= 1) am = fmaxf(am, __shfl_xor(am, o));
    return am;
}
__device__ __forceinline__ void rc_finish_fp8(const RowCvt& rc, unsigned char* dst, float* inv, int row, int lane) {
    const float am = rc_amax(rc);
    const int ex = (int)((__builtin_bit_cast(unsigned, am) >> 23) & 255u);
    const float sc = (ex == 0) ? 1.0f : __builtin_bit_cast(float, (unsigned)(127 + 7 + 127 - ex) << 23);
    const float isc = (ex == 0) ? 1.0f : __builtin_bit_cast(float, (unsigned)(ex - 7) << 23);
#pragma unroll
    for (int j = 0; j < 2; ++j) { v4u o; unsigned* op = (unsigned*)&o;
#pragma unroll
        for (int q = 0; q < 4; ++q) { int p = __builtin_amdgcn_cvt_pk_fp8_f32(rc.v[j][q].x * sc, rc.v[j][q].y * sc, 0, false);
            p = __builtin_amdgcn_cvt_pk_fp8_f32(rc.v[j][q].z * sc, rc.v[j][q].w * sc, p, true); op[q] = (unsigned)p; }
        *(v4u*)(dst + (size_t)row * D + 16 * lane + 1024 * j) = o; }
    if (lane == 0) inv[row] = isc;
}
__device__ __forceinline__ void rc_finish_i8(const RowCvt& rc, unsigned char* dst, float* inv, int row, int lane) {
    const float am = rc_amax(rc);
    const float sc = (am > 0.f) ? 127.0f / am : 0.f;
#pragma unroll
    for (int j = 0; j < 2; ++j) { v4u o;
        o.x = pack_i8x4(rc.v[j][0].x * sc, rc.v[j][0].y * sc, rc.v[j][0].z * sc, rc.v[j][0].w * sc); o.y = pack_i8x4(rc.v[j][1].x * sc, rc.v[j][1].y * sc, rc.v[j][1].z * sc, rc.v[j][1].w * sc);
        o.z = pack_i8x4(rc.v[j][2].x * sc, rc.v[j][2].y * sc, rc.v[j][2].z * sc, rc.v[j][2].w * sc); o.w = pack_i8x4(rc.v[j][3].x * sc, rc.v[j][3].y * sc, rc.v[j][3].z * sc, rc.v[j][3].w * sc);
        *(v4u*)(dst + (size_t)row * D + 16 * lane + 1024 * j) = o; }
    if (lane == 0) inv[row] = am * (1.0f / 127.0f);
}
__device__ __forceinline__ void phase_prologue(const Args& A, const Ctx& C) {
    unsigned char* ws = A.ws;
    float* mod = (float*)(ws + WS_MOD);
    {
        float* red = (float*)C.lds;
        const float* w_ada = A.in[I_WADA]; const float* cv = A.in[I_C];
        for (int it = C.bid; it < MODW / 48; it += C.nb) {
            const int c4 = C.tid % 12, kg = C.tid / 12;
            f32x4 a0 = {0.f, 0.f, 0.f, 0.f}, a1 = {0.f, 0.f, 0.f, 0.f};
            if (C.tid < 504) {
                for (int k = kg; k < D; k += 42) {
                    const f32x4 w = *(const f32x4*)(w_ada + (size_t)k * MODW + 48 * it + 4 * c4);
                    const float s0 = siluf_(cv[k]), s1 = siluf_(cv[D + k]);
                    a0 += w * s0; a1 += w * s1;
                }
                float* r = red + kg * 96 + c4 * 4;
                r[0] = a0.x; r[1] = a0.y; r[2] = a0.z; r[3] = a0.w;
                r[48 + 0] = a1.x; r[48 + 1] = a1.y; r[48 + 2] = a1.z; r[48 + 3] = a1.w;
            }
            __syncthreads();
            if (C.tid < 96) {
                float s = 0.f;
                for (int g = 0; g < 42; ++g) s += red[g * 96 + C.tid];
                const int b = C.tid / 48, col = 48 * it + (C.tid % 48);
                mod[b * MODW + col] = s + A.in[I_BADA][col];
            }
            __syncthreads();
        }
    }
    {
        float* scr = (float*)(C.lds + C.wave * 16384);
        constexpr int I_IN = (D / 64) * (IN_COLS / 32);
        for (int it = C.gw; it < I_IN; it += C.ngw) p0_transpose_item_fp8(A.in[I_WIN], D, IN_COLS, ws + WS_WIN, true, scr, it, C.lane, WIN_SCALE);
    }
    cvt_stream(A.in[I_PSK], (bf16*)(ws + WS_SK), (size_t)16 * 128 * 128, C);
}


__device__ __forceinline__ void late_transposes(const Args& A, const Ctx& C, unsigned char* ldsbase, int w0, int nw) {
    unsigned char* ws = A.ws;
    float* scr = (float*)(ldsbase + C.wave * 16384);
    int lane = lane_id(); asm volatile("" : "+v"(lane));
    constexpr int I_CO = (CONV_CH / 64) * (D / 32), I_AO = (AOW / 64) * (D / 32), I_OUT = (D / 64) * (D / 32), I_Q = I_OUT;
    constexpr int NITEMS = I_CO + I_AO + I_OUT + I_Q;
    for (int it = w0; it < NITEMS; it += nw) {
        int r = it;
        if (r < I_CO) { p0_transpose_item(A.in[I_WCO], CONV_CH, D, (bf16*)(ws + WS_WCO), false, scr, r, lane); continue; } r -= I_CO;
        if (r < I_AO) { p0_transpose_item(A.in[I_WAO], AOW, D, (bf16*)(ws + WS_WAO), false, scr, r, lane); continue; } r -= I_AO;
        if (r < I_OUT) { p0_transpose_item_fp8(A.in[I_WOUT], D, D, ws + WS_WOUT, false, scr, r, lane, WIN_SCALE); continue; } r -= I_OUT;
        p0_transpose_item(A.in[I_PWQ], D, D, (bf16*)(ws + WS_WQ), false, scr, r, lane);
    }
    { RowCvt rc; for (int row = w0; row < UP_TAIL_ROWS; row += nw) { rc_issue(rc, A.in[I_PWUP], row, lane); rc_finish_i8(rc, ws + WS_WUP, (float*)(ws + WS_SUP), row, lane); } }
}
template <bool FP8OUT>
__device__ __forceinline__ void norm_mod_store(const f32x4 (&v)[8], float ss, int m, const float* gn, const float* mod, int shift_i, int scale_i, bf16* hout, int lane) {
    const float rstd = 1.0f / sqrtf(ss * (1.0f / D) + EPS);
    const int b = m / SEQ;
    const f32x4* gp = (const f32x4*)gn; const f32x4* sc = (const f32x4*)(mod + b * MODW + scale_i * D); const f32x4* sh = (const f32x4*)(mod + b * MODW + shift_i * D);
    v2u* o = (v2u*)(hout + (size_t)m * D); unsigned* o8 = (unsigned*)((unsigned char*)hout + (size_t)m * D);
#pragma unroll
    for (int j = 0; j < 8; ++j) { const int q = lane + 64 * j; const f32x4 g = gp[q], s = sc[q], h = sh[q];
        const f32x4 y = v[j] * rstd * g * (s + 1.0f) + h;
        if constexpr (FP8OUT) { int p = __builtin_amdgcn_cvt_pk_fp8_f32(y.x, y.y, 0, false); p = __builtin_amdgcn_cvt_pk_fp8_f32(y.z, y.w, p, true); o8[q] = (unsigned)p; }
        else { v2u w; w.x = pk2(y.x, y.y); w.y = pk2(y.z, y.w); o[q] = w; } }
}
template <bool FP8OUT>
__device__ __forceinline__ void phase_norm_mod(const float* xin, const float* gn, const float* mod, int shift_i, int scale_i, bf16* hout, const Ctx& C) {
    for (int m = C.gw; m < T; m += 2 * C.ngw) {
        const int m2 = m + C.ngw; const bool has2 = m2 < T;
        const f32x4* xr = (const f32x4*)(xin + (size_t)m * D); const f32x4* xr2 = (const f32x4*)(xin + (size_t)(has2 ? m2 : m) * D);
        f32x4 v[8], v2[8]; float ss = 0.f, ss2 = 0.f;
#pragma unroll
        for (int j = 0; j < 8; ++j) v[j] = xr[C.lane + 64 * j];
#pragma unroll
        for (int j = 0; j < 8; ++j) v2[j] = xr2[C.lane + 64 * j];
#pragma unroll
        for (int j = 0; j < 8; ++j) { ss += (v[j].x * v[j].x + v[j].y * v[j].y) + (v[j].z * v[j].z + v[j].w * v[j].w); ss2 += (v2[j].x * v2[j].x + v2[j].y * v2[j].y) + (v2[j].z * v2[j].z + v2[j].w * v2[j].w); }
#pragma unroll
        for (int o = 1; o < 64; o <<= 1) { ss += __shfl_xor(ss, o); ss2 += __shfl_xor(ss2, o); }
        norm_mod_store<FP8OUT>(v, ss, m, gn, mod, shift_i, scale_i, hout, C.lane);
        if (has2) norm_mod_store<FP8OUT>(v2, ss2, m2, gn, mod, shift_i, scale_i, hout, C.lane);
    }
}

template <class Epi>
__device__ __forceinline__ void ngemm_phase(const bf16* Am, const bf16* Bt, int M, int N, int K, int lda, const Epi& E, const Ctx& C) {
    float* As = (float*)C.lds;
    float* Bs = As + 64 * 33;
    const int tid = C.tid, ty = tid >> 5, tx = tid & 31;
    const int ntm = M / 64, ntn = N / 256;
    for (int it = C.bid; it < ntm * ntn; it += C.nb) {
        const int pm = it / ntn, pn = it % ntn;
        float acc[4][8];
#pragma unroll
        for (int i = 0; i < 4; ++i)
#pragma unroll
            for (int j = 0; j < 8; ++j) acc[i][j] = 0.f;
        for (int k0 = 0; k0 < K; k0 += 32) {
            { const int r = tid >> 3, c = (tid & 7) * 4; const v2u v = *(const v2u*)(Am + (size_t)(pm * 64 + r) * lda + k0 + c);
              float* d = As + r * 33 + c; d[0] = bflo(v.x); d[1] = bfhi(v.x); d[2] = bflo(v.y); d[3] = bfhi(v.y); }
#pragma unroll
            for (int i = 0; i < 4; ++i) { const int idx = tid + 512 * i, r = idx >> 3, c = (idx & 7) * 4; const v2u v = *(const v2u*)(Bt + (size_t)(pn * 256 + r) * K + k0 + c);
              float* d = Bs + r * 33 + c; d[0] = bflo(v.x); d[1] = bfhi(v.x); d[2] = bflo(v.y); d[3] = bfhi(v.y); }
            __syncthreads();
#pragma unroll 4
            for (int k = 0; k < 32; ++k) {
                float a[4], b[8];
#pragma unroll
                for (int i = 0; i < 4; ++i) a[i] = As[(ty + 16 * i) * 33 + k];
#pragma unroll
                for (int j = 0; j < 8; ++j) b[j] = Bs[(tx + 32 * j) * 33 + k];
#pragma unroll
                for (int i = 0; i < 4; ++i)
#pragma unroll
                    for (int j = 0; j < 8; ++j) acc[i][j] += a[i] * b[j];
            }
            __syncthreads();
        }
        E(pm * 64 + ty, pn, tx, acc);
    }
}
struct NEpiIn {
    bf16 *U, *QKV, *G;
    __device__ __forceinline__ void operator()(int r0, int pn, int tx, const float (&acc)[4][8]) const {
#pragma unroll
        for (int i = 0; i < 4; ++i) { const size_t row = r0 + 16 * i;
            if (pn < 8) {
#pragma unroll
                for (int j = 0; j < 4; ++j) U[row * CONV_CH + 128 * pn + tx + 32 * j] = (bf16)f2bf(acc[i][j] * sigmoidf_(acc[i][j + 4]));
            } else if (pn < 26) {
#pragma unroll
                for (int j = 0; j < 8; ++j) QKV[row * QKVW + (pn - 8) * 256 + tx + 32 * j] = (bf16)f2bf(acc[i][j]);
            } else {
#pragma unroll
                for (int j = 0; j < 8; ++j) G[row * (2 * D) + (pn - 26) * 256 + tx + 32 * j] = (bf16)f2bf(sigmoidf_(acc[i][j]));
            } }
    }
};
struct NEpiYattn {
    const bf16* G; bf16* MG;
    __device__ __forceinline__ void operator()(int r0, int pn, int tx, const float (&acc)[4][8]) const {
#pragma unroll
        for (int i = 0; i < 4; ++i) { const size_t row = r0 + 16 * i;
#pragma unroll
            for (int j = 0; j < 8; ++j) { const int col = pn * 256 + tx + 32 * j; MG[row * D + col] = (bf16)f2bf(bf2f(G[row * (2 * D) + D + col]) * acc[i][j]); } }
    }
};
struct NEpiYconv {
    const bf16* G; bf16* MG; const float* bias;
    __device__ __forceinline__ void operator()(int r0, int pn, int tx, const float (&acc)[4][8]) const {
#pragma unroll
        for (int i = 0; i < 4; ++i) { const size_t row = r0 + 16 * i;
#pragma unroll
            for (int j = 0; j < 8; ++j) { const int col = pn * 256 + tx + 32 * j;
                MG[row * D + col] = (bf16)f2bf(bf2f(MG[row * D + col]) + bf2f(G[row * (2 * D) + col]) * (acc[i][j] + bias[col])); } }
    }
};
struct NEpiOut {
    const float* x; const float* mod; float* out;
    __device__ __forceinline__ void operator()(int r0, int pn, int tx, const float (&acc)[4][8]) const {
#pragma unroll
        for (int i = 0; i < 4; ++i) { const size_t row = r0 + 16 * i; const int b = (int)(row / SEQ);
#pragma unroll
            for (int j = 0; j < 8; ++j) { const int col = pn * 256 + tx + 32 * j; out[row * D + col] = x[row * D + col] + mod[b * MODW + 2 * D + col] * acc[i][j]; } }
    }
};
struct NEpiBf16 {
    bf16* O; int ldc;
    __device__ __forceinline__ void operator()(int r0, int pn, int tx, const float (&acc)[4][8]) const {
#pragma unroll
        for (int i = 0; i < 4; ++i) { const size_t row = r0 + 16 * i;
#pragma unroll
            for (int j = 0; j < 8; ++j) O[row * ldc + pn * 256 + tx + 32 * j] = (bf16)f2bf(acc[i][j]); }
    }
};

__device__ __forceinline__ float block_sum(float v, float* red, const Ctx& C) {
    v = wave_sum(v);
    __syncthreads();
    if (C.lane == 0) red[C.wave] = v;
    __syncthreads();
    float s = 0.f;
#pragma unroll
    for (int i = 0; i < NWAVES; ++i) s += red[i];
    return s;
}
__device__ __forceinline__ void phase_conv_naive(const Args& A, const Ctx& C) {
    const bf16* U = (const bf16*)(A.ws + WS_U); bf16* UCV = (bf16*)(A.ws + WS_UCV);
    const float* dw = A.in[I_CDW]; const float* db = A.in[I_CDB]; const float* lg = A.in[I_CLNG]; const float* lb = A.in[I_CLNB];
    float* red = (float*)C.lds;
    const int c0 = 2 * C.tid;
    for (int t = C.bid; t < T; t += C.nb) {
        const int s = t % SEQ;
        float a0 = db[c0], a1 = db[c0 + 1];
        for (int j = 0; j < CONV_K; ++j) { const int sp = s - (CONV_K - 1) + j; if (sp < 0) continue;
            const unsigned w = *(const unsigned*)(U + (size_t)(t - (CONV_K - 1) + j) * CONV_CH + c0);
            a0 += dw[j * CONV_CH + c0] * bflo(w); a1 += dw[j * CONV_CH + c0 + 1] * bfhi(w); }
        const float mean = block_sum(a0 + a1, red, C) * (1.0f / CONV_CH);
        const float d0 = a0 - mean, d1 = a1 - mean;
        const float var = block_sum(d0 * d0 + d1 * d1, red, C) * (1.0f / CONV_CH);
        const float rstd = 1.0f / sqrtf(var + EPS);
        const float y0 = d0 * rstd * lg[c0] + lb[c0], y1 = d1 * rstd * lg[c0 + 1] + lb[c0 + 1];
        *(unsigned*)(UCV + (size_t)t * CONV_CH + c0) = pk2(siluf_(y0), siluf_(y1));
    }
}
__device__ __forceinline__ void phase_attn_naive(const Args& A, const Ctx& C) {
    const bf16* QKV = (const bf16*)(A.ws + WS_QKV); bf16* O = (bf16*)(A.ws + WS_O);
    const float* qg = A.in[I_QNG]; const float* kg = A.in[I_KNG];
    const int lane = C.lane;
    for (int it = C.gw; it < T * 4; it += C.ngw) {
        const int t = it >> 2, hh = it & 3, b = t / SEQ, s = t % SEQ;
        float m = -INFINITY, l = 0.f, o0 = 0.f, o1 = 0.f;
        for (int g = 0; g < 3; ++g) {
            const int dil = (g == 0) ? 1 : (g == 1) ? 4 : 16; const int head = g * 4 + hh;
            const unsigned qw = *(const unsigned*)(QKV + (size_t)t * QKVW + head * HD + 2 * lane);
            const float q0 = bflo(qw), q1 = bfhi(qw);
            const float rq = 1.0f / sqrtf(wave_sum(q0 * q0 + q1 * q1) * (1.0f / HD) + EPS);
            const float qq0 = q0 * rq * qg[head * HD + 2 * lane] * kg[head * HD + 2 * lane], qq1 = q1 * rq * qg[head * HD + 2 * lane + 1] * kg[head * HD + 2 * lane + 1];
            for (int dist = 0; dist <= 128; ++dist) {
                const int sk = s - dist * dil; if (sk < 0) break;
                const size_t tk = (size_t)b * SEQ + sk;
                const unsigned kw = *(const unsigned*)(QKV + tk * QKVW + AW + head * HD + 2 * lane);
                const unsigned vw = *(const unsigned*)(QKV + tk * QKVW + 2 * AW + head * HD + 2 * lane);
                const float k0 = bflo(kw), k1 = bfhi(kw);
                float dot = qq0 * k0 + qq1 * k1, kss = k0 * k0 + k1 * k1;
#pragma unroll
                for (int o = 1; o < 64; o <<= 1) { dot += __shfl_xor(dot, o); kss += __shfl_xor(kss, o); }
                const float sc = dot * (1.0f / sqrtf(kss * (1.0f / HD) + EPS)) * 0.08838834764831845f;
                const float mn = fmaxf(m, sc), corr = __expf(m - mn), p = __expf(sc - mn);
                l = l * corr + p; o0 = o0 * corr + p * bflo(vw); o1 = o1 * corr + p * bfhi(vw); m = mn;
            }
        }
        const float il = 1.0f / l;
        *(unsigned*)(O + (size_t)t * AOW + hh * HD + 2 * lane) = pk2(o0 * il, o1 * il);
    }
}

__device__ __forceinline__ void wave_argmax(float& v, int& i) {
#pragma unroll
    for (int o = 32; o >= 1; o >>= 1) { const float ov = __shfl_xor(v, o); const int oi = __shfl_xor(i, o);
        if (ov > v || (ov == v && oi < i)) { v = ov; i = oi; } }
}
__device__ __forceinline__ void phase_topk_naive(const Args& A, const Ctx& C) {
    const bf16* QP = (const bf16*)(A.ws + WS_QP); const bf16* SK = (const bf16*)(A.ws + WS_SK);
    int* IDX = (int*)(A.ws + WS_IDX); float* GW = (float*)(A.ws + WS_GW);
    const int lane = C.lane;
    for (int it = C.gw; it < T * PEER_H; it += C.ngw) {
        const int t = it >> 3, h = it & 7;
        const bf16* qrow = QP + (size_t)t * D + h * 256;
        float topv[2]; int topi[2];
#pragma unroll
        for (int p = 0; p < 2; ++p) {
            float s0 = 0.f, s1 = 0.f;
            const bf16* k0r = SK + ((size_t)(h * 2 + p) * 128 + lane) * 128; const bf16* k1r = k0r + 64 * 128;
            for (int e = 0; e < 128; e += 8) {
                const v4u qv = *(const v4u*)(qrow + p * 128 + e), a = *(const v4u*)(k0r + e), bq = *(const v4u*)(k1r + e);
                s0 += bflo(qv.x) * bflo(a.x) + bfhi(qv.x) * bfhi(a.x) + bflo(qv.y) * bflo(a.y) + bfhi(qv.y) * bfhi(a.y) + bflo(qv.z) * bflo(a.z) + bfhi(qv.z) * bfhi(a.z) + bflo(qv.w) * bflo(a.w) + bfhi(qv.w) * bfhi(a.w);
                s1 += bflo(qv.x) * bflo(bq.x) + bfhi(qv.x) * bfhi(bq.x) + bflo(qv.y) * bflo(bq.y) + bfhi(qv.y) * bfhi(bq.y) + bflo(qv.z) * bflo(bq.z) + bfhi(qv.z) * bfhi(bq.z) + bflo(qv.w) * bflo(bq.w) + bfhi(qv.w) * bfhi(bq.w);
            }
            float tv = 0.f; int ti = 0;
            for (int k = 0; k < PEER_TOPK; ++k) {
                float v; int i;
                if (s0 >= s1) { v = s0; i = lane; } else { v = s1; i = lane + 64; }
                wave_argmax(v, i);
                if (i == lane) s0 = -INFINITY; else if (i == lane + 64) s1 = -INFINITY;
                if (lane == k) { tv = v; ti = i; }
            }
            topv[p] = tv; topi[p] = ti;
        }
        float cv[4];
        const float v1 = __shfl(topv[0], lane >> 2);
#pragma unroll
        for (int u = 0; u < 4; ++u) cv[u] = v1 + __shfl(topv[1], 4 * (lane & 3) + u);
        float wv = -INFINITY; int wc = 0;
        for (int k = 0; k < PEER_TOPK; ++k) {
            float v = cv[0]; int i = 4 * lane;
#pragma unroll
            for (int u = 1; u < 4; ++u) if (cv[u] > v) { v = cv[u]; i = 4 * lane + u; }
            wave_argmax(v, i);
            if ((i >> 2) == lane) {
#pragma unroll
                for (int u = 0; u < 4; ++u) if ((i & 3) == u) cv[u] = -INFINITY;
            }
            if (lane == k) { wv = v; wc = i; }
        }
        const float mx = __shfl(wv, 0);
        const float e = (lane < PEER_TOPK) ? __expf(wv - mx) : 0.f;
        const float sum = wave_sum(e);
        const int e1 = __shfl(topi[0], wc >> 4), e2 = __shfl(topi[1], wc & 15);
        if (lane < PEER_TOPK) { IDX[(size_t)t * PEER_HK + h * PEER_TOPK + lane] = e1 * PEER_NK + e2; GW[(size_t)t * PEER_HK + h * PEER_TOPK + lane] = e / sum; }
    }
}
__device__ __forceinline__ void phase_experts_naive(const Args& A, const Ctx& C) {
    const bf16* H2 = (const bf16*)(A.ws + WS_H); const bf16* WUP = (const bf16*)(A.ws + WS_WUP); const bf16* WDN = (const bf16*)(A.ws + WS_WDN);
    const int* IDX = (const int*)(A.ws + WS_IDX); const float* GW = (const float*)(A.ws + WS_GW); const float* mod = (const float*)(A.ws + WS_MOD);
    float* hs = (float*)C.lds;
    float* coef = hs + D;
    int* eidx = (int*)(coef + PEER_HK);
    for (int t = C.bid; t < T; t += C.nb) {
        { const v2u v = *(const v2u*)(H2 + (size_t)t * D + 4 * C.tid); float* d = hs + 4 * C.tid; d[0] = bflo(v.x); d[1] = bfhi(v.x); d[2] = bflo(v.y); d[3] = bfhi(v.y); }
        if (C.tid < PEER_HK) eidx[C.tid] = IDX[(size_t)t * PEER_HK + C.tid];
        __syncthreads();
        for (int i = 0; i < 16; ++i) {
            const int k = C.wave * 16 + i; const bf16* wr = WUP + (size_t)eidx[k] * D;
            float dot = 0.f;
#pragma unroll
            for (int j = 0; j < 4; ++j) { const int e0 = C.lane * 8 + 512 * j; const v4u w = *(const v4u*)(wr + e0); const float* hp = hs + e0;
                dot += hp[0] * bflo(w.x) + hp[1] * bfhi(w.x) + hp[2] * bflo(w.y) + hp[3] * bfhi(w.y) + hp[4] * bflo(w.z) + hp[5] * bfhi(w.z) + hp[6] * bflo(w.w) + hp[7] * bfhi(w.w); }
            dot = wave_sum(dot);
            if (C.lane == 0) coef[k] = GW[(size_t)t * PEER_HK + k] * gelu_erf(dot);
        }
        __syncthreads();
        float a0 = 0.f, a1 = 0.f, a2 = 0.f, a3 = 0.f;
        for (int k = 0; k < PEER_HK; ++k) { const float c = coef[k]; const v2u w = *(const v2u*)(WDN + (size_t)eidx[k] * D + 4 * C.tid);
            a0 += c * bflo(w.x); a1 += c * bfhi(w.x); a2 += c * bflo(w.y); a3 += c * bfhi(w.y); }
        const int b = t / SEQ; const f32x4 g2 = *(const f32x4*)(mod + b * MODW + 5 * D + 4 * C.tid);
        f32x4* op = (f32x4*)(A.out + (size_t)t * D + 4 * C.tid);
        f32x4 x1 = *op; x1.x += g2.x * a0; x1.y += g2.y * a1; x1.z += g2.z * a2; x1.w += g2.w * a3; *op = x1;
        __syncthreads();
    }
}


__device__ __forceinline__ unsigned f2ord(float f) { const unsigned u = __builtin_bit_cast(unsigned, f); return u ^ ((u >> 31) ? 0xFFFFFFFFu : 0x80000000u); }
__device__ __forceinline__ float ord2f(unsigned u) { return __builtin_bit_cast(float, (u & 0x80000000u) ? (u ^ 0x80000000u) : ~u); }
template <int CTRL> __device__ __forceinline__ unsigned dpp_u(unsigned x) { return (unsigned)__builtin_amdgcn_update_dpp(0, (int)x, CTRL, 0xF, 0xF, false); }
__device__ __forceinline__ unsigned rowmax_u(unsigned x) {
    x = max(x, dpp_u<0x128>(x)); x = max(x, dpp_u<0x124>(x)); x = max(x, dpp_u<0x122>(x)); x = max(x, dpp_u<0x121>(x)); return x; }
__device__ __forceinline__ float rowsum_f(float x) {
    x += __builtin_bit_cast(float, dpp_u<0x128>(__builtin_bit_cast(unsigned, x))); x += __builtin_bit_cast(float, dpp_u<0x124>(__builtin_bit_cast(unsigned, x)));
    x += __builtin_bit_cast(float, dpp_u<0x122>(__builtin_bit_cast(unsigned, x))); x += __builtin_bit_cast(float, dpp_u<0x121>(__builtin_bit_cast(unsigned, x))); return x; }
#define CE_DESC(a, b) do { const unsigned _hi = max(a, b), _lo = min(a, b); a = _hi; b = _lo; } while (0)
__device__ __forceinline__ void phase_topk(const Args& A, const Ctx& C) {
    const bf16* QP = (const bf16*)(A.ws + WS_QP); const bf16* SK = (const bf16*)(A.ws + WS_SK);
    int* IDX = (int*)(A.ws + WS_IDX); float* GW = (float*)(A.ws + WS_GW);
    const int lane = C.lane, i = lane & 15, g = lane >> 4;
    if (C.wave >= TK_W) {
        const int cw = C.bid * (NWAVES - TK_W) + (C.wave - TK_W), ncw = C.nb * (NWAVES - TK_W); RowCvt ra, rb;
        for (int row = UP_TAIL_ROWS + cw; row < 2 * PEER_E; row += 2 * ncw) {
            const int row2 = row + ncw; const bool has2 = row2 < 2 * PEER_E;
            rc_issue(ra, row < PEER_E ? A.in[I_PWUP] : A.in[I_PWDN], row < PEER_E ? row : row - PEER_E, lane);
            if (has2) rc_issue(rb, row2 < PEER_E ? A.in[I_PWUP] : A.in[I_PWDN], row2 < PEER_E ? row2 : row2 - PEER_E, lane);
            if (row < PEER_E) rc_finish_i8(ra, A.ws + WS_WUP, (float*)(A.ws + WS_SUP), row, lane); else rc_finish_fp8(ra, A.ws + WS_WDN, (float*)(A.ws + WS_SDN), row - PEER_E, lane);
            if (has2) { if (row2 < PEER_E) rc_finish_i8(rb, A.ws + WS_WUP, (float*)(A.ws + WS_SUP), row2, lane); else rc_finish_fp8(rb, A.ws + WS_WDN, (float*)(A.ws + WS_SDN), row2 - PEER_E, lane); }
        }
        return;
    }
    int crow = 2 * PEER_E; RowCvt rc;
#define CV_ISSUE() do { asm volatile("" ::: "memory"); if (crow < 2 * PEER_E) rc_issue(rc, crow < PEER_E ? A.in[I_PWUP] : A.in[I_PWDN], crow < PEER_E ? crow : crow - PEER_E, lane); } while (0)
#define CV_FINISH() do { if (crow < 2 * PEER_E) { if (crow < PEER_E) rc_finish_i8(rc, A.ws + WS_WUP, (float*)(A.ws + WS_SUP), crow, lane); \
        else rc_finish_fp8(rc, A.ws + WS_WDN, (float*)(A.ws + WS_SDN), crow - PEER_E, lane); crow += C.ngw; } asm volatile("" ::: "memory"); } while (0)
    for (int it = C.bid * TK_W + C.wave; it < (T / 16) * PEER_H; it += C.nb * TK_W) {
        const int tile = it >> 3, t0 = tile * 16; int h = it & 7; asm volatile("" : "+s"(h));
        unsigned win[2][4];
#pragma unroll
        for (int p = 0; p < 2; ++p) {
            const int slot = 2 * h + p;
            pg8::bf16x8 aq[4];
#pragma unroll
            for (int ks = 0; ks < 4; ++ks) aq[ks] = *(const pg8::bf16x8*)(QP + (size_t)(t0 + i) * D + slot * 128 + 32 * ks + 8 * g);
            unsigned K[4][8];
#pragma unroll
            for (int nt = 0; nt < 8; ++nt) {
                f32x4 acc = {0.f, 0.f, 0.f, 0.f};
                const bf16* kr = SK + ((size_t)slot * 128 + 16 * nt + i) * 128 + 8 * g;
#pragma unroll
                for (int ks = 0; ks < 4; ++ks) acc = __builtin_amdgcn_mfma_f32_16x16x32_bf16(aq[ks], *(const pg8::bf16x8*)(kr + 32 * ks), acc, 0, 0, 0);
#pragma unroll
                for (int r = 0; r < 4; ++r) K[r][nt] = (f2ord(acc[r]) & ~127u) | (unsigned)(127 - (16 * nt + i));
            }
#pragma unroll
            for (int r = 0; r < 4; ++r) {
                CV_ISSUE();
                unsigned* k = K[r];
                CE_DESC(k[0], k[1]); CE_DESC(k[2], k[3]); CE_DESC(k[4], k[5]); CE_DESC(k[6], k[7]);
                CE_DESC(k[0], k[2]); CE_DESC(k[1], k[3]); CE_DESC(k[4], k[6]); CE_DESC(k[5], k[7]);
                CE_DESC(k[1], k[2]); CE_DESC(k[5], k[6]);
                CE_DESC(k[0], k[4]); CE_DESC(k[1], k[5]); CE_DESC(k[2], k[6]); CE_DESC(k[3], k[7]);
                CE_DESC(k[2], k[4]); CE_DESC(k[3], k[5]);
                CE_DESC(k[1], k[2]); CE_DESC(k[3], k[4]); CE_DESC(k[5], k[6]);
                unsigned w = 0u;
#pragma unroll
                for (int kk = 0; kk < PEER_TOPK; ++kk) {
                    const unsigned M = rowmax_u(k[0]);
                    const bool pop = (k[0] == M);
#pragma unroll
                    for (int q = 0; q < 7; ++q) k[q] = pop ? k[q + 1] : k[q];
                    k[7] = pop ? 0u : k[7];
                    w = (i == kk) ? M : w;
                }
                win[p][r] = w;
                CV_FINISH();
            }
        }
#pragma unroll
        for (int r = 0; r < 4; ++r) {
            CV_ISSUE();
            const float v1 = ord2f(win[0][r] & ~127u), v2 = ord2f(win[1][r] & ~127u);
            int j = 0;
            float nv = __builtin_bit_cast(float, __builtin_amdgcn_ds_bpermute(4 * (16 * g), __builtin_bit_cast(int, v2)));
            unsigned key = (f2ord(v1 + nv) & ~255u) | (unsigned)(255 - 16 * i);
            unsigned w = 0u; float mx = 0.f;
#pragma unroll
            for (int kk = 0; kk < PEER_TOPK; ++kk) {
                const unsigned M = rowmax_u(key);
                if (kk == 0) mx = ord2f(M & ~255u);
                const bool pop = (key == M);
                j += pop ? 1 : 0;
                const int jj = j < 15 ? j : 15;
                nv = __builtin_bit_cast(float, __builtin_amdgcn_ds_bpermute(4 * (16 * g + jj), __builtin_bit_cast(int, v2)));
                const unsigned nk = (j < 16) ? ((f2ord(v1 + nv) & ~255u) | (unsigned)(255 - (16 * i + jj))) : 0u;
                key = pop ? nk : key;
                w = (i == kk) ? M : w;
            }
            const int ci = 255 - (int)(w & 255u);
            const int n1 = 127 - (int)(win[0][r] & 127u), n2 = 127 - (int)(win[1][r] & 127u);
            const int e1 = __builtin_amdgcn_ds_bpermute(4 * (16 * g + (ci >> 4)), n1), e2 = __builtin_amdgcn_ds_bpermute(4 * (16 * g + (ci & 15)), n2);
            const float ex = __expf(ord2f(w & ~255u) - mx);
            const float sum = rowsum_f(ex);
            const size_t o = (size_t)(t0 + 4 * g + r) * PEER_HK + h * PEER_TOPK + i;
            IDX[o] = e1 * PEER_NK + e2; GW[o] = ex / sum;
            CV_FINISH();
        }
    }
    while (crow < 2 * PEER_E) { CV_ISSUE(); CV_FINISH(); }
#undef CV_ISSUE
#undef CV_FINISH
}

typedef __bf16 bf16x2v __attribute__((ext_vector_type(2)));
__device__ __forceinline__ float dot2bf(unsigned w, unsigned x, float acc) { return __builtin_amdgcn_fdot2_f32_bf16(__builtin_bit_cast(bf16x2v, w), __builtin_bit_cast(bf16x2v, x), acc, false); }
__device__ __forceinline__ f2v fp8lo(unsigned w) { return __builtin_amdgcn_cvt_pk_f32_fp8((int)w, false); }
__device__ __forceinline__ f2v fp8hi(unsigned w) { return __builtin_amdgcn_cvt_pk_f32_fp8((int)w, true); }
constexpr int EXB = 8;
__device__ __forceinline__ void phase_experts(const Args& A, const Ctx& C, float* dst) {
    const bf16* H2 = (const bf16*)(A.ws + WS_H); const unsigned char* WUP = A.ws + WS_WUP; const unsigned char* WDN = A.ws + WS_WDN;
    const float* SUP = (const float*)(A.ws + WS_SUP); const float* SDN = (const float*)(A.ws + WS_SDN);
    const int* IDX = (const int*)(A.ws + WS_IDX); const float* GW = (const float*)(A.ws + WS_GW); const float* mod = (const float*)(A.ws + WS_MOD);
    LAS unsigned* skey = (LAS unsigned*)((LAS unsigned char*)C.lds + C.wave * 2048);
    LAS float* sg = (LAS float*)(skey + 128);
    LAS float* ssup = sg + 128;
    const int lane = C.lane;
    for (int t = C.gw; t < T; t += C.ngw) {
        const int e0 = IDX[(size_t)t * PEER_HK + lane], e1 = IDX[(size_t)t * PEER_HK + 64 + lane];
        unsigned k0 = ((unsigned)e0 << 7) | (unsigned)lane, k1 = ((unsigned)e1 << 7) | (unsigned)(64 + lane);
        sg[lane] = GW[(size_t)t * PEER_HK + lane] * SDN[e0]; sg[64 + lane] = GW[(size_t)t * PEER_HK + 64 + lane] * SDN[e1];
        ssup[lane] = SUP[e0]; ssup[64 + lane] = SUP[e1];
#pragma unroll
        for (int k = 2; k <= 128; k <<= 1) {
#pragma unroll
            for (int j = k >> 1; j >= 1; j >>= 1) {
                if (j == 64) { const unsigned a = min(k0, k1), b = max(k0, k1); k0 = a; k1 = b; }
                else {
                    const unsigned o0 = __shfl_xor(k0, j), o1 = __shfl_xor(k1, j);
                    const bool lower = (lane & j) == 0;
                    const bool up0 = (lane & k) == 0, up1 = ((lane + 64) & k) == 0;
                    k0 = (up0 == lower) ? min(k0, o0) : max(k0, o0);
                    k1 = (up1 == lower) ? min(k1, o1) : max(k1, o1);
                }
            }
        }
        skey[lane] = k0; skey[64 + lane] = k1;
        f2v hv[2][8], acc[2][8];
#pragma unroll
        for (int j = 0; j < 2; ++j) { const v4u a = *(const v4u*)(H2 + (size_t)t * D + 16 * lane + 1024 * j), b = *(const v4u*)(H2 + (size_t)t * D + 16 * lane + 1024 * j + 8);
            hv[j][0] = (f2v){bflo(a.x), bfhi(a.x)}; hv[j][1] = (f2v){bflo(a.y), bfhi(a.y)}; hv[j][2] = (f2v){bflo(a.z), bfhi(a.z)}; hv[j][3] = (f2v){bflo(a.w), bfhi(a.w)};
            hv[j][4] = (f2v){bflo(b.x), bfhi(b.x)}; hv[j][5] = (f2v){bflo(b.y), bfhi(b.y)}; hv[j][6] = (f2v){bflo(b.z), bfhi(b.z)}; hv[j][7] = (f2v){bflo(b.w), bfhi(b.w)};
#pragma unroll
            for (int q = 0; q < 8; ++q) acc[j][q] = (f2v){0.f, 0.f}; }
        asm volatile("s_waitcnt lgkmcnt(0)" ::: "memory");
        v4u bu[EXB][2], bd[EXB][2];
#pragma unroll
        for (int i = 0; i < EXB; ++i) { const unsigned e = __builtin_amdgcn_readfirstlane(skey[i]) >> 7; const unsigned char* r = WUP + (size_t)e * D + 16 * lane;
            bu[i][0] = *(const v4u*)r; bu[i][1] = *(const v4u*)(r + 1024); }
        for (int b = 0; b < PEER_HK / EXB; ++b) {
#pragma unroll
            for (int i = 0; i < EXB; ++i) { const unsigned e = __builtin_amdgcn_readfirstlane(skey[EXB * b + i]) >> 7; const unsigned char* r = WDN + (size_t)e * D + 16 * lane;
                bd[i][0] = *(const v4u*)r; bd[i][1] = *(const v4u*)(r + 1024); }
            float p[EXB];
#pragma unroll
            for (int i = 0; i < EXB; ++i) { f2v s0 = {0.f, 0.f}, s1 = {0.f, 0.f};
#pragma unroll
                for (int j = 0; j < 2; ++j) { const v4u w = bu[i][j];
                    s0 = __builtin_elementwise_fma(fp8lo(w.x), hv[j][0], s0); s1 = __builtin_elementwise_fma(fp8hi(w.x), hv[j][1], s1);
                    s0 = __builtin_elementwise_fma(fp8lo(w.y), hv[j][2], s0); s1 = __builtin_elementwise_fma(fp8hi(w.y), hv[j][3], s1);
                    s0 = __builtin_elementwise_fma(fp8lo(w.z), hv[j][4], s0); s1 = __builtin_elementwise_fma(fp8hi(w.z), hv[j][5], s1);
                    s0 = __builtin_elementwise_fma(fp8lo(w.w), hv[j][6], s0); s1 = __builtin_elementwise_fma(fp8hi(w.w), hv[j][7], s1); }
                p[i] = (s0.x + s0.y) + (s1.x + s1.y); }
            const bool b5 = (lane & 32) != 0, b4 = (lane & 16) != 0, b3 = (lane & 8) != 0;
#pragma unroll
            for (int k = 0; k < 4; ++k) { const float keep = b5 ? p[k + 4] : p[k], send = b5 ? p[k] : p[k + 4]; p[k] = keep + __shfl_xor(send, 32); }
#pragma unroll
            for (int k = 0; k < 2; ++k) { const float keep = b4 ? p[k + 2] : p[k], send = b4 ? p[k] : p[k + 2]; p[k] = keep + __shfl_xor(send, 16); }
            float d; { const float keep = b3 ? p[1] : p[0], send = b3 ? p[0] : p[1]; d = keep + __shfl_xor(send, 8); }
            d += __shfl_xor(d, 4); d += __shfl_xor(d, 2); d += __shfl_xor(d, 1);
            const unsigned myk = skey[EXB * b + (lane >> 3)];
            const float cf = gelu_erf(d * ssup[myk & 127u]) * sg[myk & 127u];
            float c[EXB];
#pragma unroll
            for (int i = 0; i < EXB; ++i) c[i] = __builtin_bit_cast(float, __builtin_amdgcn_readlane(__builtin_bit_cast(int, cf), 8 * i));
            if (b + 1 < PEER_HK / EXB) {
#pragma unroll
                for (int i = 0; i < EXB; ++i) { const unsigned e = __builtin_amdgcn_readfirstlane(skey[EXB * b + EXB + i]) >> 7; const unsigned char* r = WUP + (size_t)e * D + 16 * lane;
                    bu[i][0] = *(const v4u*)r; bu[i][1] = *(const v4u*)(r + 1024); }
            }
#pragma unroll
            for (int i = 0; i < EXB; ++i) { const f2v cc = {c[i], c[i]};
#pragma unroll
                for (int j = 0; j < 2; ++j) { const v4u w = bd[i][j];
                    acc[j][0] = __builtin_elementwise_fma(fp8lo(w.x), cc, acc[j][0]); acc[j][1] = __builtin_elementwise_fma(fp8hi(w.x), cc, acc[j][1]);
                    acc[j][2] = __builtin_elementwise_fma(fp8lo(w.y), cc, acc[j][2]); acc[j][3] = __builtin_elementwise_fma(fp8hi(w.y), cc, acc[j][3]);
                    acc[j][4] = __builtin_elementwise_fma(fp8lo(w.z), cc, acc[j][4]); acc[j][5] = __builtin_elementwise_fma(fp8hi(w.z), cc, acc[j][5]);
                    acc[j][6] = __builtin_elementwise_fma(fp8lo(w.w), cc, acc[j][6]); acc[j][7] = __builtin_elementwise_fma(fp8hi(w.w), cc, acc[j][7]); } }
        }
        const int bb = t / SEQ;
#pragma unroll
        for (int j = 0; j < 2; ++j)
#pragma unroll
            for (int q = 0; q < 4; ++q) { const int col = 16 * lane + 1024 * j + 4 * q; const f32x4 g = *(const f32x4*)(mod + bb * MODW + 5 * D + col);
                f32x4 x = *(const f32x4*)(A.out + (size_t)t * D + col);
                x.x += g.x * acc[j][2 * q].x; x.y += g.y * acc[j][2 * q].y; x.z += g.z * acc[j][2 * q + 1].x; x.w += g.w * acc[j][2 * q + 1].y; *(f32x4*)(dst + (size_t)t * D + col) = x; }
        asm volatile("s_waitcnt lgkmcnt(0)" ::: "memory");
    }
}


constexpr int EX_LDS_WAVE = 4 * 4096 + 2048;
typedef __bf16 bf16x2w __attribute__((ext_vector_type(2)));
__device__ __forceinline__ float gelu_as(float v) {
    const float av = fabsf(v), t = __builtin_amdgcn_rcpf(av * 0.2316419f + 1.0f);
    float q = t * 0.5307027145f + (-0.7265760135f); q = q * t + 0.7107068705f; q = q * t + (-0.142248368f); q = q * t + 0.127414796f; q = q * t;
    const float e = __builtin_amdgcn_exp2f((v * v) * (-0.72134752044f));
    const float m = v * (q * e);
    return v < 0.f ? m : v - m;
}
__device__ __forceinline__ v4u ldrow16(const unsigned char* sbase, unsigned voff) { return *(const v4u*)(sbase + voff); }
__device__ __forceinline__ v2u ldrow8(const unsigned char* sbase, unsigned voff) { return *(const v2u*)(sbase + voff); }
__device__ __forceinline__ int dot16_i8(const v4u w0, const v4u h0) {
    int s0 = __builtin_amdgcn_sdot4((int)w0.x, (int)h0.x, 0, false), s1 = __builtin_amdgcn_sdot4((int)w0.y, (int)h0.y, 0, false);
    s0 = __builtin_amdgcn_sdot4((int)w0.z, (int)h0.z, s0, false); s1 = __builtin_amdgcn_sdot4((int)w0.w, (int)h0.w, s1, false);
    return s0 + s1;
}
__device__ __forceinline__ int dot32_i8(const v4u w0, const v4u h0, const v4u w1, const v4u h1) {
    int s0 = __builtin_amdgcn_sdot4((int)w0.x, (int)h0.x, 0, false), s1 = __builtin_amdgcn_sdot4((int)w0.y, (int)h0.y, 0, false);
    s0 = __builtin_amdgcn_sdot4((int)w0.z, (int)h0.z, s0, false); s1 = __builtin_amdgcn_sdot4((int)w0.w, (int)h0.w, s1, false);
    s0 = __builtin_amdgcn_sdot4((int)w1.x, (int)h1.x, s0, false); s1 = __builtin_amdgcn_sdot4((int)w1.y, (int)h1.y, s1, false);
    s0 = __builtin_amdgcn_sdot4((int)w1.z, (int)h1.z, s0, false); s1 = __builtin_amdgcn_sdot4((int)w1.w, (int)h1.w, s1, false);
    return s0 + s1;
}
__device__ __forceinline__ float dot2_f2v_bf16(f2v a, unsigned h, float s) { return __builtin_amdgcn_fdot2_f32_bf16(__builtin_convertvector(a, bf16x2w), __builtin_bit_cast(bf16x2w, h), s, false); }
__device__ __forceinline__ float dot16_fp8_bf16(const v4u w, const v4u ha, const v4u hb, float s) {
#define D2(W, HI, H) s = dot2_f2v_bf16((HI) ? fp8hi(W) : fp8lo(W), H, s)
    D2(w.x, 0, ha.x); D2(w.x, 1, ha.y); D2(w.y, 0, ha.z); D2(w.y, 1, ha.w); D2(w.z, 0, hb.x); D2(w.z, 1, hb.y); D2(w.w, 0, hb.z); D2(w.w, 1, hb.w);
#undef D2
    return s;
}
#define EX_AXPY(ACC, W0, W1, CC) do { \
    ACC[0][0] = __builtin_elementwise_fma(fp8lo((W0).x), CC, ACC[0][0]); ACC[0][1] = __builtin_elementwise_fma(fp8hi((W0).x), CC, ACC[0][1]); \
    ACC[0][2] = __builtin_elementwise_fma(fp8lo((W0).y), CC, ACC[0][2]); ACC[0][3] = __builtin_elementwise_fma(fp8hi((W0).y), CC, ACC[0][3]); \
    ACC[0][4] = __builtin_elementwise_fma(fp8lo((W0).z), CC, ACC[0][4]); ACC[0][5] = __builtin_elementwise_fma(fp8hi((W0).z), CC, ACC[0][5]); \
    ACC[0][6] = __builtin_elementwise_fma(fp8lo((W0).w), CC, ACC[0][6]); ACC[0][7] = __builtin_elementwise_fma(fp8hi((W0).w), CC, ACC[0][7]); \
    ACC[1][0] = __builtin_elementwise_fma(fp8lo((W1).x), CC, ACC[1][0]); ACC[1][1] = __builtin_elementwise_fma(fp8hi((W1).x), CC, ACC[1][1]); \
    ACC[1][2] = __builtin_elementwise_fma(fp8lo((W1).y), CC, ACC[1][2]); ACC[1][3] = __builtin_elementwise_fma(fp8hi((W1).y), CC, ACC[1][3]); \
    ACC[1][4] = __builtin_elementwise_fma(fp8lo((W1).z), CC, ACC[1][4]); ACC[1][5] = __builtin_elementwise_fma(fp8hi((W1).z), CC, ACC[1][5]); \
    ACC[1][6] = __builtin_elementwise_fma(fp8lo((W1).w), CC, ACC[1][6]); ACC[1][7] = __builtin_elementwise_fma(fp8hi((W1).w), CC, ACC[1][7]); } while (0)
__device__ __forceinline__ void phase_experts3(const Args& A, const Ctx& C, float* dst, unsigned emask) {
    const bf16* H2 = (const bf16*)(A.ws + WS_H); const unsigned char* WUP = A.ws + WS_WUP; const unsigned char* WDN = A.ws + WS_WDN;
    const float* SUP = (const float*)(A.ws + WS_SUP); const float* SDN = (const float*)(A.ws + WS_SDN);
    const int* IDX = (const int*)(A.ws + WS_IDX); const float* GW = (const float*)(A.ws + WS_GW); const float* mod = (const float*)(A.ws + WS_MOD);
    LAS unsigned char* hb = (LAS unsigned char*)C.lds + C.wave * EX_LDS_WAVE;
    LAS unsigned* keys = (LAS unsigned*)(hb + 8192);
    for (int tg = C.gw; tg < T / 4; tg += C.ngw) {
        unsigned z_ = 0u; asm volatile("" : "+v"(z_));
        int lane = (int)__builtin_amdgcn_mbcnt_hi(~0u, __builtin_amdgcn_mbcnt_lo(~0u, z_));
        const int t0 = 4 * tg;
        float hs4[4];
        {
#pragma unroll
          for (int tk = 0; tk < 4; ++tk) {
              float hv[2][16]; float am = 0.f;
#pragma unroll
              for (int j = 0; j < 2; ++j) { const v4u a = *(const v4u*)(H2 + (size_t)(t0 + tk) * D + 16 * lane + 1024 * j), b = *(const v4u*)(H2 + (size_t)(t0 + tk) * D + 16 * lane + 1024 * j + 8);
                  hv[j][0] = bflo(a.x); hv[j][1] = bfhi(a.x); hv[j][2] = bflo(a.y); hv[j][3] = bfhi(a.y); hv[j][4] = bflo(a.z); hv[j][5] = bfhi(a.z); hv[j][6] = bflo(a.w); hv[j][7] = bfhi(a.w);
                  hv[j][8] = bflo(b.x); hv[j][9] = bfhi(b.x); hv[j][10] = bflo(b.y); hv[j][11] = bfhi(b.y); hv[j][12] = bflo(b.z); hv[j][13] = bfhi(b.z); hv[j][14] = bflo(b.w); hv[j][15] = bfhi(b.w);
#pragma unroll
                  for (int q = 0; q < 16; ++q) am = fmaxf(am, fabsf(hv[j][q])); }
#pragma unroll
              for (int o = 1; o < 64; o <<= 1) am = fmaxf(am, __shfl_xor(am, o));
              const float sc = (am > 0.f) ? 127.0f / am : 0.f; hs4[tk] = am * (1.0f / 127.0f);
#pragma unroll
              for (int j = 0; j < 2; ++j) { v4u o;
                  o.x = pack_i8x4(hv[j][0] * sc, hv[j][1] * sc, hv[j][2] * sc, hv[j][3] * sc); o.y = pack_i8x4(hv[j][4] * sc, hv[j][5] * sc, hv[j][6] * sc, hv[j][7] * sc);
                  o.z = pack_i8x4(hv[j][8] * sc, hv[j][9] * sc, hv[j][10] * sc, hv[j][11] * sc); o.w = pack_i8x4(hv[j][12] * sc, hv[j][13] * sc, hv[j][14] * sc, hv[j][15] * sc);
                  *(LAS v4u*)(hb + tk * 2048 + 16 * lane + 1024 * j) = o; } }
        }
        LAS unsigned* keysM = keys + 512;
        LAS float* cfl = (LAS float*)(keys + 1024);
        unsigned K[8];
#pragma unroll
        for (int s = 0; s < 8; ++s) { const int tk = s >> 1, slot = lane + 64 * (s & 1); const unsigned e = (unsigned)IDX[(size_t)(t0 + tk) * PEER_HK + slot];
            K[s] = ((unsigned)tk << 21) | (e << 7) | (unsigned)slot; }
#define EX_SORT512(KK) do { _Pragma("unroll") for (int k = 2; k <= 512; k <<= 1) { _Pragma("unroll") for (int j = k >> 1; j >= 1; j >>= 1) { \
            if (j >= 64) { const int ds = j >> 6; _Pragma("unroll") for (int s = 0; s < 8; ++s) if ((s & ds) == 0) { const bool up = ((64 * s) & k) == 0; \
                    const unsigned a_ = min(KK[s], KK[s | ds]), b_ = max(KK[s], KK[s | ds]); KK[s] = up ? a_ : b_; KK[s | ds] = up ? b_ : a_; } } \
            else { const bool lower = (lane & j) == 0; _Pragma("unroll") for (int s = 0; s < 8; ++s) { const unsigned o = __shfl_xor(KK[s], j); const bool up = ((lane + 64 * s) & k) == 0; \
                    KK[s] = (up == lower) ? min(KK[s], o) : max(KK[s], o); } } } } } while (0)
        EX_SORT512(K);
#pragma unroll
        for (int s = 0; s < 8; ++s) { const int p = lane + 64 * s; keys[(p & 127) * 4 + (p >> 7)] = K[s]; }
        asm volatile("" : "+v"(lane));
#pragma unroll
        for (int s = 0; s < 8; ++s) { const int tk = s >> 1, slot = lane + 64 * (s & 1); const unsigned e = (unsigned)IDX[(size_t)(t0 + tk) * PEER_HK + slot];
            K[s] = (e << 9) | ((unsigned)tk << 7) | (unsigned)slot; }
        EX_SORT512(K);
#pragma unroll
        for (int s = 0; s < 8; ++s) keysM[lane + 64 * s] = K[s];
#undef EX_SORT512
        asm volatile("s_waitcnt lgkmcnt(0)" ::: "memory");
        asm volatile("" : "+v"(lane));
        constexpr int EX_NB = 128;
        {
            const int gq_ = lane >> 4, li_ = lane & 15;
            v4u bw[2][8]; unsigned kcur = keysM[gq_];
#define EX_UP_LD(KW, BUF) do { const unsigned char* r_ = WUP + (size_t)(((KW) >> 9) & emask) * D + 16 * li_; \
            _Pragma("unroll") for (int q_ = 0; q_ < 8; ++q_) bw[BUF][q_] = *(const v4u*)(r_ + 256 * q_); } while (0)
#define EX_UP_STEP(B, CUR) do { \
            const unsigned knext = keysM[4 * (((B) + 1 < EX_NB) ? (B) + 1 : (B)) + gq_]; \
            EX_UP_LD(knext, (CUR) ^ 1); \
            const unsigned me = kcur >> 9, mtok = (kcur >> 7) & 3u, mslot = kcur & 127u; \
            const float gg = GW[(size_t)(t0 + (int)mtok) * PEER_HK + mslot], su = SUP[me], sd = SDN[me]; \
            LAS unsigned char* hr = hb + mtok * 2048 + 16 * li_; int s0_ = 0, s1_ = 0; \
            _Pragma("unroll") for (int q_ = 0; q_ < 8; q_ += 2) { const v4u h0 = *(LAS v4u*)(hr + 256 * q_), h1 = *(LAS v4u*)(hr + 256 * q_ + 256); \
                s0_ += dot16_i8(bw[CUR][q_], h0); s1_ += dot16_i8(bw[CUR][q_ + 1], h1); } \
            unsigned s_ = (unsigned)(s0_ + s1_); \
            s_ += dpp_u<0x128>(s_); s_ += dpp_u<0x124>(s_); s_ += dpp_u<0x122>(s_); s_ += dpp_u<0x121>(s_);            \
            const float hs_ = (mtok == 0u) ? hs4[0] : (mtok == 1u) ? hs4[1] : (mtok == 2u) ? hs4[2] : hs4[3]; \
            cfl[mtok * 128u + mslot] = gg * sd * gelu_as((float)(int)s_ * su * hs_); \
            kcur = knext; } while (0)
            EX_UP_LD(kcur, 0);
            for (int b = 0; b < EX_NB; b += 2) { EX_UP_STEP(b, 0); EX_UP_STEP(b + 1, 1); }
#undef EX_UP_LD
#undef EX_UP_STEP
        }
        asm volatile("s_waitcnt lgkmcnt(0)" ::: "memory");
        asm volatile("" : "+v"(lane));
        const int bb = t0 / SEQ;
        constexpr int EX_DB = 2;
        LAS unsigned* rowT = keys + 1536;
        LAS float* cfT = (LAS float*)(keys + 2048);
#pragma unroll
        for (int s = 0; s < 8; ++s) { const int q_ = lane + 64 * s; const unsigned kk_ = keys[q_]; const unsigned e_ = ((kk_ >> 7) & 16383u) & emask;
            rowT[q_] = e_ * (unsigned)D; cfT[q_] = cfl[(q_ & 3) * 128 + (int)(kk_ & 127u)]; }
        asm volatile("s_waitcnt lgkmcnt(0)" ::: "memory");
#define EX_AXPY1(ACC, W0, CC) do { \
    ACC[0] = __builtin_elementwise_fma(fp8lo((W0).x), CC, ACC[0]); ACC[1] = __builtin_elementwise_fma(fp8hi((W0).x), CC, ACC[1]); \
    ACC[2] = __builtin_elementwise_fma(fp8lo((W0).y), CC, ACC[2]); ACC[3] = __builtin_elementwise_fma(fp8hi((W0).y), CC, ACC[3]); } while (0)
#define EX_RO(W) ((unsigned)__builtin_amdgcn_readfirstlane((int)(W)))
#define EX_DN_LD(J, BQ, BUF) do { _Pragma("unroll") for (int bb_ = 0; bb_ < EX_DB; ++bb_) { const v4u rv = *(LAS v4u*)(rowT + 4 * ((BQ) + bb_)); \
            bd[BUF][bb_][0] = ldrow8(WDN + EX_RO(rv.x), voff_ + 512u * (J)); bd[BUF][bb_][1] = ldrow8(WDN + EX_RO(rv.y), voff_ + 512u * (J)); \
            bd[BUF][bb_][2] = ldrow8(WDN + EX_RO(rv.z), voff_ + 512u * (J)); bd[BUF][bb_][3] = ldrow8(WDN + EX_RO(rv.w), voff_ + 512u * (J)); } } while (0)
#define EX_DN_STEP(J, B, CUR) do { \
            EX_DN_LD(J, (((B) + EX_DB < EX_NB) ? (B) + EX_DB : (B)), (CUR) ^ 1); \
            _Pragma("unroll") for (int bb_ = 0; bb_ < EX_DB; ++bb_) { const f32x4 cv = *(LAS f32x4*)(cfT + 4 * ((B) + bb_)); \
                { const f2v cc = {cv.x, cv.x}; EX_AXPY1(a0, bd[CUR][bb_][0], cc); } \
                { const f2v cc = {cv.y, cv.y}; EX_AXPY1(a1, bd[CUR][bb_][1], cc); } \
                { const f2v cc = {cv.z, cv.z}; EX_AXPY1(a2, bd[CUR][bb_][2], cc); } \
                { const f2v cc = {cv.w, cv.w}; EX_AXPY1(a3, bd[CUR][bb_][3], cc); } } } while (0)
#define EX_OUT1(TK, ACC, J) do { _Pragma("unroll") for (int q = 0; q < 2; ++q) { const int col = 8 * lane + 512 * (J) + 4 * q; \
            const f32x4 g = *(const f32x4*)(mod + bb * MODW + 5 * D + col); f32x4 x = *(const f32x4*)(A.out + (size_t)(t0 + TK) * D + col); \
            x.x += g.x * ACC[2 * q].x; x.y += g.y * ACC[2 * q].y; x.z += g.z * ACC[2 * q + 1].x; x.w += g.w * ACC[2 * q + 1].y; *(f32x4*)(dst + (size_t)(t0 + TK) * D + col) = x; } } while (0)
#define EX_DN_PASS(J) do { v2u bd[2][EX_DB][4]; const unsigned voff_ = 8u * (unsigned)lane; f2v a0[4], a1[4], a2[4], a3[4]; \
            _Pragma("unroll") for (int q = 0; q < 4; ++q) { a0[q] = (f2v){0.f, 0.f}; a1[q] = (f2v){0.f, 0.f}; a2[q] = (f2v){0.f, 0.f}; a3[q] = (f2v){0.f, 0.f}; } \
            EX_DN_LD(J, 0, 0); \
            for (int b = 0; b < EX_NB; b += 2 * EX_DB) { EX_DN_STEP(J, b, 0); EX_DN_STEP(J, b + EX_DB, 1); } \
            EX_OUT1(0, a0, J); EX_OUT1(1, a1, J); EX_OUT1(2, a2, J); EX_OUT1(3, a3, J); } while (0)
        EX_DN_PASS(0);
        asm volatile("" : "+v"(lane));
        EX_DN_PASS(1);
        asm volatile("" : "+v"(lane));
        EX_DN_PASS(2);
        asm volatile("" : "+v"(lane));
        EX_DN_PASS(3);
#undef EX_DN_PASS
#undef EX_DN_LD
#undef EX_RO
#undef EX_DN_STEP
#undef EX_AXPY1
#undef EX_OUT1
        asm volatile("s_waitcnt lgkmcnt(0)" ::: "memory");
    }
}

constexpr int CONV_TT = 16;
__device__ __forceinline__ void wave_reduce16(float (&v)[16], int lane) {
    const bool b5 = lane & 32, b4 = lane & 16, b3 = lane & 8, b2 = lane & 4;
#pragma unroll
    for (int k = 0; k < 8; ++k) { const float keep = b5 ? v[k + 8] : v[k], send = b5 ? v[k] : v[k + 8]; v[k] = keep + __shfl_xor(send, 32); }
#pragma unroll
    for (int k = 0; k < 4; ++k) { const float keep = b4 ? v[k + 4] : v[k], send = b4 ? v[k] : v[k + 4]; v[k] = keep + __shfl_xor(send, 16); }
#pragma unroll
    for (int k = 0; k < 2; ++k) { const float keep = b3 ? v[k + 2] : v[k], send = b3 ? v[k] : v[k + 2]; v[k] = keep + __shfl_xor(send, 8); }
    { const float keep = b2 ? v[1] : v[0], send = b2 ? v[0] : v[1]; v[0] = keep + __shfl_xor(send, 4); }
    v[0] += __shfl_xor(v[0], 2); v[0] += __shfl_xor(v[0], 1);
}
__device__ __forceinline__ void phase_conv(const Args& A, const Ctx& C) {
    const bf16* U = (const bf16*)(A.ws + WS_U); bf16* UCV = (bf16*)(A.ws + WS_UCV);
    const float* dw = A.in[I_CDW]; const float* db = A.in[I_CDB]; const float* lg = A.in[I_CLNG]; const float* lb = A.in[I_CLNB];
    LAS float* red = (LAS float*)((LAS unsigned char*)C.lds);
    const int c0 = 2 * C.tid, lane = C.lane;
    float w0[CONV_K], w1[CONV_K];
#pragma unroll
    for (int j = 0; j < CONV_K; ++j) { const float2 w = *(const float2*)(dw + j * CONV_CH + c0); w0[j] = w.x; w1[j] = w.y; }
    const float2 bias = *(const float2*)(db + c0), gam = *(const float2*)(lg + c0), bet = *(const float2*)(lb + c0);
    const int tsel = ((lane >> 5) & 1) * 8 + ((lane >> 4) & 1) * 4 + ((lane >> 3) & 1) * 2 + ((lane >> 2) & 1);
    for (int it = C.bid; it < T / CONV_TT; it += C.nb) {
        const int t0 = it * CONV_TT, s0 = t0 % SEQ;
        unsigned in[CONV_TT + CONV_K - 1];
#pragma unroll
        for (int q = 0; q < CONV_TT + CONV_K - 1; ++q) { const int sp = s0 - (CONV_K - 1) + q;
            in[q] = (sp >= 0) ? *(const unsigned*)(U + (size_t)(t0 - (CONV_K - 1) + q) * CONV_CH + c0) : 0u; }
        float a0[CONV_TT], a1[CONV_TT];
#pragma unroll
        for (int k = 0; k < CONV_TT; ++k) { float x0 = bias.x, x1 = bias.y;
#pragma unroll
            for (int j = 0; j < CONV_K; ++j) { x0 += w0[j] * bflo(in[k + j]); x1 += w1[j] * bfhi(in[k + j]); }
            a0[k] = x0; a1[k] = x1; }
        float v[16];
#pragma unroll
        for (int k = 0; k < 16; ++k) v[k] = a0[k] + a1[k];
        wave_reduce16(v, lane);
        __syncthreads();
        if ((lane & 3) == 0) red[C.wave * 16 + tsel] = v[0];
        __syncthreads();
        float mean[16];
#pragma unroll
        for (int k = 0; k < 16; ++k) { float s = 0.f;
#pragma unroll
            for (int wv = 0; wv < NWAVES; ++wv) s += red[wv * 16 + k];
            mean[k] = s * (1.0f / CONV_CH); }
#pragma unroll
        for (int k = 0; k < 16; ++k) { a0[k] -= mean[k]; a1[k] -= mean[k]; v[k] = a0[k] * a0[k] + a1[k] * a1[k]; }
        wave_reduce16(v, lane);
        __syncthreads();
        if ((lane & 3) == 0) red[C.wave * 16 + tsel] = v[0];
        __syncthreads();
#pragma unroll
        for (int k = 0; k < 16; ++k) { float s = 0.f;
#pragma unroll
            for (int wv = 0; wv < NWAVES; ++wv) s += red[wv * 16 + k];
            const float rstd = 1.0f / sqrtf(s * (1.0f / CONV_CH) + EPS);
            const float y0 = a0[k] * rstd * gam.x + bet.x, y1 = a1[k] * rstd * gam.y + bet.y;
            *(unsigned*)(UCV + (size_t)(t0 + k) * CONV_CH + c0) = pk2(siluf_(y0), siluf_(y1)); }
    }
    __syncthreads();
}

typedef short v4i16_t __attribute__((ext_vector_type(4)));
constexpr int VROW = 288;
constexpr int ATT_V_BYTES = 256 * VROW;
constexpr int KROW = 272;
constexpr int ATT_K_OFF = ATT_V_BYTES;
constexpr int ATT_SCR_OFF = ATT_V_BYTES + 256 * KROW;
constexpr int ATT_RK_OFF = ATT_SCR_OFF + NWAVES * 256;
__device__ __forceinline__ void phase_attn(const Args& A, const Ctx& C) {
    const bf16* QKV = (const bf16*)(A.ws + WS_QKV); bf16* ON = (bf16*)(A.ws + WS_ON); float* DEN = (float*)(A.ws + WS_DEN);
    const float* qg = A.in[I_QNG]; const float* kg = A.in[I_KNG];
    LAS unsigned char* Vb = (LAS unsigned char*)C.lds;
    LAS unsigned char* Kb = Vb + ATT_K_OFF;
    LAS float* scr = (LAS float*)(Vb + ATT_SCR_OFF + C.wave * 256);
    LAS float* rkt = (LAS float*)(Vb + ATT_RK_OFF);
    unsigned z0_ = 0u; asm volatile("" : "+v"(z0_));
    const int lane = (int)__builtin_amdgcn_mbcnt_hi(~0u, __builtin_amdgcn_mbcnt_lo(~0u, z0_)), c = lane & 15, kq = lane >> 4, w = C.wave, i0 = 16 * w;
    constexpr float C2 = 0.08838834764831845f * 1.4426950408889634f;
#define ATT_DECODE(U, B_, GI_, HH_, R_, N_, DIL_) const int B_ = (U) / 384, GI_ = ((U) % 384) >> 7; const int DIL_ = (GI_ == 0) ? 1 : (GI_ == 1) ? 4 : 16; \
        const int nbk##B_ = (GI_ == 0) ? 32 : (GI_ == 1) ? 8 : 2; const int rem2##B_ = ((U) % 384) & 127; const int HH_ = rem2##B_ / (DIL_ * nbk##B_), r2##B_ = rem2##B_ % (DIL_ * nbk##B_), R_ = r2##B_ / nbk##B_, N_ = r2##B_ % nbk##B_;
#define ATT_LOAD(KD, VD, QD, RB_, N_, DIL_, HEAD_) do { unsigned zz_ = 0u; asm volatile("" : "+v"(zz_)); const int tid_ = C.wave * 64 + (int)__builtin_amdgcn_mbcnt_hi(~0u, __builtin_amdgcn_mbcnt_lo(~0u, zz_)); const int lb_ = 128 * (N_) - 128; \
        _Pragma("unroll") for (int k_ = 0; k_ < 8; ++k_) { const int idx_ = tid_ + NTHREADS * k_; int l_ = lb_ + (idx_ >> 4); l_ = l_ < 0 ? 0 : l_; \
            const bf16* rp_ = QKV + ((RB_) + (size_t)l_ * (DIL_)) * QKVW + (HEAD_) * HD + (idx_ & 15) * 8; KD[k_] = *(const v4u*)(rp_ + AW); VD[k_] = *(const v4u*)(rp_ + 2 * AW); } \
        { const bf16* qrow_ = QKV + ((RB_) + (size_t)(128 * (N_) + i0 + (tid_ & 15)) * (DIL_)) * QKVW + (HEAD_) * HD + 8 * ((tid_ & 63) >> 4); \
          _Pragma("unroll") for (int ks_ = 0; ks_ < 4; ++ks_) QD[ks_] = *(const v4u*)(qrow_ + 32 * ks_); } } while (0)
#define ATT_STORE(KD, VD) do { unsigned zz_ = 0u; asm volatile("" : "+v"(zz_)); const int tid_ = C.wave * 64 + (int)__builtin_amdgcn_mbcnt_hi(~0u, __builtin_amdgcn_mbcnt_lo(~0u, zz_)); _Pragma("unroll") for (int k_ = 0; k_ < 8; ++k_) { const int idx_ = tid_ + NTHREADS * k_; \
            *(LAS v4u*)(Kb + (idx_ >> 4) * KROW + (idx_ & 15) * 16) = KD[k_]; *(LAS v4u*)(Vb + (idx_ >> 4) * VROW + (idx_ & 15) * 16) = VD[k_]; \
            { const v4u k4 = KD[k_]; const float a0 = bflo(k4.x), a1 = bfhi(k4.x), a2 = bflo(k4.y), a3 = bfhi(k4.y), a4 = bflo(k4.z), a5 = bfhi(k4.z), a6 = bflo(k4.w), a7 = bfhi(k4.w); \
              const float ssr_ = rowsum_f((a0 * a0 + a1 * a1) + (a2 * a2 + a3 * a3) + (a4 * a4 + a5 * a5) + (a6 * a6 + a7 * a7));        \
              rkt[idx_ >> 4] = C2 / sqrtf(ssr_ * (1.0f / HD) + EPS); } } } while (0)
    v4u knext[8], vnext[8], qnext[4], qraw[4];
    if (C.bid < 768) { ATT_DECODE(C.bid, b0_, gi0_, hh0_, r0_, n0_, dil0_); ATT_LOAD(knext, vnext, qraw, (size_t)b0_ * SEQ + r0_, n0_, dil0_, gi0_ * 4 + hh0_); ATT_STORE(knext, vnext); }
    for (int u = C.bid; u < 768; u += C.nb) {
        ATT_DECODE(u, b, gi, hh, r, n, dil);
        const int head = gi * 4 + hh;
        const size_t rowbase = (size_t)b * SEQ + r;
        const int lb = 128 * n - 128;
        __syncthreads();
        const int un = u + C.nb; const bool hasn = un < 768;
        if (hasn) { ATT_DECODE(un, bn_, gin_, hhn_, rn_, nn_, diln_); ATT_LOAD(knext, vnext, qnext, (size_t)bn_ * SEQ + rn_, nn_, diln_, gin_ * 4 + hhn_); }
        pg8::bf16x8 qf[4];
        { float ss = 0.f;
#pragma unroll
          for (int ks = 0; ks < 4; ++ks) { const v4u rw = qraw[ks];
              const float a0 = bflo(rw.x), a1 = bfhi(rw.x), a2 = bflo(rw.y), a3 = bfhi(rw.y), a4 = bflo(rw.z), a5 = bfhi(rw.z), a6 = bflo(rw.w), a7 = bfhi(rw.w);
              ss += (a0 * a0 + a1 * a1) + (a2 * a2 + a3 * a3) + (a4 * a4 + a5 * a5) + (a6 * a6 + a7 * a7); }
          ss += __shfl_xor(ss, 16); ss += __shfl_xor(ss, 32);
          const float rq = 1.0f / sqrtf(ss * (1.0f / HD) + EPS);
#pragma unroll
          for (int ks = 0; ks < 4; ++ks) { const int d0 = head * HD + 32 * ks + 8 * kq; const v4u rw = qraw[ks];
              const f32x4 g0 = *(const f32x4*)(qg + d0) * *(const f32x4*)(kg + d0), g1 = *(const f32x4*)(qg + d0 + 4) * *(const f32x4*)(kg + d0 + 4);
              pg8::u32x4 pk;
              pk.x = pg8::cvt_pk_bf16(bflo(rw.x) * rq * g0.x, bfhi(rw.x) * rq * g0.y); pk.y = pg8::cvt_pk_bf16(bflo(rw.y) * rq * g0.z, bfhi(rw.y) * rq * g0.w);
              pk.z = pg8::cvt_pk_bf16(bflo(rw.z) * rq * g1.x, bfhi(rw.z) * rq * g1.y); pk.w = pg8::cvt_pk_bf16(bflo(rw.w) * rq * g1.z, bfhi(rw.w) * rq * g1.w);
              qf[ks] = __builtin_bit_cast(pg8::bf16x8, pk); } }
        unsigned Pk[10][2]; float dsum = 0.f;
#pragma unroll
        for (int kb = 0; kb < 9; ++kb) {
            const int j0 = i0 + 16 * kb;
            v4u kr[4];
#pragma unroll
            for (int ks = 0; ks < 4; ++ks) kr[ks] = *(const LAS v4u*)(Kb + (j0 + c) * KROW + 64 * ks + 16 * kq);
            const f32x4 rk4 = *(const LAS f32x4*)(rkt + j0 + 4 * kq);
            f32x4 acc = {0.f, 0.f, 0.f, 0.f};
#pragma unroll
            for (int ks = 0; ks < 4; ++ks) acc = __builtin_amdgcn_mfma_f32_16x16x32_bf16(__builtin_bit_cast(pg8::bf16x8, kr[ks]), qf[ks], acc, 0, 0, 0);
#pragma unroll
            for (int e = 0; e < 4; ++e) { const int j = j0 + 4 * kq + e; const int dist = 128 + i0 + c - j;
                const bool valid = (dist >= 0) && (dist <= 128) && (lb + j >= 0);
                const float pv = __builtin_amdgcn_exp2f(acc[e] * rk4[e]);
                acc[e] = valid ? pv : 0.f; dsum += acc[e]; }
            Pk[kb][0] = pg8::cvt_pk_bf16(acc[0], acc[1]); Pk[kb][1] = pg8::cvt_pk_bf16(acc[2], acc[3]);
        }
        Pk[9][0] = 0u; Pk[9][1] = 0u;
        dsum += __shfl_xor(dsum, 16); dsum += __shfl_xor(dsum, 32);
        if (kq == 0) scr[32 + c] = dsum;
        const f32x4 dq = *(const LAS f32x4*)(scr + 32 + 4 * kq);
        f32x4 O[8];
#pragma unroll
        for (int dt = 0; dt < 8; ++dt) O[dt] = (f32x4){0.f, 0.f, 0.f, 0.f};
#pragma unroll
        for (int s = 0; s < 5; ++s) {
            pg8::u32x4 pk; pk.x = Pk[2 * s][0]; pk.y = Pk[2 * s][1]; pk.z = Pk[2 * s + 1][0]; pk.w = Pk[2 * s + 1][1];
            const pg8::bf16x8 pf = __builtin_bit_cast(pg8::bf16x8, pk);
            const int kb1 = (2 * s + 1 < 9) ? 2 * s + 1 : 8;
            const int rowA = i0 + 32 * s + 4 * kq + (c >> 2), rowB = i0 + 16 * kb1 + 4 * kq + (c >> 2);
            LAS unsigned char* pa = Vb + rowA * VROW + (c & 3) * 8; LAS unsigned char* pb = Vb + rowB * VROW + (c & 3) * 8;
#pragma unroll
            for (int dt = 0; dt < 8; ++dt) {
                const v4i16_t lo = __builtin_amdgcn_ds_read_tr16_b64_v4i16((LAS v4i16_t*)(pa + dt * 32));
                const v4i16_t hi = __builtin_amdgcn_ds_read_tr16_b64_v4i16((LAS v4i16_t*)(pb + dt * 32));
                const pg8::bf16x8 vf = {lo[0], lo[1], lo[2], lo[3], hi[0], hi[1], hi[2], hi[3]};
                O[dt] = __builtin_amdgcn_mfma_f32_16x16x32_bf16(pf, vf, O[dt], 0, 0, 0);
            }
        }
        { float inv[4];
#pragma unroll
          for (int e = 0; e < 4; ++e) inv[e] = 1.0f / dq[e];
#pragma unroll
          for (int e = 0; e < 4; ++e) { const size_t trow = rowbase + (size_t)(128 * n + i0 + 4 * kq + e) * dil;
              bf16* op = ON + ((size_t)gi * T + trow) * AOW + hh * HD + c;
#pragma unroll
              for (int dt = 0; dt < 8; ++dt) op[16 * dt] = (bf16)f2bf(O[dt][e] * inv[e]); }
          { unsigned zq_ = 0u; asm volatile("" : "+v"(zq_)); const int l2_ = (int)__builtin_amdgcn_mbcnt_hi(~0u, __builtin_amdgcn_mbcnt_lo(~0u, zq_));
            if ((l2_ >> 4) == 0) DEN[((size_t)gi * T + rowbase + (size_t)(128 * n + 16 * C.wave + (l2_ & 15)) * dil) * 4 + hh] = dsum; } }
        __syncthreads();
        if (hasn) { ATT_STORE(knext, vnext);
#pragma unroll
            for (int ks = 0; ks < 4; ++ks) qraw[ks] = qnext[ks]; }
    }
#undef ATT_DECODE
#undef ATT_LOAD
#undef ATT_STORE
}
__device__ __forceinline__ void phase_attn_combine(const Args& A, const Ctx& C) {
    const bf16* ON = (const bf16*)(A.ws + WS_ON); const float* DEN = (const float*)(A.ws + WS_DEN); bf16* O = (bf16*)(A.ws + WS_O);
    const int gt = C.bid * NTHREADS + C.tid, ngt = C.nb * NTHREADS;
    for (int i = gt; i < T * (AOW / 8); i += ngt) {
        const int t = i >> 6, ch = i & 63, hh = ch >> 4;
        const float d0 = DEN[((size_t)0 * T + t) * 4 + hh], d1 = DEN[((size_t)1 * T + t) * 4 + hh], d2 = DEN[((size_t)2 * T + t) * 4 + hh];
        const float inv = 1.0f / (d0 + d1 + d2); const float w0 = d0 * inv, w1 = d1 * inv, w2 = d2 * inv;
        const v4u a = *(const v4u*)(ON + ((size_t)0 * T + t) * AOW + ch * 8), bq = *(const v4u*)(ON + ((size_t)1 * T + t) * AOW + ch * 8), cq = *(const v4u*)(ON + ((size_t)2 * T + t) * AOW + ch * 8);
        v4u o;
        o.x = pk2(w0 * bflo(a.x) + w1 * bflo(bq.x) + w2 * bflo(cq.x), w0 * bfhi(a.x) + w1 * bfhi(bq.x) + w2 * bfhi(cq.x));
        o.y = pk2(w0 * bflo(a.y) + w1 * bflo(bq.y) + w2 * bflo(cq.y), w0 * bfhi(a.y) + w1 * bfhi(bq.y) + w2 * bfhi(cq.y));
        o.z = pk2(w0 * bflo(a.z) + w1 * bflo(bq.z) + w2 * bflo(cq.z), w0 * bfhi(a.z) + w1 * bfhi(bq.z) + w2 * bfhi(cq.z));
        o.w = pk2(w0 * bflo(a.w) + w1 * bflo(bq.w) + w2 * bflo(cq.w), w0 * bfhi(a.w) + w1 * bfhi(bq.w) + w2 * bfhi(cq.w));
        *(v4u*)(O + (size_t)t * AOW + ch * 8) = o;
    }
}

__global__ void __launch_bounds__(NTHREADS, 2) mk_fwd(Args args) {
    extern __shared__ __attribute__((aligned(16))) unsigned char lds[];
    Ctx C;
    C.tid = threadIdx.x; C.lane = C.tid & 63; C.wave = __builtin_amdgcn_readfirstlane(C.tid >> 6);
    C.bid = blockIdx.x; C.nb = gridDim.x; C.gw = C.bid * NWAVES + C.wave; C.ngw = C.nb * NWAVES; C.lds = lds;
    volatile LAS unsigned* MISC = (volatile LAS unsigned*)((LAS unsigned char*)lds + MISC_OFF);
    if (C.tid < 32) MISC[C.tid] = 0u;
    __syncthreads();
    unsigned* ctl = (unsigned*)(args.ws + WS_CTL);
    XcdBarrier bar; bar.bar = ctl + CW_BAR; bar.x = 0; bar.st = nullptr;
    const int lo = args.ph_lo, hi = args.ph_hi;
    if (hi - lo > 1) bar = xcd_barrier_post(ctl + CW_BAR, MISC + 8);
    bar.wave = C.wave;
#define IN(k) (lo <= (k) && (k) < hi)
#define SEAM(k) do { if (IN(k) && IN((k) + 1)) xcd_barrier(bar); } while (0)
    unsigned char* ws = args.ws;
    const float* mod = (const float*)(ws + WS_MOD);
#define REP(k) for (int rep_ = 0; rep_ < ((PROBE_DUP == (k)) ? 2 : 1); ++rep_)
#define FRESH_CTX() do { unsigned z_ = 0u; asm volatile("" : "+v"(z_)); C.lane = (int)__builtin_amdgcn_mbcnt_hi(~0u, __builtin_amdgcn_mbcnt_lo(~0u, z_)); C.tid = C.wave * 64 + C.lane; } while (0)
    if (IN(0)) { FRESH_CTX(); REP(0) phase_prologue(args, C); } SEAM(0);
    if (IN(1)) { FRESH_CTX(); REP(1) phase_norm_mod<true>(args.in[I_X], args.in[I_N1G], mod, 0, 1, (bf16*)(ws + WS_H), C); } SEAM(1);
    LAS unsigned char* ldsl = (LAS unsigned char*)lds;
    if (IN(2)) { FRESH_CTX(); REP(2) { pg8::Gemm g{(const bf16*)(ws + WS_H), (const bf16*)(ws + WS_WIN), T, IN_COLS, D / 2}; pg8::StaticOrder S; S.init(T, IN_COLS, C.nb, C.bid);
                 pg8::EpiIn E{(bf16*)(ws + WS_U), (bf16*)(ws + WS_QKV), (bf16*)(ws + WS_G), 0, 1.0f / WIN_SCALE};
                 pg8::gemm_phase<pg8::EpiIn, pg8::StaticOrder, false, true, true>(ldsl, g, S, E, C.wave); }
                 { constexpr int NT6 = (T / 256) * (IN_COLS / 256) % 256;
                   if (C.nb == 256 && NT6 > 0) { if (C.bid >= NT6) late_transposes(args, C, lds, (C.bid - NT6) * NWAVES + C.wave, (256 - NT6) * NWAVES); }
                   else late_transposes(args, C, lds, C.gw, C.ngw); } } SEAM(2);
    if (IN(3)) { FRESH_CTX(); REP(3) { phase_conv(args, C); phase_attn(args, C); } } SEAM(3);
    if (IN(4)) { FRESH_CTX(); phase_attn_combine(args, C);
                 pg8::Gemm g{(const bf16*)(ws + WS_UCV), (const bf16*)(ws + WS_WCO), T, D, CONV_CH}; pg8::StaticOrder S; S.init(T, D, C.nb, C.bid);
                 pg8::EpiYconv E{(const bf16*)(ws + WS_G), (bf16*)(ws + WS_MERGED), args.in[I_BCO]};
                 pg8::gemm_phase<pg8::EpiYconv, pg8::StaticOrder, true, true>(ldsl, g, S, E, C.wave); } SEAM(4);
    if (IN(5)) { FRESH_CTX(); REP(5) { pg8::Gemm g{(const bf16*)(ws + WS_O), (const bf16*)(ws + WS_WAO), T, D, AOW}; pg8::StaticOrder S; S.init(T, D, C.nb, C.bid);
                 pg8::EpiYattn E{(const bf16*)(ws + WS_G), (const bf16*)(ws + WS_MERGED), ws + WS_QP, MG_SCALE};
                 pg8::gemm_phase<pg8::EpiYattn, pg8::StaticOrder, true, true>(ldsl, g, S, E, C.wave); } } SEAM(5);
    if (IN(6)) { FRESH_CTX(); REP(6) { pg8::Gemm g{(const bf16*)(ws + WS_QP), (const bf16*)(ws + WS_WOUT), T, D, D / 2}; pg8::StaticOrder S; S.init(T, D, C.nb, C.bid);
                 pg8::EpiOut E{args.in[I_X], mod, args.out, 1.0f / (MG_SCALE * WIN_SCALE)};
                 pg8::gemm_phase<pg8::EpiOut, pg8::StaticOrder, true, true, true>(ldsl, g, S, E, C.wave); } } SEAM(6);
    if (IN(7)) { FRESH_CTX(); REP(7) phase_norm_mod<false>(args.out, args.in[I_N2G], mod, 3, 4, (bf16*)(ws + WS_H), C); } SEAM(7);
    if (IN(8)) { FRESH_CTX(); REP(8) { pg8::Gemm g{(const bf16*)(ws + WS_H), (const bf16*)(ws + WS_WQ), T, D, D}; pg8::StaticOrder S; S.init(T, D, C.nb, C.bid);
                 pg8::EpiPlain E{(bf16*)(ws + WS_QP), D};
                 pg8::gemm_phase<pg8::EpiPlain, pg8::StaticOrder, true, true>(ldsl, g, S, E, C.wave); } } SEAM(8);
    if (IN(9)) { FRESH_CTX(); REP(9) phase_topk(args, C); } SEAM(9);
    if (IN(10)) { FRESH_CTX(); for (int rep_ = (PROBE_DUP == 10) ? 0 : 1; rep_ < 2; ++rep_) phase_experts3(args, C, rep_ ? args.out : (float*)(ws + WS_MERGED), rep_ ? 0xFFFFFFFFu : PROBE_EMASK); }
#undef REP
#undef IN
#undef SEAM
}

extern "C" void kernel_launch(void* const* d_in, const int* in_sizes, int n_in, void* d_out, int out_size, void* d_ws, size_t ws_size, hipStream_t stream) {
    static int grid = 0;
    if (grid == 0) {
        if (n_in != 21 || in_sizes[0] != T * D || out_size != T * D || ws_size < WS_END) {
            fprintf(stderr, "kernel_launch: unexpected shapes: n_in %d in0 %d out %d ws %zu (need %zu)\n", n_in, n_in > 0 ? in_sizes[0] : -1, out_size, ws_size, (size_t)WS_END); grid = -1; return; }
        int dev = 0, cus = 0, per_cu = 0;
        if (hipGetDevice(&dev) != hipSuccess || hipDeviceGetAttribute(&cus, hipDeviceAttributeMultiprocessorCount, dev) != hipSuccess) { grid = -1; return; }
        if (hipFuncSetAttribute((const void*)mk_fwd, hipFuncAttributeMaxDynamicSharedMemorySize, LDS_BYTES) != hipSuccess) { fprintf(stderr, "kernel_launch: hipFuncSetAttribute failed\n"); grid = -1; return; }
        if (hipOccupancyMaxActiveBlocksPerMultiprocessor(&per_cu, (const void*)mk_fwd, NTHREADS, LDS_BYTES) != hipSuccess || per_cu < 1)
            fprintf(stderr, "kernel_launch: note: occupancy query reports %d\n", per_cu);
        (void)hipGetLastError();
        grid = cus;
    }
    if (grid < 0) return;
    (void)hipMemsetAsync((char*)d_ws + WS_CTL, 0, CTL_ZERO_BYTES, stream);
    Args a{};
    for (int i = 0; i < 21; ++i) a.in[i] = (const float*)d_in[i];
    a.out = (float*)d_out; a.ws = (unsigned char*)d_ws;
#if N_LAUNCH_MODE == 1
    a.ph_lo = 0; a.ph_hi = NPHASES;
    hipLaunchKernelGGL(mk_fwd, dim3(grid), dim3(NTHREADS), LDS_BYTES, stream, a);
#else
    for (int p = 0; p < NPHASES; ++p) { a.ph_lo = p; a.ph_hi = p + 1; hipLaunchKernelGGL(mk_fwd, dim3(grid), dim3(NTHREADS), LDS_BYTES, stream, a); }
#endif
}
```

```cpp
#include <hip/hip_runtime.h>
#include <cstdio>
#include <cstdint>
#include <cmath>

constexpr int BATCH = 2, SEQ = 4096, D = 2048, T = BATCH * SEQ;
constexpr int CONV_CH = 1024, CONV_K = 31;
constexpr int HD = 128, NHEADS = 12, AW = 1536, AOW = 512;
constexpr int OFF_Q = 2048, OFF_G = OFF_Q + 3 * AW, IN_COLS = OFF_G + 2 * D;
constexpr int QKVW = 3 * AW;
constexpr int PEER_H = 8, PEER_NK = 128, PEER_TOPK = 16, PEER_HK = PEER_H * PEER_TOPK;
constexpr int PEER_E = PEER_NK * PEER_NK;
constexpr int MODW = 6 * D;
constexpr float EPS = 1e-6f;
constexpr int NWAVES = 8, NTHREADS = NWAVES * 64;
#ifndef N_LAUNCH_MODE
#define N_LAUNCH_MODE 1
#endif
constexpr int NPHASES = 11;
#ifndef PROBE_EMASK
#define PROBE_EMASK 0xFFFFFFFFu
#endif
#ifndef PROBE_DUP
#define PROBE_DUP (-1)
#endif
#ifndef MFMA_MASK
#define MFMA_MASK 31
#endif
#ifndef P2_SPLIT
#define P2_SPLIT 0
#endif

constexpr size_t MiB = 1u << 20;
constexpr size_t WS_CTL = 0, CTL_ZERO_BYTES = 64 * 1024;
constexpr size_t WS_MOD = 1 * MiB;
constexpr size_t WS_SK = 1 * MiB + 512 * 1024;
constexpr size_t WS_WIN = 2 * MiB;
constexpr size_t WS_WCO = 44 * MiB;
constexpr size_t WS_WAO = 48 * MiB;
constexpr size_t WS_WOUT = 50 * MiB;
constexpr size_t WS_WQ = 58 * MiB;
constexpr size_t WS_WUP = 66 * MiB;
constexpr size_t WS_WDN = 130 * MiB;
constexpr size_t WS_SUP = 98 * MiB, WS_SDN = 98 * MiB + 65536;
constexpr size_t WS_H = 194 * MiB;
constexpr size_t WS_U = 226 * MiB;
constexpr size_t WS_QKV = 242 * MiB;
constexpr size_t WS_G = 314 * MiB;
constexpr size_t WS_UCV = 378 * MiB;
constexpr size_t WS_ON = 394 * MiB;
constexpr size_t WS_DEN = 418 * MiB;
constexpr size_t WS_O = 419 * MiB;
constexpr size_t WS_MERGED = 427 * MiB;
constexpr size_t WS_QP = 459 * MiB;
constexpr size_t WS_IDX = 491 * MiB;
constexpr size_t WS_GW = 495 * MiB;
constexpr size_t WS_END = 500 * MiB;
constexpr int CW_BAR = 4096;
constexpr int TK_W = 4;
constexpr int UP_TAIL_ROWS = 4096;
constexpr float MG_SCALE = 16.0f;
constexpr float WIN_SCALE = 256.0f;

constexpr int LDS_BYTES = 147456 + 512;
constexpr int RING_BYTES = 131072, MISC_OFF = 147456 + 64;

#define GAS __attribute__((address_space(1)))
#define LAS __attribute__((address_space(3)))
typedef unsigned short bf16;
typedef unsigned v4u __attribute__((ext_vector_type(4)));
typedef unsigned v2u __attribute__((ext_vector_type(2)));
typedef float f32x4 __attribute__((ext_vector_type(4)));
#define RLX_AGENT __ATOMIC_RELAXED, __HIP_MEMORY_SCOPE_AGENT

__device__ __forceinline__ unsigned f2bf(float f) { unsigned u = __builtin_bit_cast(unsigned, f); return (u + 0x7fffu + ((u >> 16) & 1u)) >> 16; }
__device__ __forceinline__ unsigned pk2(float lo, float hi) { return f2bf(lo) | (f2bf(hi) << 16); }
__device__ __forceinline__ float bf2f(unsigned b) { return __builtin_bit_cast(float, b << 16); }
__device__ __forceinline__ float bflo(unsigned w) { return __builtin_bit_cast(float, w << 16); }
__device__ __forceinline__ float bfhi(unsigned w) { return __builtin_bit_cast(float, w & 0xffff0000u); }
__device__ __forceinline__ float wave_sum(float v) {
#pragma unroll
    for (int o = 1; o < 64; o <<= 1) v += __shfl_xor(v, o);
    return v;
}
__device__ __forceinline__ float sigmoidf_(float x) { return 1.0f / (1.0f + __expf(-x)); }
__device__ __forceinline__ float siluf_(float x) { return x / (1.0f + __expf(-x)); }
__device__ __forceinline__ float gelu_erf(float x) { return 0.5f * x * (1.0f + erff(x * 0.70710678118654752f)); }

__device__ __forceinline__ int lane_id() { return (int)__builtin_amdgcn_mbcnt_hi(~0u, __builtin_amdgcn_mbcnt_lo(~0u, 0u)); }
#define XB_TMO      128
#define XB_XCNT(j)  (256  + 64 * (j))
#define XB_XSUB(j)  (1280 + 64 * (j))
#define XB_XGEN(j)  (2304 + 64 * (j))
#define XB_TOP      3328
#define XB_TOPGEN   3392
#define XCD_BAR_WORDS 3456
#define XB_SPIN_CAP (1u << 22)
__device__ __forceinline__ unsigned xb_ld(unsigned* p)              { return __hip_atomic_load(p, __ATOMIC_RELAXED, __HIP_MEMORY_SCOPE_AGENT); }
__device__ __forceinline__ unsigned xb_add(unsigned* p, unsigned v) { return __hip_atomic_fetch_add(p, v, __ATOMIC_RELAXED, __HIP_MEMORY_SCOPE_AGENT); }
__device__ __forceinline__ unsigned xb_xcc_id() { return (unsigned)__builtin_amdgcn_s_getreg((3 << 11) | 20) & 0xFu; }
#define XB_SPIN(cond, bar) do { unsigned _sp = 0; while (cond) { __builtin_amdgcn_s_sleep(1); \
    if ((++_sp & 255u) == 0u) { if (xb_ld(&(bar)[XB_TMO])) break; if (_sp > XB_SPIN_CAP) { atomicAdd(&(bar)[XB_TMO], 1u); break; } } } } while (0)
struct XcdBarrier { unsigned* bar; unsigned x; volatile LAS unsigned* st; int wave; };
__device__ __forceinline__ XcdBarrier xcd_barrier_post(unsigned* bar, volatile LAS unsigned* st) {
    XcdBarrier b; b.bar = bar; b.x = xb_xcc_id(); b.st = st; b.wave = 0;
    if (threadIdx.x == 0) (void)xb_add(&bar[XB_XCNT(b.x)], 1u);
    return b;
}
__device__ __forceinline__ void xcd_barrier_complete(unsigned* bar, unsigned x, unsigned& nloc, unsigned& nx) {
    const unsigned G = gridDim.x * gridDim.y * gridDim.z;
    unsigned sum, cnt, mine, sp = 0u;
    for (;;) {
        sum = 0u; cnt = 0u; mine = 0u;
#pragma unroll
        for (unsigned j = 0; j < 16; ++j) { const unsigned c = xb_ld(&bar[XB_XCNT(j)]); sum += c; cnt += (c > 0u) ? 1u : 0u; mine = (j == x) ? c : mine; }
        if (sum == G) break;
        __builtin_amdgcn_s_sleep(1);
        if ((++sp & 255u) == 0u) { if (xb_ld(&bar[XB_TMO])) break; if (sp > XB_SPIN_CAP) { atomicAdd(&bar[XB_TMO], 1u); break; } }
    }
    nloc = mine > 0u ? mine : 1u; nx = cnt > 0u ? cnt : 1u;
}
__device__ __forceinline__ void xcd_barrier(const XcdBarrier& b) {
    asm volatile("s_waitcnt vmcnt(0)" ::: "memory");
    __syncthreads();
    if (b.wave == 0 && lane_id() == 0) {
        unsigned* bar = b.bar;
        __builtin_amdgcn_s_waitcnt(0);
        unsigned nloc = b.st[0], nx = b.st[1];
        if (nloc == 0u) { xcd_barrier_complete(bar, b.x, nloc, nx); b.st[0] = nloc; b.st[1] = nx; }
        const unsigned old = xb_add(&bar[XB_XSUB(b.x)], 1u);
        const unsigned gen = old / nloc;
        if (old + 1u == (gen + 1u) * nloc) {
            __builtin_amdgcn_fence(__ATOMIC_RELEASE, "agent");
            asm volatile("s_waitcnt vmcnt(0)" ::: "memory");
            const unsigned og = xb_add(&bar[XB_TOP], 1u);
            const unsigned tg = og / nx;
            if (og + 1u == (tg + 1u) * nx) xb_add(&bar[XB_TOPGEN], 1u);
            else XB_SPIN(xb_ld(&bar[XB_TOPGEN]) == tg, bar);
            __builtin_amdgcn_fence(__ATOMIC_ACQUIRE, "agent");
            xb_add(&bar[XB_XGEN(b.x)], 1u);
            asm volatile("s_waitcnt vmcnt(0)" ::: "memory");
        } else {
            XB_SPIN(xb_ld(&bar[XB_XGEN(b.x)]) == gen, bar);
            __builtin_amdgcn_fence(__ATOMIC_ACQUIRE, "agent");
            asm volatile("s_waitcnt vmcnt(0)" ::: "memory");
        }
    }
    __syncthreads();
}

namespace pg8 {
#define PG8_LAS __attribute__((address_space(3)))
typedef unsigned short bf16_t;
typedef short bf16x8 __attribute__((ext_vector_type(8)));
typedef float f32x4 __attribute__((ext_vector_type(4)));
typedef unsigned u32x4 __attribute__((ext_vector_type(4)));
constexpr int BM = 256, BK = 64, HALF = 128, HTB = HALF * BK * 2  , STAGE_BYTES = 8 * HTB, NXCD = 8, WGM = 16;

__host__ __device__ __forceinline__ int lds_byte(int r, int c) { const int st = (r >> 4) * 2 + (c >> 5), rr = r & 15, cc = c & 31, ob = rr * 64 + cc * 2; return st * 1024 + (ob ^ (((ob >> 9) & 1) << 5)); }
__host__ __device__ __forceinline__ void stage_rc(int b, int& R, int& C) { const int st = b / 1024, sb = b % 1024, swz = sb ^ (((sb >> 9) & 1) << 5); R = (st >> 1) * 16 + swz / 64; C = (st & 1) * 32 + (swz % 64) / 2; }
__host__ __device__ __forceinline__ int perm32(int rho) { const int n = rho >> 4, i = rho & 15; return 8 * (i >> 2) + 4 * n + (i & 3); }

struct Unit { int pm, pn; };
struct Gemm { const bf16_t* A; const bf16_t* Bt; int M, N, K; };

struct StaticOrder {
    int nM, nN, nwg, G, c;
    __host__ __device__ void init(int M, int N, int G_, int c_) { nM = M / BM; nN = N / BM; nwg = nM * nN; G = G_; c = c_; }
    __host__ __device__ bool next(int i, Unit& u) const {
        const long L = (long)i * G + c; if (L >= nwg) return false;
        int wgid = (int)L; { const int q = nwg / NXCD, r = nwg % NXCD, xcd = wgid % NXCD, off = wgid / NXCD; wgid = (xcd < r ? xcd * (q + 1) : r * (q + 1) + (xcd - r) * q) + off; }
        const int nig = WGM * nN, gid = wgid / nig, fm = gid * WGM, gsz = (nM - fm) < WGM ? (nM - fm) : WGM;
        u.pm = fm + ((wgid % nig) % gsz); u.pn = (wgid % nig) / gsz; return true;
    }
    __device__ __forceinline__ void a_ready(const Unit&) const {}
    __device__ __forceinline__ void done(const Unit&) const {}
};

typedef float f32x2_t __attribute__((ext_vector_type(2))); typedef __bf16 bf16x2_t __attribute__((ext_vector_type(2)));
__device__ __forceinline__ unsigned cvt_pk_bf16(float lo, float hi) { f32x2_t v = {lo, hi}; bf16x2_t b = __builtin_convertvector(v, bf16x2_t); return __builtin_bit_cast(unsigned, b); }
typedef float f32x2 __attribute__((ext_vector_type(2)));
typedef int v8i_t __attribute__((ext_vector_type(8)));
struct Frag32 { bf16x8 lo, hi; };
template <class Epi, class Sched, bool ALIGN_EPI = false, bool SP2 = false, bool FP8 = false>
__device__ __forceinline__ void gemm_phase(PG8_LAS unsigned char* lds, const Gemm g, const Sched& S, const Epi& E, int wave_idx) {
    const int wid = wave_idx, lane = lane_id(), tid = wid * 64 + lane, wr = wid >> 2, wc = wid & 3, fr = lane & 15, fq = lane >> 4;
    const int K = g.K, nt = K / BK;
    unsigned voffA[2], voffB[2];
#pragma unroll
    for (int i = 0; i < 2; ++i) { int R, C; stage_rc(tid * 16 + i * 8192, R, C); const int Rb = Epi::PERM ? ((R & ~31) + perm32(R & 31)) : R;
        voffA[i] = (unsigned)(R * K + C) * 2u; voffB[i] = (unsigned)(Rb * K + C) * 2u; }
    const size_t kstep = (size_t)(BK * 2);
    const size_t hstep = (size_t)HALF * K * 2;
    const size_t tstep = 2 * hstep;
    const unsigned ldsw = (unsigned)wid * 1024u;
    const int aoff = lds_byte(wr * 64 + fr, fq * 8), boff = lds_byte(wc * 32 + fr, fq * 8);
#define PG8_SA(b, h) (((b) * 2 + (h)) * HTB)
#define PG8_SB(b, h) ((4 + (b) * 2 + (h)) * HTB)
#define PG8_STAGE(bufoff, gbase, voff) do { _Pragma("unroll") for (int _i = 0; _i < 2; ++_i) { unsigned vo_ = (voff)[_i]; asm volatile("" : "+v"(vo_));     \
        __builtin_amdgcn_global_load_lds((const unsigned*)((const char*)(gbase) + vo_), (PG8_LAS unsigned*)(lds + (bufoff) + ldsw + _i * 8192), 16, 0, 0); } } while (0)
#define PG8_LDA(dst, b, h) do { _Pragma("unroll") for (int m = 0; m < 4; ++m) { const bf16x8 lo_ = *(const PG8_LAS bf16x8*)(lds + PG8_SA(b, h) + aoff + m * 2048), hi_ = *(const PG8_LAS bf16x8*)(lds + PG8_SA(b, h) + aoff + m * 2048 + 1024); dst[m] = __builtin_bit_cast(v8i_t, (Frag32){lo_, hi_}); } } while (0)
#define PG8_LDB(dst, b, h) do { _Pragma("unroll") for (int n = 0; n < 2; ++n) { const bf16x8 lo_ = *(const PG8_LAS bf16x8*)(lds + PG8_SB(b, h) + boff + n * 2048), hi_ = *(const PG8_LAS bf16x8*)(lds + PG8_SB(b, h) + boff + n * 2048 + 1024); dst[n] = __builtin_bit_cast(v8i_t, (Frag32){lo_, hi_}); } } while (0)
#define PG8_MMA(ai, bj, At, Bt) do { __builtin_amdgcn_s_setprio(1); \
        if constexpr (FP8) { _Pragma("unroll") for (int m = 0; m < 4; ++m) _Pragma("unroll") for (int n = 0; n < 2; ++n) \
            acc[ai][bj][m][n] = __builtin_amdgcn_mfma_scale_f32_16x16x128_f8f6f4(Bt[n], At[m], acc[ai][bj][m][n], 0, 0, 0, 0x7F7F7F7F, 0, 0x7F7F7F7F); } \
        else { _Pragma("unroll") for (int m = 0; m < 4; ++m) _Pragma("unroll") for (int n = 0; n < 2; ++n) { const Frag32 fa_ = __builtin_bit_cast(Frag32, At[m]), fb_ = __builtin_bit_cast(Frag32, Bt[n]); \
            acc[ai][bj][m][n] = __builtin_amdgcn_mfma_f32_16x16x32_bf16(fb_.lo, fa_.lo, acc[ai][bj][m][n], 0, 0, 0); acc[ai][bj][m][n] = __builtin_amdgcn_mfma_f32_16x16x32_bf16(fb_.hi, fa_.hi, acc[ai][bj][m][n], 0, 0, 0); } } \
        __builtin_amdgcn_s_setprio(0); } while (0)
#define PG8_WAIT_V(n) asm volatile("s_waitcnt vmcnt(" #n ")" ::: "memory")
#define PG8_WAIT_L(n) asm volatile("s_waitcnt lgkmcnt(" #n ")" ::: "memory")
#define PG8_BAR __builtin_amdgcn_s_barrier()
#define PG8_SCHED __builtin_amdgcn_sched_barrier(0)
    Unit cur, nxt; int ui = 0;
    if (!S.next(0, cur)) return;
    f32x4 acc[2][2][4][2];
#pragma unroll
    for (int a = 0; a < 2; ++a)
#pragma unroll
        for (int b = 0; b < 2; ++b)
#pragma unroll
            for (int m = 0; m < 4; ++m)
#pragma unroll
                for (int n = 0; n < 2; ++n) acc[a][b][m][n] = (f32x4){0.f, 0.f, 0.f, 0.f};
    v8i_t At[4], B0[2], B1[2];
    const char* cA = (const char*)g.A + (size_t)cur.pm * tstep; const char* cB = (const char*)g.Bt + (size_t)cur.pn * tstep;
    S.a_ready(cur);
    if constexpr (SP2) {
        PG8_STAGE(PG8_SB(0, 0), cB, voffB); PG8_STAGE(PG8_SB(0, 1), cB + hstep, voffB); PG8_STAGE(PG8_SA(0, 0), cA, voffA); PG8_STAGE(PG8_SA(0, 1), cA + hstep, voffA);
        if (wr == 1) PG8_BAR;
        PG8_WAIT_V(2); PG8_BAR;
        PG8_STAGE(PG8_SB(1, 0), cB + kstep, voffB); PG8_STAGE(PG8_SA(1, 0), cA + kstep, voffA); PG8_STAGE(PG8_SB(1, 1), cB + hstep + kstep, voffB);
        PG8_WAIT_V(6); PG8_BAR;
    } else {
        PG8_STAGE(PG8_SB(0, 0), cB, voffB); PG8_STAGE(PG8_SA(0, 0), cA, voffA); PG8_STAGE(PG8_SB(0, 1), cB + hstep, voffB); PG8_STAGE(PG8_SA(0, 1), cA + hstep, voffA);
        if (wr == 1) PG8_BAR;
        PG8_WAIT_V(4); PG8_BAR;
        PG8_STAGE(PG8_SB(1, 0), cB + kstep, voffB); PG8_STAGE(PG8_SA(1, 0), cA + kstep, voffA); PG8_STAGE(PG8_SB(1, 1), cB + hstep + kstep, voffB);
        PG8_WAIT_V(6); PG8_BAR;
    }
    for (;;) {
        const bool has_next = S.next(ui + 1, nxt);
        const char* nA = has_next ? (const char*)g.A + (size_t)nxt.pm * tstep : cA; const char* nB = has_next ? (const char*)g.Bt + (size_t)nxt.pn * tstep : cB;
        for (int t = 0; t < nt; t += 2) {
            const bool last = (t == nt - 2);
            const char* a1 = cA + (size_t)(t + 1) * kstep;
            const char* a2 = last ? nA : cA + (size_t)(t + 2) * kstep; const char* b2 = last ? nB : cB + (size_t)(t + 2) * kstep;
            const char* a3 = a2 + kstep; const char* b3 = b2 + kstep;
            if (last && has_next) S.a_ready(nxt);
            if constexpr (SP2) {
            PG8_LDB(B0, 0, 0); PG8_LDB(B1, 0, 1); PG8_SCHED; PG8_LDA(At, 0, 0); PG8_STAGE(PG8_SA(1, 1), a1 + hstep, voffA);
            PG8_WAIT_V(8); PG8_WAIT_L(0); PG8_BAR; PG8_MMA(0, 0, At, B0); PG8_MMA(0, 1, At, B1); PG8_BAR; PG8_SCHED;
            PG8_LDA(At, 0, 1); PG8_STAGE(PG8_SB(0, 0), b2, voffB); PG8_STAGE(PG8_SB(0, 1), b2 + hstep, voffB); PG8_STAGE(PG8_SA(0, 0), a2, voffA);
            PG8_WAIT_V(8); PG8_WAIT_L(0); PG8_BAR; PG8_MMA(1, 0, At, B0); PG8_MMA(1, 1, At, B1); PG8_BAR; PG8_SCHED;
            PG8_LDB(B0, 1, 0); PG8_LDB(B1, 1, 1); PG8_SCHED; PG8_LDA(At, 1, 0); PG8_STAGE(PG8_SA(0, 1), a2 + hstep, voffA);
            PG8_WAIT_V(8); PG8_WAIT_L(0); PG8_BAR; PG8_MMA(0, 0, At, B0); PG8_MMA(0, 1, At, B1); PG8_BAR; PG8_SCHED;
            PG8_LDA(At, 1, 1); PG8_STAGE(PG8_SB(1, 0), b3, voffB); PG8_STAGE(PG8_SB(1, 1), b3 + hstep, voffB); PG8_STAGE(PG8_SA(1, 0), a3, voffA);
            PG8_WAIT_V(8); PG8_WAIT_L(0); PG8_BAR; PG8_MMA(1, 0, At, B0); PG8_MMA(1, 1, At, B1); PG8_BAR; PG8_SCHED;
            } else {
            PG8_LDB(B0, 0, 0); PG8_SCHED; PG8_LDA(At, 0, 0); PG8_STAGE(PG8_SA(1, 1), a1 + hstep, voffA);
            PG8_WAIT_L(8); PG8_BAR; PG8_WAIT_L(0); PG8_MMA(0, 0, At, B0); PG8_BAR; PG8_SCHED;
            PG8_LDB(B1, 0, 1); PG8_STAGE(PG8_SB(0, 0), b2, voffB);
            PG8_BAR; PG8_WAIT_L(0); PG8_MMA(0, 1, At, B1); PG8_BAR;
            PG8_LDA(At, 0, 1); PG8_STAGE(PG8_SA(0, 0), a2, voffA);
            PG8_BAR; PG8_WAIT_L(0); PG8_MMA(1, 0, At, B0); PG8_BAR; PG8_SCHED;
            PG8_STAGE(PG8_SB(0, 1), b2 + hstep, voffB);
            PG8_WAIT_V(6); PG8_BAR; PG8_MMA(1, 1, At, B1); PG8_BAR;
            PG8_LDB(B0, 1, 0); PG8_SCHED; PG8_LDA(At, 1, 0); PG8_STAGE(PG8_SA(0, 1), a2 + hstep, voffA);
            PG8_WAIT_L(8); PG8_BAR; PG8_WAIT_L(0); PG8_MMA(0, 0, At, B0); PG8_BAR; PG8_SCHED;
            PG8_LDB(B1, 1, 1); PG8_STAGE(PG8_SB(1, 0), b3, voffB);
            PG8_BAR; PG8_WAIT_L(0); PG8_MMA(0, 1, At, B1); PG8_BAR;
            PG8_LDA(At, 1, 1); PG8_STAGE(PG8_SA(1, 0), a3, voffA);
            PG8_BAR; PG8_WAIT_L(0); PG8_MMA(1, 0, At, B0); PG8_BAR; PG8_SCHED;
            PG8_STAGE(PG8_SB(1, 1), b3 + hstep, voffB);
            PG8_WAIT_V(6); PG8_BAR; PG8_MMA(1, 1, At, B1); PG8_BAR;
            }
        }
        if constexpr (ALIGN_EPI) { if (wr == 0) PG8_BAR; }
        if constexpr (!Epi::AFTER_DRAIN) { int l2_ = lane_id(); asm volatile("" : "+v"(l2_)); E(acc, cur, wr, wc, l2_ & 15, l2_ >> 4); S.done(cur); }
        if (!has_next) break;
#pragma unroll
        for (int a = 0; a < 2; ++a)
#pragma unroll
            for (int b = 0; b < 2; ++b)
#pragma unroll
                for (int m = 0; m < 4; ++m)
#pragma unroll
                    for (int n = 0; n < 2; ++n) acc[a][b][m][n] = (f32x4){0.f, 0.f, 0.f, 0.f};
        cur = nxt; cA = nA; cB = nB; ++ui;
        if constexpr (ALIGN_EPI) { if (wr == 1) PG8_BAR; }
    }
    PG8_WAIT_V(0);
    if constexpr (!ALIGN_EPI) { if (wr == 0) PG8_BAR; }
    PG8_BAR;
    if constexpr (Epi::AFTER_DRAIN) { E.fused(acc, cur, wr, wc, fr, fq, lds, wid, lane); S.done(cur); }
#undef PG8_SA
#undef PG8_SB
#undef PG8_STAGE
#undef PG8_LDA
#undef PG8_LDB
#undef PG8_MMA
#undef PG8_WAIT_V
#undef PG8_WAIT_L
#undef PG8_BAR
#undef PG8_SCHED
}
}

namespace pg8 {
__device__ __forceinline__ float fsig(float x) { return __builtin_amdgcn_rcpf(1.0f + __expf(-x)); }
__device__ __forceinline__ u32x4 pack8(const f32x4& v0, const f32x4& v1) { u32x4 w; w.x = cvt_pk_bf16(v0[0], v0[1]); w.y = cvt_pk_bf16(v0[2], v0[3]); w.z = cvt_pk_bf16(v1[0], v1[1]); w.w = cvt_pk_bf16(v1[2], v1[3]); return w; }
__device__ __forceinline__ float blo(unsigned w) { return __builtin_bit_cast(float, w << 16); }
__device__ __forceinline__ float bhi(unsigned w) { return __builtin_bit_cast(float, w & 0xffff0000u); }
struct EpiIn {
    static constexpr bool PERM = true, AFTER_DRAIN = false;
    bf16_t *U, *QKV, *G; int pn0; float osc;
    __device__ __forceinline__ void operator()(const f32x4 (&acc)[2][2][4][2], const Unit& u0, int wr, int wc, int fr, int fq) const {
        Unit u; u.pm = u0.pm; u.pn = u0.pn + pn0;
        const int row0 = u.pm * BM + wr * 64 + fr, cw = wc * 32 + 8 * fq;
        if (u.pn < 8) {
#pragma unroll
            for (int ai = 0; ai < 2; ++ai)
#pragma unroll
                for (int m = 0; m < 4; ++m) { const size_t row = row0 + ai * HALF + m * 16;
                    f32x4 v0 = acc[ai][0][m][0] * osc, v1 = acc[ai][0][m][1] * osc; const f32x4 g0 = acc[ai][1][m][0] * osc, g1 = acc[ai][1][m][1] * osc;
#pragma unroll
                    for (int e = 0; e < 4; ++e) { v0[e] *= fsig(g0[e]); v1[e] *= fsig(g1[e]); }
                    *(u32x4*)(U + row * 1024 + 128 * u.pn + cw) = pack8(v0, v1); }
        } else if (u.pn < 26) {
#pragma unroll
            for (int ai = 0; ai < 2; ++ai)
#pragma unroll
                for (int m = 0; m < 4; ++m) { const size_t row = row0 + ai * HALF + m * 16;
#pragma unroll
                    for (int bj = 0; bj < 2; ++bj) *(u32x4*)(QKV + row * 4608 + (u.pn - 8) * 256 + bj * HALF + cw) = pack8(acc[ai][bj][m][0] * osc, acc[ai][bj][m][1] * osc); }
        } else {
#pragma unroll
            for (int ai = 0; ai < 2; ++ai)
#pragma unroll
                for (int m = 0; m < 4; ++m) { const size_t row = row0 + ai * HALF + m * 16;
#pragma unroll
                    for (int bj = 0; bj < 2; ++bj) { f32x4 v0 = acc[ai][bj][m][0] * osc, v1 = acc[ai][bj][m][1] * osc;
#pragma unroll
                        for (int e = 0; e < 4; ++e) { v0[e] = fsig(v0[e]); v1[e] = fsig(v1[e]); }
                        int p0 = __builtin_amdgcn_cvt_pk_fp8_f32(v0[0], v0[1], 0, false); p0 = __builtin_amdgcn_cvt_pk_fp8_f32(v0[2], v0[3], p0, true);
                        int p1 = __builtin_amdgcn_cvt_pk_fp8_f32(v1[0], v1[1], 0, false); p1 = __builtin_amdgcn_cvt_pk_fp8_f32(v1[2], v1[3], p1, true);
                        typedef unsigned u32x2g_ __attribute__((ext_vector_type(2)));
                        *(u32x2g_*)((unsigned char*)G + row * 4096 + (u.pn - 26) * 256 + bj * HALF + cw) = (u32x2g_){(unsigned)p0, (unsigned)p1}; } }
        }
    }
};
__device__ __forceinline__ void ld_gate8(const bf16_t* G, size_t byteoff, float (&g)[8]) {
    typedef unsigned u32x2h_ __attribute__((ext_vector_type(2))); typedef float f2h_ __attribute__((ext_vector_type(2)));
    const u32x2h_ w = *(const u32x2h_*)((const unsigned char*)G + byteoff);
    const f2h_ a = __builtin_amdgcn_cvt_pk_f32_fp8((int)w.x, false), b = __builtin_amdgcn_cvt_pk_f32_fp8((int)w.x, true), c = __builtin_amdgcn_cvt_pk_f32_fp8((int)w.y, false), d = __builtin_amdgcn_cvt_pk_f32_fp8((int)w.y, true);
    g[0] = a.x; g[1] = a.y; g[2] = b.x; g[3] = b.y; g[4] = c.x; g[5] = c.y; g[6] = d.x; g[7] = d.y;
}
struct EpiYconv {
    static constexpr bool PERM = true, AFTER_DRAIN = false;
    const bf16_t* G; bf16_t* MG; const float* bias;
    __device__ __forceinline__ void operator()(const f32x4 (&acc)[2][2][4][2], const Unit& u, int wr, int wc, int fr, int fq) const {
        const int row0 = u.pm * BM + wr * 64 + fr, cw = wc * 32 + 8 * fq;
#pragma unroll
        for (int bj = 0; bj < 2; ++bj) { const int col = u.pn * 256 + bj * HALF + cw; const f32x4 b0 = *(const f32x4*)(bias + col), b1 = *(const f32x4*)(bias + col + 4);
#pragma unroll
            for (int ai = 0; ai < 2; ++ai)
#pragma unroll
                for (int m = 0; m < 4; ++m) { const size_t row = row0 + ai * HALF + m * 16;
                    float g[8]; ld_gate8(G, row * 4096 + col, g);
                    f32x4 v0 = acc[ai][bj][m][0] + b0, v1 = acc[ai][bj][m][1] + b1;
                    v0[0] *= g[0]; v0[1] *= g[1]; v0[2] *= g[2]; v0[3] *= g[3]; v1[0] *= g[4]; v1[1] *= g[5]; v1[2] *= g[6]; v1[3] *= g[7];
                    *(u32x4*)(MG + row * 2048 + col) = pack8(v0, v1); } }
    }
};
struct EpiYattn {
    static constexpr bool PERM = true, AFTER_DRAIN = false;
    const bf16_t* G; const bf16_t* MG; unsigned char* MG8; float msc;
    __device__ __forceinline__ void operator()(const f32x4 (&acc)[2][2][4][2], const Unit& u, int wr, int wc, int fr, int fq) const {
        const int row0 = u.pm * BM + wr * 64 + fr, cw = wc * 32 + 8 * fq;
#pragma unroll
        for (int ai = 0; ai < 2; ++ai)
#pragma unroll
            for (int m = 0; m < 4; ++m) { const size_t row = row0 + ai * HALF + m * 16;
#pragma unroll
                for (int bj = 0; bj < 2; ++bj) { const int col = u.pn * 256 + bj * HALF + cw; float g[8]; ld_gate8(G, row * 4096 + 2048 + col, g); const u32x4 p = *(const u32x4*)(MG + row * 2048 + col);
                    f32x4 v0 = acc[ai][bj][m][0], v1 = acc[ai][bj][m][1];
                    v0[0] = (blo(p.x) + v0[0] * g[0]) * msc; v0[1] = (bhi(p.x) + v0[1] * g[1]) * msc; v0[2] = (blo(p.y) + v0[2] * g[2]) * msc; v0[3] = (bhi(p.y) + v0[3] * g[3]) * msc;
                    v1[0] = (blo(p.z) + v1[0] * g[4]) * msc; v1[1] = (bhi(p.z) + v1[1] * g[5]) * msc; v1[2] = (blo(p.w) + v1[2] * g[6]) * msc; v1[3] = (bhi(p.w) + v1[3] * g[7]) * msc;
                    int p0 = __builtin_amdgcn_cvt_pk_fp8_f32(v0[0], v0[1], 0, false); p0 = __builtin_amdgcn_cvt_pk_fp8_f32(v0[2], v0[3], p0, true);
                    int p1 = __builtin_amdgcn_cvt_pk_fp8_f32(v1[0], v1[1], 0, false); p1 = __builtin_amdgcn_cvt_pk_fp8_f32(v1[2], v1[3], p1, true);
                    typedef unsigned u32x2_ __attribute__((ext_vector_type(2))); *(u32x2_*)(MG8 + row * 2048 + col) = (u32x2_){(unsigned)p0, (unsigned)p1}; } }
    }
};
struct EpiOut {
    static constexpr bool PERM = false, AFTER_DRAIN = false;
    const float* x; const float* mod; float* out; float osc;
    __device__ __forceinline__ void operator()(const f32x4 (&acc)[2][2][4][2], const Unit& u, int wr, int wc, int fr, int fq) const {
        const int row0 = u.pm * BM + wr * 64 + fr, col0 = u.pn * BM + wc * 32 + 4 * fq; const int b = (u.pm * BM) / 4096;
#pragma unroll
        for (int bj = 0; bj < 2; ++bj)
#pragma unroll
            for (int n = 0; n < 2; ++n) { const int col = col0 + bj * HALF + n * 16; const f32x4 gt = *(const f32x4*)(mod + b * 12288 + 2 * 2048 + col) * osc;
#pragma unroll
                for (int ai = 0; ai < 2; ++ai)
#pragma unroll
                    for (int m = 0; m < 4; ++m) { const size_t off = (size_t)(row0 + ai * HALF + m * 16) * 2048 + col;
                        *(f32x4*)(out + off) = *(const f32x4*)(x + off) + gt * acc[ai][bj][m][n]; } }
    }
};
struct EpiPlain {
    static constexpr bool PERM = true, AFTER_DRAIN = false;
    bf16_t* O; int ldc;
    __device__ __forceinline__ void operator()(const f32x4 (&acc)[2][2][4][2], const Unit& u, int wr, int wc, int fr, int fq) const {
        const int row0 = u.pm * BM + wr * 64 + fr, cw = u.pn * BM + wc * 32 + 8 * fq;
#pragma unroll
        for (int ai = 0; ai < 2; ++ai)
#pragma unroll
            for (int m = 0; m < 4; ++m) { const size_t row = row0 + ai * HALF + m * 16;
#pragma unroll
                for (int bj = 0; bj < 2; ++bj) *(u32x4*)(O + row * ldc + bj * HALF + cw) = pack8(acc[ai][bj][m][0], acc[ai][bj][m][1]); }
    }
};
}

struct Args { const float* in[21]; float* out; unsigned char* ws; int ph_lo, ph_hi; };
enum { I_X = 0, I_C, I_N1G, I_N2G, I_WADA, I_BADA, I_WIN, I_CDW, I_CDB, I_CLNG, I_CLNB, I_WCO, I_BCO, I_QNG, I_KNG, I_WAO, I_WOUT, I_PWQ, I_PSK, I_PWUP, I_PWDN };

struct Ctx {
    int tid, lane, wave, bid, nb, gw, ngw;
    unsigned char* lds;
};

__device__ __forceinline__ int win_row(int n) {
    if (n < 1024) return (n >> 7) * 256 + (n & 127);
    if (n < 2048) { const int m = n - 1024; return (m >> 7) * 256 + 128 + (m & 127); }
    return n;
}
__device__ __forceinline__ void p0_transpose_item(const float* W, int K, int N, bf16* WT, bool perm, float* scr, int item, int lane) {
    const int nblk = N / 32, kb = item / nblk, nbi = item % nblk, k0 = 64 * kb, n0 = 32 * nbi;
#pragma unroll 8
    for (int i = 0; i < 32; ++i) { const int kk = 2 * i + (lane >> 5); scr[kk * 33 + (lane & 31)] = W[(size_t)(k0 + kk) * N + n0 + (lane & 31)]; }
    asm volatile("s_waitcnt lgkmcnt(0)" ::: "memory");
    const int c = lane & 7;
    const int r0 = perm ? win_row(n0) : n0;
#pragma unroll
    for (int j = 0; j < 4; ++j) { const int n = (lane >> 3) + 8 * j; const float* s = scr + (8 * c) * 33 + n;
        v4u o; o.x = pk2(s[0 * 33], s[1 * 33]); o.y = pk2(s[2 * 33], s[3 * 33]); o.z = pk2(s[4 * 33], s[5 * 33]); o.w = pk2(s[6 * 33], s[7 * 33]);
        *(v4u*)(WT + (size_t)(r0 + n) * K + k0 + 8 * c) = o; }
    asm volatile("s_waitcnt lgkmcnt(0)" ::: "memory");
}

__device__ __forceinline__ void p0_transpose_item_fp8(const float* W, int K, int N, unsigned char* WT, bool perm, float* scr, int item, int lane, float wsc) {
    const int nblk = N / 32, kb = item / nblk, nbi = item % nblk, k0 = 64 * kb, n0 = 32 * nbi;
#pragma unroll 8
    for (int i = 0; i < 32; ++i) { const int kk = 2 * i + (lane >> 5); scr[kk * 33 + (lane & 31)] = W[(size_t)(k0 + kk) * N + n0 + (lane & 31)] * wsc; }
    asm volatile("s_waitcnt lgkmcnt(0)" ::: "memory");
    const int c = lane & 3;
    const int r0 = perm ? win_row(n0) : n0;
#pragma unroll
    for (int j = 0; j < 2; ++j) { const int n = (lane >> 2) + 16 * j; const float* s = scr + (16 * c) * 33 + n; v4u o; unsigned* op = (unsigned*)&o;
#pragma unroll
        for (int q = 0; q < 4; ++q) { int p = __builtin_amdgcn_cvt_pk_fp8_f32(s[(4 * q) * 33], s[(4 * q + 1) * 33], 0, false);
            p = __builtin_amdgcn_cvt_pk_fp8_f32(s[(4 * q + 2) * 33], s[(4 * q + 3) * 33], p, true); op[q] = (unsigned)p; }
        *(v4u*)(WT + (size_t)(r0 + n) * K + k0 + 16 * c) = o; }
    asm volatile("s_waitcnt lgkmcnt(0)" ::: "memory");
}
__device__ __forceinline__ void cvt_stream(const float* src, bf16* dst, size_t n, const Ctx& C) {
    const size_t nv = n / 8;
    for (size_t i = (size_t)C.gw * 64 + C.lane; i < nv; i += (size_t)C.ngw * 64) {
        const f32x4 a = *(const f32x4*)(src + i * 8), b = *(const f32x4*)(src + i * 8 + 4);
        v4u o; o.x = pk2(a.x, a.y); o.y = pk2(a.z, a.w); o.z = pk2(b.x, b.y); o.w = pk2(b.z, b.w);
        *(v4u*)(dst + i * 8) = o;
    }
}

typedef float f2v __attribute__((ext_vector_type(2)));
__device__ __forceinline__ void cvt_rows_fp8(const float* src, unsigned char* dst, float* inv, int rows, const Ctx& C) {
    for (int r = C.gw; r < rows; r += C.ngw) {
        const float* sp = src + (size_t)r * D + 16 * C.lane;
        f32x4 v[2][4]; float am = 0.f;
#pragma unroll
        for (int j = 0; j < 2; ++j)
#pragma unroll
            for (int q = 0; q < 4; ++q) { v[j][q] = *(const f32x4*)(sp + 1024 * j + 4 * q);
                am = fmaxf(am, fmaxf(fmaxf(fabsf(v[j][q].x), fabsf(v[j][q].y)), fmaxf(fabsf(v[j][q].z), fabsf(v[j][q].w)))); }
#pragma unroll
        for (int o = 1; o < 64; o <<= 1) am = fmaxf(am, __shfl_xor(am, o));
        const int ex = (int)((__builtin_bit_cast(unsigned, am) >> 23) & 255u);
        const float sc = (ex == 0) ? 1.0f : __builtin_bit_cast(float, (unsigned)(127 + 7 + 127 - ex) << 23);
        const float isc = (ex == 0) ? 1.0f : __builtin_bit_cast(float, (unsigned)(ex - 7) << 23);
#pragma unroll
        for (int j = 0; j < 2; ++j) { v4u o; unsigned* op = (unsigned*)&o;
#pragma unroll
            for (int q = 0; q < 4; ++q) { int p = __builtin_amdgcn_cvt_pk_fp8_f32(v[j][q].x * sc, v[j][q].y * sc, 0, false);
                p = __builtin_amdgcn_cvt_pk_fp8_f32(v[j][q].z * sc, v[j][q].w * sc, p, true); op[q] = (unsigned)p; }
            *(v4u*)(dst + (size_t)r * D + 16 * C.lane + 1024 * j) = o; }
        if (C.lane == 0) inv[r] = isc;
    }
}

__device__ __forceinline__ unsigned pack_i8x4(float a, float b, float c, float d) {
    const int ia = (int)rintf(a), ib = (int)rintf(b), ic = (int)rintf(c), id = (int)rintf(d);
    return ((unsigned)ia & 255u) | (((unsigned)ib & 255u) << 8) | (((unsigned)ic & 255u) << 16) | ((unsigned)id << 24);
}
__device__ __forceinline__ void cvt_rows_i8(const float* src, unsigned char* dst, float* inv, int rows, const Ctx& C) {
    for (int r = C.gw; r < rows; r += C.ngw) {
        const float* sp = src + (size_t)r * D + 16 * C.lane;
        f32x4 v[2][4]; float am = 0.f;
#pragma unroll
        for (int j = 0; j < 2; ++j)
#pragma unroll
            for (int q = 0; q < 4; ++q) { v[j][q] = *(const f32x4*)(sp + 1024 * j + 4 * q);
                am = fmaxf(am, fmaxf(fmaxf(fabsf(v[j][q].x), fabsf(v[j][q].y)), fmaxf(fabsf(v[j][q].z), fabsf(v[j][q].w)))); }
#pragma unroll
        for (int o = 1; o < 64; o <<= 1) am = fmaxf(am, __shfl_xor(am, o));
        const float sc = (am > 0.f) ? 127.0f / am : 0.f;
#pragma unroll
        for (int j = 0; j < 2; ++j) { v4u o;
            o.x = pack_i8x4(v[j][0].x * sc, v[j][0].y * sc, v[j][0].z * sc, v[j][0].w * sc); o.y = pack_i8x4(v[j][1].x * sc, v[j][1].y * sc, v[j][1].z * sc, v[j][1].w * sc);
            o.z = pack_i8x4(v[j][2].x * sc, v[j][2].y * sc, v[j][2].z * sc, v[j][2].w * sc); o.w = pack_i8x4(v[j][3].x * sc, v[j][3].y * sc, v[j][3].z * sc, v[j][3].w * sc);
            *(v4u*)(dst + (size_t)r * D + 16 * C.lane + 1024 * j) = o; }
        if (C.lane == 0) inv[r] = am * (1.0f / 127.0f);
    }
}

struct RowCvt { f32x4 v[2][4]; };
__device__ __forceinline__ void rc_issue(RowCvt& rc, const float* src, int row, int lane) {
    const float* sp = src + (size_t)row * D + 16 * lane;
#pragma unroll
    for (int j = 0; j < 2; ++j)
#pragma unroll
        for (int q = 0; q < 4; ++q) rc.v[j][q] = *(const f32x4*)(sp + 1024 * j + 4 * q);
}
__device__ __forceinline__ float rc_amax(const RowCvt& rc) {
    float am = 0.f;
#pragma unroll
    for (int j = 0; j < 2; ++j)
#pragma unroll
        for (int q = 0; q < 4; ++q) am = fmaxf(am, fmaxf(fmaxf(fabsf(rc.v[j][q].x), fabsf(rc.v[j][q].y)), fmaxf(fabsf(rc.v[j][q].z), fabsf(rc.v[j][q].w))));
#pragma unroll
    for (int o = 1; o < 64; o <<= 1) am = fmaxf(am, __shfl_xor(am, o));
    return am;
}
__device__ __forceinline__ void rc_finish_fp8(const RowCvt& rc, unsigned char* dst, float* inv, int row, int lane) {
    const float am = rc_amax(rc);
    const int ex = (int)((__builtin_bit_cast(unsigned, am) >> 23) & 255u);
    const float sc = (ex == 0) ? 1.0f : __builtin_bit_cast(float, (unsigned)(127 + 7 + 127 - ex) << 23);
    const float isc = (ex == 0) ? 1.0f : __builtin_bit_cast(float, (unsigned)(ex - 7) << 23);
#pragma unroll
    for (int j = 0; j < 2; ++j) { v4u o; unsigned* op = (unsigned*)&o;
#pragma unroll
        for (int q = 0; q < 4; ++q) { int p = __builtin_amdgcn_cvt_pk_fp8_f32(rc.v[j][q].x * sc, rc.v[j][q].y * sc, 0, false);
            p = __builtin_amdgcn_cvt_pk_fp8_f32(rc.v[j][q].z * sc, rc.v[j][q].w * sc, p, true); op[q] = (unsigned)p; }
        *(v4u*)(dst + (size_t)row * D + 16 * lane + 1024 * j) = o; }
    if (lane == 0) inv[row] = isc;
}
__device__ __forceinline__ void rc_finish_i8(const RowCvt& rc, unsigned char* dst, float* inv, int row, int lane) {
    const float am = rc_amax(rc);
    const float sc = (am > 0.f) ? 127.0f / am : 0.f;
#pragma unroll
    for (int j = 0; j < 2; ++j) { v4u o;
        o.x = pack_i8x4(rc.v[j][0].x * sc, rc.v[j][0].y * sc, rc.v[j][0].z * sc, rc.v[j][0].w * sc); o.y = pack_i8x4(rc.v[j][1].x * sc, rc.v[j][1].y * sc, rc.v[j][1].z * sc, rc.v[j][1].w * sc);
        o.z = pack_i8x4(rc.v[j][2].x * sc, rc.v[j][2].y * sc, rc.v[j][2].z * sc, rc.v[j][2].w * sc); o.w = pack_i8x4(rc.v[j][3].x * sc, rc.v[j][3].y * sc, rc.v[j][3].z * sc, rc.v[j][3].w * sc);
        *(v4u*)(dst + (size_t)row * D + 16 * lane + 1024 * j) = o; }
    if (lane == 0) inv[row] = am * (1.0f / 127.0f);
}
__device__ __forceinline__ void phase_prologue(const Args& A, const Ctx& C) {
    unsigned char* ws = A.ws;
    float* mod = (float*)(ws + WS_MOD);
    {
        float* red = (float*)C.lds;
        const float* w_ada = A.in[I_WADA]; const float* cv = A.in[I_C];
        for (int it = C.bid; it < MODW / 48; it += C.nb) {
            const int c4 = C.tid % 12, kg = C.tid / 12;
            f32x4 a0 = {0.f, 0.f, 0.f, 0.f}, a1 = {0.f, 0.f, 0.f, 0.f};
            if (C.tid < 504) {
                for (int k = kg; k < D; k += 42) {
                    const f32x4 w = *(const f32x4*)(w_ada + (size_t)k * MODW + 48 * it + 4 * c4);
                    const float s0 = siluf_(cv[k]), s1 = siluf_(cv[D + k]);
                    a0 += w * s0; a1 += w * s1;
                }
                float* r = red + kg * 96 + c4 * 4;
                r[0] = a0.x; r[1] = a0.y; r[2] = a0.z; r[3] = a0.w;
                r[48 + 0] = a1.x; r[48 + 1] = a1.y; r[48 + 2] = a1.z; r[48 + 3] = a1.w;
            }
            __syncthreads();
            if (C.tid < 96) {
                float s = 0.f;
                for (int g = 0; g < 42; ++g) s += red[g * 96 + C.tid];
                const int b = C.tid / 48, col = 48 * it + (C.tid % 48);
                mod[b * MODW + col] = s + A.in[I_BADA][col];
            }
            __syncthreads();
        }
    }
    {
        float* scr = (float*)(C.lds + C.wave * 16384);
        constexpr int I_IN = (D / 64) * (IN_COLS / 32);
        for (int it = C.gw; it < I_IN; it += C.ngw) p0_transpose_item_fp8(A.in[I_WIN], D, IN_COLS, ws + WS_WIN, true, scr, it, C.lane, WIN_SCALE);
    }
    cvt_stream(A.in[I_PSK], (bf16*)(ws + WS_SK), (size_t)16 * 128 * 128, C);
}


__device__ __forceinline__ void late_transposes(const Args& A, const Ctx& C, unsigned char* ldsbase, int w0, int nw) {
    unsigned char* ws = A.ws;
    float* scr = (float*)(ldsbase + C.wave * 16384);
    int lane = lane_id(); asm volatile("" : "+v"(lane));
    constexpr int I_CO = (CONV_CH / 64) * (D / 32), I_AO = (AOW / 64) * (D / 32), I_OUT = (D / 64) * (D / 32), I_Q = I_OUT;
    constexpr int NITEMS = I_CO + I_AO + I_OUT + I_Q;
    for (int it = w0; it < NITEMS; it += nw) {
        int r = it;
        if (r < I_CO) { p0_transpose_item(A.in[I_WCO], CONV_CH, D, (bf16*)(ws + WS_WCO), false, scr, r, lane); continue; } r -= I_CO;
        if (r < I_AO) { p0_transpose_item(A.in[I_WAO], AOW, D, (bf16*)(ws + WS_WAO), false, scr, r, lane); continue; } r -= I_AO;
        if (r < I_OUT) { p0_transpose_item_fp8(A.in[I_WOUT], D, D, ws + WS_WOUT, false, scr, r, lane, WIN_SCALE); continue; } r -= I_OUT;
        p0_transpose_item(A.in[I_PWQ], D, D, (bf16*)(ws + WS_WQ), false, scr, r, lane);
    }
    { RowCvt rc; for (int row = w0; row < UP_TAIL_ROWS; row += nw) { rc_issue(rc, A.in[I_PWUP], row, lane); rc_finish_i8(rc, ws + WS_WUP, (float*)(ws + WS_SUP), row, lane); } }
}
template <bool FP8OUT>
__device__ __forceinline__ void norm_mod_store(const f32x4 (&v)[8], float ss, int m, const float* gn, const float* mod, int shift_i, int scale_i, bf16* hout, int lane) {
    const float rstd = 1.0f / sqrtf(ss * (1.0f / D) + EPS);
    const int b = m / SEQ;
    const f32x4* gp = (const f32x4*)gn; const f32x4* sc = (const f32x4*)(mod + b * MODW + scale_i * D); const f32x4* sh = (const f32x4*)(mod + b * MODW + shift_i * D);
    v2u* o = (v2u*)(hout + (size_t)m * D); unsigned* o8 = (unsigned*)((unsigned char*)hout + (size_t)m * D);
#pragma unroll
    for (int j = 0; j < 8; ++j) { const int q = lane + 64 * j; const f32x4 g = gp[q], s = sc[q], h = sh[q];
        const f32x4 y = v[j] * rstd * g * (s + 1.0f) + h;
        if constexpr (FP8OUT) { int p = __builtin_amdgcn_cvt_pk_fp8_f32(y.x, y.y, 0, false); p = __builtin_amdgcn_cvt_pk_fp8_f32(y.z, y.w, p, true); o8[q] = (unsigned)p; }
        else { v2u w; w.x = pk2(y.x, y.y); w.y = pk2(y.z, y.w); o[q] = w; } }
}
template <bool FP8OUT>
__device__ __forceinline__ void phase_norm_mod(const float* xin, const float* gn, const float* mod, int shift_i, int scale_i, bf16* hout, const Ctx& C) {
    for (int m = C.gw; m < T; m += 2 * C.ngw) {
        const int m2 = m + C.ngw; const bool has2 = m2 < T;
        const f32x4* xr = (const f32x4*)(xin + (size_t)m * D); const f32x4* xr2 = (const f32x4*)(xin + (size_t)(has2 ? m2 : m) * D);
        f32x4 v[8], v2[8]; float ss = 0.f, ss2 = 0.f;
#pragma unroll
        for (int j = 0; j < 8; ++j) v[j] = xr[C.lane + 64 * j];
#pragma unroll
        for (int j = 0; j < 8; ++j) v2[j] = xr2[C.lane + 64 * j];
#pragma unroll
        for (int j = 0; j < 8; ++j) { ss += (v[j].x * v[j].x + v[j].y * v[j].y) + (v[j].z * v[j].z + v[j].w * v[j].w); ss2 += (v2[j].x * v2[j].x + v2[j].y * v2[j].y) + (v2[j].z * v2[j].z + v2[j].w * v2[j].w); }
#pragma unroll
        for (int o = 1; o < 64; o <<= 1) { ss += __shfl_xor(ss, o); ss2 += __shfl_xor(ss2, o); }
        norm_mod_store<FP8OUT>(v, ss, m, gn, mod, shift_i, scale_i, hout, C.lane);
        if (has2) norm_mod_store<FP8OUT>(v2, ss2, m2, gn, mod, shift_i, scale_i, hout, C.lane);
    }
}

template <class Epi>
__device__ __forceinline__ void ngemm_phase(const bf16* Am, const bf16* Bt, int M, int N, int K, int lda, const Epi& E, const Ctx& C) {
    float* As = (float*)C.lds;
    float* Bs = As + 64 * 33;
    const int tid = C.tid, ty = tid >> 5, tx = tid & 31;
    const int ntm = M / 64, ntn = N / 256;
    for (int it = C.bid; it < ntm * ntn; it += C.nb) {
        const int pm = it / ntn, pn = it % ntn;
        float acc[4][8];
#pragma unroll
        for (int i = 0; i < 4; ++i)
#pragma unroll
            for (int j = 0; j < 8; ++j) acc[i][j] = 0.f;
        for (int k0 = 0; k0 < K; k0 += 32) {
            { const int r = tid >> 3, c = (tid & 7) * 4; const v2u v = *(const v2u*)(Am + (size_t)(pm * 64 + r) * lda + k0 + c);
              float* d = As + r * 33 + c; d[0] = bflo(v.x); d[1] = bfhi(v.x); d[2] = bflo(v.y); d[3] = bfhi(v.y); }
#pragma unroll
            for (int i = 0; i < 4; ++i) { const int idx = tid + 512 * i, r = idx >> 3, c = (idx & 7) * 4; const v2u v = *(const v2u*)(Bt + (size_t)(pn * 256 + r) * K + k0 + c);
              float* d = Bs + r * 33 + c; d[0] = bflo(v.x); d[1] = bfhi(v.x); d[2] = bflo(v.y); d[3] = bfhi(v.y); }
            __syncthreads();
#pragma unroll 4
            for (int k = 0; k < 32; ++k) {
                float a[4], b[8];
#pragma unroll
                for (int i = 0; i < 4; ++i) a[i] = As[(ty + 16 * i) * 33 + k];
#pragma unroll
                for (int j = 0; j < 8; ++j) b[j] = Bs[(tx + 32 * j) * 33 + k];
#pragma unroll
                for (int i = 0; i < 4; ++i)
#pragma unroll
                    for (int j = 0; j < 8; ++j) acc[i][j] += a[i] * b[j];
            }
            __syncthreads();
        }
        E(pm * 64 + ty, pn, tx, acc);
    }
}
struct NEpiIn {
    bf16 *U, *QKV, *G;
    __device__ __forceinline__ void operator()(int r0, int pn, int tx, const float (&acc)[4][8]) const {
#pragma unroll
        for (int i = 0; i < 4; ++i) { const size_t row = r0 + 16 * i;
            if (pn < 8) {
#pragma unroll
                for (int j = 0; j < 4; ++j) U[row * CONV_CH + 128 * pn + tx + 32 * j] = (bf16)f2bf(acc[i][j] * sigmoidf_(acc[i][j + 4]));
            } else if (pn < 26) {
#pragma unroll
                for (int j = 0; j < 8; ++j) QKV[row * QKVW + (pn - 8) * 256 + tx + 32 * j] = (bf16)f2bf(acc[i][j]);
            } else {
#pragma unroll
                for (int j = 0; j < 8; ++j) G[row * (2 * D) + (pn - 26) * 256 + tx + 32 * j] = (bf16)f2bf(sigmoidf_(acc[i][j]));
            } }
    }
};
struct NEpiYattn {
    const bf16* G; bf16* MG;
    __device__ __forceinline__ void operator()(int r0, int pn, int tx, const float (&acc)[4][8]) const {
#pragma unroll
        for (int i = 0; i < 4; ++i) { const size_t row = r0 + 16 * i;
#pragma unroll
            for (int j = 0; j < 8; ++j) { const int col = pn * 256 + tx + 32 * j; MG[row * D + col] = (bf16)f2bf(bf2f(G[row * (2 * D) + D + col]) * acc[i][j]); } }
    }
};
struct NEpiYconv {
    const bf16* G; bf16* MG; const float* bias;
    __device__ __forceinline__ void operator()(int r0, int pn, int tx, const float (&acc)[4][8]) const {
#pragma unroll
        for (int i = 0; i < 4; ++i) { const size_t row = r0 + 16 * i;
#pragma unroll
            for (int j = 0; j < 8; ++j) { const int col = pn * 256 + tx + 32 * j;
                MG[row * D + col] = (bf16)f2bf(bf2f(MG[row * D + col]) + bf2f(G[row * (2 * D) + col]) * (acc[i][j] + bias[col])); } }
    }
};
struct NEpiOut {
    const float* x; const float* mod; float* out;
    __device__ __forceinline__ void operator()(int r0, int pn, int tx, const float (&acc)[4][8]) const {
#pragma unroll
        for (int i = 0; i < 4; ++i) { const size_t row = r0 + 16 * i; const int b = (int)(row / SEQ);
#pragma unroll
            for (int j = 0; j < 8; ++j) { const int col = pn * 256 + tx + 32 * j; out[row * D + col] = x[row * D + col] + mod[b * MODW + 2 * D + col] * acc[i][j]; } }
    }
};
struct NEpiBf16 {
    bf16* O; int ldc;
    __device__ __forceinline__ void operator()(int r0, int pn, int tx, const float (&acc)[4][8]) const {
#pragma unroll
        for (int i = 0; i < 4; ++i) { const size_t row = r0 + 16 * i;
#pragma unroll
            for (int j = 0; j < 8; ++j) O[row * ldc + pn * 256 + tx + 32 * j] = (bf16)f2bf(acc[i][j]); }
    }
};

__device__ __forceinline__ float block_sum(float v, float* red, const Ctx& C) {
    v = wave_sum(v);
    __syncthreads();
    if (C.lane == 0) red[C.wave] = v;
    __syncthreads();
    float s = 0.f;
#pragma unroll
    for (int i = 0; i < NWAVES; ++i) s += red[i];
    return s;
}
__device__ __forceinline__ void phase_conv_naive(const Args& A, const Ctx& C) {
    const bf16* U = (const bf16*)(A.ws + WS_U); bf16* UCV = (bf16*)(A.ws + WS_UCV);
    const float* dw = A.in[I_CDW]; const float* db = A.in[I_CDB]; const float* lg = A.in[I_CLNG]; const float* lb = A.in[I_CLNB];
    float* red = (float*)C.lds;
    const int c0 = 2 * C.tid;
    for (int t = C.bid; t < T; t += C.nb) {
        const int s = t % SEQ;
        float a0 = db[c0], a1 = db[c0 + 1];
        for (int j = 0; j < CONV_K; ++j) { const int sp = s - (CONV_K - 1) + j; if (sp < 0) continue;
            const unsigned w = *(const unsigned*)(U + (size_t)(t - (CONV_K - 1) + j) * CONV_CH + c0);
            a0 += dw[j * CONV_CH + c0] * bflo(w); a1 += dw[j * CONV_CH + c0 + 1] * bfhi(w); }
        const float mean = block_sum(a0 + a1, red, C) * (1.0f / CONV_CH);
        const float d0 = a0 - mean, d1 = a1 - mean;
        const float var = block_sum(d0 * d0 + d1 * d1, red, C) * (1.0f / CONV_CH);
        const float rstd = 1.0f / sqrtf(var + EPS);
        const float y0 = d0 * rstd * lg[c0] + lb[c0], y1 = d1 * rstd * lg[c0 + 1] + lb[c0 + 1];
        *(unsigned*)(UCV + (size_t)t * CONV_CH + c0) = pk2(siluf_(y0), siluf_(y1));
    }
}
__device__ __forceinline__ void phase_attn_naive(const Args& A, const Ctx& C) {
    const bf16* QKV = (const bf16*)(A.ws + WS_QKV); bf16* O = (bf16*)(A.ws + WS_O);
    const float* qg = A.in[I_QNG]; const float* kg = A.in[I_KNG];
    const int lane = C.lane;
    for (int it = C.gw; it < T * 4; it += C.ngw) {
        const int t = it >> 2, hh = it & 3, b = t / SEQ, s = t % SEQ;
        float m = -INFINITY, l = 0.f, o0 = 0.f, o1 = 0.f;
        for (int g = 0; g < 3; ++g) {
            const int dil = (g == 0) ? 1 : (g == 1) ? 4 : 16; const int head = g * 4 + hh;
            const unsigned qw = *(const unsigned*)(QKV + (size_t)t * QKVW + head * HD + 2 * lane);
            const float q0 = bflo(qw), q1 = bfhi(qw);
            const float rq = 1.0f / sqrtf(wave_sum(q0 * q0 + q1 * q1) * (1.0f / HD) + EPS);
            const float qq0 = q0 * rq * qg[head * HD + 2 * lane] * kg[head * HD + 2 * lane], qq1 = q1 * rq * qg[head * HD + 2 * lane + 1] * kg[head * HD + 2 * lane + 1];
            for (int dist = 0; dist <= 128; ++dist) {
                const int sk = s - dist * dil; if (sk < 0) break;
                const size_t tk = (size_t)b * SEQ + sk;
                const unsigned kw = *(const unsigned*)(QKV + tk * QKVW + AW + head * HD + 2 * lane);
                const unsigned vw = *(const unsigned*)(QKV + tk * QKVW + 2 * AW + head * HD + 2 * lane);
                const float k0 = bflo(kw), k1 = bfhi(kw);
                float dot = qq0 * k0 + qq1 * k1, kss = k0 * k0 + k1 * k1;
#pragma unroll
                for (int o = 1; o < 64; o <<= 1) { dot += __shfl_xor(dot, o); kss += __shfl_xor(kss, o); }
                const float sc = dot * (1.0f / sqrtf(kss * (1.0f / HD) + EPS)) * 0.08838834764831845f;
                const float mn = fmaxf(m, sc), corr = __expf(m - mn), p = __expf(sc - mn);
                l = l * corr + p; o0 = o0 * corr + p * bflo(vw); o1 = o1 * corr + p * bfhi(vw); m = mn;
            }
        }
        const float il = 1.0f / l;
        *(unsigned*)(O + (size_t)t * AOW + hh * HD + 2 * lane) = pk2(o0 * il, o1 * il);
    }
}

__device__ __forceinline__ void wave_argmax(float& v, int& i) {
#pragma unroll
    for (int o = 32; o >= 1; o >>= 1) { const float ov = __shfl_xor(v, o); const int oi = __shfl_xor(i, o);
        if (ov > v || (ov == v && oi < i)) { v = ov; i = oi; } }
}
__device__ __forceinline__ void phase_topk_naive(const Args& A, const Ctx& C) {
    const bf16* QP = (const bf16*)(A.ws + WS_QP); const bf16* SK = (const bf16*)(A.ws + WS_SK);
    int* IDX = (int*)(A.ws + WS_IDX); float* GW = (float*)(A.ws + WS_GW);
    const int lane = C.lane;
    for (int it = C.gw; it < T * PEER_H; it += C.ngw) {
        const int t = it >> 3, h = it & 7;
        const bf16* qrow = QP + (size_t)t * D + h * 256;
        float topv[2]; int topi[2];
#pragma unroll
        for (int p = 0; p < 2; ++p) {
            float s0 = 0.f, s1 = 0.f;
            const bf16* k0r = SK + ((size_t)(h * 2 + p) * 128 + lane) * 128; const bf16* k1r = k0r + 64 * 128;
            for (int e = 0; e < 128; e += 8) {
                const v4u qv = *(const v4u*)(qrow + p * 128 + e), a = *(const v4u*)(k0r + e), bq = *(const v4u*)(k1r + e);
                s0 += bflo(qv.x) * bflo(a.x) + bfhi(qv.x) * bfhi(a.x) + bflo(qv.y) * bflo(a.y) + bfhi(qv.y) * bfhi(a.y) + bflo(qv.z) * bflo(a.z) + bfhi(qv.z) * bfhi(a.z) + bflo(qv.w) * bflo(a.w) + bfhi(qv.w) * bfhi(a.w);
                s1 += bflo(qv.x) * bflo(bq.x) + bfhi(qv.x) * bfhi(bq.x) + bflo(qv.y) * bflo(bq.y) + bfhi(qv.y) * bfhi(bq.y) + bflo(qv.z) * bflo(bq.z) + bfhi(qv.z) * bfhi(bq.z) + bflo(qv.w) * bflo(bq.w) + bfhi(qv.w) * bfhi(bq.w);
            }
            float tv = 0.f; int ti = 0;
            for (int k = 0; k < PEER_TOPK; ++k) {
                float v; int i;
                if (s0 >= s1) { v = s0; i = lane; } else { v = s1; i = lane + 64; }
                wave_argmax(v, i);
                if (i == lane) s0 = -INFINITY; else if (i == lane + 64) s1 = -INFINITY;
                if (lane == k) { tv = v; ti = i; }
            }
            topv[p] = tv; topi[p] = ti;
        }
        float cv[4];
        const float v1 = __shfl(topv[0], lane >> 2);
#pragma unroll
        for (int u = 0; u < 4; ++u) cv[u] = v1 + __shfl(topv[1], 4 * (lane & 3) + u);
        float wv = -INFINITY; int wc = 0;
        for (int k = 0; k < PEER_TOPK; ++k) {
            float v = cv[0]; int i = 4 * lane;
#pragma unroll
            for (int u = 1; u < 4; ++u) if (cv[u] > v) { v = cv[u]; i = 4 * lane + u; }
            wave_argmax(v, i);
            if ((i >> 2) == lane) {
#pragma unroll
                for (int u = 0; u < 4; ++u) if ((i & 3) == u) cv[u] = -INFINITY;
            }
            if (lane == k) { wv = v; wc = i; }
        }
        const float mx = __shfl(wv, 0);
        const float e = (lane < PEER_TOPK) ? __expf(wv - mx) : 0.f;
        const float sum = wave_sum(e);
        const int e1 = __shfl(topi[0], wc >> 4), e2 = __shfl(topi[1], wc & 15);
        if (lane < PEER_TOPK) { IDX[(size_t)t * PEER_HK + h * PEER_TOPK + lane] = e1 * PEER_NK + e2; GW[(size_t)t * PEER_HK + h * PEER_TOPK + lane] = e / sum; }
    }
}
__device__ __forceinline__ void phase_experts_naive(const Args& A, const Ctx& C) {
    const bf16* H2 = (const bf16*)(A.ws + WS_H); const bf16* WUP = (const bf16*)(A.ws + WS_WUP); const bf16* WDN = (const bf16*)(A.ws + WS_WDN);
    const int* IDX = (const int*)(A.ws + WS_IDX); const float* GW = (const float*)(A.ws + WS_GW); const float* mod = (const float*)(A.ws + WS_MOD);
    float* hs = (float*)C.lds;
    float* coef = hs + D;
    int* eidx = (int*)(coef + PEER_HK);
    for (int t = C.bid; t < T; t += C.nb) {
        { const v2u v = *(const v2u*)(H2 + (size_t)t * D + 4 * C.tid); float* d = hs + 4 * C.tid; d[0] = bflo(v.x); d[1] = bfhi(v.x); d[2] = bflo(v.y); d[3] = bfhi(v.y); }
        if (C.tid < PEER_HK) eidx[C.tid] = IDX[(size_t)t * PEER_HK + C.tid];
        __syncthreads();
        for (int i = 0; i < 16; ++i) {
            const int k = C.wave * 16 + i; const bf16* wr = WUP + (size_t)eidx[k] * D;
            float dot = 0.f;
#pragma unroll
            for (int j = 0; j < 4; ++j) { const int e0 = C.lane * 8 + 512 * j; const v4u w = *(const v4u*)(wr + e0); const float* hp = hs + e0;
                dot += hp[0] * bflo(w.x) + hp[1] * bfhi(w.x) + hp[2] * bflo(w.y) + hp[3] * bfhi(w.y) + hp[4] * bflo(w.z) + hp[5] * bfhi(w.z) + hp[6] * bflo(w.w) + hp[7] * bfhi(w.w); }
            dot = wave_sum(dot);
            if (C.lane == 0) coef[k] = GW[(size_t)t * PEER_HK + k] * gelu_erf(dot);
        }
        __syncthreads();
        float a0 = 0.f, a1 = 0.f, a2 = 0.f, a3 = 0.f;
        for (int k = 0; k < PEER_HK; ++k) { const float c = coef[k]; const v2u w = *(const v2u*)(WDN + (size_t)eidx[k] * D + 4 * C.tid);
            a0 += c * bflo(w.x); a1 += c * bfhi(w.x); a2 += c * bflo(w.y); a3 += c * bfhi(w.y); }
        const int b = t / SEQ; const f32x4 g2 = *(const f32x4*)(mod + b * MODW + 5 * D + 4 * C.tid);
        f32x4* op = (f32x4*)(A.out + (size_t)t * D + 4 * C.tid);
        f32x4 x1 = *op; x1.x += g2.x * a0; x1.y += g2.y * a1; x1.z += g2.z * a2; x1.w += g2.w * a3; *op = x1;
        __syncthreads();
    }
}


__device__ __forceinline__ unsigned f2ord(float f) { const unsigned u = __builtin_bit_cast(unsigned, f); return u ^ ((u >> 31) ? 0xFFFFFFFFu : 0x80000000u); }
__device__ __forceinline__ float ord2f(unsigned u) { return __builtin_bit_cast(float, (u & 0x80000000u) ? (u ^ 0x80000000u) : ~u); }
template <int CTRL> __device__ __forceinline__ unsigned dpp_u(unsigned x) { return (unsigned)__builtin_amdgcn_update_dpp(0, (int)x, CTRL, 0xF, 0xF, false); }
__device__ __forceinline__ unsigned rowmax_u(unsigned x) {
    x = max(x, dpp_u<0x128>(x)); x = max(x, dpp_u<0x124>(x)); x = max(x, dpp_u<0x122>(x)); x = max(x, dpp_u<0x121>(x)); return x; }
__device__ __forceinline__ float rowsum_f(float x) {
    x += __builtin_bit_cast(float, dpp_u<0x128>(__builtin_bit_cast(unsigned, x))); x += __builtin_bit_cast(float, dpp_u<0x124>(__builtin_bit_cast(unsigned, x)));
    x += __builtin_bit_cast(float, dpp_u<0x122>(__builtin_bit_cast(unsigned, x))); x += __builtin_bit_cast(float, dpp_u<0x121>(__builtin_bit_cast(unsigned, x))); return x; }
#define CE_DESC(a, b) do { const unsigned _hi = max(a, b), _lo = min(a, b); a = _hi; b = _lo; } while (0)
__device__ __forceinline__ void phase_topk(const Args& A, const Ctx& C) {
    const bf16* QP = (const bf16*)(A.ws + WS_QP); const bf16* SK = (const bf16*)(A.ws + WS_SK);
    int* IDX = (int*)(A.ws + WS_IDX); float* GW = (float*)(A.ws + WS_GW);
    const int lane = C.lane, i = lane & 15, g = lane >> 4;
    if (C.wave >= TK_W) {
        const int cw = C.bid * (NWAVES - TK_W) + (C.wave - TK_W), ncw = C.nb * (NWAVES - TK_W); RowCvt ra, rb;
        for (int row = UP_TAIL_ROWS + cw; row < 2 * PEER_E; row += 2 * ncw) {
            const int row2 = row + ncw; const bool has2 = row2 < 2 * PEER_E;
            rc_issue(ra, row < PEER_E ? A.in[I_PWUP] : A.in[I_PWDN], row < PEER_E ? row : row - PEER_E, lane);
            if (has2) rc_issue(rb, row2 < PEER_E ? A.in[I_PWUP] : A.in[I_PWDN], row2 < PEER_E ? row2 : row2 - PEER_E, lane);
            if (row < PEER_E) rc_finish_i8(ra, A.ws + WS_WUP, (float*)(A.ws + WS_SUP), row, lane); else rc_finish_fp8(ra, A.ws + WS_WDN, (float*)(A.ws + WS_SDN), row - PEER_E, lane);
            if (has2) { if (row2 < PEER_E) rc_finish_i8(rb, A.ws + WS_WUP, (float*)(A.ws + WS_SUP), row2, lane); else rc_finish_fp8(rb, A.ws + WS_WDN, (float*)(A.ws + WS_SDN), row2 - PEER_E, lane); }
        }
        return;
    }
    int crow = 2 * PEER_E; RowCvt rc;
#define CV_ISSUE() do { asm volatile("" ::: "memory"); if (crow < 2 * PEER_E) rc_issue(rc, crow < PEER_E ? A.in[I_PWUP] : A.in[I_PWDN], crow < PEER_E ? crow : crow - PEER_E, lane); } while (0)
#define CV_FINISH() do { if (crow < 2 * PEER_E) { if (crow < PEER_E) rc_finish_i8(rc, A.ws + WS_WUP, (float*)(A.ws + WS_SUP), crow, lane); \
        else rc_finish_fp8(rc, A.ws + WS_WDN, (float*)(A.ws + WS_SDN), crow - PEER_E, lane); crow += C.ngw; } asm volatile("" ::: "memory"); } while (0)
    for (int it = C.bid * TK_W + C.wave; it < (T / 16) * PEER_H; it += C.nb * TK_W) {
        const int tile = it >> 3, t0 = tile * 16; int h = it & 7; asm volatile("" : "+s"(h));
        unsigned win[2][4];
#pragma unroll
        for (int p = 0; p < 2; ++p) {
            const int slot = 2 * h + p;
            pg8::bf16x8 aq[4];
#pragma unroll
            for (int ks = 0; ks < 4; ++ks) aq[ks] = *(const pg8::bf16x8*)(QP + (size_t)(t0 + i) * D + slot * 128 + 32 * ks + 8 * g);
            unsigned K[4][8];
#pragma unroll
            for (int nt = 0; nt < 8; ++nt) {
                f32x4 acc = {0.f, 0.f, 0.f, 0.f};
                const bf16* kr = SK + ((size_t)slot * 128 + 16 * nt + i) * 128 + 8 * g;
#pragma unroll
                for (int ks = 0; ks < 4; ++ks) acc = __builtin_amdgcn_mfma_f32_16x16x32_bf16(aq[ks], *(const pg8::bf16x8*)(kr + 32 * ks), acc, 0, 0, 0);
#pragma unroll
                for (int r = 0; r < 4; ++r) K[r][nt] = (f2ord(acc[r]) & ~127u) | (unsigned)(127 - (16 * nt + i));
            }
#pragma unroll
            for (int r = 0; r < 4; ++r) {
                CV_ISSUE();
                unsigned* k = K[r];
                CE_DESC(k[0], k[1]); CE_DESC(k[2], k[3]); CE_DESC(k[4], k[5]); CE_DESC(k[6], k[7]);
                CE_DESC(k[0], k[2]); CE_DESC(k[1], k[3]); CE_DESC(k[4], k[6]); CE_DESC(k[5], k[7]);
                CE_DESC(k[1], k[2]); CE_DESC(k[5], k[6]);
                CE_DESC(k[0], k[4]); CE_DESC(k[1], k[5]); CE_DESC(k[2], k[6]); CE_DESC(k[3], k[7]);
                CE_DESC(k[2], k[4]); CE_DESC(k[3], k[5]);
                CE_DESC(k[1], k[2]); CE_DESC(k[3], k[4]); CE_DESC(k[5], k[6]);
                unsigned w = 0u;
#pragma unroll
                for (int kk = 0; kk < PEER_TOPK; ++kk) {
                    const unsigned M = rowmax_u(k[0]);
                    const bool pop = (k[0] == M);
#pragma unroll
                    for (int q = 0; q < 7; ++q) k[q] = pop ? k[q + 1] : k[q];
                    k[7] = pop ? 0u : k[7];
                    w = (i == kk) ? M : w;
                }
                win[p][r] = w;
                CV_FINISH();
            }
        }
#pragma unroll
        for (int r = 0; r < 4; ++r) {
            CV_ISSUE();
            const float v1 = ord2f(win[0][r] & ~127u), v2 = ord2f(win[1][r] & ~127u);
            int j = 0;
            float nv = __builtin_bit_cast(float, __builtin_amdgcn_ds_bpermute(4 * (16 * g), __builtin_bit_cast(int, v2)));
            unsigned key = (f2ord(v1 + nv) & ~255u) | (unsigned)(255 - 16 * i);
            unsigned w = 0u; float mx = 0.f;
#pragma unroll
            for (int kk = 0; kk < PEER_TOPK; ++kk) {
                const unsigned M = rowmax_u(key);
                if (kk == 0) mx = ord2f(M & ~255u);
                const bool pop = (key == M);
                j += pop ? 1 : 0;
                const int jj = j < 15 ? j : 15;
                nv = __builtin_bit_cast(float, __builtin_amdgcn_ds_bpermute(4 * (16 * g + jj), __builtin_bit_cast(int, v2)));
                const unsigned nk = (j < 16) ? ((f2ord(v1 + nv) & ~255u) | (unsigned)(255 - (16 * i + jj))) : 0u;
                key = pop ? nk : key;
                w = (i == kk) ? M : w;
            }
            const int ci = 255 - (int)(w & 255u);
            const int n1 = 127 - (int)(win[0][r] & 127u), n2 = 127 - (int)(win[1][r] & 127u);
            const int e1 = __builtin_amdgcn_ds_bpermute(4 * (16 * g + (ci >> 4)), n1), e2 = __builtin_amdgcn_ds_bpermute(4 * (16 * g + (ci & 15)), n2);
            const float ex = __expf(ord2f(w & ~255u) - mx);
            const float sum = rowsum_f(ex);
            const size_t o = (size_t)(t0 + 4 * g + r) * PEER_HK + h * PEER_TOPK + i;
            IDX[o] = e1 * PEER_NK + e2; GW[o] = ex / sum;
            CV_FINISH();
        }
    }
    while (crow < 2 * PEER_E) { CV_ISSUE(); CV_FINISH(); }
#undef CV_ISSUE
#undef CV_FINISH
}

typedef __bf16 bf16x2v __attribute__((ext_vector_type(2)));
__device__ __forceinline__ float dot2bf(unsigned w, unsigned x, float acc) { return __builtin_amdgcn_fdot2_f32_bf16(__builtin_bit_cast(bf16x2v, w), __builtin_bit_cast(bf16x2v, x), acc, false); }
__device__ __forceinline__ f2v fp8lo(unsigned w) { return __builtin_amdgcn_cvt_pk_f32_fp8((int)w, false); }
__device__ __forceinline__ f2v fp8hi(unsigned w) { return __builtin_amdgcn_cvt_pk_f32_fp8((int)w, true); }
constexpr int EXB = 8;
__device__ __forceinline__ void phase_experts(const Args& A, const Ctx& C, float* dst) {
    const bf16* H2 = (const bf16*)(A.ws + WS_H); const unsigned char* WUP = A.ws + WS_WUP; const unsigned char* WDN = A.ws + WS_WDN;
    const float* SUP = (const float*)(A.ws + WS_SUP); const float* SDN = (const float*)(A.ws + WS_SDN);
    const int* IDX = (const int*)(A.ws + WS_IDX); const float* GW = (const float*)(A.ws + WS_GW); const float* mod = (const float*)(A.ws + WS_MOD);
    LAS unsigned* skey = (LAS unsigned*)((LAS unsigned char*)C.lds + C.wave * 2048);
    LAS float* sg = (LAS float*)(skey + 128);
    LAS float* ssup = sg + 128;
    const int lane = C.lane;
    for (int t = C.gw; t < T; t += C.ngw) {
        const int e0 = IDX[(size_t)t * PEER_HK + lane], e1 = IDX[(size_t)t * PEER_HK + 64 + lane];
        unsigned k0 = ((unsigned)e0 << 7) | (unsigned)lane, k1 = ((unsigned)e1 << 7) | (unsigned)(64 + lane);
        sg[lane] = GW[(size_t)t * PEER_HK + lane] * SDN[e0]; sg[64 + lane] = GW[(size_t)t * PEER_HK + 64 + lane] * SDN[e1];
        ssup[lane] = SUP[e0]; ssup[64 + lane] = SUP[e1];
#pragma unroll
        for (int k = 2; k <= 128; k <<= 1) {
#pragma unroll
            for (int j = k >> 1; j >= 1; j >>= 1) {
                if (j == 64) { const unsigned a = min(k0, k1), b = max(k0, k1); k0 = a; k1 = b; }
                else {
                    const unsigned o0 = __shfl_xor(k0, j), o1 = __shfl_xor(k1, j);
                    const bool lower = (lane & j) == 0;
                    const bool up0 = (lane & k) == 0, up1 = ((lane + 64) & k) == 0;
                    k0 = (up0 == lower) ? min(k0, o0) : max(k0, o0);
                    k1 = (up1 == lower) ? min(k1, o1) : max(k1, o1);
                }
            }
        }
        skey[lane] = k0; skey[64 + lane] = k1;
        f2v hv[2][8], acc[2][8];
#pragma unroll
        for (int j = 0; j < 2; ++j) { const v4u a = *(const v4u*)(H2 + (size_t)t * D + 16 * lane + 1024 * j), b = *(const v4u*)(H2 + (size_t)t * D + 16 * lane + 1024 * j + 8);
            hv[j][0] = (f2v){bflo(a.x), bfhi(a.x)}; hv[j][1] = (f2v){bflo(a.y), bfhi(a.y)}; hv[j][2] = (f2v){bflo(a.z), bfhi(a.z)}; hv[j][3] = (f2v){bflo(a.w), bfhi(a.w)};
            hv[j][4] = (f2v){bflo(b.x), bfhi(b.x)}; hv[j][5] = (f2v){bflo(b.y), bfhi(b.y)}; hv[j][6] = (f2v){bflo(b.z), bfhi(b.z)}; hv[j][7] = (f2v){bflo(b.w), bfhi(b.w)};
#pragma unroll
            for (int q = 0; q < 8; ++q) acc[j][q] = (f2v){0.f, 0.f}; }
        asm volatile("s_waitcnt lgkmcnt(0)" ::: "memory");
        v4u bu[EXB][2], bd[EXB][2];
#pragma unroll
        for (int i = 0; i < EXB; ++i) { const unsigned e = __builtin_amdgcn_readfirstlane(skey[i]) >> 7; const unsigned char* r = WUP + (size_t)e * D + 16 * lane;
            bu[i][0] = *(const v4u*)r; bu[i][1] = *(const v4u*)(r + 1024); }
        for (int b = 0; b < PEER_HK / EXB; ++b) {
#pragma unroll
            for (int i = 0; i < EXB; ++i) { const unsigned e = __builtin_amdgcn_readfirstlane(skey[EXB * b + i]) >> 7; const unsigned char* r = WDN + (size_t)e * D + 16 * lane;
                bd[i][0] = *(const v4u*)r; bd[i][1] = *(const v4u*)(r + 1024); }
            float p[EXB];
#pragma unroll
            for (int i = 0; i < EXB; ++i) { f2v s0 = {0.f, 0.f}, s1 = {0.f, 0.f};
#pragma unroll
                for (int j = 0; j < 2; ++j) { const v4u w = bu[i][j];
                    s0 = __builtin_elementwise_fma(fp8lo(w.x), hv[j][0], s0); s1 = __builtin_elementwise_fma(fp8hi(w.x), hv[j][1], s1);
                    s0 = __builtin_elementwise_fma(fp8lo(w.y), hv[j][2], s0); s1 = __builtin_elementwise_fma(fp8hi(w.y), hv[j][3], s1);
                    s0 = __builtin_elementwise_fma(fp8lo(w.z), hv[j][4], s0); s1 = __builtin_elementwise_fma(fp8hi(w.z), hv[j][5], s1);
                    s0 = __builtin_elementwise_fma(fp8lo(w.w), hv[j][6], s0); s1 = __builtin_elementwise_fma(fp8hi(w.w), hv[j][7], s1); }
                p[i] = (s0.x + s0.y) + (s1.x + s1.y); }
            const bool b5 = (lane & 32) != 0, b4 = (lane & 16) != 0, b3 = (lane & 8) != 0;
#pragma unroll
            for (int k = 0; k < 4; ++k) { const float keep = b5 ? p[k + 4] : p[k], send = b5 ? p[k] : p[k + 4]; p[k] = keep + __shfl_xor(send, 32); }
#pragma unroll
            for (int k = 0; k < 2; ++k) { const float keep = b4 ? p[k + 2] : p[k], send = b4 ? p[k] : p[k + 2]; p[k] = keep + __shfl_xor(send, 16); }
            float d; { const float keep = b3 ? p[1] : p[0], send = b3 ? p[0] : p[1]; d = keep + __shfl_xor(send, 8); }
            d += __shfl_xor(d, 4); d += __shfl_xor(d, 2); d += __shfl_xor(d, 1);
            const unsigned myk = skey[EXB * b + (lane >> 3)];
            const float cf = gelu_erf(d * ssup[myk & 127u]) * sg[myk & 127u];
            float c[EXB];
#pragma unroll
            for (int i = 0; i < EXB; ++i) c[i] = __builtin_bit_cast(float, __builtin_amdgcn_readlane(__builtin_bit_cast(int, cf), 8 * i));
            if (b + 1 < PEER_HK / EXB) {
#pragma unroll
                for (int i = 0; i < EXB; ++i) { const unsigned e = __builtin_amdgcn_readfirstlane(skey[EXB * b + EXB + i]) >> 7; const unsigned char* r = WUP + (size_t)e * D + 16 * lane;
                    bu[i][0] = *(const v4u*)r; bu[i][1] = *(const v4u*)(r + 1024); }
            }
#pragma unroll
            for (int i = 0; i < EXB; ++i) { const f2v cc = {c[i], c[i]};
#pragma unroll
                for (int j = 0; j < 2; ++j) { const v4u w = bd[i][j];
                    acc[j][0] = __builtin_elementwise_fma(fp8lo(w.x), cc, acc[j][0]); acc[j][1] = __builtin_elementwise_fma(fp8hi(w.x), cc, acc[j][1]);
                    acc[j][2] = __builtin_elementwise_fma(fp8lo(w.y), cc, acc[j][2]); acc[j][3] = __builtin_elementwise_fma(fp8hi(w.y), cc, acc[j][3]);
                    acc[j][4] = __builtin_elementwise_fma(fp8lo(w.z), cc, acc[j][4]); acc[j][5] = __builtin_elementwise_fma(fp8hi(w.z), cc, acc[j][5]);
                    acc[j][6] = __builtin_elementwise_fma(fp8lo(w.w), cc, acc[j][6]); acc[j][7] = __builtin_elementwise_fma(fp8hi(w.w), cc, acc[j][7]); } }
        }
        const int bb = t / SEQ;
#pragma unroll
        for (int j = 0; j < 2; ++j)
#pragma unroll
            for (int q = 0; q < 4; ++q) { const int col = 16 * lane + 1024 * j + 4 * q; const f32x4 g = *(const f32x4*)(mod + bb * MODW + 5 * D + col);
                f32x4 x = *(const f32x4*)(A.out + (size_t)t * D + col);
                x.x += g.x * acc[j][2 * q].x; x.y += g.y * acc[j][2 * q].y; x.z += g.z * acc[j][2 * q + 1].x; x.w += g.w * acc[j][2 * q + 1].y; *(f32x4*)(dst + (size_t)t * D + col) = x; }
        asm volatile("s_waitcnt lgkmcnt(0)" ::: "memory");
    }
}


constexpr int EX_LDS_WAVE = 4 * 4096 + 2048;
typedef __bf16 bf16x2w __attribute__((ext_vector_type(2)));
__device__ __forceinline__ float gelu_as(float v) {
    const float av = fabsf(v), t = __builtin_amdgcn_rcpf(av * 0.2316419f + 1.0f);
    float q = t * 0.5307027145f + (-0.7265760135f); q = q * t + 0.7107068705f; q = q * t + (-0.142248368f); q = q * t + 0.127414796f; q = q * t;
    const float e = __builtin_amdgcn_exp2f((v * v) * (-0.72134752044f));
    const float m = v * (q * e);
    return v < 0.f ? m : v - m;
}
__device__ __forceinline__ v4u ldrow16(const unsigned char* sbase, unsigned voff) { return *(const v4u*)(sbase + voff); }
__device__ __forceinline__ v2u ldrow8(const unsigned char* sbase, unsigned voff) { return *(const v2u*)(sbase + voff); }
__device__ __forceinline__ int dot16_i8(const v4u w0, const v4u h0) {
    int s0 = __builtin_amdgcn_sdot4((int)w0.x, (int)h0.x, 0, false), s1 = __builtin_amdgcn_sdot4((int)w0.y, (int)h0.y, 0, false);
    s0 = __builtin_amdgcn_sdot4((int)w0.z, (int)h0.z, s0, false); s1 = __builtin_amdgcn_sdot4((int)w0.w, (int)h0.w, s1, false);
    return s0 + s1;
}
__device__ __forceinline__ int dot32_i8(const v4u w0, const v4u h0, const v4u w1, const v4u h1) {
    int s0 = __builtin_amdgcn_sdot4((int)w0.x, (int)h0.x, 0, false), s1 = __builtin_amdgcn_sdot4((int)w0.y, (int)h0.y, 0, false);
    s0 = __builtin_amdgcn_sdot4((int)w0.z, (int)h0.z, s0, false); s1 = __builtin_amdgcn_sdot4((int)w0.w, (int)h0.w, s1, false);
    s0 = __builtin_amdgcn_sdot4((int)w1.x, (int)h1.x, s0, false); s1 = __builtin_amdgcn_sdot4((int)w1.y, (int)h1.y, s1, false);
    s0 = __builtin_amdgcn_sdot4((int)w1.z, (int)h1.z, s0, false); s1 = __builtin_amdgcn_sdot4((int)w1.w, (int)h1.w, s1, false);
    return s0 + s1;
}
__device__ __forceinline__ float dot2_f2v_bf16(f2v a, unsigned h, float s) { return __builtin_amdgcn_fdot2_f32_bf16(__builtin_convertvector(a, bf16x2w), __builtin_bit_cast(bf16x2w, h), s, false); }
__device__ __forceinline__ float dot16_fp8_bf16(const v4u w, const v4u ha, const v4u hb, float s) {
#define D2(W, HI, H) s = dot2_f2v_bf16((HI) ? fp8hi(W) : fp8lo(W), H, s)
    D2(w.x, 0, ha.x); D2(w.x, 1, ha.y); D2(w.y, 0, ha.z); D2(w.y, 1, ha.w); D2(w.z, 0, hb.x); D2(w.z, 1, hb.y); D2(w.w, 0, hb.z); D2(w.w, 1, hb.w);
#undef D2
    return s;
}
#define EX_AXPY(ACC, W0, W1, CC) do { \
    ACC[0][0] = __builtin_elementwise_fma(fp8lo((W0).x), CC, ACC[0][0]); ACC[0][1] = __builtin_elementwise_fma(fp8hi((W0).x), CC, ACC[0][1]); \
    ACC[0][2] = __builtin_elementwise_fma(fp8lo((W0).y), CC, ACC[0][2]); ACC[0][3] = __builtin_elementwise_fma(fp8hi((W0).y), CC, ACC[0][3]); \
    ACC[0][4] = __builtin_elementwise_fma(fp8lo((W0).z), CC, ACC[0][4]); ACC[0][5] = __builtin_elementwise_fma(fp8hi((W0).z), CC, ACC[0][5]); \
    ACC[0][6] = __builtin_elementwise_fma(fp8lo((W0).w), CC, ACC[0][6]); ACC[0][7] = __builtin_elementwise_fma(fp8hi((W0).w), CC, ACC[0][7]); \
    ACC[1][0] = __builtin_elementwise_fma(fp8lo((W1).x), CC, ACC[1][0]); ACC[1][1] = __builtin_elementwise_fma(fp8hi((W1).x), CC, ACC[1][1]); \
    ACC[1][2] = __builtin_elementwise_fma(fp8lo((W1).y), CC, ACC[1][2]); ACC[1][3] = __builtin_elementwise_fma(fp8hi((W1).y), CC, ACC[1][3]); \
    ACC[1][4] = __builtin_elementwise_fma(fp8lo((W1).z), CC, ACC[1][4]); ACC[1][5] = __builtin_elementwise_fma(fp8hi((W1).z), CC, ACC[1][5]); \
    ACC[1][6] = __builtin_elementwise_fma(fp8lo((W1).w), CC, ACC[1][6]); ACC[1][7] = __builtin_elementwise_fma(fp8hi((W1).w), CC, ACC[1][7]); } while (0)
__device__ __forceinline__ void phase_experts3(const Args& A, const Ctx& C, float* dst, unsigned emask) {
    const bf16* H2 = (const bf16*)(A.ws + WS_H); const unsigned char* WUP = A.ws + WS_WUP; const unsigned char* WDN = A.ws + WS_WDN;
    const float* SUP = (const float*)(A.ws + WS_SUP); const float* SDN = (const float*)(A.ws + WS_SDN);
    const int* IDX = (const int*)(A.ws + WS_IDX); const float* GW = (const float*)(A.ws + WS_GW); const float* mod = (const float*)(A.ws + WS_MOD);
    LAS unsigned char* hb = (LAS unsigned char*)C.lds + C.wave * EX_LDS_WAVE;
    LAS unsigned* keys = (LAS unsigned*)(hb + 8192);
    for (int tg = C.gw; tg < T / 4; tg += C.ngw) {
        unsigned z_ = 0u; asm volatile("" : "+v"(z_));
        int lane = (int)__builtin_amdgcn_mbcnt_hi(~0u, __builtin_amdgcn_mbcnt_lo(~0u, z_));
        const int t0 = 4 * tg;
        float hs4[4];
        {
#pragma unroll
          for (int tk = 0; tk < 4; ++tk) {
              float hv[2][16]; float am = 0.f;
#pragma unroll
              for (int j = 0; j < 2; ++j) { const v4u a = *(const v4u*)(H2 + (size_t)(t0 + tk) * D + 16 * lane + 1024 * j), b = *(const v4u*)(H2 + (size_t)(t0 + tk) * D + 16 * lane + 1024 * j + 8);
                  hv[j][0] = bflo(a.x); hv[j][1] = bfhi(a.x); hv[j][2] = bflo(a.y); hv[j][3] = bfhi(a.y); hv[j][4] = bflo(a.z); hv[j][5] = bfhi(a.z); hv[j][6] = bflo(a.w); hv[j][7] = bfhi(a.w);
                  hv[j][8] = bflo(b.x); hv[j][9] = bfhi(b.x); hv[j][10] = bflo(b.y); hv[j][11] = bfhi(b.y); hv[j][12] = bflo(b.z); hv[j][13] = bfhi(b.z); hv[j][14] = bflo(b.w); hv[j][15] = bfhi(b.w);
#pragma unroll
                  for (int q = 0; q < 16; ++q) am = fmaxf(am, fabsf(hv[j][q])); }
#pragma unroll
              for (int o = 1; o < 64; o <<= 1) am = fmaxf(am, __shfl_xor(am, o));
              const float sc = (am > 0.f) ? 127.0f / am : 0.f; hs4[tk] = am * (1.0f / 127.0f);
#pragma unroll
              for (int j = 0; j < 2; ++j) { v4u o;
                  o.x = pack_i8x4(hv[j][0] * sc, hv[j][1] * sc, hv[j][2] * sc, hv[j][3] * sc); o.y = pack_i8x4(hv[j][4] * sc, hv[j][5] * sc, hv[j][6] * sc, hv[j][7] * sc);
                  o.z = pack_i8x4(hv[j][8] * sc, hv[j][9] * sc, hv[j][10] * sc, hv[j][11] * sc); o.w = pack_i8x4(hv[j][12] * sc, hv[j][13] * sc, hv[j][14] * sc, hv[j][15] * sc);
                  *(LAS v4u*)(hb + tk * 2048 + 16 * lane + 1024 * j) = o; } }
        }
        LAS unsigned* keysM = keys + 512;
        LAS float* cfl = (LAS float*)(keys + 1024);
        unsigned K[8];
#pragma unroll
        for (int s = 0; s < 8; ++s) { const int tk = s >> 1, slot = lane + 64 * (s & 1); const unsigned e = (unsigned)IDX[(size_t)(t0 + tk) * PEER_HK + slot];
            K[s] = ((unsigned)tk << 21) | (e << 7) | (unsigned)slot; }
#define EX_SORT512(KK) do { _Pragma("unroll") for (int k = 2; k <= 512; k <<= 1) { _Pragma("unroll") for (int j = k >> 1; j >= 1; j >>= 1) { \
            if (j >= 64) { const int ds = j >> 6; _Pragma("unroll") for (int s = 0; s < 8; ++s) if ((s & ds) == 0) { const bool up = ((64 * s) & k) == 0; \
                    const unsigned a_ = min(KK[s], KK[s | ds]), b_ = max(KK[s], KK[s | ds]); KK[s] = up ? a_ : b_; KK[s | ds] = up ? b_ : a_; } } \
            else { const bool lower = (lane & j) == 0; _Pragma("unroll") for (int s = 0; s < 8; ++s) { const unsigned o = __shfl_xor(KK[s], j); const bool up = ((lane + 64 * s) & k) == 0; \
                    KK[s] = (up == lower) ? min(KK[s], o) : max(KK[s], o); } } } } } while (0)
        EX_SORT512(K);
#pragma unroll
        for (int s = 0; s < 8; ++s) { const int p = lane + 64 * s; keys[(p & 127) * 4 + (p >> 7)] = K[s]; }
        asm volatile("" : "+v"(lane));
#pragma unroll
        for (int s = 0; s < 8; ++s) { const int tk = s >> 1, slot = lane + 64 * (s & 1); const unsigned e = (unsigned)IDX[(size_t)(t0 + tk) * PEER_HK + slot];
            K[s] = (e << 9) | ((unsigned)tk << 7) | (unsigned)slot; }
        EX_SORT512(K);
#pragma unroll
        for (int s = 0; s < 8; ++s) keysM[lane + 64 * s] = K[s];
#undef EX_SORT512
        asm volatile("s_waitcnt lgkmcnt(0)" ::: "memory");
        asm volatile("" : "+v"(lane));
        constexpr int EX_NB = 128;
        {
            const int gq_ = lane >> 4, li_ = lane & 15;
            v4u bw[2][8]; unsigned kcur = keysM[gq_];
#define EX_UP_LD(KW, BUF) do { const unsigned char* r_ = WUP + (size_t)(((KW) >> 9) & emask) * D + 16 * li_; \
            _Pragma("unroll") for (int q_ = 0; q_ < 8; ++q_) bw[BUF][q_] = *(const v4u*)(r_ + 256 * q_); } while (0)
#define EX_UP_STEP(B, CUR) do { \
            const unsigned knext = keysM[4 * (((B) + 1 < EX_NB) ? (B) + 1 : (B)) + gq_]; \
            EX_UP_LD(knext, (CUR) ^ 1); \
            const unsigned me = kcur >> 9, mtok = (kcur >> 7) & 3u, mslot = kcur & 127u; \
            const float gg = GW[(size_t)(t0 + (int)mtok) * PEER_HK + mslot], su = SUP[me], sd = SDN[me]; \
            LAS unsigned char* hr = hb + mtok * 2048 + 16 * li_; int s0_ = 0, s1_ = 0; \
            _Pragma("unroll") for (int q_ = 0; q_ < 8; q_ += 2) { const v4u h0 = *(LAS v4u*)(hr + 256 * q_), h1 = *(LAS v4u*)(hr + 256 * q_ + 256); \
                s0_ += dot16_i8(bw[CUR][q_], h0); s1_ += dot16_i8(bw[CUR][q_ + 1], h1); } \
            unsigned s_ = (unsigned)(s0_ + s1_); \
            s_ += dpp_u<0x128>(s_); s_ += dpp_u<0x124>(s_); s_ += dpp_u<0x122>(s_); s_ += dpp_u<0x121>(s_);            \
            const float hs_ = (mtok == 0u) ? hs4[0] : (mtok == 1u) ? hs4[1] : (mtok == 2u) ? hs4[2] : hs4[3]; \
            cfl[mtok * 128u + mslot] = gg * sd * gelu_as((float)(int)s_ * su * hs_); \
            kcur = knext; } while (0)
            EX_UP_LD(kcur, 0);
            for (int b = 0; b < EX_NB; b += 2) { EX_UP_STEP(b, 0); EX_UP_STEP(b + 1, 1); }
#undef EX_UP_LD
#undef EX_UP_STEP
        }
        asm volatile("s_waitcnt lgkmcnt(0)" ::: "memory");
        asm volatile("" : "+v"(lane));
        const int bb = t0 / SEQ;
        constexpr int EX_DB = 2;
        LAS unsigned* rowT = keys + 1536;
        LAS float* cfT = (LAS float*)(keys + 2048);
#pragma unroll
        for (int s = 0; s < 8; ++s) { const int q_ = lane + 64 * s; const unsigned kk_ = keys[q_]; const unsigned e_ = ((kk_ >> 7) & 16383u) & emask;
            rowT[q_] = e_ * (unsigned)D; cfT[q_] = cfl[(q_ & 3) * 128 + (int)(kk_ & 127u)]; }
        asm volatile("s_waitcnt lgkmcnt(0)" ::: "memory");
#define EX_AXPY1(ACC, W0, CC) do { \
    ACC[0] = __builtin_elementwise_fma(fp8lo((W0).x), CC, ACC[0]); ACC[1] = __builtin_elementwise_fma(fp8hi((W0).x), CC, ACC[1]); \
    ACC[2] = __builtin_elementwise_fma(fp8lo((W0).y), CC, ACC[2]); ACC[3] = __builtin_elementwise_fma(fp8hi((W0).y), CC, ACC[3]); } while (0)
#define EX_RO(W) ((unsigned)__builtin_amdgcn_readfirstlane((int)(W)))
#define EX_DN_LD(J, BQ, BUF) do { _Pragma("unroll") for (int bb_ = 0; bb_ < EX_DB; ++bb_) { const v4u rv = *(LAS v4u*)(rowT + 4 * ((BQ) + bb_)); \
            bd[BUF][bb_][0] = ldrow8(WDN + EX_RO(rv.x), voff_ + 512u * (J)); bd[BUF][bb_][1] = ldrow8(WDN + EX_RO(rv.y), voff_ + 512u * (J)); \
            bd[BUF][bb_][2] = ldrow8(WDN + EX_RO(rv.z), voff_ + 512u * (J)); bd[BUF][bb_][3] = ldrow8(WDN + EX_RO(rv.w), voff_ + 512u * (J)); } } while (0)
#define EX_DN_STEP(J, B, CUR) do { \
            EX_DN_LD(J, (((B) + EX_DB < EX_NB) ? (B) + EX_DB : (B)), (CUR) ^ 1); \
            _Pragma("unroll") for (int bb_ = 0; bb_ < EX_DB; ++bb_) { const f32x4 cv = *(LAS f32x4*)(cfT + 4 * ((B) + bb_)); \
                { const f2v cc = {cv.x, cv.x}; EX_AXPY1(a0, bd[CUR][bb_][0], cc); } \
                { const f2v cc = {cv.y, cv.y}; EX_AXPY1(a1, bd[CUR][bb_][1], cc); } \
                { const f2v cc = {cv.z, cv.z}; EX_AXPY1(a2, bd[CUR][bb_][2], cc); } \
                { const f2v cc = {cv.w, cv.w}; EX_AXPY1(a3, bd[CUR][bb_][3], cc); } } } while (0)
#define EX_OUT1(TK, ACC, J) do { _Pragma("unroll") for (int q = 0; q < 2; ++q) { const int col = 8 * lane + 512 * (J) + 4 * q; \
            const f32x4 g = *(const f32x4*)(mod + bb * MODW + 5 * D + col); f32x4 x = *(const f32x4*)(A.out + (size_t)(t0 + TK) * D + col); \
            x.x += g.x * ACC[2 * q].x; x.y += g.y * ACC[2 * q].y; x.z += g.z * ACC[2 * q + 1].x; x.w += g.w * ACC[2 * q + 1].y; *(f32x4*)(dst + (size_t)(t0 + TK) * D + col) = x; } } while (0)
#define EX_DN_PASS(J) do { v2u bd[2][EX_DB][4]; const unsigned voff_ = 8u * (unsigned)lane; f2v a0[4], a1[4], a2[4], a3[4]; \
            _Pragma("unroll") for (int q = 0; q < 4; ++q) { a0[q] = (f2v){0.f, 0.f}; a1[q] = (f2v){0.f, 0.f}; a2[q] = (f2v){0.f, 0.f}; a3[q] = (f2v){0.f, 0.f}; } \
            EX_DN_LD(J, 0, 0); \
            for (int b = 0; b < EX_NB; b += 2 * EX_DB) { EX_DN_STEP(J, b, 0); EX_DN_STEP(J, b + EX_DB, 1); } \
            EX_OUT1(0, a0, J); EX_OUT1(1, a1, J); EX_OUT1(2, a2, J); EX_OUT1(3, a3, J); } while (0)
        EX_DN_PASS(0);
        asm volatile("" : "+v"(lane));
        EX_DN_PASS(1);
        asm volatile("" : "+v"(lane));
        EX_DN_PASS(2);
        asm volatile("" : "+v"(lane));
        EX_DN_PASS(3);
#undef EX_DN_PASS
#undef EX_DN_LD
#undef EX_RO
#undef EX_DN_STEP
#undef EX_AXPY1
#undef EX_OUT1
        asm volatile("s_waitcnt lgkmcnt(0)" ::: "memory");
    }
}

constexpr int CONV_TT = 16;
__device__ __forceinline__ void wave_reduce16(float (&v)[16], int lane) {
    const bool b5 = lane & 32, b4 = lane & 16, b3 = lane & 8, b2 = lane & 4;
#pragma unroll
    for (int k = 0; k < 8; ++k) { const float keep = b5 ? v[k + 8] : v[k], send = b5 ? v[k] : v[k + 8]; v[k] = keep + __shfl_xor(send, 32); }
#pragma unroll
    for (int k = 0; k < 4; ++k) { const float keep = b4 ? v[k + 4] : v[k], send = b4 ? v[k] : v[k + 4]; v[k] = keep + __shfl_xor(send, 16); }
#pragma unroll
    for (int k = 0; k < 2; ++k) { const float keep = b3 ? v[k + 2] : v[k], send = b3 ? v[k] : v[k + 2]; v[k] = keep + __shfl_xor(send, 8); }
    { const float keep = b2 ? v[1] : v[0], send = b2 ? v[0] : v[1]; v[0] = keep + __shfl_xor(send, 4); }
    v[0] += __shfl_xor(v[0], 2); v[0] += __shfl_xor(v[0], 1);
}
__device__ __forceinline__ void phase_conv(const Args& A, const Ctx& C) {
    const bf16* U = (const bf16*)(A.ws + WS_U); bf16* UCV = (bf16*)(A.ws + WS_UCV);
    const float* dw = A.in[I_CDW]; const float* db = A.in[I_CDB]; const float* lg = A.in[I_CLNG]; const float* lb = A.in[I_CLNB];
    LAS float* red = (LAS float*)((LAS unsigned char*)C.lds);
    const int c0 = 2 * C.tid, lane = C.lane;
    float w0[CONV_K], w1[CONV_K];
#pragma unroll
    for (int j = 0; j < CONV_K; ++j) { const float2 w = *(const float2*)(dw + j * CONV_CH + c0); w0[j] = w.x; w1[j] = w.y; }
    const float2 bias = *(const float2*)(db + c0), gam = *(const float2*)(lg + c0), bet = *(const float2*)(lb + c0);
    const int tsel = ((lane >> 5) & 1) * 8 + ((lane >> 4) & 1) * 4 + ((lane >> 3) & 1) * 2 + ((lane >> 2) & 1);
    for (int it = C.bid; it < T / CONV_TT; it += C.nb) {
        const int t0 = it * CONV_TT, s0 = t0 % SEQ;
        unsigned in[CONV_TT + CONV_K - 1];
#pragma unroll
        for (int q = 0; q < CONV_TT + CONV_K - 1; ++q) { const int sp = s0 - (CONV_K - 1) + q;
            in[q] = (sp >= 0) ? *(const unsigned*)(U + (size_t)(t0 - (CONV_K - 1) + q) * CONV_CH + c0) : 0u; }
        float a0[CONV_TT], a1[CONV_TT];
#pragma unroll
        for (int k = 0; k < CONV_TT; ++k) { float x0 = bias.x, x1 = bias.y;
#pragma unroll
            for (int j = 0; j < CONV_K; ++j) { x0 += w0[j] * bflo(in[k + j]); x1 += w1[j] * bfhi(in[k + j]); }
            a0[k] = x0; a1[k] = x1; }
        float v[16];
#pragma unroll
        for (int k = 0; k < 16; ++k) v[k] = a0[k] + a1[k];
        wave_reduce16(v, lane);
        __syncthreads();
        if ((lane & 3) == 0) red[C.wave * 16 + tsel] = v[0];
        __syncthreads();
        float mean[16];
#pragma unroll
        for (int k = 0; k < 16; ++k) { float s = 0.f;
#pragma unroll
            for (int wv = 0; wv < NWAVES; ++wv) s += red[wv * 16 + k];
            mean[k] = s * (1.0f / CONV_CH); }
#pragma unroll
        for (int k = 0; k < 16; ++k) { a0[k] -= mean[k]; a1[k] -= mean[k]; v[k] = a0[k] * a0[k] + a1[k] * a1[k]; }
        wave_reduce16(v, lane);
        __syncthreads();
        if ((lane & 3) == 0) red[C.wave * 16 + tsel] = v[0];
        __syncthreads();
#pragma unroll
        for (int k = 0; k < 16; ++k) { float s = 0.f;
#pragma unroll
            for (int wv = 0; wv < NWAVES; ++wv) s += red[wv * 16 + k];
            const float rstd = 1.0f / sqrtf(s * (1.0f / CONV_CH) + EPS);
            const float y0 = a0[k] * rstd * gam.x + bet.x, y1 = a1[k] * rstd * gam.y + bet.y;
            *(unsigned*)(UCV + (size_t)(t0 + k) * CONV_CH + c0) = pk2(siluf_(y0), siluf_(y1)); }
    }
    __syncthreads();
}

typedef short v4i16_t __attribute__((ext_vector_type(4)));
constexpr int VROW = 288;
constexpr int ATT_V_BYTES = 256 * VROW;
constexpr int KROW = 272;
constexpr int ATT_K_OFF = ATT_V_BYTES;
constexpr int ATT_SCR_OFF = ATT_V_BYTES + 256 * KROW;
constexpr int ATT_RK_OFF = ATT_SCR_OFF + NWAVES * 256;
__device__ __forceinline__ void phase_attn(const Args& A, const Ctx& C) {
    const bf16* QKV = (const bf16*)(A.ws + WS_QKV); bf16* ON = (bf16*)(A.ws + WS_ON); float* DEN = (float*)(A.ws + WS_DEN);
    const float* qg = A.in[I_QNG]; const float* kg = A.in[I_KNG];
    LAS unsigned char* Vb = (LAS unsigned char*)C.lds;
    LAS unsigned char* Kb = Vb + ATT_K_OFF;
    LAS float* scr = (LAS float*)(Vb + ATT_SCR_OFF + C.wave * 256);
    LAS float* rkt = (LAS float*)(Vb + ATT_RK_OFF);
    unsigned z0_ = 0u; asm volatile("" : "+v"(z0_));
    const int lane = (int)__builtin_amdgcn_mbcnt_hi(~0u, __builtin_amdgcn_mbcnt_lo(~0u, z0_)), c = lane & 15, kq = lane >> 4, w = C.wave, i0 = 16 * w;
    constexpr float C2 = 0.08838834764831845f * 1.4426950408889634f;
#define ATT_DECODE(U, B_, GI_, HH_, R_, N_, DIL_) const int B_ = (U) / 384, GI_ = ((U) % 384) >> 7; const int DIL_ = (GI_ == 0) ? 1 : (GI_ == 1) ? 4 : 16; \
        const int nbk##B_ = (GI_ == 0) ? 32 : (GI_ == 1) ? 8 : 2; const int rem2##B_ = ((U) % 384) & 127; const int HH_ = rem2##B_ / (DIL_ * nbk##B_), r2##B_ = rem2##B_ % (DIL_ * nbk##B_), R_ = r2##B_ / nbk##B_, N_ = r2##B_ % nbk##B_;
#define ATT_LOAD(KD, VD, QD, RB_, N_, DIL_, HEAD_) do { unsigned zz_ = 0u; asm volatile("" : "+v"(zz_)); const int tid_ = C.wave * 64 + (int)__builtin_amdgcn_mbcnt_hi(~0u, __builtin_amdgcn_mbcnt_lo(~0u, zz_)); const int lb_ = 128 * (N_) - 128; \
        _Pragma("unroll") for (int k_ = 0; k_ < 8; ++k_) { const int idx_ = tid_ + NTHREADS * k_; int l_ = lb_ + (idx_ >> 4); l_ = l_ < 0 ? 0 : l_; \
            const bf16* rp_ = QKV + ((RB_) + (size_t)l_ * (DIL_)) * QKVW + (HEAD_) * HD + (idx_ & 15) * 8; KD[k_] = *(const v4u*)(rp_ + AW); VD[k_] = *(const v4u*)(rp_ + 2 * AW); } \
        { const bf16* qrow_ = QKV + ((RB_) + (size_t)(128 * (N_) + i0 + (tid_ & 15)) * (DIL_)) * QKVW + (HEAD_) * HD + 8 * ((tid_ & 63) >> 4); \
          _Pragma("unroll") for (int ks_ = 0; ks_ < 4; ++ks_) QD[ks_] = *(const v4u*)(qrow_ + 32 * ks_); } } while (0)
#define ATT_STORE(KD, VD) do { unsigned zz_ = 0u; asm volatile("" : "+v"(zz_)); const int tid_ = C.wave * 64 + (int)__builtin_amdgcn_mbcnt_hi(~0u, __builtin_amdgcn_mbcnt_lo(~0u, zz_)); _Pragma("unroll") for (int k_ = 0; k_ < 8; ++k_) { const int idx_ = tid_ + NTHREADS * k_; \
            *(LAS v4u*)(Kb + (idx_ >> 4) * KROW + (idx_ & 15) * 16) = KD[k_]; *(LAS v4u*)(Vb + (idx_ >> 4) * VROW + (idx_ & 15) * 16) = VD[k_]; \
            { const v4u k4 = KD[k_]; const float a0 = bflo(k4.x), a1 = bfhi(k4.x), a2 = bflo(k4.y), a3 = bfhi(k4.y), a4 = bflo(k4.z), a5 = bfhi(k4.z), a6 = bflo(k4.w), a7 = bfhi(k4.w); \
              const float ssr_ = rowsum_f((a0 * a0 + a1 * a1) + (a2 * a2 + a3 * a3) + (a4 * a4 + a5 * a5) + (a6 * a6 + a7 * a7));        \
              rkt[idx_ >> 4] = C2 / sqrtf(ssr_ * (1.0f / HD) + EPS); } } } while (0)
    v4u knext[8], vnext[8], qnext[4], qraw[4];
    if (C.bid < 768) { ATT_DECODE(C.bid, b0_, gi0_, hh0_, r0_, n0_, dil0_); ATT_LOAD(knext, vnext, qraw, (size_t)b0_ * SEQ + r0_, n0_, dil0_, gi0_ * 4 + hh0_); ATT_STORE(knext, vnext); }
    for (int u = C.bid; u < 768; u += C.nb) {
        ATT_DECODE(u, b, gi, hh, r, n, dil);
        const int head = gi * 4 + hh;
        const size_t rowbase = (size_t)b * SEQ + r;
        const int lb = 128 * n - 128;
        __syncthreads();
        const int un = u + C.nb; const bool hasn = un < 768;
        if (hasn) { ATT_DECODE(un, bn_, gin_, hhn_, rn_, nn_, diln_); ATT_LOAD(knext, vnext, qnext, (size_t)bn_ * SEQ + rn_, nn_, diln_, gin_ * 4 + hhn_); }
        pg8::bf16x8 qf[4];
        { float ss = 0.f;
#pragma unroll
          for (int ks = 0; ks < 4; ++ks) { const v4u rw = qraw[ks];
              const float a0 = bflo(rw.x), a1 = bfhi(rw.x), a2 = bflo(rw.y), a3 = bfhi(rw.y), a4 = bflo(rw.z), a5 = bfhi(rw.z), a6 = bflo(rw.w), a7 = bfhi(rw.w);
              ss += (a0 * a0 + a1 * a1) + (a2 * a2 + a3 * a3) + (a4 * a4 + a5 * a5) + (a6 * a6 + a7 * a7); }
          ss += __shfl_xor(ss, 16); ss += __shfl_xor(ss, 32);
          const float rq = 1.0f / sqrtf(ss * (1.0f / HD) + EPS);
#pragma unroll
          for (int ks = 0; ks < 4; ++ks) { const int d0 = head * HD + 32 * ks + 8 * kq; const v4u rw = qraw[ks];
              const f32x4 g0 = *(const f32x4*)(qg + d0) * *(const f32x4*)(kg + d0), g1 = *(const f32x4*)(qg + d0 + 4) * *(const f32x4*)(kg + d0 + 4);
              pg8::u32x4 pk;
              pk.x = pg8::cvt_pk_bf16(bflo(rw.x) * rq * g0.x, bfhi(rw.x) * rq * g0.y); pk.y = pg8::cvt_pk_bf16(bflo(rw.y) * rq * g0.z, bfhi(rw.y) * rq * g0.w);
              pk.z = pg8::cvt_pk_bf16(bflo(rw.z) * rq * g1.x, bfhi(rw.z) * rq * g1.y); pk.w = pg8::cvt_pk_bf16(bflo(rw.w) * rq * g1.z, bfhi(rw.w) * rq * g1.w);
              qf[ks] = __builtin_bit_cast(pg8::bf16x8, pk); } }
        unsigned Pk[10][2]; float dsum = 0.f;
#pragma unroll
        for (int kb = 0; kb < 9; ++kb) {
            const int j0 = i0 + 16 * kb;
            v4u kr[4];
#pragma unroll
            for (int ks = 0; ks < 4; ++ks) kr[ks] = *(const LAS v4u*)(Kb + (j0 + c) * KROW + 64 * ks + 16 * kq);
            const f32x4 rk4 = *(const LAS f32x4*)(rkt + j0 + 4 * kq);
            f32x4 acc = {0.f, 0.f, 0.f, 0.f};
#pragma unroll
            for (int ks = 0; ks < 4; ++ks) acc = __builtin_amdgcn_mfma_f32_16x16x32_bf16(__builtin_bit_cast(pg8::bf16x8, kr[ks]), qf[ks], acc, 0, 0, 0);
#pragma unroll
            for (int e = 0; e < 4; ++e) { const int j = j0 + 4 * kq + e; const int dist = 128 + i0 + c - j;
                const bool valid = (dist >= 0) && (dist <= 128) && (lb + j >= 0);
                const float pv = __builtin_amdgcn_exp2f(acc[e] * rk4[e]);
                acc[e] = valid ? pv : 0.f; dsum += acc[e]; }
            Pk[kb][0] = pg8::cvt_pk_bf16(acc[0], acc[1]); Pk[kb][1] = pg8::cvt_pk_bf16(acc[2], acc[3]);
        }
        Pk[9][0] = 0u; Pk[9][1] = 0u;
        dsum += __shfl_xor(dsum, 16); dsum += __shfl_xor(dsum, 32);
        if (kq == 0) scr[32 + c] = dsum;
        const f32x4 dq = *(const LAS f32x4*)(scr + 32 + 4 * kq);
        f32x4 O[8];
#pragma unroll
        for (int dt = 0; dt < 8; ++dt) O[dt] = (f32x4){0.f, 0.f, 0.f, 0.f};
#pragma unroll
        for (int s = 0; s < 5; ++s) {
            pg8::u32x4 pk; pk.x = Pk[2 * s][0]; pk.y = Pk[2 * s][1]; pk.z = Pk[2 * s + 1][0]; pk.w = Pk[2 * s + 1][1];
            const pg8::bf16x8 pf = __builtin_bit_cast(pg8::bf16x8, pk);
            const int kb1 = (2 * s + 1 < 9) ? 2 * s + 1 : 8;
            const int rowA = i0 + 32 * s + 4 * kq + (c >> 2), rowB = i0 + 16 * kb1 + 4 * kq + (c >> 2);
            LAS unsigned char* pa = Vb + rowA * VROW + (c & 3) * 8; LAS unsigned char* pb = Vb + rowB * VROW + (c & 3) * 8;
#pragma unroll
            for (int dt = 0; dt < 8; ++dt) {
                const v4i16_t lo = __builtin_amdgcn_ds_read_tr16_b64_v4i16((LAS v4i16_t*)(pa + dt * 32));
                const v4i16_t hi = __builtin_amdgcn_ds_read_tr16_b64_v4i16((LAS v4i16_t*)(pb + dt * 32));
                const pg8::bf16x8 vf = {lo[0], lo[1], lo[2], lo[3], hi[0], hi[1], hi[2], hi[3]};
                O[dt] = __builtin_amdgcn_mfma_f32_16x16x32_bf16(pf, vf, O[dt], 0, 0, 0);
            }
        }
        { float inv[4];
#pragma unroll
          for (int e = 0; e < 4; ++e) inv[e] = 1.0f / dq[e];
#pragma unroll
          for (int e = 0; e < 4; ++e) { const size_t trow = rowbase + (size_t)(128 * n + i0 + 4 * kq + e) * dil;
              bf16* op = ON + ((size_t)gi * T + trow) * AOW + hh * HD + c;
#pragma unroll
              for (int dt = 0; dt < 8; ++dt) op[16 * dt] = (bf16)f2bf(O[dt][e] * inv[e]); }
          { unsigned zq_ = 0u; asm volatile("" : "+v"(zq_)); const int l2_ = (int)__builtin_amdgcn_mbcnt_hi(~0u, __builtin_amdgcn_mbcnt_lo(~0u, zq_));
            if ((l2_ >> 4) == 0) DEN[((size_t)gi * T + rowbase + (size_t)(128 * n + 16 * C.wave + (l2_ & 15)) * dil) * 4 + hh] = dsum; } }
        __syncthreads();
        if (hasn) { ATT_STORE(knext, vnext);
#pragma unroll
            for (int ks = 0; ks < 4; ++ks) qraw[ks] = qnext[ks]; }
    }
#undef ATT_DECODE
#undef ATT_LOAD
#undef ATT_STORE
}
__device__ __forceinline__ void phase_attn_combine(const Args& A, const Ctx& C) {
    const bf16* ON = (const bf16*)(A.ws + WS_ON); const float* DEN = (const float*)(A.ws + WS_DEN); bf16* O = (bf16*)(A.ws + WS_O);
    const int gt = C.bid * NTHREADS + C.tid, ngt = C.nb * NTHREADS;
    for (int i = gt; i < T * (AOW / 8); i += ngt) {
        const int t = i >> 6, ch = i & 63, hh = ch >> 4;
        const float d0 = DEN[((size_t)0 * T + t) * 4 + hh], d1 = DEN[((size_t)1 * T + t) * 4 + hh], d2 = DEN[((size_t)2 * T + t) * 4 + hh];
        const float inv = 1.0f / (d0 + d1 + d2); const float w0 = d0 * inv, w1 = d1 * inv, w2 = d2 * inv;
        const v4u a = *(const v4u*)(ON + ((size_t)0 * T + t) * AOW + ch * 8), bq = *(const v4u*)(ON + ((size_t)1 * T + t) * AOW + ch * 8), cq = *(const v4u*)(ON + ((size_t)2 * T + t) * AOW + ch * 8);
        v4u o;
        o.x = pk2(w0 * bflo(a.x) + w1 * bflo(bq.x) + w2 * bflo(cq.x), w0 * bfhi(a.x) + w1 * bfhi(bq.x) + w2 * bfhi(cq.x));
        o.y = pk2(w0 * bflo(a.y) + w1 * bflo(bq.y) + w2 * bflo(cq.y), w0 * bfhi(a.y) + w1 * bfhi(bq.y) + w2 * bfhi(cq.y));
        o.z = pk2(w0 * bflo(a.z) + w1 * bflo(bq.z) + w2 * bflo(cq.z), w0 * bfhi(a.z) + w1 * bfhi(bq.z) + w2 * bfhi(cq.z));
        o.w = pk2(w0 * bflo(a.w) + w1 * bflo(bq.w) + w2 * bflo(cq.w), w0 * bfhi(a.w) + w1 * bfhi(bq.w) + w2 * bfhi(cq.w));
        *(v4u*)(O + (size_t)t * AOW + ch * 8) = o;
    }
}

__global__ void __launch_bounds__(NTHREADS, 2) mk_fwd(Args args) {
    extern __shared__ __attribute__((aligned(16))) unsigned char lds[];
    Ctx C;
    C.tid = threadIdx.x; C.lane = C.tid & 63; C.wave = __builtin_amdgcn_readfirstlane(C.tid >> 6);
    C.bid = blockIdx.x; C.nb = gridDim.x; C.gw = C.bid * NWAVES + C.wave; C.ngw = C.nb * NWAVES; C.lds = lds;
    volatile LAS unsigned* MISC = (volatile LAS unsigned*)((LAS unsigned char*)lds + MISC_OFF);
    if (C.tid < 32) MISC[C.tid] = 0u;
    __syncthreads();
    unsigned* ctl = (unsigned*)(args.ws + WS_CTL);
    XcdBarrier bar; bar.bar = ctl + CW_BAR; bar.x = 0; bar.st = nullptr;
    const int lo = args.ph_lo, hi = args.ph_hi;
    if (hi - lo > 1) bar = xcd_barrier_post(ctl + CW_BAR, MISC + 8);
    bar.wave = C.wave;
#define IN(k) (lo <= (k) && (k) < hi)
#define SEAM(k) do { if (IN(k) && IN((k) + 1)) xcd_barrier(bar); } while (0)
    unsigned char* ws = args.ws;
    const float* mod = (const float*)(ws + WS_MOD);
#define REP(k) for (int rep_ = 0; rep_ < ((PROBE_DUP == (k)) ? 2 : 1); ++rep_)
#define FRESH_CTX() do { unsigned z_ = 0u; asm volatile("" : "+v"(z_)); C.lane = (int)__builtin_amdgcn_mbcnt_hi(~0u, __builtin_amdgcn_mbcnt_lo(~0u, z_)); C.tid = C.wave * 64 + C.lane; } while (0)
    if (IN(0)) { FRESH_CTX(); REP(0) phase_prologue(args, C); } SEAM(0);
    if (IN(1)) { FRESH_CTX(); REP(1) phase_norm_mod<true>(args.in[I_X], args.in[I_N1G], mod, 0, 1, (bf16*)(ws + WS_H), C); } SEAM(1);
    LAS unsigned char* ldsl = (LAS unsigned char*)lds;
    if (IN(2)) { FRESH_CTX(); REP(2) { pg8::Gemm g{(const bf16*)(ws + WS_H), (const bf16*)(ws + WS_WIN), T, IN_COLS, D / 2}; pg8::StaticOrder S; S.init(T, IN_COLS, C.nb, C.bid);
                 pg8::EpiIn E{(bf16*)(ws + WS_U), (bf16*)(ws + WS_QKV), (bf16*)(ws + WS_G), 0, 1.0f / WIN_SCALE};
                 pg8::gemm_phase<pg8::EpiIn, pg8::StaticOrder, false, true, true>(ldsl, g, S, E, C.wave); }
                 { constexpr int NT6 = (T / 256) * (IN_COLS / 256) % 256;
                   if (C.nb == 256 && NT6 > 0) { if (C.bid >= NT6) late_transposes(args, C, lds, (C.bid - NT6) * NWAVES + C.wave, (256 - NT6) * NWAVES); }
                   else late_transposes(args, C, lds, C.gw, C.ngw); } } SEAM(2);
    if (IN(3)) { FRESH_CTX(); REP(3) { phase_conv(args, C); phase_attn(args, C); } } SEAM(3);
    if (IN(4)) { FRESH_CTX(); phase_attn_combine(args, C);
                 pg8::Gemm g{(const bf16*)(ws + WS_UCV), (const bf16*)(ws + WS_WCO), T, D, CONV_CH}; pg8::StaticOrder S; S.init(T, D, C.nb, C.bid);
                 pg8::EpiYconv E{(const bf16*)(ws + WS_G), (bf16*)(ws + WS_MERGED), args.in[I_BCO]};
                 pg8::gemm_phase<pg8::EpiYconv, pg8::StaticOrder, true, true>(ldsl, g, S, E, C.wave); } SEAM(4);
    if (IN(5)) { FRESH_CTX(); REP(5) { pg8::Gemm g{(const bf16*)(ws + WS_O), (const bf16*)(ws + WS_WAO), T, D, AOW}; pg8::StaticOrder S; S.init(T, D, C.nb, C.bid);
                 pg8::EpiYattn E{(const bf16*)(ws + WS_G), (const bf16*)(ws + WS_MERGED), ws + WS_QP, MG_SCALE};
                 pg8::gemm_phase<pg8::EpiYattn, pg8::StaticOrder, true, true>(ldsl, g, S, E, C.wave); } } SEAM(5);
    if (IN(6)) { FRESH_CTX(); REP(6) { pg8::Gemm g{(const bf16*)(ws + WS_QP), (const bf16*)(ws + WS_WOUT), T, D, D / 2}; pg8::StaticOrder S; S.init(T, D, C.nb, C.bid);
                 pg8::EpiOut E{args.in[I_X], mod, args.out, 1.0f / (MG_SCALE * WIN_SCALE)};
                 pg8::gemm_phase<pg8::EpiOut, pg8::StaticOrder, true, true, true>(ldsl, g, S, E, C.wave); } } SEAM(6);
    if (IN(7)) { FRESH_CTX(); REP(7) phase_norm_mod<false>(args.out, args.in[I_N2G], mod, 3, 4, (bf16*)(ws + WS_H), C); } SEAM(7);
    if (IN(8)) { FRESH_CTX(); REP(8) { pg8::Gemm g{(const bf16*)(ws + WS_H), (const bf16*)(ws + WS_WQ), T, D, D}; pg8::StaticOrder S; S.init(T, D, C.nb, C.bid);
                 pg8::EpiPlain E{(bf16*)(ws + WS_QP), D};
                 pg8::gemm_phase<pg8::EpiPlain, pg8::StaticOrder, true, true>(ldsl, g, S, E, C.wave); } } SEAM(8);
    if (IN(9)) { FRESH_CTX(); REP(9) phase_topk(args, C); } SEAM(9);
    if (IN(10)) { FRESH_CTX(); for (int rep_ = (PROBE_DUP == 10) ? 0 : 1; rep_ < 2; ++rep_) phase_experts3(args, C, rep_ ? args.out : (float*)(ws + WS_MERGED), rep_ ? 0xFFFFFFFFu : PROBE_EMASK); }
#undef REP
#undef IN
#undef SEAM
}

extern "C" void kernel_launch(void* const* d_in, const int* in_sizes, int n_in, void* d_out, int out_size, void* d_ws, size_t ws_size, hipStream_t stream) {
    static int grid = 0;
    if (grid == 0) {
        if (n_in != 21 || in_sizes[0] != T * D || out_size != T * D || ws_size < WS_END) {
            fprintf(stderr, "kernel_launch: unexpected shapes: n_in %d in0 %d out %d ws %zu (need %zu)\n", n_in, n_in > 0 ? in_sizes[0] : -1, out_size, ws_size, (size_t)WS_END); grid = -1; return; }
        int dev = 0, cus = 0, per_cu = 0;
        if (hipGetDevice(&dev) != hipSuccess || hipDeviceGetAttribute(&cus, hipDeviceAttributeMultiprocessorCount, dev) != hipSuccess) { grid = -1; return; }
        if (hipFuncSetAttribute((const void*)mk_fwd, hipFuncAttributeMaxDynamicSharedMemorySize, LDS_BYTES) != hipSuccess) { fprintf(stderr, "kernel_launch: hipFuncSetAttribute failed\n"); grid = -1; return; }
        if (hipOccupancyMaxActiveBlocksPerMultiprocessor(&per_cu, (const void*)mk_fwd, NTHREADS, LDS_BYTES) != hipSuccess || per_cu < 1)
            fprintf(stderr, "kernel_launch: note: occupancy query reports %d\n", per_cu);
        (void)hipGetLastError();
        grid = cus;
    }
    if (grid < 0) return;
    (void)hipMemsetAsync((char*)d_ws + WS_CTL, 0, CTL_ZERO_BYTES, stream);
    Args a{};
    for (int i = 0; i < 21; ++i) a.in[i] = (const float*)d_in[i];
    a.out = (float*)d_out; a.ws = (unsigned char*)d_ws;
#if N_LAUNCH_MODE == 1
    a.ph_lo = 0; a.ph_hi = NPHASES;
    hipLaunchKernelGGL(mk_fwd, dim3(grid), dim3(NTHREADS), LDS_BYTES, stream, a);
#else
    for (int p = 0; p < NPHASES; ++p) { a.ph_lo = p; a.ph_hi = p + 1; hipLaunchKernelGGL(mk_fwd, dim3(grid), dim3(NTHREADS), LDS_BYTES, stream, a); }
#endif
}
```

```cpp
#include <hip/hip_runtime.h>
#include <cstdio>
#include <cstdint>
#include <cmath>

constexpr int BATCH = 2, SEQ = 4096, D = 2048, T = BATCH * SEQ;
constexpr int CONV_CH = 1024, CONV_K = 31;
constexpr int HD = 128, NHEADS = 12, AW = 1536, AOW = 512;
constexpr int OFF_Q = 2048, OFF_G = OFF_Q + 3 * AW, IN_COLS = OFF_G + 2 * D;
constexpr int QKVW = 3 * AW;
constexpr int PEER_H = 8, PEER_NK = 128, PEER_TOPK = 16, PEER_HK = PEER_H * PEER_TOPK;
constexpr int PEER_E = PEER_NK * PEER_NK;
constexpr int MODW = 6 * D;
constexpr float EPS = 1e-6f;
constexpr int NWAVES = 8, NTHREADS = NWAVES * 64;
#ifndef N_LAUNCH_MODE
#define N_LAUNCH_MODE 1
#endif
constexpr int NPHASES = 11;
#ifndef PROBE_EMASK
#define PROBE_EMASK 0xFFFFFFFFu
#endif
#ifndef PROBE_DUP
#define PROBE_DUP (-1)
#endif
#ifndef MFMA_MASK
#define MFMA_MASK 31
#endif
#ifndef P2_SPLIT
#define P2_SPLIT 0
#endif

constexpr size_t MiB = 1u << 20;
constexpr size_t WS_CTL = 0, CTL_ZERO_BYTES = 64 * 1024;
constexpr size_t WS_MOD = 1 * MiB;
constexpr size_t WS_SK = 1 * MiB + 512 * 1024;
constexpr size_t WS_WIN = 2 * MiB;
constexpr size_t WS_WCO = 44 * MiB;
constexpr size_t WS_WAO = 48 * MiB;
constexpr size_t WS_WOUT = 50 * MiB;
constexpr size_t WS_WQ = 58 * MiB;
constexpr size_t WS_WUP = 66 * MiB;
constexpr size_t WS_WDN = 130 * MiB;
constexpr size_t WS_SUP = 98 * MiB, WS_SDN = 98 * MiB + 65536;
constexpr size_t WS_H = 194 * MiB;
constexpr size_t WS_U = 226 * MiB;
constexpr size_t WS_QKV = 242 * MiB;
constexpr size_t WS_G = 314 * MiB;
constexpr size_t WS_UCV = 378 * MiB;
constexpr size_t WS_ON = 394 * MiB;
constexpr size_t WS_DEN = 418 * MiB;
constexpr size_t WS_O = 419 * MiB;
constexpr size_t WS_MERGED = 427 * MiB;
constexpr size_t WS_QP = 459 * MiB;
constexpr size_t WS_IDX = 491 * MiB;
constexpr size_t WS_GW = 495 * MiB;
constexpr size_t WS_END = 500 * MiB;
constexpr int CW_BAR = 4096;
constexpr int TK_W = 4;
constexpr int UP_TAIL_ROWS = 4096;
constexpr float MG_SCALE = 16.0f;
constexpr float WIN_SCALE = 256.0f;

constexpr int LDS_BYTES = 147456 + 512;
constexpr int RING_BYTES = 131072, MISC_OFF = 147456 + 64;

#define GAS __attribute__((address_space(1)))
#define LAS __attribute__((address_space(3)))
typedef unsigned short bf16;
typedef unsigned v4u __attribute__((ext_vector_type(4)));
typedef unsigned v2u __attribute__((ext_vector_type(2)));
typedef float f32x4 __attribute__((ext_vector_type(4)));
#define RLX_AGENT __ATOMIC_RELAXED, __HIP_MEMORY_SCOPE_AGENT

__device__ __forceinline__ unsigned f2bf(float f) { unsigned u = __builtin_bit_cast(unsigned, f); return (u + 0x7fffu + ((u >> 16) & 1u)) >> 16; }
__device__ __forceinline__ unsigned pk2(float lo, float hi) { return f2bf(lo) | (f2bf(hi) << 16); }
__device__ __forceinline__ float bf2f(unsigned b) { return __builtin_bit_cast(float, b << 16); }
__device__ __forceinline__ float bflo(unsigned w) { return __builtin_bit_cast(float, w << 16); }
__device__ __forceinline__ float bfhi(unsigned w) { return __builtin_bit_cast(float, w & 0xffff0000u); }
__device__ __forceinline__ float wave_sum(float v) {
#pragma unroll
    for (int o = 1; o < 64; o <<= 1) v += __shfl_xor(v, o);
    return v;
}
__device__ __forceinline__ float sigmoidf_(float x) { return 1.0f / (1.0f + __expf(-x)); }
__device__ __forceinline__ float siluf_(float x) { return x / (1.0f + __expf(-x)); }
__device__ __forceinline__ float gelu_erf(float x) { return 0.5f * x * (1.0f + erff(x * 0.70710678118654752f)); }

__device__ __forceinline__ int lane_id() { return (int)__builtin_amdgcn_mbcnt_hi(~0u, __builtin_amdgcn_mbcnt_lo(~0u, 0u)); }
#define XB_TMO      128
#define XB_XCNT(j)  (256  + 64 * (j))
#define XB_XSUB(j)  (1280 + 64 * (j))
#define XB_XGEN(j)  (2304 + 64 * (j))
#define XB_TOP      3328
#define XB_TOPGEN   3392
#define XCD_BAR_WORDS 3456
#define XB_SPIN_CAP (1u << 22)
__device__ __forceinline__ unsigned xb_ld(unsigned* p)              { return __hip_atomic_load(p, __ATOMIC_RELAXED, __HIP_MEMORY_SCOPE_AGENT); }
__device__ __forceinline__ unsigned xb_add(unsigned* p, unsigned v) { return __hip_atomic_fetch_add(p, v, __ATOMIC_RELAXED, __HIP_MEMORY_SCOPE_AGENT); }
__device__ __forceinline__ unsigned xb_xcc_id() { return (unsigned)__builtin_amdgcn_s_getreg((3 << 11) | 20) & 0xFu; }
#define XB_SPIN(cond, bar) do { unsigned _sp = 0; while (cond) { __builtin_amdgcn_s_sleep(1); \
    if ((++_sp & 255u) == 0u) { if (xb_ld(&(bar)[XB_TMO])) break; if (_sp > XB_SPIN_CAP) { atomicAdd(&(bar)[XB_TMO], 1u); break; } } } } while (0)
struct XcdBarrier { unsigned* bar; unsigned x; volatile LAS unsigned* st; int wave; };
__device__ __forceinline__ XcdBarrier xcd_barrier_post(unsigned* bar, volatile LAS unsigned* st) {
    XcdBarrier b; b.bar = bar; b.x = xb_xcc_id(); b.st = st; b.wave = 0;
    if (threadIdx.x == 0) (void)xb_add(&bar[XB_XCNT(b.x)], 1u);
    return b;
}
__device__ __forceinline__ void xcd_barrier_complete(unsigned* bar, unsigned x, unsigned& nloc, unsigned& nx) {
    const unsigned G = gridDim.x * gridDim.y * gridDim.z;
    unsigned sum, cnt, mine, sp = 0u;
    for (;;) {
        sum = 0u; cnt = 0u; mine = 0u;
#pragma unroll
        for (unsigned j = 0; j < 16; ++j) { const unsigned c = xb_ld(&bar[XB_XCNT(j)]); sum += c; cnt += (c > 0u) ? 1u : 0u; mine = (j == x) ? c : mine; }
        if (sum == G) break;
        __builtin_amdgcn_s_sleep(1);
        if ((++sp & 255u) == 0u) { if (xb_ld(&bar[XB_TMO])) break; if (sp > XB_SPIN_CAP) { atomicAdd(&bar[XB_TMO], 1u); break; } }
    }
    nloc = mine > 0u ? mine : 1u; nx = cnt > 0u ? cnt : 1u;
}
__device__ __forceinline__ void xcd_barrier(const XcdBarrier& b) {
    asm volatile("s_waitcnt vmcnt(0)" ::: "memory");
    __syncthreads();
    if (b.wave == 0 && lane_id() == 0) {
        unsigned* bar = b.bar;
        __builtin_amdgcn_s_waitcnt(0);
        unsigned nloc = b.st[0], nx = b.st[1];
        if (nloc == 0u) { xcd_barrier_complete(bar, b.x, nloc, nx); b.st[0] = nloc; b.st[1] = nx; }
        const unsigned old = xb_add(&bar[XB_XSUB(b.x)], 1u);
        const unsigned gen = old / nloc;
        if (old + 1u == (gen + 1u) * nloc) {
            __builtin_amdgcn_fence(__ATOMIC_RELEASE, "agent");
            asm volatile("s_waitcnt vmcnt(0)" ::: "memory");
            const unsigned og = xb_add(&bar[XB_TOP], 1u);
            const unsigned tg = og / nx;
            if (og + 1u == (tg + 1u) * nx) xb_add(&bar[XB_TOPGEN], 1u);
            else XB_SPIN(xb_ld(&bar[XB_TOPGEN]) == tg, bar);
            __builtin_amdgcn_fence(__ATOMIC_ACQUIRE, "agent");
            xb_add(&bar[XB_XGEN(b.x)], 1u);
            asm volatile("s_waitcnt vmcnt(0)" ::: "memory");
        } else {
            XB_SPIN(xb_ld(&bar[XB_XGEN(b.x)]) == gen, bar);
            __builtin_amdgcn_fence(__ATOMIC_ACQUIRE, "agent");
            asm volatile("s_waitcnt vmcnt(0)" ::: "memory");
        }
    }
    __syncthreads();
}

namespace pg8 {
#define PG8_LAS __attribute__((address_space(3)))
typedef unsigned short bf16_t;
typedef short bf16x8 __attribute__((ext_vector_type(8)));
typedef float f32x4 __attribute__((ext_vector_type(4)));
typedef unsigned u32x4 __attribute__((ext_vector_type(4)));
constexpr int BM = 256, BK = 64, HALF = 128, HTB = HALF * BK * 2  , STAGE_BYTES = 8 * HTB, NXCD = 8, WGM = 16;

__host__ __device__ __forceinline__ int lds_byte(int r, int c) { const int st = (r >> 4) * 2 + (c >> 5), rr = r & 15, cc = c & 31, ob = rr * 64 + cc * 2; return st * 1024 + (ob ^ (((ob >> 9) & 1) << 5)); }
__host__ __device__ __forceinline__ void stage_rc(int b, int& R, int& C) { const int st = b / 1024, sb = b % 1024, swz = sb ^ (((sb >> 9) & 1) << 5); R = (st >> 1) * 16 + swz / 64; C = (st & 1) * 32 + (swz % 64) / 2; }
__host__ __device__ __forceinline__ int perm32(int rho) { const int n = rho >> 4, i = rho & 15; return 8 * (i >> 2) + 4 * n + (i & 3); }

struct Unit { int pm, pn; };
struct Gemm { const bf16_t* A; const bf16_t* Bt; int M, N, K; };

struct StaticOrder {
    int nM, nN, nwg, G, c;
    __host__ __device__ void init(int M, int N, int G_, int c_) { nM = M / BM; nN = N / BM; nwg = nM * nN; G = G_; c = c_; }
    __host__ __device__ bool next(int i, Unit& u) const {
        const long L = (long)i * G + c; if (L >= nwg) return false;
        int wgid = (int)L; { const int q = nwg / NXCD, r = nwg % NXCD, xcd = wgid % NXCD, off = wgid / NXCD; wgid = (xcd < r ? xcd * (q + 1) : r * (q + 1) + (xcd - r) * q) + off; }
        const int nig = WGM * nN, gid = wgid / nig, fm = gid * WGM, gsz = (nM - fm) < WGM ? (nM - fm) : WGM;
        u.pm = fm + ((wgid % nig) % gsz); u.pn = (wgid % nig) / gsz; return true;
    }
    __device__ __forceinline__ void a_ready(const Unit&) const {}
    __device__ __forceinline__ void done(const Unit&) const {}
};

typedef float f32x2_t __attribute__((ext_vector_type(2))); typedef __bf16 bf16x2_t __attribute__((ext_vector_type(2)));
__device__ __forceinline__ unsigned cvt_pk_bf16(float lo, float hi) { f32x2_t v = {lo, hi}; bf16x2_t b = __builtin_convertvector(v, bf16x2_t); return __builtin_bit_cast(unsigned, b); }
typedef float f32x2 __attribute__((ext_vector_type(2)));
typedef int v8i_t __attribute__((ext_vector_type(8)));
struct Frag32 { bf16x8 lo, hi; };
template <class Epi, class Sched, bool ALIGN_EPI = false, bool SP2 = false, bool FP8 = false>
__device__ __forceinline__ void gemm_phase(PG8_LAS unsigned char* lds, const Gemm g, const Sched& S, const Epi& E, int wave_idx) {
    const int wid = wave_idx, lane = lane_id(), tid = wid * 64 + lane, wr = wid >> 2, wc = wid & 3, fr = lane & 15, fq = lane >> 4;
    const int K = g.K, nt = K / BK;
    unsigned voffA[2], voffB[2];
#pragma unroll
    for (int i = 0; i < 2; ++i) { int R, C; stage_rc(tid * 16 + i * 8192, R, C); const int Rb = Epi::PERM ? ((R & ~31) + perm32(R & 31)) : R;
        voffA[i] = (unsigned)(R * K + C) * 2u; voffB[i] = (unsigned)(Rb * K + C) * 2u; }
    const size_t kstep = (size_t)(BK * 2);
    const size_t hstep = (size_t)HALF * K * 2;
    const size_t tstep = 2 * hstep;
    const unsigned ldsw = (unsigned)wid * 1024u;
    const int aoff = lds_byte(wr * 64 + fr, fq * 8), boff = lds_byte(wc * 32 + fr, fq * 8);
#define PG8_SA(b, h) (((b) * 2 + (h)) * HTB)
#define PG8_SB(b, h) ((4 + (b) * 2 + (h)) * HTB)
#define PG8_STAGE(bufoff, gbase, voff) do { _Pragma("unroll") for (int _i = 0; _i < 2; ++_i) { unsigned vo_ = (voff)[_i]; asm volatile("" : "+v"(vo_));     \
        __builtin_amdgcn_global_load_lds((const unsigned*)((const char*)(gbase) + vo_), (PG8_LAS unsigned*)(lds + (bufoff) + ldsw + _i * 8192), 16, 0, 0); } } while (0)
#define PG8_LDA(dst, b, h) do { _Pragma("unroll") for (int m = 0; m < 4; ++m) { const bf16x8 lo_ = *(const PG8_LAS bf16x8*)(lds + PG8_SA(b, h) + aoff + m * 2048), hi_ = *(const PG8_LAS bf16x8*)(lds + PG8_SA(b, h) + aoff + m * 2048 + 1024); dst[m] = __builtin_bit_cast(v8i_t, (Frag32){lo_, hi_}); } } while (0)
#define PG8_LDB(dst, b, h) do { _Pragma("unroll") for (int n = 0; n < 2; ++n) { const bf16x8 lo_ = *(const PG8_LAS bf16x8*)(lds + PG8_SB(b, h) + boff + n * 2048), hi_ = *(const PG8_LAS bf16x8*)(lds + PG8_SB(b, h) + boff + n * 2048 + 1024); dst[n] = __builtin_bit_cast(v8i_t, (Frag32){lo_, hi_}); } } while (0)
#define PG8_MMA(ai, bj, At, Bt) do { __builtin_amdgcn_s_setprio(1); \
        if constexpr (FP8) { _Pragma("unroll") for (int m = 0; m < 4; ++m) _Pragma("unroll") for (int n = 0; n < 2; ++n) \
            acc[ai][bj][m][n] = __builtin_amdgcn_mfma_scale_f32_16x16x128_f8f6f4(Bt[n], At[m], acc[ai][bj][m][n], 0, 0, 0, 0x7F7F7F7F, 0, 0x7F7F7F7F); } \
        else { _Pragma("unroll") for (int m = 0; m < 4; ++m) _Pragma("unroll") for (int n = 0; n < 2; ++n) { const Frag32 fa_ = __builtin_bit_cast(Frag32, At[m]), fb_ = __builtin_bit_cast(Frag32, Bt[n]); \
            acc[ai][bj][m][n] = __builtin_amdgcn_mfma_f32_16x16x32_bf16(fb_.lo, fa_.lo, acc[ai][bj][m][n], 0, 0, 0); acc[ai][bj][m][n] = __builtin_amdgcn_mfma_f32_16x16x32_bf16(fb_.hi, fa_.hi, acc[ai][bj][m][n], 0, 0, 0); } } \
        __builtin_amdgcn_s_setprio(0); } while (0)
#define PG8_WAIT_V(n) asm volatile("s_waitcnt vmcnt(" #n ")" ::: "memory")
#define PG8_WAIT_L(n) asm volatile("s_waitcnt lgkmcnt(" #n ")" ::: "memory")
#define PG8_BAR __builtin_amdgcn_s_barrier()
#define PG8_SCHED __builtin_amdgcn_sched_barrier(0)
    Unit cur, nxt; int ui = 0;
    if (!S.next(0, cur)) return;
    f32x4 acc[2][2][4][2];
#pragma unroll
    for (int a = 0; a < 2; ++a)
#pragma unroll
        for (int b = 0; b < 2; ++b)
#pragma unroll
            for (int m = 0; m < 4; ++m)
#pragma unroll
                for (int n = 0; n < 2; ++n) acc[a][b][m][n] = (f32x4){0.f, 0.f, 0.f, 0.f};
    v8i_t At[4], B0[2], B1[2];
    const char* cA = (const char*)g.A + (size_t)cur.pm * tstep; const char* cB = (const char*)g.Bt + (size_t)cur.pn * tstep;
    S.a_ready(cur);
    if constexpr (SP2) {
        PG8_STAGE(PG8_SB(0, 0), cB, voffB); PG8_STAGE(PG8_SB(0, 1), cB + hstep, voffB); PG8_STAGE(PG8_SA(0, 0), cA, voffA); PG8_STAGE(PG8_SA(0, 1), cA + hstep, voffA);
        if (wr == 1) PG8_BAR;
        PG8_WAIT_V(2); PG8_BAR;
        PG8_STAGE(PG8_SB(1, 0), cB + kstep, voffB); PG8_STAGE(PG8_SA(1, 0), cA + kstep, voffA); PG8_STAGE(PG8_SB(1, 1), cB + hstep + kstep, voffB);
        PG8_WAIT_V(6); PG8_BAR;
    } else {
        PG8_STAGE(PG8_SB(0, 0), cB, voffB); PG8_STAGE(PG8_SA(0, 0), cA, voffA); PG8_STAGE(PG8_SB(0, 1), cB + hstep, voffB); PG8_STAGE(PG8_SA(0, 1), cA + hstep, voffA);
        if (wr == 1) PG8_BAR;
        PG8_WAIT_V(4); PG8_BAR;
        PG8_STAGE(PG8_SB(1, 0), cB + kstep, voffB); PG8_STAGE(PG8_SA(1, 0), cA + kstep, voffA); PG8_STAGE(PG8_SB(1, 1), cB + hstep + kstep, voffB);
        PG8_WAIT_V(6); PG8_BAR;
    }
    for (;;) {
        const bool has_next = S.next(ui + 1, nxt);
        const char* nA = has_next ? (const char*)g.A + (size_t)nxt.pm * tstep : cA; const char* nB = has_next ? (const char*)g.Bt + (size_t)nxt.pn * tstep : cB;
        for (int t = 0; t < nt; t += 2) {
            const bool last = (t == nt - 2);
            const char* a1 = cA + (size_t)(t + 1) * kstep;
            const char* a2 = last ? nA : cA + (size_t)(t + 2) * kstep; const char* b2 = last ? nB : cB + (size_t)(t + 2) * kstep;
            const char* a3 = a2 + kstep; const char* b3 = b2 + kstep;
            if (last && has_next) S.a_ready(nxt);
            if constexpr (SP2) {
            PG8_LDB(B0, 0, 0); PG8_LDB(B1, 0, 1); PG8_SCHED; PG8_LDA(At, 0, 0); PG8_STAGE(PG8_SA(1, 1), a1 + hstep, voffA);
            PG8_WAIT_V(8); PG8_WAIT_L(0); PG8_BAR; PG8_MMA(0, 0, At, B0); PG8_MMA(0, 1, At, B1); PG8_BAR; PG8_SCHED;
            PG8_LDA(At, 0, 1); PG8_STAGE(PG8_SB(0, 0), b2, voffB); PG8_STAGE(PG8_SB(0, 1), b2 + hstep, voffB); PG8_STAGE(PG8_SA(0, 0), a2, voffA);
            PG8_WAIT_V(8); PG8_WAIT_L(0); PG8_BAR; PG8_MMA(1, 0, At, B0); PG8_MMA(1, 1, At, B1); PG8_BAR; PG8_SCHED;
            PG8_LDB(B0, 1, 0); PG8_LDB(B1, 1, 1); PG8_SCHED; PG8_LDA(At, 1, 0); PG8_STAGE(PG8_SA(0, 1), a2 + hstep, voffA);
            PG8_WAIT_V(8); PG8_WAIT_L(0); PG8_BAR; PG8_MMA(0, 0, At, B0); PG8_MMA(0, 1, At, B1); PG8_BAR; PG8_SCHED;
            PG8_LDA(At, 1, 1); PG8_STAGE(PG8_SB(1, 0), b3, voffB); PG8_STAGE(PG8_SB(1, 1), b3 + hstep, voffB); PG8_STAGE(PG8_SA(1, 0), a3, voffA);
            PG8_WAIT_V(8); PG8_WAIT_L(0); PG8_BAR; PG8_MMA(1, 0, At, B0); PG8_MMA(1, 1, At, B1); PG8_BAR; PG8_SCHED;
            } else {
            PG8_LDB(B0, 0, 0); PG8_SCHED; PG8_LDA(At, 0, 0); PG8_STAGE(PG8_SA(1, 1), a1 + hstep, voffA);
            PG8_WAIT_L(8); PG8_BAR; PG8_WAIT_L(0); PG8_MMA(0, 0, At, B0); PG8_BAR; PG8_SCHED;
            PG8_LDB(B1, 0, 1); PG8_STAGE(PG8_SB(0, 0), b2, voffB);
            PG8_BAR; PG8_WAIT_L(0); PG8_MMA(0, 1, At, B1); PG8_BAR;
            PG8_LDA(At, 0, 1); PG8_STAGE(PG8_SA(0, 0), a2, voffA);
            PG8_BAR; PG8_WAIT_L(0); PG8_MMA(1, 0, At, B0); PG8_BAR; PG8_SCHED;
            PG8_STAGE(PG8_SB(0, 1), b2 + hstep, voffB);
            PG8_WAIT_V(6); PG8_BAR; PG8_MMA(1, 1, At, B1); PG8_BAR;
            PG8_LDB(B0, 1, 0); PG8_SCHED; PG8_LDA(At, 1, 0); PG8_STAGE(PG8_SA(0, 1), a2 + hstep, voffA);
            PG8_WAIT_L(8); PG8_BAR; PG8_WAIT_L(0); PG8_MMA(0, 0, At, B0); PG8_BAR; PG8_SCHED;
            PG8_LDB(B1, 1, 1); PG8_STAGE(PG8_SB(1, 0), b3, voffB);
            PG8_BAR; PG8_WAIT_L(0); PG8_MMA(0, 1, At, B1); PG8_BAR;
            PG8_LDA(At, 1, 1); PG8_STAGE(PG8_SA(1, 0), a3, voffA);
            PG8_BAR; PG8_WAIT_L(0); PG8_MMA(1, 0, At, B0); PG8_BAR; PG8_SCHED;
            PG8_STAGE(PG8_SB(1, 1), b3 + hstep, voffB);
            PG8_WAIT_V(6); PG8_BAR; PG8_MMA(1, 1, At, B1); PG8_BAR;
            }
        }
        if constexpr (ALIGN_EPI) { if (wr == 0) PG8_BAR; }
        if constexpr (!Epi::AFTER_DRAIN) { int l2_ = lane_id(); asm volatile("" : "+v"(l2_)); E(acc, cur, wr, wc, l2_ & 15, l2_ >> 4); S.done(cur); }
        if (!has_next) break;
#pragma unroll
        for (int a = 0; a < 2; ++a)
#pragma unroll
            for (int b = 0; b < 2; ++b)
#pragma unroll
                for (int m = 0; m < 4; ++m)
#pragma unroll
                    for (int n = 0; n < 2; ++n) acc[a][b][m][n] = (f32x4){0.f, 0.f, 0.f, 0.f};
        cur = nxt; cA = nA; cB = nB; ++ui;
        if constexpr (ALIGN_EPI) { if (wr == 1) PG8_BAR; }
    }
    PG8_WAIT_V(0);
    if constexpr (!ALIGN_EPI) { if (wr == 0) PG8_BAR; }
    PG8_BAR;
    if constexpr (Epi::AFTER_DRAIN) { E.fused(acc, cur, wr, wc, fr, fq, lds, wid, lane); S.done(cur); }
#undef PG8_SA
#undef PG8_SB
#undef PG8_STAGE
#undef PG8_LDA
#undef PG8_LDB
#undef PG8_MMA
#undef PG8_WAIT_V
#undef PG8_WAIT_L
#undef PG8_BAR
#undef PG8_SCHED
}
}

namespace pg8 {
__device__ __forceinline__ float fsig(float x) { return __builtin_amdgcn_rcpf(1.0f + __expf(-x)); }
__device__ __forceinline__ u32x4 pack8(const f32x4& v0, const f32x4& v1) { u32x4 w; w.x = cvt_pk_bf16(v0[0], v0[1]); w.y = cvt_pk_bf16(v0[2], v0[3]); w.z = cvt_pk_bf16(v1[0], v1[1]); w.w = cvt_pk_bf16(v1[2], v1[3]); return w; }
__device__ __forceinline__ float blo(unsigned w) { return __builtin_bit_cast(float, w << 16); }
__device__ __forceinline__ float bhi(unsigned w) { return __builtin_bit_cast(float, w & 0xffff0000u); }
struct EpiIn {
    static constexpr bool PERM = true, AFTER_DRAIN = false;
    bf16_t *U, *QKV, *G; int pn0; float osc;
    __device__ __forceinline__ void operator()(const f32x4 (&acc)[2][2][4][2], const Unit& u0, int wr, int wc, int fr, int fq) const {
        Unit u; u.pm = u0.pm; u.pn = u0.pn + pn0;
        const int row0 = u.pm * BM + wr * 64 + fr, cw = wc * 32 + 8 * fq;
        if (u.pn < 8) {
#pragma unroll
            for (int ai = 0; ai < 2; ++ai)
#pragma unroll
                for (int m = 0; m < 4; ++m) { const size_t row = row0 + ai * HALF + m * 16;
                    f32x4 v0 = acc[ai][0][m][0] * osc, v1 = acc[ai][0][m][1] * osc; const f32x4 g0 = acc[ai][1][m][0] * osc, g1 = acc[ai][1][m][1] * osc;
#pragma unroll
                    for (int e = 0; e < 4; ++e) { v0[e] *= fsig(g0[e]); v1[e] *= fsig(g1[e]); }
                    *(u32x4*)(U + row * 1024 + 128 * u.pn + cw) = pack8(v0, v1); }
        } else if (u.pn < 26) {
#pragma unroll
            for (int ai = 0; ai < 2; ++ai)
#pragma unroll
                for (int m = 0; m < 4; ++m) { const size_t row = row0 + ai * HALF + m * 16;
#pragma unroll
                    for (int bj = 0; bj < 2; ++bj) *(u32x4*)(QKV + row * 4608 + (u.pn - 8) * 256 + bj * HALF + cw) = pack8(acc[ai][bj][m][0] * osc, acc[ai][bj][m][1] * osc); }
        } else {
#pragma unroll
            for (int ai = 0; ai < 2; ++ai)
#pragma unroll
                for (int m = 0; m < 4; ++m) { const size_t row = row0 + ai * HALF + m * 16;
#pragma unroll
                    for (int bj = 0; bj < 2; ++bj) { f32x4 v0 = acc[ai][bj][m][0] * osc, v1 = acc[ai][bj][m][1] * osc;
#pragma unroll
                        for (int e = 0; e < 4; ++e) { v0[e] = fsig(v0[e]); v1[e] = fsig(v1[e]); }
                        int p0 = __builtin_amdgcn_cvt_pk_fp8_f32(v0[0], v0[1], 0, false); p0 = __builtin_amdgcn_cvt_pk_fp8_f32(v0[2], v0[3], p0, true);
                        int p1 = __builtin_amdgcn_cvt_pk_fp8_f32(v1[0], v1[1], 0, false); p1 = __builtin_amdgcn_cvt_pk_fp8_f32(v1[2], v1[3], p1, true);
                        typedef unsigned u32x2g_ __attribute__((ext_vector_type(2)));
                        *(u32x2g_*)((unsigned char*)G + row * 4096 + (u.pn - 26) * 256 + bj * HALF + cw) = (u32x2g_){(unsigned)p0, (unsigned)p1}; } }
        }
    }
};
__device__ __forceinline__ void ld_gate8(const bf16_t* G, size_t byteoff, float (&g)[8]) {
    typedef unsigned u32x2h_ __attribute__((ext_vector_type(2))); typedef float f2h_ __attribute__((ext_vector_type(2)));
    const u32x2h_ w = *(const u32x2h_*)((const unsigned char*)G + byteoff);
    const f2h_ a = __builtin_amdgcn_cvt_pk_f32_fp8((int)w.x, false), b = __builtin_amdgcn_cvt_pk_f32_fp8((int)w.x, true), c = __builtin_amdgcn_cvt_pk_f32_fp8((int)w.y, false), d = __builtin_amdgcn_cvt_pk_f32_fp8((int)w.y, true);
    g[0] = a.x; g[1] = a.y; g[2] = b.x; g[3] = b.y; g[4] = c.x; g[5] = c.y; g[6] = d.x; g[7] = d.y;
}
struct EpiYconv {
    static constexpr bool PERM = true, AFTER_DRAIN = false;
    const bf16_t* G; bf16_t* MG; const float* bias;
    __device__ __forceinline__ void operator()(const f32x4 (&acc)[2][2][4][2], const Unit& u, int wr, int wc, int fr, int fq) const {
        const int row0 = u.pm * BM + wr * 64 + fr, cw = wc * 32 + 8 * fq;
#pragma unroll
        for (int bj = 0; bj < 2; ++bj) { const int col = u.pn * 256 + bj * HALF + cw; const f32x4 b0 = *(const f32x4*)(bias + col), b1 = *(const f32x4*)(bias + col + 4);
#pragma unroll
            for (int ai = 0; ai < 2; ++ai)
#pragma unroll
                for (int m = 0; m < 4; ++m) { const size_t row = row0 + ai * HALF + m * 16;
                    float g[8]; ld_gate8(G, row * 4096 + col, g);
                    f32x4 v0 = acc[ai][bj][m][0] + b0, v1 = acc[ai][bj][m][1] + b1;
                    v0[0] *= g[0]; v0[1] *= g[1]; v0[2] *= g[2]; v0[3] *= g[3]; v1[0] *= g[4]; v1[1] *= g[5]; v1[2] *= g[6]; v1[3] *= g[7];
                    *(u32x4*)(MG + row * 2048 + col) = pack8(v0, v1); } }
    }
};
struct EpiYattn {
    static constexpr bool PERM = true, AFTER_DRAIN = false;
    const bf16_t* G; const bf16_t* MG; unsigned char* MG8; float msc;
    __device__ __forceinline__ void operator()(const f32x4 (&acc)[2][2][4][2], const Unit& u, int wr, int wc, int fr, int fq) const {
        const int row0 = u.pm * BM + wr * 64 + fr, cw = wc * 32 + 8 * fq;
#pragma unroll
        for (int ai = 0; ai < 2; ++ai)
#pragma unroll
            for (int m = 0; m < 4; ++m) { const size_t row = row0 + ai * HALF + m * 16;
#pragma unroll
                for (int bj = 0; bj < 2; ++bj) { const int col = u.pn * 256 + bj * HALF + cw; float g[8]; ld_gate8(G, row * 4096 + 2048 + col, g); const u32x4 p = *(const u32x4*)(MG + row * 2048 + col);
                    f32x4 v0 = acc[ai][bj][m][0], v1 = acc[ai][bj][m][1];
                    v0[0] = (blo(p.x) + v0[0] * g[0]) * msc; v0[1] = (bhi(p.x) + v0[1] * g[1]) * msc; v0[2] = (blo(p.y) + v0[2] * g[2]) * msc; v0[3] = (bhi(p.y) + v0[3] * g[3]) * msc;
                    v1[0] = (blo(p.z) + v1[0] * g[4]) * msc; v1[1] = (bhi(p.z) + v1[1] * g[5]) * msc; v1[2] = (blo(p.w) + v1[2] * g[6]) * msc; v1[3] = (bhi(p.w) + v1[3] * g[7]) * msc;
                    int p0 = __builtin_amdgcn_cvt_pk_fp8_f32(v0[0], v0[1], 0, false); p0 = __builtin_amdgcn_cvt_pk_fp8_f32(v0[2], v0[3], p0, true);
                    int p1 = __builtin_amdgcn_cvt_pk_fp8_f32(v1[0], v1[1], 0, false); p1 = __builtin_amdgcn_cvt_pk_fp8_f32(v1[2], v1[3], p1, true);
                    typedef unsigned u32x2_ __attribute__((ext_vector_type(2))); *(u32x2_*)(MG8 + row * 2048 + col) = (u32x2_){(unsigned)p0, (unsigned)p1}; } }
    }
};
struct EpiOut {
    static constexpr bool PERM = false, AFTER_DRAIN = false;
    const float* x; const float* mod; float* out; float osc;
    __device__ __forceinline__ void operator()(const f32x4 (&acc)[2][2][4][2], const Unit& u, int wr, int wc, int fr, int fq) const {
        const int row0 = u.pm * BM + wr * 64 + fr, col0 = u.pn * BM + wc * 32 + 4 * fq; const int b = (u.pm * BM) / 4096;
#pragma unroll
        for (int bj = 0; bj < 2; ++bj)
#pragma unroll
            for (int n = 0; n < 2; ++n) { const int col = col0 + bj * HALF + n * 16; const f32x4 gt = *(const f32x4*)(mod + b * 12288 + 2 * 2048 + col) * osc;
#pragma unroll
                for (int ai = 0; ai < 2; ++ai)
#pragma unroll
                    for (int m = 0; m < 4; ++m) { const size_t off = (size_t)(row0 + ai * HALF + m * 16) * 2048 + col;
                        *(f32x4*)(out + off) = *(const f32x4*)(x + off) + gt * acc[ai][bj][m][n]; } }
    }
};
struct EpiPlain {
    static constexpr bool PERM = true, AFTER_DRAIN = false;
    bf16_t* O; int ldc;
    __device__ __forceinline__ void operator()(const f32x4 (&acc)[2][2][4][2], const Unit& u, int wr, int wc, int fr, int fq) const {
        const int row0 = u.pm * BM + wr * 64 + fr, cw = u.pn * BM + wc * 32 + 8 * fq;
#pragma unroll
        for (int ai = 0; ai < 2; ++ai)
#pragma unroll
            for (int m = 0; m < 4; ++m) { const size_t row = row0 + ai * HALF + m * 16;
#pragma unroll
                for (int bj = 0; bj < 2; ++bj) *(u32x4*)(O + row * ldc + bj * HALF + cw) = pack8(acc[ai][bj][m][0], acc[ai][bj][m][1]); }
    }
};
}

struct Args { const float* in[21]; float* out; unsigned char* ws; int ph_lo, ph_hi; };
enum { I_X = 0, I_C, I_N1G, I_N2G, I_WADA, I_BADA, I_WIN, I_CDW, I_CDB, I_CLNG, I_CLNB, I_WCO, I_BCO, I_QNG, I_KNG, I_WAO, I_WOUT, I_PWQ, I_PSK, I_PWUP, I_PWDN };

struct Ctx {
    int tid, lane, wave, bid, nb, gw, ngw;
    unsigned char* lds;
};

__device__ __forceinline__ int win_row(int n) {
    if (n < 1024) return (n >> 7) * 256 + (n & 127);
    if (n < 2048) { const int m = n - 1024; return (m >> 7) * 256 + 128 + (m & 127); }
    return n;
}
__device__ __forceinline__ void p0_transpose_item(const float* W, int K, int N, bf16* WT, bool perm, float* scr, int item, int lane) {
    const int nblk = N / 32, kb = item / nblk, nbi = item % nblk, k0 = 64 * kb, n0 = 32 * nbi;
#pragma unroll 8
    for (int i = 0; i < 32; ++i) { const int kk = 2 * i + (lane >> 5); scr[kk * 33 + (lane & 31)] = W[(size_t)(k0 + kk) * N + n0 + (lane & 31)]; }
    asm volatile("s_waitcnt lgkmcnt(0)" ::: "memory");
    const int c = lane & 7;
    const int r0 = perm ? win_row(n0) : n0;
#pragma unroll
    for (int j = 0; j < 4; ++j) { const int n = (lane >> 3) + 8 * j; const float* s = scr + (8 * c) * 33 + n;
        v4u o; o.x = pk2(s[0 * 33], s[1 * 33]); o.y = pk2(s[2 * 33], s[3 * 33]); o.z = pk2(s[4 * 33], s[5 * 33]); o.w = pk2(s[6 * 33], s[7 * 33]);
        *(v4u*)(WT + (size_t)(r0 + n) * K + k0 + 8 * c) = o; }
    asm volatile("s_waitcnt lgkmcnt(0)" ::: "memory");
}

__device__ __forceinline__ void p0_transpose_item_fp8(const float* W, int K, int N, unsigned char* WT, bool perm, float* scr, int item, int lane, float wsc) {
    const int nblk = N / 32, kb = item / nblk, nbi = item % nblk, k0 = 64 * kb, n0 = 32 * nbi;
#pragma unroll 8
    for (int i = 0; i < 32; ++i) { const int kk = 2 * i + (lane >> 5); scr[kk * 33 + (lane & 31)] = W[(size_t)(k0 + kk) * N + n0 + (lane & 31)] * wsc; }
    asm volatile("s_waitcnt lgkmcnt(0)" ::: "memory");
    const int c = lane & 3;
    const int r0 = perm ? win_row(n0) : n0;
#pragma unroll
    for (int j = 0; j < 2; ++j) { const int n = (lane >> 2) + 16 * j; const float* s = scr + (16 * c) * 33 + n; v4u o; unsigned* op = (unsigned*)&o;
#pragma unroll
        for (int q = 0; q < 4; ++q) { int p = __builtin_amdgcn_cvt_pk_fp8_f32(s[(4 * q) * 33], s[(4 * q + 1) * 33], 0, false);
            p = __builtin_amdgcn_cvt_pk_fp8_f32(s[(4 * q + 2) * 33], s[(4 * q + 3) * 33], p, true); op[q] = (unsigned)p; }
        *(v4u*)(WT + (size_t)(r0 + n) * K + k0 + 16 * c) = o; }
    asm volatile("s_waitcnt lgkmcnt(0)" ::: "memory");
}
__device__ __forceinline__ void cvt_stream(const float* src, bf16* dst, size_t n, const Ctx& C) {
    const size_t nv = n / 8;
    for (size_t i = (size_t)C.gw * 64 + C.lane; i < nv; i += (size_t)C.ngw * 64) {
        const f32x4 a = *(const f32x4*)(src + i * 8), b = *(const f32x4*)(src + i * 8 + 4);
        v4u o; o.x = pk2(a.x, a.y); o.y = pk2(a.z, a.w); o.z = pk2(b.x, b.y); o.w = pk2(b.z, b.w);
        *(v4u*)(dst + i * 8) = o;
    }
}

typedef float f2v __attribute__((ext_vector_type(2)));

__device__ __forceinline__ unsigned pack_i8x4(float a, float b, float c, float d) {
    const int ia = (int)rintf(a), ib = (int)rintf(b), ic = (int)rintf(c), id = (int)rintf(d);
    return ((unsigned)ia & 255u) | (((unsigned)ib & 255u) << 8) | (((unsigned)ic & 255u) << 16) | ((unsigned)id << 24);
}

struct RowCvt { f32x4 v[2][4]; };
__device__ __forceinline__ void rc_issue(RowCvt& rc, const float* src, int row, int lane) {
    const float* sp = src + (size_t)row * D + 16 * lane;
#pragma unroll
    for (int j = 0; j < 2; ++j)
#pragma unroll
        for (int q = 0; q < 4; ++q) rc.v[j][q] = *(const f32x4*)(sp + 1024 * j + 4 * q);
}
__device__ __forceinline__ float rc_amax(const RowCvt& rc) {
    float am = 0.f;
#pragma unroll
    for (int j = 0; j < 2; ++j)
#pragma unroll
        for (int q = 0; q < 4; ++q) am = fmaxf(am, fmaxf(fmaxf(fabsf(rc.v[j][q].x), fabsf(rc.v[j][q].y)), fmaxf(fabsf(rc.v[j][q].z), fabsf(rc.v[j][q].w))));
#pragma unroll
    for (int o = 1; o < 64; o <<= 1) am = fmaxf(am, __shfl_xor(am, o));
    return am;
}
__device__ __forceinline__ void rc_finish_fp8(const RowCvt& rc, unsigned char* dst, float* inv, int row, int lane) {
    const float am = rc_amax(rc);
    const int ex = (int)((__builtin_bit_cast(unsigned, am) >> 23) & 255u);
    const float sc = (ex == 0) ? 1.0f : __builtin_bit_cast(float, (unsigned)(127 + 7 + 127 - ex) << 23);
    const float isc = (ex == 0) ? 1.0f : __builtin_bit_cast(float, (unsigned)(ex - 7) << 23);
#pragma unroll
    for (int j = 0; j < 2; ++j) { v4u o; unsigned* op = (unsigned*)&o;
#pragma unroll
        for (int q = 0; q < 4; ++q) { int p = __builtin_amdgcn_cvt_pk_fp8_f32(rc.v[j][q].x * sc, rc.v[j][q].y * sc, 0, false);
            p = __builtin_amdgcn_cvt_pk_fp8_f32(rc.v[j][q].z * sc, rc.v[j][q].w * sc, p, true); op[q] = (unsigned)p; }
        *(v4u*)(dst + (size_t)row * D + 16 * lane + 1024 * j) = o; }
    if (lane == 0) inv[row] = isc;
}
__device__ __forceinline__ void rc_finish_i8(const RowCvt& rc, unsigned char* dst, float* inv, int row, int lane) {
    const float am = rc_amax(rc);
    const float sc = (am > 0.f) ? 127.0f / am : 0.f;
#pragma unroll
    for (int j = 0; j < 2; ++j) { v4u o;
        o.x = pack_i8x4(rc.v[j][0].x * sc, rc.v[j][0].y * sc, rc.v[j][0].z * sc, rc.v[j][0].w * sc); o.y = pack_i8x4(rc.v[j][1].x * sc, rc.v[j][1].y * sc, rc.v[j][1].z * sc, rc.v[j][1].w * sc);
        o.z = pack_i8x4(rc.v[j][2].x * sc, rc.v[j][2].y * sc, rc.v[j][2].z * sc, rc.v[j][2].w * sc); o.w = pack_i8x4(rc.v[j][3].x * sc, rc.v[j][3].y * sc, rc.v[j][3].z * sc, rc.v[j][3].w * sc);
        *(v4u*)(dst + (size_t)row * D + 16 * lane + 1024 * j) = o; }
    if (lane == 0) inv[row] = am * (1.0f / 127.0f);
}
__device__ __forceinline__ void phase_prologue(const Args& A, const Ctx& C) {
    unsigned char* ws = A.ws;
    float* mod = (float*)(ws + WS_MOD);
    {
        float* red = (float*)C.lds;
        const float* w_ada = A.in[I_WADA]; const float* cv = A.in[I_C];
        for (int it = C.bid; it < MODW / 48; it += C.nb) {
            const int c4 = C.tid % 12, kg = C.tid / 12;
            f32x4 a0 = {0.f, 0.f, 0.f, 0.f}, a1 = {0.f, 0.f, 0.f, 0.f};
            if (C.tid < 504) {
                for (int k = kg; k < D; k += 42) {
                    const f32x4 w = *(const f32x4*)(w_ada + (size_t)k * MODW + 48 * it + 4 * c4);
                    const float s0 = siluf_(cv[k]), s1 = siluf_(cv[D + k]);
                    a0 += w * s0; a1 += w * s1;
                }
                float* r = red + kg * 96 + c4 * 4;
                r[0] = a0.x; r[1] = a0.y; r[2] = a0.z; r[3] = a0.w;
                r[48 + 0] = a1.x; r[48 + 1] = a1.y; r[48 + 2] = a1.z; r[48 + 3] = a1.w;
            }
            __syncthreads();
            if (C.tid < 96) {
                float s = 0.f;
                for (int g = 0; g < 42; ++g) s += red[g * 96 + C.tid];
                const int b = C.tid / 48, col = 48 * it + (C.tid % 48);
                mod[b * MODW + col] = s + A.in[I_BADA][col];
            }
            __syncthreads();
        }
    }
    {
        float* scr = (float*)(C.lds + C.wave * 16384);
        constexpr int I_IN = (D / 64) * (IN_COLS / 32);
        for (int it = C.gw; it < I_IN; it += C.ngw) p0_transpose_item_fp8(A.in[I_WIN], D, IN_COLS, ws + WS_WIN, true, scr, it, C.lane, WIN_SCALE);
    }
    cvt_stream(A.in[I_PSK], (bf16*)(ws + WS_SK), (size_t)16 * 128 * 128, C);
}


__device__ __forceinline__ void late_transposes(const Args& A, const Ctx& C, unsigned char* ldsbase, int w0, int nw) {
    unsigned char* ws = A.ws;
    float* scr = (float*)(ldsbase + C.wave * 16384);
    int lane = lane_id(); asm volatile("" : "+v"(lane));
    constexpr int I_CO = (CONV_CH / 64) * (D / 32), I_AO = (AOW / 64) * (D / 32), I_OUT = (D / 64) * (D / 32), I_Q = I_OUT;
    constexpr int NITEMS = I_CO + I_AO + I_OUT + I_Q;
    for (int it = w0; it < NITEMS; it += nw) {
        int r = it;
        if (r < I_CO) { p0_transpose_item(A.in[I_WCO], CONV_CH, D, (bf16*)(ws + WS_WCO), false, scr, r, lane); continue; } r -= I_CO;
        if (r < I_AO) { p0_transpose_item(A.in[I_WAO], AOW, D, (bf16*)(ws + WS_WAO), false, scr, r, lane); continue; } r -= I_AO;
        if (r < I_OUT) { p0_transpose_item_fp8(A.in[I_WOUT], D, D, ws + WS_WOUT, false, scr, r, lane, WIN_SCALE); continue; } r -= I_OUT;
        p0_transpose_item(A.in[I_PWQ], D, D, (bf16*)(ws + WS_WQ), false, scr, r, lane);
    }
    { RowCvt rc; for (int row = w0; row < UP_TAIL_ROWS; row += nw) { rc_issue(rc, A.in[I_PWUP], row, lane); rc_finish_i8(rc, ws + WS_WUP, (float*)(ws + WS_SUP), row, lane); } }
}
template <bool FP8OUT>
__device__ __forceinline__ void norm_mod_store(const f32x4 (&v)[8], float ss, int m, const float* gn, const float* mod, int shift_i, int scale_i, bf16* hout, int lane) {
    const float rstd = 1.0f / sqrtf(ss * (1.0f / D) + EPS);
    const int b = m / SEQ;
    const f32x4* gp = (const f32x4*)gn; const f32x4* sc = (const f32x4*)(mod + b * MODW + scale_i * D); const f32x4* sh = (const f32x4*)(mod + b * MODW + shift_i * D);
    v2u* o = (v2u*)(hout + (size_t)m * D); unsigned* o8 = (unsigned*)((unsigned char*)hout + (size_t)m * D);
#pragma unroll
    for (int j = 0; j < 8; ++j) { const int q = lane + 64 * j; const f32x4 g = gp[q], s = sc[q], h = sh[q];
        const f32x4 y = v[j] * rstd * g * (s + 1.0f) + h;
        if constexpr (FP8OUT) { int p = __builtin_amdgcn_cvt_pk_fp8_f32(y.x, y.y, 0, false); p = __builtin_amdgcn_cvt_pk_fp8_f32(y.z, y.w, p, true); o8[q] = (unsigned)p; }
        else { v2u w; w.x = pk2(y.x, y.y); w.y = pk2(y.z, y.w); o[q] = w; } }
}
template <bool FP8OUT>
__device__ __forceinline__ void phase_norm_mod(const float* xin, const float* gn, const float* mod, int shift_i, int scale_i, bf16* hout, const Ctx& C) {
    for (int m = C.gw; m < T; m += 2 * C.ngw) {
        const int m2 = m + C.ngw; const bool has2 = m2 < T;
        const f32x4* xr = (const f32x4*)(xin + (size_t)m * D); const f32x4* xr2 = (const f32x4*)(xin + (size_t)(has2 ? m2 : m) * D);
        f32x4 v[8], v2[8]; float ss = 0.f, ss2 = 0.f;
#pragma unroll
        for (int j = 0; j < 8; ++j) v[j] = xr[C.lane + 64 * j];
#pragma unroll
        for (int j = 0; j < 8; ++j) v2[j] = xr2[C.lane + 64 * j];
#pragma unroll
        for (int j = 0; j < 8; ++j) { ss += (v[j].x * v[j].x + v[j].y * v[j].y) + (v[j].z * v[j].z + v[j].w * v[j].w); ss2 += (v2[j].x * v2[j].x + v2[j].y * v2[j].y) + (v2[j].z * v2[j].z + v2[j].w * v2[j].w); }
#pragma unroll
        for (int o = 1; o < 64; o <<= 1) { ss += __shfl_xor(ss, o); ss2 += __shfl_xor(ss2, o); }
        norm_mod_store<FP8OUT>(v, ss, m, gn, mod, shift_i, scale_i, hout, C.lane);
        if (has2) norm_mod_store<FP8OUT>(v2, ss2, m2, gn, mod, shift_i, scale_i, hout, C.lane);
    }
}

__device__ __forceinline__ unsigned f2ord(float f) { const unsigned u = __builtin_bit_cast(unsigned, f); return u ^ ((u >> 31) ? 0xFFFFFFFFu : 0x80000000u); }
__device__ __forceinline__ float ord2f(unsigned u) { return __builtin_bit_cast(float, (u & 0x80000000u) ? (u ^ 0x80000000u) : ~u); }
template <int CTRL> __device__ __forceinline__ unsigned dpp_u(unsigned x) { return (unsigned)__builtin_amdgcn_update_dpp(0, (int)x, CTRL, 0xF, 0xF, false); }
__device__ __forceinline__ unsigned rowmax_u(unsigned x) {
    x = max(x, dpp_u<0x128>(x)); x = max(x, dpp_u<0x124>(x)); x = max(x, dpp_u<0x122>(x)); x = max(x, dpp_u<0x121>(x)); return x; }
__device__ __forceinline__ float rowsum_f(float x) {
    x += __builtin_bit_cast(float, dpp_u<0x128>(__builtin_bit_cast(unsigned, x))); x += __builtin_bit_cast(float, dpp_u<0x124>(__builtin_bit_cast(unsigned, x)));
    x += __builtin_bit_cast(float, dpp_u<0x122>(__builtin_bit_cast(unsigned, x))); x += __builtin_bit_cast(float, dpp_u<0x121>(__builtin_bit_cast(unsigned, x))); return x; }
#define CE_DESC(a, b) do { const unsigned _hi = max(a, b), _lo = min(a, b); a = _hi; b = _lo; } while (0)
__device__ __forceinline__ void phase_topk(const Args& A, const Ctx& C) {
    const bf16* QP = (const bf16*)(A.ws + WS_QP); const bf16* SK = (const bf16*)(A.ws + WS_SK);
    int* IDX = (int*)(A.ws + WS_IDX); float* GW = (float*)(A.ws + WS_GW);
    const int lane = C.lane, i = lane & 15, g = lane >> 4;
    if (C.wave >= TK_W) {
        const int cw = C.bid * (NWAVES - TK_W) + (C.wave - TK_W), ncw = C.nb * (NWAVES - TK_W); RowCvt ra, rb;
        for (int row = UP_TAIL_ROWS + cw; row < 2 * PEER_E; row += 2 * ncw) {
            const int row2 = row + ncw; const bool has2 = row2 < 2 * PEER_E;
            rc_issue(ra, row < PEER_E ? A.in[I_PWUP] : A.in[I_PWDN], row < PEER_E ? row : row - PEER_E, lane);
            if (has2) rc_issue(rb, row2 < PEER_E ? A.in[I_PWUP] : A.in[I_PWDN], row2 < PEER_E ? row2 : row2 - PEER_E, lane);
            if (row < PEER_E) rc_finish_i8(ra, A.ws + WS_WUP, (float*)(A.ws + WS_SUP), row, lane); else rc_finish_fp8(ra, A.ws + WS_WDN, (float*)(A.ws + WS_SDN), row - PEER_E, lane);
            if (has2) { if (row2 < PEER_E) rc_finish_i8(rb, A.ws + WS_WUP, (float*)(A.ws + WS_SUP), row2, lane); else rc_finish_fp8(rb, A.ws + WS_WDN, (float*)(A.ws + WS_SDN), row2 - PEER_E, lane); }
        }
        return;
    }
    int crow = 2 * PEER_E; RowCvt rc;
#define CV_ISSUE() do { asm volatile("" ::: "memory"); if (crow < 2 * PEER_E) rc_issue(rc, crow < PEER_E ? A.in[I_PWUP] : A.in[I_PWDN], crow < PEER_E ? crow : crow - PEER_E, lane); } while (0)
#define CV_FINISH() do { if (crow < 2 * PEER_E) { if (crow < PEER_E) rc_finish_i8(rc, A.ws + WS_WUP, (float*)(A.ws + WS_SUP), crow, lane); \
        else rc_finish_fp8(rc, A.ws + WS_WDN, (float*)(A.ws + WS_SDN), crow - PEER_E, lane); crow += C.ngw; } asm volatile("" ::: "memory"); } while (0)
    for (int it = C.bid * TK_W + C.wave; it < (T / 16) * PEER_H; it += C.nb * TK_W) {
        const int tile = it >> 3, t0 = tile * 16; int h = it & 7; asm volatile("" : "+s"(h));
        unsigned win[2][4];
#pragma unroll
        for (int p = 0; p < 2; ++p) {
            const int slot = 2 * h + p;
            pg8::bf16x8 aq[4];
#pragma unroll
            for (int ks = 0; ks < 4; ++ks) aq[ks] = *(const pg8::bf16x8*)(QP + (size_t)(t0 + i) * D + slot * 128 + 32 * ks + 8 * g);
            unsigned K[4][8];
#pragma unroll
            for (int nt = 0; nt < 8; ++nt) {
                f32x4 acc = {0.f, 0.f, 0.f, 0.f};
                const bf16* kr = SK + ((size_t)slot * 128 + 16 * nt + i) * 128 + 8 * g;
#pragma unroll
                for (int ks = 0; ks < 4; ++ks) acc = __builtin_amdgcn_mfma_f32_16x16x32_bf16(aq[ks], *(const pg8::bf16x8*)(kr + 32 * ks), acc, 0, 0, 0);
#pragma unroll
                for (int r = 0; r < 4; ++r) K[r][nt] = (f2ord(acc[r]) & ~127u) | (unsigned)(127 - (16 * nt + i));
            }
#pragma unroll
            for (int r = 0; r < 4; ++r) {
                CV_ISSUE();
                unsigned* k = K[r];
                CE_DESC(k[0], k[1]); CE_DESC(k[2], k[3]); CE_DESC(k[4], k[5]); CE_DESC(k[6], k[7]);
                CE_DESC(k[0], k[2]); CE_DESC(k[1], k[3]); CE_DESC(k[4], k[6]); CE_DESC(k[5], k[7]);
                CE_DESC(k[1], k[2]); CE_DESC(k[5], k[6]);
                CE_DESC(k[0], k[4]); CE_DESC(k[1], k[5]); CE_DESC(k[2], k[6]); CE_DESC(k[3], k[7]);
                CE_DESC(k[2], k[4]); CE_DESC(k[3], k[5]);
                CE_DESC(k[1], k[2]); CE_DESC(k[3], k[4]); CE_DESC(k[5], k[6]);
                unsigned w = 0u;
#pragma unroll
                for (int kk = 0; kk < PEER_TOPK; ++kk) {
                    const unsigned M = rowmax_u(k[0]);
                    const bool pop = (k[0] == M);
#pragma unroll
                    for (int q = 0; q < 7; ++q) k[q] = pop ? k[q + 1] : k[q];
                    k[7] = pop ? 0u : k[7];
                    w = (i == kk) ? M : w;
                }
                win[p][r] = w;
                CV_FINISH();
            }
        }
#pragma unroll
        for (int r = 0; r < 4; ++r) {
            CV_ISSUE();
            const float v1 = ord2f(win[0][r] & ~127u), v2 = ord2f(win[1][r] & ~127u);
            int j = 0;
            float nv = __builtin_bit_cast(float, __builtin_amdgcn_ds_bpermute(4 * (16 * g), __builtin_bit_cast(int, v2)));
            unsigned key = (f2ord(v1 + nv) & ~255u) | (unsigned)(255 - 16 * i);
            unsigned w = 0u; float mx = 0.f;
#pragma unroll
            for (int kk = 0; kk < PEER_TOPK; ++kk) {
                const unsigned M = rowmax_u(key);
                if (kk == 0) mx = ord2f(M & ~255u);
                const bool pop = (key == M);
                j += pop ? 1 : 0;
                const int jj = j < 15 ? j : 15;
                nv = __builtin_bit_cast(float, __builtin_amdgcn_ds_bpermute(4 * (16 * g + jj), __builtin_bit_cast(int, v2)));
                const unsigned nk = (j < 16) ? ((f2ord(v1 + nv) & ~255u) | (unsigned)(255 - (16 * i + jj))) : 0u;
                key = pop ? nk : key;
                w = (i == kk) ? M : w;
            }
            const int ci = 255 - (int)(w & 255u);
            const int n1 = 127 - (int)(win[0][r] & 127u), n2 = 127 - (int)(win[1][r] & 127u);
            const int e1 = __builtin_amdgcn_ds_bpermute(4 * (16 * g + (ci >> 4)), n1), e2 = __builtin_amdgcn_ds_bpermute(4 * (16 * g + (ci & 15)), n2);
            const float ex = __expf(ord2f(w & ~255u) - mx);
            const float sum = rowsum_f(ex);
            const size_t o = (size_t)(t0 + 4 * g + r) * PEER_HK + h * PEER_TOPK + i;
            IDX[o] = e1 * PEER_NK + e2; GW[o] = ex / sum;
            CV_FINISH();
        }
    }
    while (crow < 2 * PEER_E) { CV_ISSUE(); CV_FINISH(); }
#undef CV_ISSUE
#undef CV_FINISH
}

typedef __bf16 bf16x2v __attribute__((ext_vector_type(2)));
__device__ __forceinline__ float dot2bf(unsigned w, unsigned x, float acc) { return __builtin_amdgcn_fdot2_f32_bf16(__builtin_bit_cast(bf16x2v, w), __builtin_bit_cast(bf16x2v, x), acc, false); }
__device__ __forceinline__ f2v fp8lo(unsigned w) { return __builtin_amdgcn_cvt_pk_f32_fp8((int)w, false); }
__device__ __forceinline__ f2v fp8hi(unsigned w) { return __builtin_amdgcn_cvt_pk_f32_fp8((int)w, true); }
constexpr int EXB = 8;


constexpr int EX_LDS_WAVE = 4 * 4096 + 2048;
typedef __bf16 bf16x2w __attribute__((ext_vector_type(2)));
__device__ __forceinline__ float gelu_as(float v) {
    const float av = fabsf(v), t = __builtin_amdgcn_rcpf(av * 0.2316419f + 1.0f);
    float q = t * 0.5307027145f + (-0.7265760135f); q = q * t + 0.7107068705f; q = q * t + (-0.142248368f); q = q * t + 0.127414796f; q = q * t;
    const float e = __builtin_amdgcn_exp2f((v * v) * (-0.72134752044f));
    const float m = v * (q * e);
    return v < 0.f ? m : v - m;
}
__device__ __forceinline__ v4u ldrow16(const unsigned char* sbase, unsigned voff) { return *(const v4u*)(sbase + voff); }
__device__ __forceinline__ v2u ldrow8(const unsigned char* sbase, unsigned voff) { return *(const v2u*)(sbase + voff); }
__device__ __forceinline__ int dot16_i8(const v4u w0, const v4u h0) {
    int s0 = __builtin_amdgcn_sdot4((int)w0.x, (int)h0.x, 0, false), s1 = __builtin_amdgcn_sdot4((int)w0.y, (int)h0.y, 0, false);
    s0 = __builtin_amdgcn_sdot4((int)w0.z, (int)h0.z, s0, false); s1 = __builtin_amdgcn_sdot4((int)w0.w, (int)h0.w, s1, false);
    return s0 + s1;
}
__device__ __forceinline__ int dot32_i8(const v4u w0, const v4u h0, const v4u w1, const v4u h1) {
    int s0 = __builtin_amdgcn_sdot4((int)w0.x, (int)h0.x, 0, false), s1 = __builtin_amdgcn_sdot4((int)w0.y, (int)h0.y, 0, false);
    s0 = __builtin_amdgcn_sdot4((int)w0.z, (int)h0.z, s0, false); s1 = __builtin_amdgcn_sdot4((int)w0.w, (int)h0.w, s1, false);
    s0 = __builtin_amdgcn_sdot4((int)w1.x, (int)h1.x, s0, false); s1 = __builtin_amdgcn_sdot4((int)w1.y, (int)h1.y, s1, false);
    s0 = __builtin_amdgcn_sdot4((int)w1.z, (int)h1.z, s0, false); s1 = __builtin_amdgcn_sdot4((int)w1.w, (int)h1.w, s1, false);
    return s0 + s1;
}
__device__ __forceinline__ float dot2_f2v_bf16(f2v a, unsigned h, float s) { return __builtin_amdgcn_fdot2_f32_bf16(__builtin_convertvector(a, bf16x2w), __builtin_bit_cast(bf16x2w, h), s, false); }
__device__ __forceinline__ float dot16_fp8_bf16(const v4u w, const v4u ha, const v4u hb, float s) {
#define D2(W, HI, H) s = dot2_f2v_bf16((HI) ? fp8hi(W) : fp8lo(W), H, s)
    D2(w.x, 0, ha.x); D2(w.x, 1, ha.y); D2(w.y, 0, ha.z); D2(w.y, 1, ha.w); D2(w.z, 0, hb.x); D2(w.z, 1, hb.y); D2(w.w, 0, hb.z); D2(w.w, 1, hb.w);
#undef D2
    return s;
}
#define EX_AXPY(ACC, W0, W1, CC) do { \
    ACC[0][0] = __builtin_elementwise_fma(fp8lo((W0).x), CC, ACC[0][0]); ACC[0][1] = __builtin_elementwise_fma(fp8hi((W0).x), CC, ACC[0][1]); \
    ACC[0][2] = __builtin_elementwise_fma(fp8lo((W0).y), CC, ACC[0][2]); ACC[0][3] = __builtin_elementwise_fma(fp8hi((W0).y), CC, ACC[0][3]); \
    ACC[0][4] = __builtin_elementwise_fma(fp8lo((W0).z), CC, ACC[0][4]); ACC[0][5] = __builtin_elementwise_fma(fp8hi((W0).z), CC, ACC[0][5]); \
    ACC[0][6] = __builtin_elementwise_fma(fp8lo((W0).w), CC, ACC[0][6]); ACC[0][7] = __builtin_elementwise_fma(fp8hi((W0).w), CC, ACC[0][7]); \
    ACC[1][0] = __builtin_elementwise_fma(fp8lo((W1).x), CC, ACC[1][0]); ACC[1][1] = __builtin_elementwise_fma(fp8hi((W1).x), CC, ACC[1][1]); \
    ACC[1][2] = __builtin_elementwise_fma(fp8lo((W1).y), CC, ACC[1][2]); ACC[1][3] = __builtin_elementwise_fma(fp8hi((W1).y), CC, ACC[1][3]); \
    ACC[1][4] = __builtin_elementwise_fma(fp8lo((W1).z), CC, ACC[1][4]); ACC[1][5] = __builtin_elementwise_fma(fp8hi((W1).z), CC, ACC[1][5]); \
    ACC[1][6] = __builtin_elementwise_fma(fp8lo((W1).w), CC, ACC[1][6]); ACC[1][7] = __builtin_elementwise_fma(fp8hi((W1).w), CC, ACC[1][7]); } while (0)
__device__ __forceinline__ void phase_experts3(const Args& A, const Ctx& C, float* dst, unsigned emask) {
    const bf16* H2 = (const bf16*)(A.ws + WS_H); const unsigned char* WUP = A.ws + WS_WUP; const unsigned char* WDN = A.ws + WS_WDN;
    const float* SUP = (const float*)(A.ws + WS_SUP); const float* SDN = (const float*)(A.ws + WS_SDN);
    const int* IDX = (const int*)(A.ws + WS_IDX); const float* GW = (const float*)(A.ws + WS_GW); const float* mod = (const float*)(A.ws + WS_MOD);
    LAS unsigned char* hb = (LAS unsigned char*)C.lds + C.wave * EX_LDS_WAVE;
    LAS unsigned* keys = (LAS unsigned*)(hb + 8192);
    for (int tg = C.gw; tg < T / 4; tg += C.ngw) {
        unsigned z_ = 0u; asm volatile("" : "+v"(z_));
        int lane = (int)__builtin_amdgcn_mbcnt_hi(~0u, __builtin_amdgcn_mbcnt_lo(~0u, z_));
        const int t0 = 4 * tg;
        float hs4[4];
        {
#pragma unroll
          for (int tk = 0; tk < 4; ++tk) {
              float hv[2][16]; float am = 0.f;
#pragma unroll
              for (int j = 0; j < 2; ++j) { const v4u a = *(const v4u*)(H2 + (size_t)(t0 + tk) * D + 16 * lane + 1024 * j), b = *(const v4u*)(H2 + (size_t)(t0 + tk) * D + 16 * lane + 1024 * j + 8);
                  hv[j][0] = bflo(a.x); hv[j][1] = bfhi(a.x); hv[j][2] = bflo(a.y); hv[j][3] = bfhi(a.y); hv[j][4] = bflo(a.z); hv[j][5] = bfhi(a.z); hv[j][6] = bflo(a.w); hv[j][7] = bfhi(a.w);
                  hv[j][8] = bflo(b.x); hv[j][9] = bfhi(b.x); hv[j][10] = bflo(b.y); hv[j][11] = bfhi(b.y); hv[j][12] = bflo(b.z); hv[j][13] = bfhi(b.z); hv[j][14] = bflo(b.w); hv[j][15] = bfhi(b.w);
#pragma unroll
                  for (int q = 0; q < 16; ++q) am = fmaxf(am, fabsf(hv[j][q])); }
#pragma unroll
              for (int o = 1; o < 64; o <<= 1) am = fmaxf(am, __shfl_xor(am, o));
              const float sc = (am > 0.f) ? 127.0f / am : 0.f; hs4[tk] = am * (1.0f / 127.0f);
#pragma unroll
              for (int j = 0; j < 2; ++j) { v4u o;
                  o.x = pack_i8x4(hv[j][0] * sc, hv[j][1] * sc, hv[j][2] * sc, hv[j][3] * sc); o.y = pack_i8x4(hv[j][4] * sc, hv[j][5] * sc, hv[j][6] * sc, hv[j][7] * sc);
                  o.z = pack_i8x4(hv[j][8] * sc, hv[j][9] * sc, hv[j][10] * sc, hv[j][11] * sc); o.w = pack_i8x4(hv[j][12] * sc, hv[j][13] * sc, hv[j][14] * sc, hv[j][15] * sc);
                  *(LAS v4u*)(hb + tk * 2048 + 16 * lane + 1024 * j) = o; } }
        }
        LAS unsigned* keysM = keys + 512;
        LAS float* cfl = (LAS float*)(keys + 1024);
        unsigned K[8];
#pragma unroll
        for (int s = 0; s < 8; ++s) { const int tk = s >> 1, slot = lane + 64 * (s & 1); const unsigned e = (unsigned)IDX[(size_t)(t0 + tk) * PEER_HK + slot];
            K[s] = ((unsigned)tk << 21) | (e << 7) | (unsigned)slot; }
#define EX_SORT512(KK) do { _Pragma("unroll") for (int k = 2; k <= 512; k <<= 1) { _Pragma("unroll") for (int j = k >> 1; j >= 1; j >>= 1) { \
            if (j >= 64) { const int ds = j >> 6; _Pragma("unroll") for (int s = 0; s < 8; ++s) if ((s & ds) == 0) { const bool up = ((64 * s) & k) == 0; \
                    const unsigned a_ = min(KK[s], KK[s | ds]), b_ = max(KK[s], KK[s | ds]); KK[s] = up ? a_ : b_; KK[s | ds] = up ? b_ : a_; } } \
            else { const bool lower = (lane & j) == 0; _Pragma("unroll") for (int s = 0; s < 8; ++s) { const unsigned o = __shfl_xor(KK[s], j); const bool up = ((lane + 64 * s) & k) == 0; \
                    KK[s] = (up == lower) ? min(KK[s], o) : max(KK[s], o); } } } } } while (0)
        EX_SORT512(K);
#pragma unroll
        for (int s = 0; s < 8; ++s) { const int p = lane + 64 * s; keys[(p & 127) * 4 + (p >> 7)] = K[s]; }
        asm volatile("" : "+v"(lane));
#pragma unroll
        for (int s = 0; s < 8; ++s) { const int tk = s >> 1, slot = lane + 64 * (s & 1); const unsigned e = (unsigned)IDX[(size_t)(t0 + tk) * PEER_HK + slot];
            K[s] = (e << 9) | ((unsigned)tk << 7) | (unsigned)slot; }
        EX_SORT512(K);
#pragma unroll
        for (int s = 0; s < 8; ++s) keysM[lane + 64 * s] = K[s];
#undef EX_SORT512
        asm volatile("s_waitcnt lgkmcnt(0)" ::: "memory");
        asm volatile("" : "+v"(lane));
        constexpr int EX_NB = 128;
        {
            const int gq_ = lane >> 4, li_ = lane & 15;
            v4u bw[2][8]; unsigned kcur = keysM[gq_];
#define EX_UP_LD(KW, BUF) do { const unsigned char* r_ = WUP + (size_t)(((KW) >> 9) & emask) * D + 16 * li_; \
            _Pragma("unroll") for (int q_ = 0; q_ < 8; ++q_) bw[BUF][q_] = *(const v4u*)(r_ + 256 * q_); } while (0)
#define EX_UP_STEP(B, CUR) do { \
            const unsigned knext = keysM[4 * (((B) + 1 < EX_NB) ? (B) + 1 : (B)) + gq_]; \
            EX_UP_LD(knext, (CUR) ^ 1); \
            const unsigned me = kcur >> 9, mtok = (kcur >> 7) & 3u, mslot = kcur & 127u; \
            const float gg = GW[(size_t)(t0 + (int)mtok) * PEER_HK + mslot], su = SUP[me], sd = SDN[me]; \
            LAS unsigned char* hr = hb + mtok * 2048 + 16 * li_; int s0_ = 0, s1_ = 0; \
            _Pragma("unroll") for (int q_ = 0; q_ < 8; q_ += 2) { const v4u h0 = *(LAS v4u*)(hr + 256 * q_), h1 = *(LAS v4u*)(hr + 256 * q_ + 256); \
                s0_ += dot16_i8(bw[CUR][q_], h0); s1_ += dot16_i8(bw[CUR][q_ + 1], h1); } \
            unsigned s_ = (unsigned)(s0_ + s1_); \
            s_ += dpp_u<0x128>(s_); s_ += dpp_u<0x124>(s_); s_ += dpp_u<0x122>(s_); s_ += dpp_u<0x121>(s_);            \
            const float hs_ = (mtok == 0u) ? hs4[0] : (mtok == 1u) ? hs4[1] : (mtok == 2u) ? hs4[2] : hs4[3]; \
            cfl[mtok * 128u + mslot] = gg * sd * gelu_as((float)(int)s_ * su * hs_); \
            kcur = knext; } while (0)
            EX_UP_LD(kcur, 0);
            for (int b = 0; b < EX_NB; b += 2) { EX_UP_STEP(b, 0); EX_UP_STEP(b + 1, 1); }
#undef EX_UP_LD
#undef EX_UP_STEP
        }
        asm volatile("s_waitcnt lgkmcnt(0)" ::: "memory");
        asm volatile("" : "+v"(lane));
        const int bb = t0 / SEQ;
        constexpr int EX_DB = 2;
        LAS unsigned* rowT = keys + 1536;
        LAS float* cfT = (LAS float*)(keys + 2048);
#pragma unroll
        for (int s = 0; s < 8; ++s) { const int q_ = lane + 64 * s; const unsigned kk_ = keys[q_]; const unsigned e_ = ((kk_ >> 7) & 16383u) & emask;
            rowT[q_] = e_ * (unsigned)D; cfT[q_] = cfl[(q_ & 3) * 128 + (int)(kk_ & 127u)]; }
        asm volatile("s_waitcnt lgkmcnt(0)" ::: "memory");
#define EX_AXPY1(ACC, W0, CC) do { \
    ACC[0] = __builtin_elementwise_fma(fp8lo((W0).x), CC, ACC[0]); ACC[1] = __builtin_elementwise_fma(fp8hi((W0).x), CC, ACC[1]); \
    ACC[2] = __builtin_elementwise_fma(fp8lo((W0).y), CC, ACC[2]); ACC[3] = __builtin_elementwise_fma(fp8hi((W0).y), CC, ACC[3]); } while (0)
#define EX_RO(W) ((unsigned)__builtin_amdgcn_readfirstlane((int)(W)))
#define EX_DN_LD(J, BQ, BUF) do { _Pragma("unroll") for (int bb_ = 0; bb_ < EX_DB; ++bb_) { const v4u rv = *(LAS v4u*)(rowT + 4 * ((BQ) + bb_)); \
            bd[BUF][bb_][0] = ldrow8(WDN + EX_RO(rv.x), voff_ + 512u * (J)); bd[BUF][bb_][1] = ldrow8(WDN + EX_RO(rv.y), voff_ + 512u * (J)); \
            bd[BUF][bb_][2] = ldrow8(WDN + EX_RO(rv.z), voff_ + 512u * (J)); bd[BUF][bb_][3] = ldrow8(WDN + EX_RO(rv.w), voff_ + 512u * (J)); } } while (0)
#define EX_DN_STEP(J, B, CUR) do { \
            EX_DN_LD(J, (((B) + EX_DB < EX_NB) ? (B) + EX_DB : (B)), (CUR) ^ 1); \
            _Pragma("unroll") for (int bb_ = 0; bb_ < EX_DB; ++bb_) { const f32x4 cv = *(LAS f32x4*)(cfT + 4 * ((B) + bb_)); \
                { const f2v cc = {cv.x, cv.x}; EX_AXPY1(a0, bd[CUR][bb_][0], cc); } \
                { const f2v cc = {cv.y, cv.y}; EX_AXPY1(a1, bd[CUR][bb_][1], cc); } \
                { const f2v cc = {cv.z, cv.z}; EX_AXPY1(a2, bd[CUR][bb_][2], cc); } \
                { const f2v cc = {cv.w, cv.w}; EX_AXPY1(a3, bd[CUR][bb_][3], cc); } } } while (0)
#define EX_OUT1(TK, ACC, J) do { _Pragma("unroll") for (int q = 0; q < 2; ++q) { const int col = 8 * lane + 512 * (J) + 4 * q; \
            const f32x4 g = *(const f32x4*)(mod + bb * MODW + 5 * D + col); f32x4 x = *(const f32x4*)(A.out + (size_t)(t0 + TK) * D + col); \
            x.x += g.x * ACC[2 * q].x; x.y += g.y * ACC[2 * q].y; x.z += g.z * ACC[2 * q + 1].x; x.w += g.w * ACC[2 * q + 1].y; *(f32x4*)(dst + (size_t)(t0 + TK) * D + col) = x; } } while (0)
#define EX_DN_PASS(J) do { v2u bd[2][EX_DB][4]; const unsigned voff_ = 8u * (unsigned)lane; f2v a0[4], a1[4], a2[4], a3[4]; \
            _Pragma("unroll") for (int q = 0; q < 4; ++q) { a0[q] = (f2v){0.f, 0.f}; a1[q] = (f2v){0.f, 0.f}; a2[q] = (f2v){0.f, 0.f}; a3[q] = (f2v){0.f, 0.f}; } \
            EX_DN_LD(J, 0, 0); \
            for (int b = 0; b < EX_NB; b += 2 * EX_DB) { EX_DN_STEP(J, b, 0); EX_DN_STEP(J, b + EX_DB, 1); } \
            EX_OUT1(0, a0, J); EX_OUT1(1, a1, J); EX_OUT1(2, a2, J); EX_OUT1(3, a3, J); } while (0)
        EX_DN_PASS(0);
        asm volatile("" : "+v"(lane));
        EX_DN_PASS(1);
        asm volatile("" : "+v"(lane));
        EX_DN_PASS(2);
        asm volatile("" : "+v"(lane));
        EX_DN_PASS(3);
#undef EX_DN_PASS
#undef EX_DN_LD
#undef EX_RO
#undef EX_DN_STEP
#undef EX_AXPY1
#undef EX_OUT1
        asm volatile("s_waitcnt lgkmcnt(0)" ::: "memory");
    }
}

constexpr int CONV_TT = 16;
__device__ __forceinline__ void wave_reduce16(float (&v)[16], int lane) {
    const bool b5 = lane & 32, b4 = lane & 16, b3 = lane & 8, b2 = lane & 4;
#pragma unroll
    for (int k = 0; k < 8; ++k) { const float keep = b5 ? v[k + 8] : v[k], send = b5 ? v[k] : v[k + 8]; v[k] = keep + __shfl_xor(send, 32); }
#pragma unroll
    for (int k = 0; k < 4; ++k) { const float keep = b4 ? v[k + 4] : v[k], send = b4 ? v[k] : v[k + 4]; v[k] = keep + __shfl_xor(send, 16); }
#pragma unroll
    for (int k = 0; k < 2; ++k) { const float keep = b3 ? v[k + 2] : v[k], send = b3 ? v[k] : v[k + 2]; v[k] = keep + __shfl_xor(send, 8); }
    { const float keep = b2 ? v[1] : v[0], send = b2 ? v[0] : v[1]; v[0] = keep + __shfl_xor(send, 4); }
    v[0] += __shfl_xor(v[0], 2); v[0] += __shfl_xor(v[0], 1);
}
__device__ __forceinline__ void phase_conv(const Args& A, const Ctx& C) {
    const bf16* U = (const bf16*)(A.ws + WS_U); bf16* UCV = (bf16*)(A.ws + WS_UCV);
    const float* dw = A.in[I_CDW]; const float* db = A.in[I_CDB]; const float* lg = A.in[I_CLNG]; const float* lb = A.in[I_CLNB];
    LAS float* red = (LAS float*)((LAS unsigned char*)C.lds);
    const int c0 = 2 * C.tid, lane = C.lane;
    float w0[CONV_K], w1[CONV_K];
#pragma unroll
    for (int j = 0; j < CONV_K; ++j) { const float2 w = *(const float2*)(dw + j * CONV_CH + c0); w0[j] = w.x; w1[j] = w.y; }
    const float2 bias = *(const float2*)(db + c0), gam = *(const float2*)(lg + c0), bet = *(const float2*)(lb + c0);
    const int tsel = ((lane >> 5) & 1) * 8 + ((lane >> 4) & 1) * 4 + ((lane >> 3) & 1) * 2 + ((lane >> 2) & 1);
    for (int it = C.bid; it < T / CONV_TT; it += C.nb) {
        const int t0 = it * CONV_TT, s0 = t0 % SEQ;
        unsigned in[CONV_TT + CONV_K - 1];
#pragma unroll
        for (int q = 0; q < CONV_TT + CONV_K - 1; ++q) { const int sp = s0 - (CONV_K - 1) + q;
            in[q] = (sp >= 0) ? *(const unsigned*)(U + (size_t)(t0 - (CONV_K - 1) + q) * CONV_CH + c0) : 0u; }
        float a0[CONV_TT], a1[CONV_TT];
#pragma unroll
        for (int k = 0; k < CONV_TT; ++k) { float x0 = bias.x, x1 = bias.y;
#pragma unroll
            for (int j = 0; j < CONV_K; ++j) { x0 += w0[j] * bflo(in[k + j]); x1 += w1[j] * bfhi(in[k + j]); }
            a0[k] = x0; a1[k] = x1; }
        float v[16];
#pragma unroll
        for (int k = 0; k < 16; ++k) v[k] = a0[k] + a1[k];
        wave_reduce16(v, lane);
        __syncthreads();
        if ((lane & 3) == 0) red[C.wave * 16 + tsel] = v[0];
        __syncthreads();
        float mean[16];
#pragma unroll
        for (int k = 0; k < 16; ++k) { float s = 0.f;
#pragma unroll
            for (int wv = 0; wv < NWAVES; ++wv) s += red[wv * 16 + k];
            mean[k] = s * (1.0f / CONV_CH); }
#pragma unroll
        for (int k = 0; k < 16; ++k) { a0[k] -= mean[k]; a1[k] -= mean[k]; v[k] = a0[k] * a0[k] + a1[k] * a1[k]; }
        wave_reduce16(v, lane);
        __syncthreads();
        if ((lane & 3) == 0) red[C.wave * 16 + tsel] = v[0];
        __syncthreads();
#pragma unroll
        for (int k = 0; k < 16; ++k) { float s = 0.f;
#pragma unroll
            for (int wv = 0; wv < NWAVES; ++wv) s += red[wv * 16 + k];
            const float rstd = 1.0f / sqrtf(s * (1.0f / CONV_CH) + EPS);
            const float y0 = a0[k] * rstd * gam.x + bet.x, y1 = a1[k] * rstd * gam.y + bet.y;
            *(unsigned*)(UCV + (size_t)(t0 + k) * CONV_CH + c0) = pk2(siluf_(y0), siluf_(y1)); }
    }
    __syncthreads();
}

typedef short v4i16_t __attribute__((ext_vector_type(4)));
constexpr int VROW = 288;
constexpr int ATT_V_BYTES = 256 * VROW;
constexpr int KROW = 272;
constexpr int ATT_K_OFF = ATT_V_BYTES;
constexpr int ATT_SCR_OFF = ATT_V_BYTES + 256 * KROW;
constexpr int ATT_RK_OFF = ATT_SCR_OFF + NWAVES * 256;
__device__ __forceinline__ void phase_attn(const Args& A, const Ctx& C) {
    const bf16* QKV = (const bf16*)(A.ws + WS_QKV); bf16* ON = (bf16*)(A.ws + WS_ON); float* DEN = (float*)(A.ws + WS_DEN);
    const float* qg = A.in[I_QNG]; const float* kg = A.in[I_KNG];
    LAS unsigned char* Vb = (LAS unsigned char*)C.lds;
    LAS unsigned char* Kb = Vb + ATT_K_OFF;
    LAS float* scr = (LAS float*)(Vb + ATT_SCR_OFF + C.wave * 256);
    LAS float* rkt = (LAS float*)(Vb + ATT_RK_OFF);
    unsigned z0_ = 0u; asm volatile("" : "+v"(z0_));
    const int lane = (int)__builtin_amdgcn_mbcnt_hi(~0u, __builtin_amdgcn_mbcnt_lo(~0u, z0_)), c = lane & 15, kq = lane >> 4, w = C.wave, i0 = 16 * w;
    constexpr float C2 = 0.08838834764831845f * 1.4426950408889634f;
#define ATT_DECODE(U, B_, GI_, HH_, R_, N_, DIL_) const int B_ = (U) / 384, GI_ = ((U) % 384) >> 7; const int DIL_ = (GI_ == 0) ? 1 : (GI_ == 1) ? 4 : 16; \
        const int nbk##B_ = (GI_ == 0) ? 32 : (GI_ == 1) ? 8 : 2; const int rem2##B_ = ((U) % 384) & 127; const int HH_ = rem2##B_ / (DIL_ * nbk##B_), r2##B_ = rem2##B_ % (DIL_ * nbk##B_), R_ = r2##B_ / nbk##B_, N_ = r2##B_ % nbk##B_;
#define ATT_LOAD(KD, VD, QD, RB_, N_, DIL_, HEAD_) do { unsigned zz_ = 0u; asm volatile("" : "+v"(zz_)); const int tid_ = C.wave * 64 + (int)__builtin_amdgcn_mbcnt_hi(~0u, __builtin_amdgcn_mbcnt_lo(~0u, zz_)); const int lb_ = 128 * (N_) - 128; \
        _Pragma("unroll") for (int k_ = 0; k_ < 8; ++k_) { const int idx_ = tid_ + NTHREADS * k_; int l_ = lb_ + (idx_ >> 4); l_ = l_ < 0 ? 0 : l_; \
            const bf16* rp_ = QKV + ((RB_) + (size_t)l_ * (DIL_)) * QKVW + (HEAD_) * HD + (idx_ & 15) * 8; KD[k_] = *(const v4u*)(rp_ + AW); VD[k_] = *(const v4u*)(rp_ + 2 * AW); } \
        { const bf16* qrow_ = QKV + ((RB_) + (size_t)(128 * (N_) + i0 + (tid_ & 15)) * (DIL_)) * QKVW + (HEAD_) * HD + 8 * ((tid_ & 63) >> 4); \
          _Pragma("unroll") for (int ks_ = 0; ks_ < 4; ++ks_) QD[ks_] = *(const v4u*)(qrow_ + 32 * ks_); } } while (0)
#define ATT_STORE(KD, VD) do { unsigned zz_ = 0u; asm volatile("" : "+v"(zz_)); const int tid_ = C.wave * 64 + (int)__builtin_amdgcn_mbcnt_hi(~0u, __builtin_amdgcn_mbcnt_lo(~0u, zz_)); _Pragma("unroll") for (int k_ = 0; k_ < 8; ++k_) { const int idx_ = tid_ + NTHREADS * k_; \
            *(LAS v4u*)(Kb + (idx_ >> 4) * KROW + (idx_ & 15) * 16) = KD[k_]; *(LAS v4u*)(Vb + (idx_ >> 4) * VROW + (idx_ & 15) * 16) = VD[k_]; \
            { const v4u k4 = KD[k_]; const float a0 = bflo(k4.x), a1 = bfhi(k4.x), a2 = bflo(k4.y), a3 = bfhi(k4.y), a4 = bflo(k4.z), a5 = bfhi(k4.z), a6 = bflo(k4.w), a7 = bfhi(k4.w); \
              const float ssr_ = rowsum_f((a0 * a0 + a1 * a1) + (a2 * a2 + a3 * a3) + (a4 * a4 + a5 * a5) + (a6 * a6 + a7 * a7));        \
              rkt[idx_ >> 4] = C2 / sqrtf(ssr_ * (1.0f / HD) + EPS); } } } while (0)
    v4u knext[8], vnext[8], qnext[4], qraw[4];
    if (C.bid < 768) { ATT_DECODE(C.bid, b0_, gi0_, hh0_, r0_, n0_, dil0_); ATT_LOAD(knext, vnext, qraw, (size_t)b0_ * SEQ + r0_, n0_, dil0_, gi0_ * 4 + hh0_); ATT_STORE(knext, vnext); }
    for (int u = C.bid; u < 768; u += C.nb) {
        ATT_DECODE(u, b, gi, hh, r, n, dil);
        const int head = gi * 4 + hh;
        const size_t rowbase = (size_t)b * SEQ + r;
        const int lb = 128 * n - 128;
        __syncthreads();
        const int un = u + C.nb; const bool hasn = un < 768;
        if (hasn) { ATT_DECODE(un, bn_, gin_, hhn_, rn_, nn_, diln_); ATT_LOAD(knext, vnext, qnext, (size_t)bn_ * SEQ + rn_, nn_, diln_, gin_ * 4 + hhn_); }
        pg8::bf16x8 qf[4];
        { float ss = 0.f;
#pragma unroll
          for (int ks = 0; ks < 4; ++ks) { const v4u rw = qraw[ks];
              const float a0 = bflo(rw.x), a1 = bfhi(rw.x), a2 = bflo(rw.y), a3 = bfhi(rw.y), a4 = bflo(rw.z), a5 = bfhi(rw.z), a6 = bflo(rw.w), a7 = bfhi(rw.w);
              ss += (a0 * a0 + a1 * a1) + (a2 * a2 + a3 * a3) + (a4 * a4 + a5 * a5) + (a6 * a6 + a7 * a7); }
          ss += __shfl_xor(ss, 16); ss += __shfl_xor(ss, 32);
          const float rq = 1.0f / sqrtf(ss * (1.0f / HD) + EPS);
#pragma unroll
          for (int ks = 0; ks < 4; ++ks) { const int d0 = head * HD + 32 * ks + 8 * kq; const v4u rw = qraw[ks];
              const f32x4 g0 = *(const f32x4*)(qg + d0) * *(const f32x4*)(kg + d0), g1 = *(const f32x4*)(qg + d0 + 4) * *(const f32x4*)(kg + d0 + 4);
              pg8::u32x4 pk;
              pk.x = pg8::cvt_pk_bf16(bflo(rw.x) * rq * g0.x, bfhi(rw.x) * rq * g0.y); pk.y = pg8::cvt_pk_bf16(bflo(rw.y) * rq * g0.z, bfhi(rw.y) * rq * g0.w);
              pk.z = pg8::cvt_pk_bf16(bflo(rw.z) * rq * g1.x, bfhi(rw.z) * rq * g1.y); pk.w = pg8::cvt_pk_bf16(bflo(rw.w) * rq * g1.z, bfhi(rw.w) * rq * g1.w);
              qf[ks] = __builtin_bit_cast(pg8::bf16x8, pk); } }
        unsigned Pk[10][2]; float dsum = 0.f;
#pragma unroll
        for (int kb = 0; kb < 9; ++kb) {
            const int j0 = i0 + 16 * kb;
            v4u kr[4];
#pragma unroll
            for (int ks = 0; ks < 4; ++ks) kr[ks] = *(const LAS v4u*)(Kb + (j0 + c) * KROW + 64 * ks + 16 * kq);
            const f32x4 rk4 = *(const LAS f32x4*)(rkt + j0 + 4 * kq);
            f32x4 acc = {0.f, 0.f, 0.f, 0.f};
#pragma unroll
            for (int ks = 0; ks < 4; ++ks) acc = __builtin_amdgcn_mfma_f32_16x16x32_bf16(__builtin_bit_cast(pg8::bf16x8, kr[ks]), qf[ks], acc, 0, 0, 0);
#pragma unroll
            for (int e = 0; e < 4; ++e) { const int j = j0 + 4 * kq + e; const int dist = 128 + i0 + c - j;
                const bool valid = (dist >= 0) && (dist <= 128) && (lb + j >= 0);
                const float pv = __builtin_amdgcn_exp2f(acc[e] * rk4[e]);
                acc[e] = valid ? pv : 0.f; dsum += acc[e]; }
            Pk[kb][0] = pg8::cvt_pk_bf16(acc[0], acc[1]); Pk[kb][1] = pg8::cvt_pk_bf16(acc[2], acc[3]);
        }
        Pk[9][0] = 0u; Pk[9][1] = 0u;
        dsum += __shfl_xor(dsum, 16); dsum += __shfl_xor(dsum, 32);
        if (kq == 0) scr[32 + c] = dsum;
        const f32x4 dq = *(const LAS f32x4*)(scr + 32 + 4 * kq);
        f32x4 O[8];
#pragma unroll
        for (int dt = 0; dt < 8; ++dt) O[dt] = (f32x4){0.f, 0.f, 0.f, 0.f};
#pragma unroll
        for (int s = 0; s < 5; ++s) {
            pg8::u32x4 pk; pk.x = Pk[2 * s][0]; pk.y = Pk[2 * s][1]; pk.z = Pk[2 * s + 1][0]; pk.w = Pk[2 * s + 1][1];
            const pg8::bf16x8 pf = __builtin_bit_cast(pg8::bf16x8, pk);
            const int kb1 = (2 * s + 1 < 9) ? 2 * s + 1 : 8;
            const int rowA = i0 + 32 * s + 4 * kq + (c >> 2), rowB = i0 + 16 * kb1 + 4 * kq + (c >> 2);
            LAS unsigned char* pa = Vb + rowA * VROW + (c & 3) * 8; LAS unsigned char* pb = Vb + rowB * VROW + (c & 3) * 8;
#pragma unroll
            for (int dt = 0; dt < 8; ++dt) {
                const v4i16_t lo = __builtin_amdgcn_ds_read_tr16_b64_v4i16((LAS v4i16_t*)(pa + dt * 32));
                const v4i16_t hi = __builtin_amdgcn_ds_read_tr16_b64_v4i16((LAS v4i16_t*)(pb + dt * 32));
                const pg8::bf16x8 vf = {lo[0], lo[1], lo[2], lo[3], hi[0], hi[1], hi[2], hi[3]};
                O[dt] = __builtin_amdgcn_mfma_f32_16x16x32_bf16(pf, vf, O[dt], 0, 0, 0);
            }
        }
        { float inv[4];
#pragma unroll
          for (int e = 0; e < 4; ++e) inv[e] = 1.0f / dq[e];
#pragma unroll
          for (int e = 0; e < 4; ++e) { const size_t trow = rowbase + (size_t)(128 * n + i0 + 4 * kq + e) * dil;
              bf16* op = ON + ((size_t)gi * T + trow) * AOW + hh * HD + c;
#pragma unroll
              for (int dt = 0; dt < 8; ++dt) op[16 * dt] = (bf16)f2bf(O[dt][e] * inv[e]); }
          { unsigned zq_ = 0u; asm volatile("" : "+v"(zq_)); const int l2_ = (int)__builtin_amdgcn_mbcnt_hi(~0u, __builtin_amdgcn_mbcnt_lo(~0u, zq_));
            if ((l2_ >> 4) == 0) DEN[((size_t)gi * T + rowbase + (size_t)(128 * n + 16 * C.wave + (l2_ & 15)) * dil) * 4 + hh] = dsum; } }
        __syncthreads();
        if (hasn) { ATT_STORE(knext, vnext);
#pragma unroll
            for (int ks = 0; ks < 4; ++ks) qraw[ks] = qnext[ks]; }
    }
#undef ATT_DECODE
#undef ATT_LOAD
#undef ATT_STORE
}
__device__ __forceinline__ void phase_attn_combine(const Args& A, const Ctx& C) {
    const bf16* ON = (const bf16*)(A.ws + WS_ON); const float* DEN = (const float*)(A.ws + WS_DEN); bf16* O = (bf16*)(A.ws + WS_O);
    const int gt = C.bid * NTHREADS + C.tid, ngt = C.nb * NTHREADS;
    for (int i = gt; i < T * (AOW / 8); i += ngt) {
        const int t = i >> 6, ch = i & 63, hh = ch >> 4;
        const float d0 = DEN[((size_t)0 * T + t) * 4 + hh], d1 = DEN[((size_t)1 * T + t) * 4 + hh], d2 = DEN[((size_t)2 * T + t) * 4 + hh];
        const float inv = 1.0f / (d0 + d1 + d2); const float w0 = d0 * inv, w1 = d1 * inv, w2 = d2 * inv;
        const v4u a = *(const v4u*)(ON + ((size_t)0 * T + t) * AOW + ch * 8), bq = *(const v4u*)(ON + ((size_t)1 * T + t) * AOW + ch * 8), cq = *(const v4u*)(ON + ((size_t)2 * T + t) * AOW + ch * 8);
        v4u o;
        o.x = pk2(w0 * bflo(a.x) + w1 * bflo(bq.x) + w2 * bflo(cq.x), w0 * bfhi(a.x) + w1 * bfhi(bq.x) + w2 * bfhi(cq.x));
        o.y = pk2(w0 * bflo(a.y) + w1 * bflo(bq.y) + w2 * bflo(cq.y), w0 * bfhi(a.y) + w1 * bfhi(bq.y) + w2 * bfhi(cq.y));
        o.z = pk2(w0 * bflo(a.z) + w1 * bflo(bq.z) + w2 * bflo(cq.z), w0 * bfhi(a.z) + w1 * bfhi(bq.z) + w2 * bfhi(cq.z));
        o.w = pk2(w0 * bflo(a.w) + w1 * bflo(bq.w) + w2 * bflo(cq.w), w0 * bfhi(a.w) + w1 * bfhi(bq.w) + w2 * bfhi(cq.w));
        *(v4u*)(O + (size_t)t * AOW + ch * 8) = o;
    }
}

__global__ void __launch_bounds__(NTHREADS, 2) mk_fwd(Args args) {
    extern __shared__ __attribute__((aligned(16))) unsigned char lds[];
    Ctx C;
    C.tid = threadIdx.x; C.lane = C.tid & 63; C.wave = __builtin_amdgcn_readfirstlane(C.tid >> 6);
    C.bid = blockIdx.x; C.nb = gridDim.x; C.gw = C.bid * NWAVES + C.wave; C.ngw = C.nb * NWAVES; C.lds = lds;
    volatile LAS unsigned* MISC = (volatile LAS unsigned*)((LAS unsigned char*)lds + MISC_OFF);
    if (C.tid < 32) MISC[C.tid] = 0u;
    __syncthreads();
    unsigned* ctl = (unsigned*)(args.ws + WS_CTL);
    XcdBarrier bar; bar.bar = ctl + CW_BAR; bar.x = 0; bar.st = nullptr;
    const int lo = args.ph_lo, hi = args.ph_hi;
    if (hi - lo > 1) bar = xcd_barrier_post(ctl + CW_BAR, MISC + 8);
    bar.wave = C.wave;
#define IN(k) (lo <= (k) && (k) < hi)
#define SEAM(k) do { if (IN(k) && IN((k) + 1)) xcd_barrier(bar); } while (0)
    unsigned char* ws = args.ws;
    const float* mod = (const float*)(ws + WS_MOD);
#define REP(k) for (int rep_ = 0; rep_ < ((PROBE_DUP == (k)) ? 2 : 1); ++rep_)
#define FRESH_CTX() do { unsigned z_ = 0u; asm volatile("" : "+v"(z_)); C.lane = (int)__builtin_amdgcn_mbcnt_hi(~0u, __builtin_amdgcn_mbcnt_lo(~0u, z_)); C.tid = C.wave * 64 + C.lane; } while (0)
    if (IN(0)) { FRESH_CTX(); REP(0) phase_prologue(args, C); } SEAM(0);
    if (IN(1)) { FRESH_CTX(); REP(1) phase_norm_mod<true>(args.in[I_X], args.in[I_N1G], mod, 0, 1, (bf16*)(ws + WS_H), C); } SEAM(1);
    LAS unsigned char* ldsl = (LAS unsigned char*)lds;
    if (IN(2)) { FRESH_CTX(); REP(2) { pg8::Gemm g{(const bf16*)(ws + WS_H), (const bf16*)(ws + WS_WIN), T, IN_COLS, D / 2}; pg8::StaticOrder S; S.init(T, IN_COLS, C.nb, C.bid);
                 pg8::EpiIn E{(bf16*)(ws + WS_U), (bf16*)(ws + WS_QKV), (bf16*)(ws + WS_G), 0, 1.0f / WIN_SCALE};
                 pg8::gemm_phase<pg8::EpiIn, pg8::StaticOrder, false, true, true>(ldsl, g, S, E, C.wave); }
                 { constexpr int NT6 = (T / 256) * (IN_COLS / 256) % 256;
                   if (C.nb == 256 && NT6 > 0) { if (C.bid >= NT6) late_transposes(args, C, lds, (C.bid - NT6) * NWAVES + C.wave, (256 - NT6) * NWAVES); }
                   else late_transposes(args, C, lds, C.gw, C.ngw); } } SEAM(2);
    if (IN(3)) { FRESH_CTX(); REP(3) { phase_conv(args, C); phase_attn(args, C); } } SEAM(3);
    if (IN(4)) { FRESH_CTX(); phase_attn_combine(args, C);
                 pg8::Gemm g{(const bf16*)(ws + WS_UCV), (const bf16*)(ws + WS_WCO), T, D, CONV_CH}; pg8::StaticOrder S; S.init(T, D, C.nb, C.bid);
                 pg8::EpiYconv E{(const bf16*)(ws + WS_G), (bf16*)(ws + WS_MERGED), args.in[I_BCO]};
                 pg8::gemm_phase<pg8::EpiYconv, pg8::StaticOrder, true, true>(ldsl, g, S, E, C.wave); } SEAM(4);
    if (IN(5)) { FRESH_CTX(); REP(5) { pg8::Gemm g{(const bf16*)(ws + WS_O), (const bf16*)(ws + WS_WAO), T, D, AOW}; pg8::StaticOrder S; S.init(T, D, C.nb, C.bid);
                 pg8::EpiYattn E{(const bf16*)(ws + WS_G), (const bf16*)(ws + WS_MERGED), ws + WS_QP, MG_SCALE};
                 pg8::gemm_phase<pg8::EpiYattn, pg8::StaticOrder, true, true>(ldsl, g, S, E, C.wave); } } SEAM(5);
    if (IN(6)) { FRESH_CTX(); REP(6) { pg8::Gemm g{(const bf16*)(ws + WS_QP), (const bf16*)(ws + WS_WOUT), T, D, D / 2}; pg8::StaticOrder S; S.init(T, D, C.nb, C.bid);
                 pg8::EpiOut E{args.in[I_X], mod, args.out, 1.0f / (MG_SCALE * WIN_SCALE)};
                 pg8::gemm_phase<pg8::EpiOut, pg8::StaticOrder, true, true, true>(ldsl, g, S, E, C.wave); } } SEAM(6);
    if (IN(7)) { FRESH_CTX(); REP(7) phase_norm_mod<false>(args.out, args.in[I_N2G], mod, 3, 4, (bf16*)(ws + WS_H), C); } SEAM(7);
    if (IN(8)) { FRESH_CTX(); REP(8) { pg8::Gemm g{(const bf16*)(ws + WS_H), (const bf16*)(ws + WS_WQ), T, D, D}; pg8::StaticOrder S; S.init(T, D, C.nb, C.bid);
                 pg8::EpiPlain E{(bf16*)(ws + WS_QP), D};
                 pg8::gemm_phase<pg8::EpiPlain, pg8::StaticOrder, true, true>(ldsl, g, S, E, C.wave); } } SEAM(8);
    if (IN(9)) { FRESH_CTX(); REP(9) phase_topk(args, C); } SEAM(9);
    if (IN(10)) { FRESH_CTX(); for (int rep_ = (PROBE_DUP == 10) ? 0 : 1; rep_ < 2; ++rep_) phase_experts3(args, C, rep_ ? args.out : (float*)(ws + WS_MERGED), rep_ ? 0xFFFFFFFFu : PROBE_EMASK); }
#undef REP
#undef IN
#undef SEAM
}

extern "C" void kernel_launch(void* const* d_in, const int* in_sizes, int n_in, void* d_out, int out_size, void* d_ws, size_t ws_size, hipStream_t stream) {
    static int grid = 0;
    if (grid == 0) {
        if (n_in != 21 || in_sizes[0] != T * D || out_size != T * D || ws_size < WS_END) {
            fprintf(stderr, "kernel_launch: unexpected shapes: n_in %d in0 %d out %d ws %zu (need %zu)\n", n_in, n_in > 0 ? in_sizes[0] : -1, out_size, ws_size, (size_t)WS_END); grid = -1; return; }
        int dev = 0, cus = 0, per_cu = 0;
        if (hipGetDevice(&dev) != hipSuccess || hipDeviceGetAttribute(&cus, hipDeviceAttributeMultiprocessorCount, dev) != hipSuccess) { grid = -1; return; }
        if (hipFuncSetAttribute((const void*)mk_fwd, hipFuncAttributeMaxDynamicSharedMemorySize, LDS_BYTES) != hipSuccess) { fprintf(stderr, "kernel_launch: hipFuncSetAttribute failed\n"); grid = -1; return; }
        if (hipOccupancyMaxActiveBlocksPerMultiprocessor(&per_cu, (const void*)mk_fwd, NTHREADS, LDS_BYTES) != hipSuccess || per_cu < 1)
            fprintf(stderr, "kernel_launch: note: occupancy query reports %d\n", per_cu);
        (void)hipGetLastError();
        grid = cus;
    }
    if (grid < 0) return;
    (void)hipMemsetAsync((char*)d_ws + WS_CTL, 0, CTL_ZERO_BYTES, stream);
    Args a{};
    for (int i = 0; i < 21; ++i) a.in[i] = (const float*)d_in[i];
    a.out = (float*)d_out; a.ws = (unsigned char*)d_ws;
#if N_LAUNCH_MODE == 1
    a.ph_lo = 0; a.ph_hi = NPHASES;
    hipLaunchKernelGGL(mk_fwd, dim3(grid), dim3(NTHREADS), LDS_BYTES, stream, a);
#else
    for (int p = 0; p < NPHASES; ++p) { a.ph_lo = p; a.ph_hi = p + 1; hipLaunchKernelGGL(mk_fwd, dim3(grid), dim3(NTHREADS), LDS_BYTES, stream, a); }
#endif
}
```

```cpp
#include <hip/hip_runtime.h>
#include <cstdio>
#include <cstdint>
#include <cmath>

constexpr int BATCH = 2, SEQ = 4096, D = 2048, T = BATCH * SEQ;
constexpr int CONV_CH = 1024, CONV_K = 31;
constexpr int HD = 128, NHEADS = 12, AW = 1536, AOW = 512;
constexpr int OFF_Q = 2048, OFF_G = OFF_Q + 3 * AW, IN_COLS = OFF_G + 2 * D;
constexpr int QKVW = 3 * AW;
constexpr int PEER_H = 8, PEER_NK = 128, PEER_TOPK = 16, PEER_HK = PEER_H * PEER_TOPK;
constexpr int PEER_E = PEER_NK * PEER_NK;
constexpr int MODW = 6 * D;
constexpr float EPS = 1e-6f;
constexpr int NWAVES = 8, NTHREADS = NWAVES * 64;
#ifndef N_LAUNCH_MODE
#define N_LAUNCH_MODE 1
#endif
constexpr int NPHASES = 10;
#ifndef PROBE_EMASK
#define PROBE_EMASK 0xFFFFFFFFu
#endif
#ifndef PROBE_DUP
#define PROBE_DUP (-1)
#endif
#ifndef MFMA_MASK
#define MFMA_MASK 31
#endif
#ifndef P2_SPLIT
#define P2_SPLIT 0
#endif

constexpr size_t MiB = 1u << 20;
constexpr size_t WS_CTL = 0, CTL_ZERO_BYTES = 64 * 1024;
constexpr size_t WS_MOD = 1 * MiB;
constexpr size_t WS_SK = 1 * MiB + 512 * 1024;
constexpr size_t WS_WIN = 2 * MiB;
constexpr size_t WS_WCO = 44 * MiB;
constexpr size_t WS_WAO = 48 * MiB;
constexpr size_t WS_WOUT = 50 * MiB;
constexpr size_t WS_WQ = 58 * MiB;
constexpr size_t WS_WUP = 66 * MiB;
constexpr size_t WS_WDN = 130 * MiB;
constexpr size_t WS_SUP = 98 * MiB, WS_SDN = 98 * MiB + 65536;
constexpr size_t WS_H = 194 * MiB;
constexpr size_t WS_U = 226 * MiB;
constexpr size_t WS_SSQ = WS_U, WS_CVEC = WS_U + 2 * MiB;
constexpr size_t WS_QKV = 242 * MiB;
constexpr size_t WS_G = 314 * MiB;
constexpr size_t WS_UCV = 378 * MiB;
constexpr size_t WS_ON = 394 * MiB;
constexpr size_t WS_DEN = 418 * MiB;
constexpr size_t WS_O = 419 * MiB;
constexpr size_t WS_MERGED = 427 * MiB;
constexpr size_t WS_QP = 459 * MiB;
constexpr size_t WS_IDX = 491 * MiB;
constexpr size_t WS_GW = 495 * MiB;
constexpr size_t WS_END = 500 * MiB;
constexpr int CW_BAR = 4096;
constexpr int TK_W = 4;
constexpr int UP_TAIL_ROWS = 4096;
constexpr float MG_SCALE = 16.0f;
constexpr float WIN_SCALE = 256.0f;

constexpr int LDS_BYTES = 147456 + 512;
constexpr int RING_BYTES = 131072, MISC_OFF = 147456 + 64;

#define GAS __attribute__((address_space(1)))
#define LAS __attribute__((address_space(3)))
typedef unsigned short bf16;
typedef unsigned v4u __attribute__((ext_vector_type(4)));
typedef unsigned v2u __attribute__((ext_vector_type(2)));
typedef float f32x4 __attribute__((ext_vector_type(4)));
#define RLX_AGENT __ATOMIC_RELAXED, __HIP_MEMORY_SCOPE_AGENT

__device__ __forceinline__ unsigned f2bf(float f) { unsigned u = __builtin_bit_cast(unsigned, f); return (u + 0x7fffu + ((u >> 16) & 1u)) >> 16; }
__device__ __forceinline__ unsigned pk2(float lo, float hi) { return f2bf(lo) | (f2bf(hi) << 16); }
__device__ __forceinline__ float bf2f(unsigned b) { return __builtin_bit_cast(float, b << 16); }
__device__ __forceinline__ float bflo(unsigned w) { return __builtin_bit_cast(float, w << 16); }
__device__ __forceinline__ float bfhi(unsigned w) { return __builtin_bit_cast(float, w & 0xffff0000u); }
__device__ __forceinline__ float wave_sum(float v) {
#pragma unroll
    for (int o = 1; o < 64; o <<= 1) v += __shfl_xor(v, o);
    return v;
}
__device__ __forceinline__ float sigmoidf_(float x) { return 1.0f / (1.0f + __expf(-x)); }
__device__ __forceinline__ float siluf_(float x) { return x / (1.0f + __expf(-x)); }
__device__ __forceinline__ float gelu_erf(float x) { return 0.5f * x * (1.0f + erff(x * 0.70710678118654752f)); }

__device__ __forceinline__ int lane_id() { return (int)__builtin_amdgcn_mbcnt_hi(~0u, __builtin_amdgcn_mbcnt_lo(~0u, 0u)); }
#define XB_TMO      128
#define XB_XCNT(j)  (256  + 64 * (j))
#define XB_XSUB(j)  (1280 + 64 * (j))
#define XB_XGEN(j)  (2304 + 64 * (j))
#define XB_TOP      3328
#define XB_TOPGEN   3392
#define XCD_BAR_WORDS 3456
#define XB_SPIN_CAP (1u << 22)
__device__ __forceinline__ unsigned xb_ld(unsigned* p)              { return __hip_atomic_load(p, __ATOMIC_RELAXED, __HIP_MEMORY_SCOPE_AGENT); }
__device__ __forceinline__ unsigned xb_add(unsigned* p, unsigned v) { return __hip_atomic_fetch_add(p, v, __ATOMIC_RELAXED, __HIP_MEMORY_SCOPE_AGENT); }
__device__ __forceinline__ unsigned xb_xcc_id() { return (unsigned)__builtin_amdgcn_s_getreg((3 << 11) | 20) & 0xFu; }
#define XB_SPIN(cond, bar) do { unsigned _sp = 0; while (cond) { __builtin_amdgcn_s_sleep(1); \
    if ((++_sp & 255u) == 0u) { if (xb_ld(&(bar)[XB_TMO])) break; if (_sp > XB_SPIN_CAP) { atomicAdd(&(bar)[XB_TMO], 1u); break; } } } } while (0)
struct XcdBarrier { unsigned* bar; unsigned x; volatile LAS unsigned* st; int wave; };
__device__ __forceinline__ XcdBarrier xcd_barrier_post(unsigned* bar, volatile LAS unsigned* st) {
    XcdBarrier b; b.bar = bar; b.x = xb_xcc_id(); b.st = st; b.wave = 0;
    if (threadIdx.x == 0) (void)xb_add(&bar[XB_XCNT(b.x)], 1u);
    return b;
}
__device__ __forceinline__ void xcd_barrier_complete(unsigned* bar, unsigned x, unsigned& nloc, unsigned& nx) {
    const unsigned G = gridDim.x * gridDim.y * gridDim.z;
    unsigned sum, cnt, mine, sp = 0u;
    for (;;) {
        sum = 0u; cnt = 0u; mine = 0u;
#pragma unroll
        for (unsigned j = 0; j < 16; ++j) { const unsigned c = xb_ld(&bar[XB_XCNT(j)]); sum += c; cnt += (c > 0u) ? 1u : 0u; mine = (j == x) ? c : mine; }
        if (sum == G) break;
        __builtin_amdgcn_s_sleep(1);
        if ((++sp & 255u) == 0u) { if (xb_ld(&bar[XB_TMO])) break; if (sp > XB_SPIN_CAP) { atomicAdd(&bar[XB_TMO], 1u); break; } }
    }
    nloc = mine > 0u ? mine : 1u; nx = cnt > 0u ? cnt : 1u;
}
__device__ __forceinline__ void xcd_barrier(const XcdBarrier& b) {
    asm volatile("s_waitcnt vmcnt(0)" ::: "memory");
    __syncthreads();
    if (b.wave == 0 && lane_id() == 0) {
        unsigned* bar = b.bar;
        __builtin_amdgcn_s_waitcnt(0);
        unsigned nloc = b.st[0], nx = b.st[1];
        if (nloc == 0u) { xcd_barrier_complete(bar, b.x, nloc, nx); b.st[0] = nloc; b.st[1] = nx; }
        const unsigned old = xb_add(&bar[XB_XSUB(b.x)], 1u);
        const unsigned gen = old / nloc;
        if (old + 1u == (gen + 1u) * nloc) {
            __builtin_amdgcn_fence(__ATOMIC_RELEASE, "agent");
            asm volatile("s_waitcnt vmcnt(0)" ::: "memory");
            const unsigned og = xb_add(&bar[XB_TOP], 1u);
            const unsigned tg = og / nx;
            if (og + 1u == (tg + 1u) * nx) xb_add(&bar[XB_TOPGEN], 1u);
            else XB_SPIN(xb_ld(&bar[XB_TOPGEN]) == tg, bar);
            __builtin_amdgcn_fence(__ATOMIC_ACQUIRE, "agent");
            xb_add(&bar[XB_XGEN(b.x)], 1u);
            asm volatile("s_waitcnt vmcnt(0)" ::: "memory");
        } else {
            XB_SPIN(xb_ld(&bar[XB_XGEN(b.x)]) == gen, bar);
            __builtin_amdgcn_fence(__ATOMIC_ACQUIRE, "agent");
            asm volatile("s_waitcnt vmcnt(0)" ::: "memory");
        }
    }
    __syncthreads();
}

namespace pg8 {
#define PG8_LAS __attribute__((address_space(3)))
typedef unsigned short bf16_t;
typedef short bf16x8 __attribute__((ext_vector_type(8)));
typedef float f32x4 __attribute__((ext_vector_type(4)));
typedef unsigned u32x4 __attribute__((ext_vector_type(4)));
constexpr int BM = 256, BK = 64, HALF = 128, HTB = HALF * BK * 2  , STAGE_BYTES = 8 * HTB, NXCD = 8, WGM = 16;

__host__ __device__ __forceinline__ int lds_byte(int r, int c) { const int st = (r >> 4) * 2 + (c >> 5), rr = r & 15, cc = c & 31, ob = rr * 64 + cc * 2; return st * 1024 + (ob ^ (((ob >> 9) & 1) << 5)); }
__host__ __device__ __forceinline__ void stage_rc(int b, int& R, int& C) { const int st = b / 1024, sb = b % 1024, swz = sb ^ (((sb >> 9) & 1) << 5); R = (st >> 1) * 16 + swz / 64; C = (st & 1) * 32 + (swz % 64) / 2; }
__host__ __device__ __forceinline__ int perm32(int rho) { const int n = rho >> 4, i = rho & 15; return 8 * (i >> 2) + 4 * n + (i & 3); }

struct Unit { int pm, pn; };
struct Gemm { const bf16_t* A; const bf16_t* Bt; int M, N, K; };

struct StaticOrder {
    int nM, nN, nwg, G, c;
    __host__ __device__ void init(int M, int N, int G_, int c_) { nM = M / BM; nN = N / BM; nwg = nM * nN; G = G_; c = c_; }
    __host__ __device__ bool next(int i, Unit& u) const {
        const long L = (long)i * G + c; if (L >= nwg) return false;
        int wgid = (int)L; { const int q = nwg / NXCD, r = nwg % NXCD, xcd = wgid % NXCD, off = wgid / NXCD; wgid = (xcd < r ? xcd * (q + 1) : r * (q + 1) + (xcd - r) * q) + off; }
        const int nig = WGM * nN, gid = wgid / nig, fm = gid * WGM, gsz = (nM - fm) < WGM ? (nM - fm) : WGM;
        u.pm = fm + ((wgid % nig) % gsz); u.pn = (wgid % nig) / gsz; return true;
    }
    __device__ __forceinline__ void a_ready(const Unit&) const {}
    __device__ __forceinline__ void done(const Unit&) const {}
};

typedef float f32x2_t __attribute__((ext_vector_type(2))); typedef __bf16 bf16x2_t __attribute__((ext_vector_type(2)));
__device__ __forceinline__ unsigned cvt_pk_bf16(float lo, float hi) { f32x2_t v = {lo, hi}; bf16x2_t b = __builtin_convertvector(v, bf16x2_t); return __builtin_bit_cast(unsigned, b); }
typedef float f32x2 __attribute__((ext_vector_type(2)));
typedef int v8i_t __attribute__((ext_vector_type(8)));
struct Frag32 { bf16x8 lo, hi; };
template <class Epi, class Sched, bool ALIGN_EPI = false, bool SP2 = false, bool FP8 = false>
__device__ __forceinline__ void gemm_phase(PG8_LAS unsigned char* lds, const Gemm g, const Sched& S, const Epi& E, int wave_idx) {
    const int wid = wave_idx, lane = lane_id(), tid = wid * 64 + lane, wr = wid >> 2, wc = wid & 3, fr = lane & 15, fq = lane >> 4;
    const int K = g.K, nt = K / BK;
    unsigned voffA[2], voffB[2];
#pragma unroll
    for (int i = 0; i < 2; ++i) { int R, C; stage_rc(tid * 16 + i * 8192, R, C); const int Rb = Epi::PERM ? ((R & ~31) + perm32(R & 31)) : R;
        voffA[i] = (unsigned)(R * K + C) * 2u; voffB[i] = (unsigned)(Rb * K + C) * 2u; }
    const size_t kstep = (size_t)(BK * 2);
    const size_t hstep = (size_t)HALF * K * 2;
    const size_t tstep = 2 * hstep;
    const unsigned ldsw = (unsigned)wid * 1024u;
    const int aoff = lds_byte(wr * 64 + fr, fq * 8), boff = lds_byte(wc * 32 + fr, fq * 8);
#define PG8_SA(b, h) (((b) * 2 + (h)) * HTB)
#define PG8_SB(b, h) ((4 + (b) * 2 + (h)) * HTB)
#define PG8_STAGE(bufoff, gbase, voff) do { _Pragma("unroll") for (int _i = 0; _i < 2; ++_i) { unsigned vo_ = (voff)[_i]; asm volatile("" : "+v"(vo_));     \
        __builtin_amdgcn_global_load_lds((const unsigned*)((const char*)(gbase) + vo_), (PG8_LAS unsigned*)(lds + (bufoff) + ldsw + _i * 8192), 16, 0, 0); } } while (0)
#define PG8_LDA(dst, b, h) do { _Pragma("unroll") for (int m = 0; m < 4; ++m) { const bf16x8 lo_ = *(const PG8_LAS bf16x8*)(lds + PG8_SA(b, h) + aoff + m * 2048), hi_ = *(const PG8_LAS bf16x8*)(lds + PG8_SA(b, h) + aoff + m * 2048 + 1024); dst[m] = __builtin_bit_cast(v8i_t, (Frag32){lo_, hi_}); } } while (0)
#define PG8_LDB(dst, b, h) do { _Pragma("unroll") for (int n = 0; n < 2; ++n) { const bf16x8 lo_ = *(const PG8_LAS bf16x8*)(lds + PG8_SB(b, h) + boff + n * 2048), hi_ = *(const PG8_LAS bf16x8*)(lds + PG8_SB(b, h) + boff + n * 2048 + 1024); dst[n] = __builtin_bit_cast(v8i_t, (Frag32){lo_, hi_}); } } while (0)
#define PG8_MMA(ai, bj, At, Bt) do { __builtin_amdgcn_s_setprio(1); \
        if constexpr (FP8) { _Pragma("unroll") for (int m = 0; m < 4; ++m) _Pragma("unroll") for (int n = 0; n < 2; ++n) \
            acc[ai][bj][m][n] = __builtin_amdgcn_mfma_scale_f32_16x16x128_f8f6f4(Bt[n], At[m], acc[ai][bj][m][n], 0, 0, 0, 0x7F7F7F7F, 0, 0x7F7F7F7F); } \
        else { _Pragma("unroll") for (int m = 0; m < 4; ++m) _Pragma("unroll") for (int n = 0; n < 2; ++n) { const Frag32 fa_ = __builtin_bit_cast(Frag32, At[m]), fb_ = __builtin_bit_cast(Frag32, Bt[n]); \
            acc[ai][bj][m][n] = __builtin_amdgcn_mfma_f32_16x16x32_bf16(fb_.lo, fa_.lo, acc[ai][bj][m][n], 0, 0, 0); acc[ai][bj][m][n] = __builtin_amdgcn_mfma_f32_16x16x32_bf16(fb_.hi, fa_.hi, acc[ai][bj][m][n], 0, 0, 0); } } \
        __builtin_amdgcn_s_setprio(0); } while (0)
#define PG8_WAIT_V(n) asm volatile("s_waitcnt vmcnt(" #n ")" ::: "memory")
#define PG8_WAIT_L(n) asm volatile("s_waitcnt lgkmcnt(" #n ")" ::: "memory")
#define PG8_BAR __builtin_amdgcn_s_barrier()
#define PG8_SCHED __builtin_amdgcn_sched_barrier(0)
    Unit cur, nxt; int ui = 0;
    if (!S.next(0, cur)) return;
    f32x4 acc[2][2][4][2];
#pragma unroll
    for (int a = 0; a < 2; ++a)
#pragma unroll
        for (int b = 0; b < 2; ++b)
#pragma unroll
            for (int m = 0; m < 4; ++m)
#pragma unroll
                for (int n = 0; n < 2; ++n) acc[a][b][m][n] = (f32x4){0.f, 0.f, 0.f, 0.f};
    v8i_t At[4], B0[2], B1[2];
    const char* cA = (const char*)g.A + (size_t)cur.pm * tstep; const char* cB = (const char*)g.Bt + (size_t)cur.pn * tstep;
    S.a_ready(cur);
    if constexpr (SP2) {
        PG8_STAGE(PG8_SB(0, 0), cB, voffB); PG8_STAGE(PG8_SB(0, 1), cB + hstep, voffB); PG8_STAGE(PG8_SA(0, 0), cA, voffA); PG8_STAGE(PG8_SA(0, 1), cA + hstep, voffA);
        if (wr == 1) PG8_BAR;
        PG8_WAIT_V(2); PG8_BAR;
        PG8_STAGE(PG8_SB(1, 0), cB + kstep, voffB); PG8_STAGE(PG8_SA(1, 0), cA + kstep, voffA); PG8_STAGE(PG8_SB(1, 1), cB + hstep + kstep, voffB);
        PG8_WAIT_V(6); PG8_BAR;
    } else {
        PG8_STAGE(PG8_SB(0, 0), cB, voffB); PG8_STAGE(PG8_SA(0, 0), cA, voffA); PG8_STAGE(PG8_SB(0, 1), cB + hstep, voffB); PG8_STAGE(PG8_SA(0, 1), cA + hstep, voffA);
        if (wr == 1) PG8_BAR;
        PG8_WAIT_V(4); PG8_BAR;
        PG8_STAGE(PG8_SB(1, 0), cB + kstep, voffB); PG8_STAGE(PG8_SA(1, 0), cA + kstep, voffA); PG8_STAGE(PG8_SB(1, 1), cB + hstep + kstep, voffB);
        PG8_WAIT_V(6); PG8_BAR;
    }
    for (;;) {
        const bool has_next = S.next(ui + 1, nxt);
        const char* nA = has_next ? (const char*)g.A + (size_t)nxt.pm * tstep : cA; const char* nB = has_next ? (const char*)g.Bt + (size_t)nxt.pn * tstep : cB;
        for (int t = 0; t < nt; t += 2) {
            const bool last = (t == nt - 2);
            const char* a1 = cA + (size_t)(t + 1) * kstep;
            const char* a2 = last ? nA : cA + (size_t)(t + 2) * kstep; const char* b2 = last ? nB : cB + (size_t)(t + 2) * kstep;
            const char* a3 = a2 + kstep; const char* b3 = b2 + kstep;
            if (last && has_next) S.a_ready(nxt);
            if constexpr (SP2) {
            PG8_LDB(B0, 0, 0); PG8_LDB(B1, 0, 1); PG8_SCHED; PG8_LDA(At, 0, 0); PG8_STAGE(PG8_SA(1, 1), a1 + hstep, voffA);
            PG8_WAIT_V(8); PG8_WAIT_L(0); PG8_BAR; PG8_MMA(0, 0, At, B0); PG8_MMA(0, 1, At, B1); PG8_BAR; PG8_SCHED;
            PG8_LDA(At, 0, 1); PG8_STAGE(PG8_SB(0, 0), b2, voffB); PG8_STAGE(PG8_SB(0, 1), b2 + hstep, voffB); PG8_STAGE(PG8_SA(0, 0), a2, voffA);
            PG8_WAIT_V(8); PG8_WAIT_L(0); PG8_BAR; PG8_MMA(1, 0, At, B0); PG8_MMA(1, 1, At, B1); PG8_BAR; PG8_SCHED;
            PG8_LDB(B0, 1, 0); PG8_LDB(B1, 1, 1); PG8_SCHED; PG8_LDA(At, 1, 0); PG8_STAGE(PG8_SA(0, 1), a2 + hstep, voffA);
            PG8_WAIT_V(8); PG8_WAIT_L(0); PG8_BAR; PG8_MMA(0, 0, At, B0); PG8_MMA(0, 1, At, B1); PG8_BAR; PG8_SCHED;
            PG8_LDA(At, 1, 1); PG8_STAGE(PG8_SB(1, 0), b3, voffB); PG8_STAGE(PG8_SB(1, 1), b3 + hstep, voffB); PG8_STAGE(PG8_SA(1, 0), a3, voffA);
            PG8_WAIT_V(8); PG8_WAIT_L(0); PG8_BAR; PG8_MMA(1, 0, At, B0); PG8_MMA(1, 1, At, B1); PG8_BAR; PG8_SCHED;
            } else {
            PG8_LDB(B0, 0, 0); PG8_SCHED; PG8_LDA(At, 0, 0); PG8_STAGE(PG8_SA(1, 1), a1 + hstep, voffA);
            PG8_WAIT_L(8); PG8_BAR; PG8_WAIT_L(0); PG8_MMA(0, 0, At, B0); PG8_BAR; PG8_SCHED;
            PG8_LDB(B1, 0, 1); PG8_STAGE(PG8_SB(0, 0), b2, voffB);
            PG8_BAR; PG8_WAIT_L(0); PG8_MMA(0, 1, At, B1); PG8_BAR;
            PG8_LDA(At, 0, 1); PG8_STAGE(PG8_SA(0, 0), a2, voffA);
            PG8_BAR; PG8_WAIT_L(0); PG8_MMA(1, 0, At, B0); PG8_BAR; PG8_SCHED;
            PG8_STAGE(PG8_SB(0, 1), b2 + hstep, voffB);
            PG8_WAIT_V(6); PG8_BAR; PG8_MMA(1, 1, At, B1); PG8_BAR;
            PG8_LDB(B0, 1, 0); PG8_SCHED; PG8_LDA(At, 1, 0); PG8_STAGE(PG8_SA(0, 1), a2 + hstep, voffA);
            PG8_WAIT_L(8); PG8_BAR; PG8_WAIT_L(0); PG8_MMA(0, 0, At, B0); PG8_BAR; PG8_SCHED;
            PG8_LDB(B1, 1, 1); PG8_STAGE(PG8_SB(1, 0), b3, voffB);
            PG8_BAR; PG8_WAIT_L(0); PG8_MMA(0, 1, At, B1); PG8_BAR;
            PG8_LDA(At, 1, 1); PG8_STAGE(PG8_SA(1, 0), a3, voffA);
            PG8_BAR; PG8_WAIT_L(0); PG8_MMA(1, 0, At, B0); PG8_BAR; PG8_SCHED;
            PG8_STAGE(PG8_SB(1, 1), b3 + hstep, voffB);
            PG8_WAIT_V(6); PG8_BAR; PG8_MMA(1, 1, At, B1); PG8_BAR;
            }
        }
        if constexpr (ALIGN_EPI) { if (wr == 0) PG8_BAR; }
        if constexpr (!Epi::AFTER_DRAIN) { int l2_ = lane_id(); asm volatile("" : "+v"(l2_)); E(acc, cur, wr, wc, l2_ & 15, l2_ >> 4); S.done(cur); }
        if (!has_next) break;
#pragma unroll
        for (int a = 0; a < 2; ++a)
#pragma unroll
            for (int b = 0; b < 2; ++b)
#pragma unroll
                for (int m = 0; m < 4; ++m)
#pragma unroll
                    for (int n = 0; n < 2; ++n) acc[a][b][m][n] = (f32x4){0.f, 0.f, 0.f, 0.f};
        cur = nxt; cA = nA; cB = nB; ++ui;
        if constexpr (ALIGN_EPI) { if (wr == 1) PG8_BAR; }
    }
    PG8_WAIT_V(0);
    if constexpr (!ALIGN_EPI) { if (wr == 0) PG8_BAR; }
    PG8_BAR;
    if constexpr (Epi::AFTER_DRAIN) { E.fused(acc, cur, wr, wc, fr, fq, lds, wid, lane); S.done(cur); }
#undef PG8_SA
#undef PG8_SB
#undef PG8_STAGE
#undef PG8_LDA
#undef PG8_LDB
#undef PG8_MMA
#undef PG8_WAIT_V
#undef PG8_WAIT_L
#undef PG8_BAR
#undef PG8_SCHED
}
}

namespace pg8 {
__device__ __forceinline__ float fsig(float x) { return __builtin_amdgcn_rcpf(1.0f + __expf(-x)); }
__device__ __forceinline__ u32x4 pack8(const f32x4& v0, const f32x4& v1) { u32x4 w; w.x = cvt_pk_bf16(v0[0], v0[1]); w.y = cvt_pk_bf16(v0[2], v0[3]); w.z = cvt_pk_bf16(v1[0], v1[1]); w.w = cvt_pk_bf16(v1[2], v1[3]); return w; }
__device__ __forceinline__ float blo(unsigned w) { return __builtin_bit_cast(float, w << 16); }
__device__ __forceinline__ float bhi(unsigned w) { return __builtin_bit_cast(float, w & 0xffff0000u); }
struct EpiIn {
    static constexpr bool PERM = true, AFTER_DRAIN = false;
    bf16_t *U, *QKV, *G; int pn0; float osc;
    __device__ __forceinline__ void operator()(const f32x4 (&acc)[2][2][4][2], const Unit& u0, int wr, int wc, int fr, int fq) const {
        Unit u; u.pm = u0.pm; u.pn = u0.pn + pn0;
        const int row0 = u.pm * BM + wr * 64 + fr, cw = wc * 32 + 8 * fq;
        if (u.pn < 8) {
#pragma unroll
            for (int ai = 0; ai < 2; ++ai)
#pragma unroll
                for (int m = 0; m < 4; ++m) { const size_t row = row0 + ai * HALF + m * 16;
                    f32x4 v0 = acc[ai][0][m][0] * osc, v1 = acc[ai][0][m][1] * osc; const f32x4 g0 = acc[ai][1][m][0] * osc, g1 = acc[ai][1][m][1] * osc;
#pragma unroll
                    for (int e = 0; e < 4; ++e) { v0[e] *= fsig(g0[e]); v1[e] *= fsig(g1[e]); }
                    *(u32x4*)(U + row * 1024 + 128 * u.pn + cw) = pack8(v0, v1); }
        } else if (u.pn < 26) {
#pragma unroll
            for (int ai = 0; ai < 2; ++ai)
#pragma unroll
                for (int m = 0; m < 4; ++m) { const size_t row = row0 + ai * HALF + m * 16;
#pragma unroll
                    for (int bj = 0; bj < 2; ++bj) *(u32x4*)(QKV + row * 4608 + (u.pn - 8) * 256 + bj * HALF + cw) = pack8(acc[ai][bj][m][0] * osc, acc[ai][bj][m][1] * osc); }
        } else {
#pragma unroll
            for (int ai = 0; ai < 2; ++ai)
#pragma unroll
                for (int m = 0; m < 4; ++m) { const size_t row = row0 + ai * HALF + m * 16;
#pragma unroll
                    for (int bj = 0; bj < 2; ++bj) { f32x4 v0 = acc[ai][bj][m][0] * osc, v1 = acc[ai][bj][m][1] * osc;
#pragma unroll
                        for (int e = 0; e < 4; ++e) { v0[e] = fsig(v0[e]); v1[e] = fsig(v1[e]); }
                        int p0 = __builtin_amdgcn_cvt_pk_fp8_f32(v0[0], v0[1], 0, false); p0 = __builtin_amdgcn_cvt_pk_fp8_f32(v0[2], v0[3], p0, true);
                        int p1 = __builtin_amdgcn_cvt_pk_fp8_f32(v1[0], v1[1], 0, false); p1 = __builtin_amdgcn_cvt_pk_fp8_f32(v1[2], v1[3], p1, true);
                        typedef unsigned u32x2g_ __attribute__((ext_vector_type(2)));
                        *(u32x2g_*)((unsigned char*)G + row * 4096 + (u.pn - 26) * 256 + bj * HALF + cw) = (u32x2g_){(unsigned)p0, (unsigned)p1}; } }
        }
    }
};
__device__ __forceinline__ void ld_gate8(const bf16_t* G, size_t byteoff, float (&g)[8]) {
    typedef unsigned u32x2h_ __attribute__((ext_vector_type(2))); typedef float f2h_ __attribute__((ext_vector_type(2)));
    const u32x2h_ w = *(const u32x2h_*)((const unsigned char*)G + byteoff);
    const f2h_ a = __builtin_amdgcn_cvt_pk_f32_fp8((int)w.x, false), b = __builtin_amdgcn_cvt_pk_f32_fp8((int)w.x, true), c = __builtin_amdgcn_cvt_pk_f32_fp8((int)w.y, false), d = __builtin_amdgcn_cvt_pk_f32_fp8((int)w.y, true);
    g[0] = a.x; g[1] = a.y; g[2] = b.x; g[3] = b.y; g[4] = c.x; g[5] = c.y; g[6] = d.x; g[7] = d.y;
}
struct EpiYconv {
    static constexpr bool PERM = true, AFTER_DRAIN = false;
    const bf16_t* G; bf16_t* MG; const float* bias;
    __device__ __forceinline__ void operator()(const f32x4 (&acc)[2][2][4][2], const Unit& u, int wr, int wc, int fr, int fq) const {
        const int row0 = u.pm * BM + wr * 64 + fr, cw = wc * 32 + 8 * fq;
#pragma unroll
        for (int bj = 0; bj < 2; ++bj) { const int col = u.pn * 256 + bj * HALF + cw; const f32x4 b0 = *(const f32x4*)(bias + col), b1 = *(const f32x4*)(bias + col + 4);
#pragma unroll
            for (int ai = 0; ai < 2; ++ai)
#pragma unroll
                for (int m = 0; m < 4; ++m) { const size_t row = row0 + ai * HALF + m * 16;
                    float g[8]; ld_gate8(G, row * 4096 + col, g);
                    f32x4 v0 = acc[ai][bj][m][0] + b0, v1 = acc[ai][bj][m][1] + b1;
                    v0[0] *= g[0]; v0[1] *= g[1]; v0[2] *= g[2]; v0[3] *= g[3]; v1[0] *= g[4]; v1[1] *= g[5]; v1[2] *= g[6]; v1[3] *= g[7];
                    *(u32x4*)(MG + row * 2048 + col) = pack8(v0, v1); } }
    }
};
struct EpiYattn {
    static constexpr bool PERM = true, AFTER_DRAIN = false;
    const bf16_t* G; const bf16_t* MG; unsigned char* MG8; float msc;
    __device__ __forceinline__ void operator()(const f32x4 (&acc)[2][2][4][2], const Unit& u, int wr, int wc, int fr, int fq) const {
        const int row0 = u.pm * BM + wr * 64 + fr, cw = wc * 32 + 8 * fq;
#pragma unroll
        for (int ai = 0; ai < 2; ++ai)
#pragma unroll
            for (int m = 0; m < 4; ++m) { const size_t row = row0 + ai * HALF + m * 16;
#pragma unroll
                for (int bj = 0; bj < 2; ++bj) { const int col = u.pn * 256 + bj * HALF + cw; float g[8]; ld_gate8(G, row * 4096 + 2048 + col, g); const u32x4 p = *(const u32x4*)(MG + row * 2048 + col);
                    f32x4 v0 = acc[ai][bj][m][0], v1 = acc[ai][bj][m][1];
                    v0[0] = (blo(p.x) + v0[0] * g[0]) * msc; v0[1] = (bhi(p.x) + v0[1] * g[1]) * msc; v0[2] = (blo(p.y) + v0[2] * g[2]) * msc; v0[3] = (bhi(p.y) + v0[3] * g[3]) * msc;
                    v1[0] = (blo(p.z) + v1[0] * g[4]) * msc; v1[1] = (bhi(p.z) + v1[1] * g[5]) * msc; v1[2] = (blo(p.w) + v1[2] * g[6]) * msc; v1[3] = (bhi(p.w) + v1[3] * g[7]) * msc;
                    int p0 = __builtin_amdgcn_cvt_pk_fp8_f32(v0[0], v0[1], 0, false); p0 = __builtin_amdgcn_cvt_pk_fp8_f32(v0[2], v0[3], p0, true);
                    int p1 = __builtin_amdgcn_cvt_pk_fp8_f32(v1[0], v1[1], 0, false); p1 = __builtin_amdgcn_cvt_pk_fp8_f32(v1[2], v1[3], p1, true);
                    typedef unsigned u32x2_ __attribute__((ext_vector_type(2))); *(u32x2_*)(MG8 + row * 2048 + col) = (u32x2_){(unsigned)p0, (unsigned)p1}; } }
    }
};
struct EpiOut {
    static constexpr bool PERM = true, AFTER_DRAIN = false;
    const float* x; const float* mod; const float* g2; float* out; bf16_t* XA; float* SSQ; float osc;
    __device__ __forceinline__ void operator()(const f32x4 (&acc)[2][2][4][2], const Unit& u, int wr, int wc, int fr, int fq) const {
        const int row0 = u.pm * BM + wr * 64 + fr, cw = wc * 32 + 8 * fq; const int b = (u.pm * BM) / 4096;
        float ss[2][4];
#pragma unroll
        for (int ai = 0; ai < 2; ++ai)
#pragma unroll
            for (int m = 0; m < 4; ++m) ss[ai][m] = 0.f;
#pragma unroll
        for (int bj = 0; bj < 2; ++bj) { const int col = u.pn * 256 + bj * HALF + cw;
            const f32x4 gt0 = *(const f32x4*)(mod + b * 12288 + 2 * 2048 + col) * osc, gt1 = *(const f32x4*)(mod + b * 12288 + 2 * 2048 + col + 4) * osc;
            const f32x4 a0 = *(const f32x4*)(g2 + col) * (*(const f32x4*)(mod + b * 12288 + 4 * 2048 + col) + 1.0f), a1 = *(const f32x4*)(g2 + col + 4) * (*(const f32x4*)(mod + b * 12288 + 4 * 2048 + col + 4) + 1.0f);
#pragma unroll
            for (int ai = 0; ai < 2; ++ai)
#pragma unroll
                for (int m = 0; m < 4; ++m) { const size_t off = (size_t)(row0 + ai * HALF + m * 16) * 2048 + col;
                    const f32x4 y0 = *(const f32x4*)(x + off) + gt0 * acc[ai][bj][m][0], y1 = *(const f32x4*)(x + off + 4) + gt1 * acc[ai][bj][m][1];
                    *(f32x4*)(out + off) = y0; *(f32x4*)(out + off + 4) = y1;
                    ss[ai][m] += ((y0.x * y0.x + y0.y * y0.y) + (y0.z * y0.z + y0.w * y0.w)) + ((y1.x * y1.x + y1.y * y1.y) + (y1.z * y1.z + y1.w * y1.w));
                    *(u32x4*)(XA + off) = pack8(y0 * a0, y1 * a1); } }
#pragma unroll
        for (int ai = 0; ai < 2; ++ai)
#pragma unroll
            for (int m = 0; m < 4; ++m) { float s_ = ss[ai][m]; s_ += __shfl_xor(s_, 16); s_ += __shfl_xor(s_, 32);
                if (fq == 0) SSQ[(size_t)(row0 + ai * HALF + m * 16) * 32 + u.pn * 4 + wc] = s_; }
    }
};
struct EpiQ {
    static constexpr bool PERM = true, AFTER_DRAIN = false;
    bf16_t* O; const float* SSQ; const float* cvec;
    __device__ __forceinline__ void operator()(const f32x4 (&acc)[2][2][4][2], const Unit& u, int wr, int wc, int fr, int fq) const {
        const int row0 = u.pm * BM + wr * 64 + fr, cw = u.pn * BM + wc * 32 + 8 * fq; const int b = (u.pm * BM) / 4096;
        float rs[2][4];
#pragma unroll
        for (int ai = 0; ai < 2; ++ai)
#pragma unroll
            for (int m = 0; m < 4; ++m) { const float* pp = SSQ + (size_t)(row0 + ai * HALF + m * 16) * 32 + 8 * fq; const f32x4 p0 = *(const f32x4*)pp, p1 = *(const f32x4*)(pp + 4);
                float s_ = ((p0.x + p0.y) + (p0.z + p0.w)) + ((p1.x + p1.y) + (p1.z + p1.w)); s_ += __shfl_xor(s_, 16); s_ += __shfl_xor(s_, 32);
                rs[ai][m] = rsqrtf(s_ * (1.0f / 2048.0f) + 1e-6f); }
#pragma unroll
        for (int bj = 0; bj < 2; ++bj) { const f32x4 c0 = *(const f32x4*)(cvec + b * 2048 + bj * HALF + cw), c1 = *(const f32x4*)(cvec + b * 2048 + bj * HALF + cw + 4);
#pragma unroll
            for (int ai = 0; ai < 2; ++ai)
#pragma unroll
                for (int m = 0; m < 4; ++m) { const size_t row = row0 + ai * HALF + m * 16;
                    *(u32x4*)(O + row * 2048 + bj * HALF + cw) = pack8(acc[ai][bj][m][0] * rs[ai][m] + c0, acc[ai][bj][m][1] * rs[ai][m] + c1); } }
    }
};
struct EpiPlain {
    static constexpr bool PERM = true, AFTER_DRAIN = false;
    bf16_t* O; int ldc;
    __device__ __forceinline__ void operator()(const f32x4 (&acc)[2][2][4][2], const Unit& u, int wr, int wc, int fr, int fq) const {
        const int row0 = u.pm * BM + wr * 64 + fr, cw = u.pn * BM + wc * 32 + 8 * fq;
#pragma unroll
        for (int ai = 0; ai < 2; ++ai)
#pragma unroll
            for (int m = 0; m < 4; ++m) { const size_t row = row0 + ai * HALF + m * 16;
#pragma unroll
                for (int bj = 0; bj < 2; ++bj) *(u32x4*)(O + row * ldc + bj * HALF + cw) = pack8(acc[ai][bj][m][0], acc[ai][bj][m][1]); }
    }
};
}

struct Args { const float* in[21]; float* out; unsigned char* ws; int ph_lo, ph_hi; };
enum { I_X = 0, I_C, I_N1G, I_N2G, I_WADA, I_BADA, I_WIN, I_CDW, I_CDB, I_CLNG, I_CLNB, I_WCO, I_BCO, I_QNG, I_KNG, I_WAO, I_WOUT, I_PWQ, I_PSK, I_PWUP, I_PWDN };

struct Ctx {
    int tid, lane, wave, bid, nb, gw, ngw;
    unsigned char* lds;
};

__device__ __forceinline__ int win_row(int n) {
    if (n < 1024) return (n >> 7) * 256 + (n & 127);
    if (n < 2048) { const int m = n - 1024; return (m >> 7) * 256 + 128 + (m & 127); }
    return n;
}
__device__ __forceinline__ void p0_transpose_item(const float* W, int K, int N, bf16* WT, bool perm, float* scr, int item, int lane) {
    const int nblk = N / 32, kb = item / nblk, nbi = item % nblk, k0 = 64 * kb, n0 = 32 * nbi;
    { f32x4 v_[8];
#pragma unroll
      for (int i = 0; i < 8; ++i) v_[i] = *(const f32x4*)(W + (size_t)(k0 + (lane >> 3) + 8 * i) * N + n0 + 4 * (lane & 7));
#pragma unroll
      for (int i = 0; i < 8; ++i) { float* d_ = scr + ((lane >> 3) + 8 * i) * 33 + 4 * (lane & 7); d_[0] = v_[i].x; d_[1] = v_[i].y; d_[2] = v_[i].z; d_[3] = v_[i].w; } }
    asm volatile("s_waitcnt lgkmcnt(0)" ::: "memory");
    const int c = lane & 7;
    const int r0 = perm ? win_row(n0) : n0;
#pragma unroll
    for (int j = 0; j < 4; ++j) { const int n = (lane >> 3) + 8 * j; const float* s = scr + (8 * c) * 33 + n;
        v4u o; o.x = pk2(s[0 * 33], s[1 * 33]); o.y = pk2(s[2 * 33], s[3 * 33]); o.z = pk2(s[4 * 33], s[5 * 33]); o.w = pk2(s[6 * 33], s[7 * 33]);
        *(v4u*)(WT + (size_t)(r0 + n) * K + k0 + 8 * c) = o; }
    asm volatile("s_waitcnt lgkmcnt(0)" ::: "memory");
}

__device__ __forceinline__ void p0_transpose_item_fp8(const float* W, int K, int N, unsigned char* WT, bool perm, float* scr, int item, int lane, float wsc) {
    const int nblk = N / 32, kb = item / nblk, nbi = item % nblk, k0 = 64 * kb, n0 = 32 * nbi;
    { f32x4 v_[8];
#pragma unroll
      for (int i = 0; i < 8; ++i) v_[i] = *(const f32x4*)(W + (size_t)(k0 + (lane >> 3) + 8 * i) * N + n0 + 4 * (lane & 7));
#pragma unroll
      for (int i = 0; i < 8; ++i) { float* d_ = scr + ((lane >> 3) + 8 * i) * 33 + 4 * (lane & 7); d_[0] = v_[i].x * wsc; d_[1] = v_[i].y * wsc; d_[2] = v_[i].z * wsc; d_[3] = v_[i].w * wsc; } }
    asm volatile("s_waitcnt lgkmcnt(0)" ::: "memory");
    const int c = lane & 3;
    const int r0 = perm ? win_row(n0) : n0;
#pragma unroll
    for (int j = 0; j < 2; ++j) { const int n = (lane >> 2) + 16 * j; const float* s = scr + (16 * c) * 33 + n; v4u o; unsigned* op = (unsigned*)&o;
#pragma unroll
        for (int q = 0; q < 4; ++q) { int p = __builtin_amdgcn_cvt_pk_fp8_f32(s[(4 * q) * 33], s[(4 * q + 1) * 33], 0, false);
            p = __builtin_amdgcn_cvt_pk_fp8_f32(s[(4 * q + 2) * 33], s[(4 * q + 3) * 33], p, true); op[q] = (unsigned)p; }
        *(v4u*)(WT + (size_t)(r0 + n) * K + k0 + 16 * c) = o; }
    asm volatile("s_waitcnt lgkmcnt(0)" ::: "memory");
}
__device__ __forceinline__ void cvt_stream(const float* src, bf16* dst, size_t n, const Ctx& C) {
    const size_t nv = n / 8;
    for (size_t i = (size_t)C.gw * 64 + C.lane; i < nv; i += (size_t)C.ngw * 64) {
        const f32x4 a = *(const f32x4*)(src + i * 8), b = *(const f32x4*)(src + i * 8 + 4);
        v4u o; o.x = pk2(a.x, a.y); o.y = pk2(a.z, a.w); o.z = pk2(b.x, b.y); o.w = pk2(b.z, b.w);
        *(v4u*)(dst + i * 8) = o;
    }
}

typedef float f2v __attribute__((ext_vector_type(2)));

__device__ __forceinline__ unsigned pack_i8x4(float a, float b, float c, float d) {
    const int ia = (int)rintf(a), ib = (int)rintf(b), ic = (int)rintf(c), id = (int)rintf(d);
    return ((unsigned)ia & 255u) | (((unsigned)ib & 255u) << 8) | (((unsigned)ic & 255u) << 16) | ((unsigned)id << 24);
}

struct RowCvt { f32x4 v[2][4]; };
__device__ __forceinline__ void rc_issue(RowCvt& rc, const float* src, int row, int lane) {
    const float* sp = src + (size_t)row * D + 16 * lane;
#pragma unroll
    for (int j = 0; j < 2; ++j)
#pragma unroll
        for (int q = 0; q < 4; ++q) rc.v[j][q] = *(const f32x4*)(sp + 1024 * j + 4 * q);
}
__device__ __forceinline__ float rc_amax(const RowCvt& rc) {
    float am = 0.f;
#pragma unroll
    for (int j = 0; j < 2; ++j)
#pragma unroll
        for (int q = 0; q < 4; ++q) am = fmaxf(am, fmaxf(fmaxf(fabsf(rc.v[j][q].x), fabsf(rc.v[j][q].y)), fmaxf(fabsf(rc.v[j][q].z), fabsf(rc.v[j][q].w))));
#pragma unroll
    for (int o = 1; o < 64; o <<= 1) am = fmaxf(am, __shfl_xor(am, o));
    return am;
}
__device__ __forceinline__ void rc_finish_fp8(const RowCvt& rc, unsigned char* dst, float* inv, int row, int lane) {
    const float am = rc_amax(rc);
    const int ex = (int)((__builtin_bit_cast(unsigned, am) >> 23) & 255u);
    const float sc = (ex == 0) ? 1.0f : __builtin_bit_cast(float, (unsigned)(127 + 7 + 127 - ex) << 23);
    const float isc = (ex == 0) ? 1.0f : __builtin_bit_cast(float, (unsigned)(ex - 7) << 23);
#pragma unroll
    for (int j = 0; j < 2; ++j) { v4u o; unsigned* op = (unsigned*)&o;
#pragma unroll
        for (int q = 0; q < 4; ++q) { int p = __builtin_amdgcn_cvt_pk_fp8_f32(rc.v[j][q].x * sc, rc.v[j][q].y * sc, 0, false);
            p = __builtin_amdgcn_cvt_pk_fp8_f32(rc.v[j][q].z * sc, rc.v[j][q].w * sc, p, true); op[q] = (unsigned)p; }
        *(v4u*)(dst + (size_t)row * D + 16 * lane + 1024 * j) = o; }
    if (lane == 0) inv[row] = isc;
}
__device__ __forceinline__ void rc_finish_i8(const RowCvt& rc, unsigned char* dst, float* inv, int row, int lane) {
    const float am = rc_amax(rc);
    const float sc = (am > 0.f) ? 127.0f / am : 0.f;
#pragma unroll
    for (int j = 0; j < 2; ++j) { v4u o;
        o.x = pack_i8x4(rc.v[j][0].x * sc, rc.v[j][0].y * sc, rc.v[j][0].z * sc, rc.v[j][0].w * sc); o.y = pack_i8x4(rc.v[j][1].x * sc, rc.v[j][1].y * sc, rc.v[j][1].z * sc, rc.v[j][1].w * sc);
        o.z = pack_i8x4(rc.v[j][2].x * sc, rc.v[j][2].y * sc, rc.v[j][2].z * sc, rc.v[j][2].w * sc); o.w = pack_i8x4(rc.v[j][3].x * sc, rc.v[j][3].y * sc, rc.v[j][3].z * sc, rc.v[j][3].w * sc);
        *(v4u*)(dst + (size_t)row * D + 16 * lane + 1024 * j) = o; }
    if (lane == 0) inv[row] = am * (1.0f / 127.0f);
}
__device__ __forceinline__ void phase_prologue(const Args& A, const Ctx& C) {
    unsigned char* ws = A.ws;
    float* mod = (float*)(ws + WS_MOD);
    {
        float* red = (float*)C.lds;
        const float* w_ada = A.in[I_WADA]; const float* cv = A.in[I_C];
        for (int it = C.bid; it < MODW / 48; it += C.nb) {
            const int c4 = C.tid % 12, kg = C.tid / 12;
            f32x4 a0 = {0.f, 0.f, 0.f, 0.f}, a1 = {0.f, 0.f, 0.f, 0.f};
            if (C.tid < 504) {
                for (int k = kg; k < D; k += 42) {
                    const f32x4 w = *(const f32x4*)(w_ada + (size_t)k * MODW + 48 * it + 4 * c4);
                    const float s0 = siluf_(cv[k]), s1 = siluf_(cv[D + k]);
                    a0 += w * s0; a1 += w * s1;
                }
                float* r = red + kg * 96 + c4 * 4;
                r[0] = a0.x; r[1] = a0.y; r[2] = a0.z; r[3] = a0.w;
                r[48 + 0] = a1.x; r[48 + 1] = a1.y; r[48 + 2] = a1.z; r[48 + 3] = a1.w;
            }
            __syncthreads();
            if (C.tid < 96) {
                float s = 0.f;
                for (int g = 0; g < 42; ++g) s += red[g * 96 + C.tid];
                const int b = C.tid / 48, col = 48 * it + (C.tid % 48);
                mod[b * MODW + col] = s + A.in[I_BADA][col];
            }
            __syncthreads();
        }
    }
    {
        float* scr = (float*)(C.lds + C.wave * 16384);
        constexpr int I_IN = (D / 64) * (IN_COLS / 32);
        for (int it = C.gw; it < I_IN; it += C.ngw) p0_transpose_item_fp8(A.in[I_WIN], D, IN_COLS, ws + WS_WIN, true, scr, it, C.lane, WIN_SCALE);
    }
    cvt_stream(A.in[I_PSK], (bf16*)(ws + WS_SK), (size_t)16 * 128 * 128, C);
}


__device__ __forceinline__ void late_transposes(const Args& A, const Ctx& C, unsigned char* ldsbase, int w0, int nw) {
    unsigned char* ws = A.ws;
    float* scr = (float*)(ldsbase + C.wave * 16384);
    int lane = lane_id(); asm volatile("" : "+v"(lane));
    constexpr int I_CO = (CONV_CH / 64) * (D / 32), I_AO = (AOW / 64) * (D / 32), I_OUT = (D / 64) * (D / 32), I_Q = I_OUT;
    constexpr int NITEMS = I_CO + I_AO + I_OUT + I_Q;
    for (int it = w0; it < NITEMS; it += nw) {
        int r = it;
        if (r < I_CO) { p0_transpose_item(A.in[I_WCO], CONV_CH, D, (bf16*)(ws + WS_WCO), false, scr, r, lane); continue; } r -= I_CO;
        if (r < I_AO) { p0_transpose_item(A.in[I_WAO], AOW, D, (bf16*)(ws + WS_WAO), false, scr, r, lane); continue; } r -= I_AO;
        if (r < I_OUT) { p0_transpose_item_fp8(A.in[I_WOUT], D, D, ws + WS_WOUT, false, scr, r, lane, WIN_SCALE); continue; } r -= I_OUT;
        p0_transpose_item(A.in[I_PWQ], D, D, (bf16*)(ws + WS_WQ), false, scr, r, lane);
    }
    { RowCvt rc; for (int row = w0; row < UP_TAIL_ROWS; row += nw) { rc_issue(rc, A.in[I_PWUP], row, lane); rc_finish_i8(rc, ws + WS_WUP, (float*)(ws + WS_SUP), row, lane); } }
}
template <bool FP8OUT>
__device__ __forceinline__ void norm_mod_store(const f32x4 (&v)[8], float ss, int m, const float* gn, const float* mod, int shift_i, int scale_i, bf16* hout, int lane) {
    const float rstd = 1.0f / sqrtf(ss * (1.0f / D) + EPS);
    const int b = m / SEQ;
    const f32x4* gp = (const f32x4*)gn; const f32x4* sc = (const f32x4*)(mod + b * MODW + scale_i * D); const f32x4* sh = (const f32x4*)(mod + b * MODW + shift_i * D);
    v2u* o = (v2u*)(hout + (size_t)m * D); unsigned* o8 = (unsigned*)((unsigned char*)hout + (size_t)m * D);
#pragma unroll
    for (int j = 0; j < 8; ++j) { const int q = lane + 64 * j; const f32x4 g = gp[q], s = sc[q], h = sh[q];
        const f32x4 y = v[j] * rstd * g * (s + 1.0f) + h;
        if constexpr (FP8OUT) { int p = __builtin_amdgcn_cvt_pk_fp8_f32(y.x, y.y, 0, false); p = __builtin_amdgcn_cvt_pk_fp8_f32(y.z, y.w, p, true); o8[q] = (unsigned)p; }
        else { v2u w; w.x = pk2(y.x, y.y); w.y = pk2(y.z, y.w); o[q] = w; } }
}
template <bool FP8OUT>
__device__ __forceinline__ void phase_norm_mod(const float* xin, const float* gn, const float* mod, int shift_i, int scale_i, bf16* hout, const Ctx& C) {
    for (int m = C.gw; m < T; m += 2 * C.ngw) {
        const int m2 = m + C.ngw; const bool has2 = m2 < T;
        const f32x4* xr = (const f32x4*)(xin + (size_t)m * D); const f32x4* xr2 = (const f32x4*)(xin + (size_t)(has2 ? m2 : m) * D);
        f32x4 v[8], v2[8]; float ss = 0.f, ss2 = 0.f;
#pragma unroll
        for (int j = 0; j < 8; ++j) v[j] = xr[C.lane + 64 * j];
#pragma unroll
        for (int j = 0; j < 8; ++j) v2[j] = xr2[C.lane + 64 * j];
#pragma unroll
        for (int j = 0; j < 8; ++j) { ss += (v[j].x * v[j].x + v[j].y * v[j].y) + (v[j].z * v[j].z + v[j].w * v[j].w); ss2 += (v2[j].x * v2[j].x + v2[j].y * v2[j].y) + (v2[j].z * v2[j].z + v2[j].w * v2[j].w); }
#pragma unroll
        for (int o = 1; o < 64; o <<= 1) { ss += __shfl_xor(ss, o); ss2 += __shfl_xor(ss2, o); }
        norm_mod_store<FP8OUT>(v, ss, m, gn, mod, shift_i, scale_i, hout, C.lane);
        if (has2) norm_mod_store<FP8OUT>(v2, ss2, m2, gn, mod, shift_i, scale_i, hout, C.lane);
    }
}

__device__ __forceinline__ unsigned f2ord(float f) { const unsigned u = __builtin_bit_cast(unsigned, f); return u ^ ((u >> 31) ? 0xFFFFFFFFu : 0x80000000u); }
__device__ __forceinline__ float ord2f(unsigned u) { return __builtin_bit_cast(float, (u & 0x80000000u) ? (u ^ 0x80000000u) : ~u); }
template <int CTRL> __device__ __forceinline__ unsigned dpp_u(unsigned x) { return (unsigned)__builtin_amdgcn_update_dpp(0, (int)x, CTRL, 0xF, 0xF, false); }
__device__ __forceinline__ unsigned rowmax_u(unsigned x) {
    x = max(x, dpp_u<0x128>(x)); x = max(x, dpp_u<0x124>(x)); x = max(x, dpp_u<0x122>(x)); x = max(x, dpp_u<0x121>(x)); return x; }
__device__ __forceinline__ float rowsum_f(float x) {
    x += __builtin_bit_cast(float, dpp_u<0x128>(__builtin_bit_cast(unsigned, x))); x += __builtin_bit_cast(float, dpp_u<0x124>(__builtin_bit_cast(unsigned, x)));
    x += __builtin_bit_cast(float, dpp_u<0x122>(__builtin_bit_cast(unsigned, x))); x += __builtin_bit_cast(float, dpp_u<0x121>(__builtin_bit_cast(unsigned, x))); return x; }
#define CE_DESC(a, b) do { const unsigned _hi = max(a, b), _lo = min(a, b); a = _hi; b = _lo; } while (0)
__device__ __forceinline__ void phase_topk(const Args& A, const Ctx& C) {
    const bf16* QP = (const bf16*)(A.ws + WS_QP); const bf16* SK = (const bf16*)(A.ws + WS_SK);
    int* IDX = (int*)(A.ws + WS_IDX); float* GW = (float*)(A.ws + WS_GW);
    const int lane = C.lane, i = lane & 15, g = lane >> 4;
    if (C.wave >= TK_W) {
        const int cw = C.bid * (NWAVES - TK_W) + (C.wave - TK_W), ncw = C.nb * (NWAVES - TK_W); RowCvt ra, rb;
        for (int row = UP_TAIL_ROWS + cw; row < 2 * PEER_E; row += 2 * ncw) {
            const int row2 = row + ncw; const bool has2 = row2 < 2 * PEER_E;
            rc_issue(ra, row < PEER_E ? A.in[I_PWUP] : A.in[I_PWDN], row < PEER_E ? row : row - PEER_E, lane);
            if (has2) rc_issue(rb, row2 < PEER_E ? A.in[I_PWUP] : A.in[I_PWDN], row2 < PEER_E ? row2 : row2 - PEER_E, lane);
            if (row < PEER_E) rc_finish_i8(ra, A.ws + WS_WUP, (float*)(A.ws + WS_SUP), row, lane); else rc_finish_fp8(ra, A.ws + WS_WDN, (float*)(A.ws + WS_SDN), row - PEER_E, lane);
            if (has2) { if (row2 < PEER_E) rc_finish_i8(rb, A.ws + WS_WUP, (float*)(A.ws + WS_SUP), row2, lane); else rc_finish_fp8(rb, A.ws + WS_WDN, (float*)(A.ws + WS_SDN), row2 - PEER_E, lane); }
        }
        return;
    }
    int crow = 2 * PEER_E; RowCvt rc;
#define CV_ISSUE() do { asm volatile("" ::: "memory"); if (crow < 2 * PEER_E) rc_issue(rc, crow < PEER_E ? A.in[I_PWUP] : A.in[I_PWDN], crow < PEER_E ? crow : crow - PEER_E, lane); } while (0)
#define CV_FINISH() do { if (crow < 2 * PEER_E) { if (crow < PEER_E) rc_finish_i8(rc, A.ws + WS_WUP, (float*)(A.ws + WS_SUP), crow, lane); \
        else rc_finish_fp8(rc, A.ws + WS_WDN, (float*)(A.ws + WS_SDN), crow - PEER_E, lane); crow += C.ngw; } asm volatile("" ::: "memory"); } while (0)
    for (int it = C.bid * TK_W + C.wave; it < (T / 16) * PEER_H; it += C.nb * TK_W) {
        const int tile = it >> 3, t0 = tile * 16; int h = it & 7; asm volatile("" : "+s"(h));
        unsigned win[2][4];
#pragma unroll
        for (int p = 0; p < 2; ++p) {
            const int slot = 2 * h + p;
            pg8::bf16x8 aq[4];
#pragma unroll
            for (int ks = 0; ks < 4; ++ks) aq[ks] = *(const pg8::bf16x8*)(QP + (size_t)(t0 + i) * D + slot * 128 + 32 * ks + 8 * g);
            unsigned K[4][8];
#pragma unroll
            for (int nt = 0; nt < 8; ++nt) {
                f32x4 acc = {0.f, 0.f, 0.f, 0.f};
                const bf16* kr = SK + ((size_t)slot * 128 + 16 * nt + i) * 128 + 8 * g;
#pragma unroll
                for (int ks = 0; ks < 4; ++ks) acc = __builtin_amdgcn_mfma_f32_16x16x32_bf16(aq[ks], *(const pg8::bf16x8*)(kr + 32 * ks), acc, 0, 0, 0);
#pragma unroll
                for (int r = 0; r < 4; ++r) K[r][nt] = (f2ord(acc[r]) & ~127u) | (unsigned)(127 - (16 * nt + i));
            }
#pragma unroll
            for (int r = 0; r < 4; ++r) {
                CV_ISSUE();
                unsigned* k = K[r];
                CE_DESC(k[0], k[1]); CE_DESC(k[2], k[3]); CE_DESC(k[4], k[5]); CE_DESC(k[6], k[7]);
                CE_DESC(k[0], k[2]); CE_DESC(k[1], k[3]); CE_DESC(k[4], k[6]); CE_DESC(k[5], k[7]);
                CE_DESC(k[1], k[2]); CE_DESC(k[5], k[6]);
                CE_DESC(k[0], k[4]); CE_DESC(k[1], k[5]); CE_DESC(k[2], k[6]); CE_DESC(k[3], k[7]);
                CE_DESC(k[2], k[4]); CE_DESC(k[3], k[5]);
                CE_DESC(k[1], k[2]); CE_DESC(k[3], k[4]); CE_DESC(k[5], k[6]);
                unsigned w = 0u;
#pragma unroll
                for (int kk = 0; kk < PEER_TOPK; ++kk) {
                    const unsigned M = rowmax_u(k[0]);
                    const bool pop = (k[0] == M);
#pragma unroll
                    for (int q = 0; q < 7; ++q) k[q] = pop ? k[q + 1] : k[q];
                    k[7] = pop ? 0u : k[7];
                    w = (i == kk) ? M : w;
                }
                win[p][r] = w;
                CV_FINISH();
            }
        }
#pragma unroll
        for (int r = 0; r < 4; ++r) {
            CV_ISSUE();
            const float v1 = ord2f(win[0][r] & ~127u), v2 = ord2f(win[1][r] & ~127u);
            int j = 0;
            float nv = __builtin_bit_cast(float, __builtin_amdgcn_ds_bpermute(4 * (16 * g), __builtin_bit_cast(int, v2)));
            unsigned key = (f2ord(v1 + nv) & ~255u) | (unsigned)(255 - 16 * i);
            unsigned w = 0u; float mx = 0.f;
#pragma unroll
            for (int kk = 0; kk < PEER_TOPK; ++kk) {
                const unsigned M = rowmax_u(key);
                if (kk == 0) mx = ord2f(M & ~255u);
                const bool pop = (key == M);
                j += pop ? 1 : 0;
                const int jj = j < 15 ? j : 15;
                nv = __builtin_bit_cast(float, __builtin_amdgcn_ds_bpermute(4 * (16 * g + jj), __builtin_bit_cast(int, v2)));
                const unsigned nk = (j < 16) ? ((f2ord(v1 + nv) & ~255u) | (unsigned)(255 - (16 * i + jj))) : 0u;
                key = pop ? nk : key;
                w = (i == kk) ? M : w;
            }
            const int ci = 255 - (int)(w & 255u);
            const int n1 = 127 - (int)(win[0][r] & 127u), n2 = 127 - (int)(win[1][r] & 127u);
            const int e1 = __builtin_amdgcn_ds_bpermute(4 * (16 * g + (ci >> 4)), n1), e2 = __builtin_amdgcn_ds_bpermute(4 * (16 * g + (ci & 15)), n2);
            const float ex = __expf(ord2f(w & ~255u) - mx);
            const float sum = rowsum_f(ex);
            const size_t o = (size_t)(t0 + 4 * g + r) * PEER_HK + h * PEER_TOPK + i;
            IDX[o] = e1 * PEER_NK + e2; GW[o] = ex / sum;
            CV_FINISH();
        }
    }
    while (crow < 2 * PEER_E) { CV_ISSUE(); CV_FINISH(); }
#undef CV_ISSUE
#undef CV_FINISH
}

typedef __bf16 bf16x2v __attribute__((ext_vector_type(2)));
__device__ __forceinline__ float dot2bf(unsigned w, unsigned x, float acc) { return __builtin_amdgcn_fdot2_f32_bf16(__builtin_bit_cast(bf16x2v, w), __builtin_bit_cast(bf16x2v, x), acc, false); }
__device__ __forceinline__ f2v fp8lo(unsigned w) { return __builtin_amdgcn_cvt_pk_f32_fp8((int)w, false); }
__device__ __forceinline__ f2v fp8hi(unsigned w) { return __builtin_amdgcn_cvt_pk_f32_fp8((int)w, true); }
constexpr int EXB = 8;


constexpr int EX_LDS_WAVE = 4 * 4096 + 2048;
typedef __bf16 bf16x2w __attribute__((ext_vector_type(2)));
__device__ __forceinline__ float gelu_as(float v) {
    const float av = fabsf(v), t = __builtin_amdgcn_rcpf(av * 0.2316419f + 1.0f);
    float q = t * 0.5307027145f + (-0.7265760135f); q = q * t + 0.7107068705f; q = q * t + (-0.142248368f); q = q * t + 0.127414796f; q = q * t;
    const float e = __builtin_amdgcn_exp2f((v * v) * (-0.72134752044f));
    const float m = v * (q * e);
    return v < 0.f ? m : v - m;
}
__device__ __forceinline__ v4u ldrow16(const unsigned char* sbase, unsigned voff) { return *(const v4u*)(sbase + voff); }
__device__ __forceinline__ v2u ldrow8(const unsigned char* sbase, unsigned voff) { return *(const v2u*)(sbase + voff); }
__device__ __forceinline__ int dot16_i8(const v4u w0, const v4u h0) {
    int s0 = __builtin_amdgcn_sdot4((int)w0.x, (int)h0.x, 0, false), s1 = __builtin_amdgcn_sdot4((int)w0.y, (int)h0.y, 0, false);
    s0 = __builtin_amdgcn_sdot4((int)w0.z, (int)h0.z, s0, false); s1 = __builtin_amdgcn_sdot4((int)w0.w, (int)h0.w, s1, false);
    return s0 + s1;
}
__device__ __forceinline__ int dot32_i8(const v4u w0, const v4u h0, const v4u w1, const v4u h1) {
    int s0 = __builtin_amdgcn_sdot4((int)w0.x, (int)h0.x, 0, false), s1 = __builtin_amdgcn_sdot4((int)w0.y, (int)h0.y, 0, false);
    s0 = __builtin_amdgcn_sdot4((int)w0.z, (int)h0.z, s0, false); s1 = __builtin_amdgcn_sdot4((int)w0.w, (int)h0.w, s1, false);
    s0 = __builtin_amdgcn_sdot4((int)w1.x, (int)h1.x, s0, false); s1 = __builtin_amdgcn_sdot4((int)w1.y, (int)h1.y, s1, false);
    s0 = __builtin_amdgcn_sdot4((int)w1.z, (int)h1.z, s0, false); s1 = __builtin_amdgcn_sdot4((int)w1.w, (int)h1.w, s1, false);
    return s0 + s1;
}
__device__ __forceinline__ float dot2_f2v_bf16(f2v a, unsigned h, float s) { return __builtin_amdgcn_fdot2_f32_bf16(__builtin_convertvector(a, bf16x2w), __builtin_bit_cast(bf16x2w, h), s, false); }
__device__ __forceinline__ float dot16_fp8_bf16(const v4u w, const v4u ha, const v4u hb, float s) {
#define D2(W, HI, H) s = dot2_f2v_bf16((HI) ? fp8hi(W) : fp8lo(W), H, s)
    D2(w.x, 0, ha.x); D2(w.x, 1, ha.y); D2(w.y, 0, ha.z); D2(w.y, 1, ha.w); D2(w.z, 0, hb.x); D2(w.z, 1, hb.y); D2(w.w, 0, hb.z); D2(w.w, 1, hb.w);
#undef D2
    return s;
}
#define EX_AXPY(ACC, W0, W1, CC) do { \
    ACC[0][0] = __builtin_elementwise_fma(fp8lo((W0).x), CC, ACC[0][0]); ACC[0][1] = __builtin_elementwise_fma(fp8hi((W0).x), CC, ACC[0][1]); \
    ACC[0][2] = __builtin_elementwise_fma(fp8lo((W0).y), CC, ACC[0][2]); ACC[0][3] = __builtin_elementwise_fma(fp8hi((W0).y), CC, ACC[0][3]); \
    ACC[0][4] = __builtin_elementwise_fma(fp8lo((W0).z), CC, ACC[0][4]); ACC[0][5] = __builtin_elementwise_fma(fp8hi((W0).z), CC, ACC[0][5]); \
    ACC[0][6] = __builtin_elementwise_fma(fp8lo((W0).w), CC, ACC[0][6]); ACC[0][7] = __builtin_elementwise_fma(fp8hi((W0).w), CC, ACC[0][7]); \
    ACC[1][0] = __builtin_elementwise_fma(fp8lo((W1).x), CC, ACC[1][0]); ACC[1][1] = __builtin_elementwise_fma(fp8hi((W1).x), CC, ACC[1][1]); \
    ACC[1][2] = __builtin_elementwise_fma(fp8lo((W1).y), CC, ACC[1][2]); ACC[1][3] = __builtin_elementwise_fma(fp8hi((W1).y), CC, ACC[1][3]); \
    ACC[1][4] = __builtin_elementwise_fma(fp8lo((W1).z), CC, ACC[1][4]); ACC[1][5] = __builtin_elementwise_fma(fp8hi((W1).z), CC, ACC[1][5]); \
    ACC[1][6] = __builtin_elementwise_fma(fp8lo((W1).w), CC, ACC[1][6]); ACC[1][7] = __builtin_elementwise_fma(fp8hi((W1).w), CC, ACC[1][7]); } while (0)
__device__ __forceinline__ void phase_experts3(const Args& A, const Ctx& C, float* dst, unsigned emask) {
    const bf16* H2 = (const bf16*)(A.ws + WS_H); const unsigned char* WUP = A.ws + WS_WUP; const unsigned char* WDN = A.ws + WS_WDN;
    const float* SUP = (const float*)(A.ws + WS_SUP); const float* SDN = (const float*)(A.ws + WS_SDN);
    const int* IDX = (const int*)(A.ws + WS_IDX); const float* GW = (const float*)(A.ws + WS_GW); const float* mod = (const float*)(A.ws + WS_MOD);
    LAS unsigned char* hb = (LAS unsigned char*)C.lds + C.wave * EX_LDS_WAVE;
    LAS unsigned* keys = (LAS unsigned*)(hb + 8192);
    for (int tg = C.gw; tg < T / 4; tg += C.ngw) {
        unsigned z_ = 0u; asm volatile("" : "+v"(z_));
        int lane = (int)__builtin_amdgcn_mbcnt_hi(~0u, __builtin_amdgcn_mbcnt_lo(~0u, z_));
        const int t0 = 4 * tg;
        float hs4[4];
        {
          float rs4[4]; float sv[2][16];
          { const float* SSQ = (const float*)(A.ws + WS_SSQ);
            float sa = SSQ[(size_t)(t0 + (lane >> 5)) * 32 + (lane & 31)], sb = SSQ[(size_t)(t0 + 2 + (lane >> 5)) * 32 + (lane & 31)];
#pragma unroll
            for (int o = 1; o < 32; o <<= 1) { sa += __shfl_xor(sa, o); sb += __shfl_xor(sb, o); }
            const float q0 = __builtin_bit_cast(float, __builtin_amdgcn_readlane(__builtin_bit_cast(int, sa), 0)), q1 = __builtin_bit_cast(float, __builtin_amdgcn_readlane(__builtin_bit_cast(int, sa), 32));
            const float q2 = __builtin_bit_cast(float, __builtin_amdgcn_readlane(__builtin_bit_cast(int, sb), 0)), q3 = __builtin_bit_cast(float, __builtin_amdgcn_readlane(__builtin_bit_cast(int, sb), 32));
            rs4[0] = 1.0f / sqrtf(q0 * (1.0f / D) + EPS); rs4[1] = 1.0f / sqrtf(q1 * (1.0f / D) + EPS); rs4[2] = 1.0f / sqrtf(q2 * (1.0f / D) + EPS); rs4[3] = 1.0f / sqrtf(q3 * (1.0f / D) + EPS);
            const float* sh = mod + (t0 / SEQ) * 12288 + 3 * 2048;
#pragma unroll
            for (int j = 0; j < 2; ++j)
#pragma unroll
                for (int q4 = 0; q4 < 4; ++q4) { const f32x4 v_ = *(const f32x4*)(sh + 16 * lane + 1024 * j + 4 * q4); sv[j][4 * q4] = v_.x; sv[j][4 * q4 + 1] = v_.y; sv[j][4 * q4 + 2] = v_.z; sv[j][4 * q4 + 3] = v_.w; } }
#pragma unroll
          for (int tk = 0; tk < 4; ++tk) {
              float hv[2][16]; float am = 0.f;
#pragma unroll
              for (int j = 0; j < 2; ++j) { const v4u a = *(const v4u*)(H2 + (size_t)(t0 + tk) * D + 16 * lane + 1024 * j), b = *(const v4u*)(H2 + (size_t)(t0 + tk) * D + 16 * lane + 1024 * j + 8);
                  hv[j][0] = bflo(a.x); hv[j][1] = bfhi(a.x); hv[j][2] = bflo(a.y); hv[j][3] = bfhi(a.y); hv[j][4] = bflo(a.z); hv[j][5] = bfhi(a.z); hv[j][6] = bflo(a.w); hv[j][7] = bfhi(a.w);
                  hv[j][8] = bflo(b.x); hv[j][9] = bfhi(b.x); hv[j][10] = bflo(b.y); hv[j][11] = bfhi(b.y); hv[j][12] = bflo(b.z); hv[j][13] = bfhi(b.z); hv[j][14] = bflo(b.w); hv[j][15] = bfhi(b.w);
#pragma unroll
                  for (int q = 0; q < 16; ++q) { hv[j][q] = hv[j][q] * rs4[tk] + sv[j][q]; am = fmaxf(am, fabsf(hv[j][q])); } }
#pragma unroll
              for (int o = 1; o < 64; o <<= 1) am = fmaxf(am, __shfl_xor(am, o));
              const float sc = (am > 0.f) ? 127.0f / am : 0.f; hs4[tk] = am * (1.0f / 127.0f);
#pragma unroll
              for (int j = 0; j < 2; ++j) { v4u o;
                  o.x = pack_i8x4(hv[j][0] * sc, hv[j][1] * sc, hv[j][2] * sc, hv[j][3] * sc); o.y = pack_i8x4(hv[j][4] * sc, hv[j][5] * sc, hv[j][6] * sc, hv[j][7] * sc);
                  o.z = pack_i8x4(hv[j][8] * sc, hv[j][9] * sc, hv[j][10] * sc, hv[j][11] * sc); o.w = pack_i8x4(hv[j][12] * sc, hv[j][13] * sc, hv[j][14] * sc, hv[j][15] * sc);
                  *(LAS v4u*)(hb + tk * 2048 + 16 * lane + 1024 * j) = o; } }
        }
        LAS unsigned* keysM = keys + 512;
        LAS float* cfl = (LAS float*)(keys + 1024);
        unsigned K[8];
#pragma unroll
        for (int s = 0; s < 8; ++s) { const int tk = s >> 1, slot = lane + 64 * (s & 1); const unsigned e = (unsigned)IDX[(size_t)(t0 + tk) * PEER_HK + slot];
            K[s] = ((unsigned)tk << 21) | (e << 7) | (unsigned)slot; }
#define EX_SORT512(KK) do { _Pragma("unroll") for (int k = 2; k <= 512; k <<= 1) { _Pragma("unroll") for (int j = k >> 1; j >= 1; j >>= 1) { \
            if (j >= 64) { const int ds = j >> 6; _Pragma("unroll") for (int s = 0; s < 8; ++s) if ((s & ds) == 0) { const bool up = ((64 * s) & k) == 0; \
                    const unsigned a_ = min(KK[s], KK[s | ds]), b_ = max(KK[s], KK[s | ds]); KK[s] = up ? a_ : b_; KK[s | ds] = up ? b_ : a_; } } \
            else { const bool lower = (lane & j) == 0; _Pragma("unroll") for (int s = 0; s < 8; ++s) { const unsigned o = __shfl_xor(KK[s], j); const bool up = ((lane + 64 * s) & k) == 0; \
                    KK[s] = (up == lower) ? min(KK[s], o) : max(KK[s], o); } } } } } while (0)
        EX_SORT512(K);
#pragma unroll
        for (int s = 0; s < 8; ++s) { const int p = lane + 64 * s; keys[(p & 127) * 4 + (p >> 7)] = K[s]; }
        asm volatile("" : "+v"(lane));
#pragma unroll
        for (int s = 0; s < 8; ++s) { const int tk = s >> 1, slot = lane + 64 * (s & 1); const unsigned e = (unsigned)IDX[(size_t)(t0 + tk) * PEER_HK + slot];
            K[s] = (e << 9) | ((unsigned)tk << 7) | (unsigned)slot; }
        EX_SORT512(K);
#pragma unroll
        for (int s = 0; s < 8; ++s) keysM[lane + 64 * s] = K[s];
#undef EX_SORT512
        asm volatile("s_waitcnt lgkmcnt(0)" ::: "memory");
        asm volatile("" : "+v"(lane));
        constexpr int EX_NB = 128;
        {
            const int gq_ = lane >> 4, li_ = lane & 15;
            v4u bw[2][8]; unsigned kcur = keysM[gq_];
#define EX_UP_LD(KW, BUF) do { const unsigned char* r_ = WUP + (size_t)(((KW) >> 9) & emask) * D + 16 * li_; \
            _Pragma("unroll") for (int q_ = 0; q_ < 8; ++q_) bw[BUF][q_] = *(const v4u*)(r_ + 256 * q_); } while (0)
#define EX_UP_STEP(B, CUR) do { \
            const unsigned knext = keysM[4 * (((B) + 1 < EX_NB) ? (B) + 1 : (B)) + gq_]; \
            EX_UP_LD(knext, (CUR) ^ 1); \
            const unsigned me = kcur >> 9, mtok = (kcur >> 7) & 3u, mslot = kcur & 127u; \
            const float gg = GW[(size_t)(t0 + (int)mtok) * PEER_HK + mslot], su = SUP[me], sd = SDN[me]; \
            LAS unsigned char* hr = hb + mtok * 2048 + 16 * li_; int s0_ = 0, s1_ = 0; \
            _Pragma("unroll") for (int q_ = 0; q_ < 8; q_ += 2) { const v4u h0 = *(LAS v4u*)(hr + 256 * q_), h1 = *(LAS v4u*)(hr + 256 * q_ + 256); \
                s0_ += dot16_i8(bw[CUR][q_], h0); s1_ += dot16_i8(bw[CUR][q_ + 1], h1); } \
            unsigned s_ = (unsigned)(s0_ + s1_); \
            s_ += dpp_u<0x128>(s_); s_ += dpp_u<0x124>(s_); s_ += dpp_u<0x122>(s_); s_ += dpp_u<0x121>(s_);            \
            const float hs_ = (mtok == 0u) ? hs4[0] : (mtok == 1u) ? hs4[1] : (mtok == 2u) ? hs4[2] : hs4[3]; \
            cfl[mtok * 128u + mslot] = gg * sd * gelu_as((float)(int)s_ * su * hs_); \
            kcur = knext; } while (0)
            EX_UP_LD(kcur, 0);
            for (int b = 0; b < EX_NB; b += 2) { EX_UP_STEP(b, 0); EX_UP_STEP(b + 1, 1); }
#undef EX_UP_LD
#undef EX_UP_STEP
        }
        asm volatile("s_waitcnt lgkmcnt(0)" ::: "memory");
        asm volatile("" : "+v"(lane));
        const int bb = t0 / SEQ;
        constexpr int EX_DB = 2;
        LAS unsigned* rowT = keys + 1536;
        LAS float* cfT = (LAS float*)(keys + 2048);
#pragma unroll
        for (int s = 0; s < 8; ++s) { const int q_ = lane + 64 * s; const unsigned kk_ = keys[q_]; const unsigned e_ = ((kk_ >> 7) & 16383u) & emask;
            rowT[q_] = e_ * (unsigned)D; cfT[q_] = cfl[(q_ & 3) * 128 + (int)(kk_ & 127u)]; }
        asm volatile("s_waitcnt lgkmcnt(0)" ::: "memory");
#define EX_AXPY1(ACC, W0, CC) do { \
    ACC[0] = __builtin_elementwise_fma(fp8lo((W0).x), CC, ACC[0]); ACC[1] = __builtin_elementwise_fma(fp8hi((W0).x), CC, ACC[1]); \
    ACC[2] = __builtin_elementwise_fma(fp8lo((W0).y), CC, ACC[2]); ACC[3] = __builtin_elementwise_fma(fp8hi((W0).y), CC, ACC[3]); } while (0)
#define EX_RO(W) ((unsigned)__builtin_amdgcn_readfirstlane((int)(W)))
#define EX_DN_LD(J, BQ, BUF) do { _Pragma("unroll") for (int bb_ = 0; bb_ < EX_DB; ++bb_) { const v4u rv = *(LAS v4u*)(rowT + 4 * ((BQ) + bb_)); \
            bd[BUF][bb_][0] = ldrow8(WDN + EX_RO(rv.x), voff_ + 512u * (J)); bd[BUF][bb_][1] = ldrow8(WDN + EX_RO(rv.y), voff_ + 512u * (J)); \
            bd[BUF][bb_][2] = ldrow8(WDN + EX_RO(rv.z), voff_ + 512u * (J)); bd[BUF][bb_][3] = ldrow8(WDN + EX_RO(rv.w), voff_ + 512u * (J)); } } while (0)
#define EX_DN_STEP(J, B, CUR) do { \
            EX_DN_LD(J, (((B) + EX_DB < EX_NB) ? (B) + EX_DB : (B)), (CUR) ^ 1); \
            _Pragma("unroll") for (int bb_ = 0; bb_ < EX_DB; ++bb_) { const f32x4 cv = *(LAS f32x4*)(cfT + 4 * ((B) + bb_)); \
                { const f2v cc = {cv.x, cv.x}; EX_AXPY1(a0, bd[CUR][bb_][0], cc); } \
                { const f2v cc = {cv.y, cv.y}; EX_AXPY1(a1, bd[CUR][bb_][1], cc); } \
                { const f2v cc = {cv.z, cv.z}; EX_AXPY1(a2, bd[CUR][bb_][2], cc); } \
                { const f2v cc = {cv.w, cv.w}; EX_AXPY1(a3, bd[CUR][bb_][3], cc); } } } while (0)
#define EX_OUT1(TK, ACC, J) do { _Pragma("unroll") for (int q = 0; q < 2; ++q) { const int col = 8 * lane + 512 * (J) + 4 * q; \
            const f32x4 g = *(const f32x4*)(mod + bb * MODW + 5 * D + col); f32x4 x = *(const f32x4*)(A.out + (size_t)(t0 + TK) * D + col); \
            x.x += g.x * ACC[2 * q].x; x.y += g.y * ACC[2 * q].y; x.z += g.z * ACC[2 * q + 1].x; x.w += g.w * ACC[2 * q + 1].y; *(f32x4*)(dst + (size_t)(t0 + TK) * D + col) = x; } } while (0)
#define EX_DN_PASS(J) do { v2u bd[2][EX_DB][4]; const unsigned voff_ = 8u * (unsigned)lane; f2v a0[4], a1[4], a2[4], a3[4]; \
            _Pragma("unroll") for (int q = 0; q < 4; ++q) { a0[q] = (f2v){0.f, 0.f}; a1[q] = (f2v){0.f, 0.f}; a2[q] = (f2v){0.f, 0.f}; a3[q] = (f2v){0.f, 0.f}; } \
            EX_DN_LD(J, 0, 0); \
            for (int b = 0; b < EX_NB; b += 2 * EX_DB) { EX_DN_STEP(J, b, 0); EX_DN_STEP(J, b + EX_DB, 1); } \
            EX_OUT1(0, a0, J); EX_OUT1(1, a1, J); EX_OUT1(2, a2, J); EX_OUT1(3, a3, J); } while (0)
        EX_DN_PASS(0);
        asm volatile("" : "+v"(lane));
        EX_DN_PASS(1);
        asm volatile("" : "+v"(lane));
        EX_DN_PASS(2);
        asm volatile("" : "+v"(lane));
        EX_DN_PASS(3);
#undef EX_DN_PASS
#undef EX_DN_LD
#undef EX_RO
#undef EX_DN_STEP
#undef EX_AXPY1
#undef EX_OUT1
        asm volatile("s_waitcnt lgkmcnt(0)" ::: "memory");
    }
}

constexpr int CONV_TT = 16;
__device__ __forceinline__ void wave_reduce16(float (&v)[16], int lane) {
    const bool b5 = lane & 32, b4 = lane & 16, b3 = lane & 8, b2 = lane & 4;
#pragma unroll
    for (int k = 0; k < 8; ++k) { const float keep = b5 ? v[k + 8] : v[k], send = b5 ? v[k] : v[k + 8]; v[k] = keep + __shfl_xor(send, 32); }
#pragma unroll
    for (int k = 0; k < 4; ++k) { const float keep = b4 ? v[k + 4] : v[k], send = b4 ? v[k] : v[k + 4]; v[k] = keep + __shfl_xor(send, 16); }
#pragma unroll
    for (int k = 0; k < 2; ++k) { const float keep = b3 ? v[k + 2] : v[k], send = b3 ? v[k] : v[k + 2]; v[k] = keep + __shfl_xor(send, 8); }
    { const float keep = b2 ? v[1] : v[0], send = b2 ? v[0] : v[1]; v[0] = keep + __shfl_xor(send, 4); }
    v[0] += __shfl_xor(v[0], 2); v[0] += __shfl_xor(v[0], 1);
}
__device__ __forceinline__ void phase_conv(const Args& A, const Ctx& C) {
    const bf16* U = (const bf16*)(A.ws + WS_U); bf16* UCV = (bf16*)(A.ws + WS_UCV);
    const float* dw = A.in[I_CDW]; const float* db = A.in[I_CDB]; const float* lg = A.in[I_CLNG]; const float* lb = A.in[I_CLNB];
    LAS float* red = (LAS float*)((LAS unsigned char*)C.lds);
    const int c0 = 2 * C.tid, lane = C.lane;
    float w0[CONV_K], w1[CONV_K];
#pragma unroll
    for (int j = 0; j < CONV_K; ++j) { const float2 w = *(const float2*)(dw + j * CONV_CH + c0); w0[j] = w.x; w1[j] = w.y; }
    const float2 bias = *(const float2*)(db + c0), gam = *(const float2*)(lg + c0), bet = *(const float2*)(lb + c0);
    const int tsel = ((lane >> 5) & 1) * 8 + ((lane >> 4) & 1) * 4 + ((lane >> 3) & 1) * 2 + ((lane >> 2) & 1);
    for (int it = C.bid; it < T / CONV_TT; it += C.nb) {
        const int t0 = it * CONV_TT, s0 = t0 % SEQ;
        unsigned in[CONV_TT + CONV_K - 1];
#pragma unroll
        for (int q = 0; q < CONV_TT + CONV_K - 1; ++q) { const int sp = s0 - (CONV_K - 1) + q;
            in[q] = (sp >= 0) ? *(const unsigned*)(U + (size_t)(t0 - (CONV_K - 1) + q) * CONV_CH + c0) : 0u; }
        float a0[CONV_TT], a1[CONV_TT];
#pragma unroll
        for (int k = 0; k < CONV_TT; ++k) { float x0 = bias.x, x1 = bias.y;
#pragma unroll
            for (int j = 0; j < CONV_K; ++j) { x0 += w0[j] * bflo(in[k + j]); x1 += w1[j] * bfhi(in[k + j]); }
            a0[k] = x0; a1[k] = x1; }
        float v[16];
#pragma unroll
        for (int k = 0; k < 16; ++k) v[k] = a0[k] + a1[k];
        wave_reduce16(v, lane);
        __syncthreads();
        if ((lane & 3) == 0) red[C.wave * 16 + tsel] = v[0];
        __syncthreads();
        float mean[16];
#pragma unroll
        for (int k = 0; k < 16; ++k) { float s = 0.f;
#pragma unroll
            for (int wv = 0; wv < NWAVES; ++wv) s += red[wv * 16 + k];
            mean[k] = s * (1.0f / CONV_CH); }
#pragma unroll
        for (int k = 0; k < 16; ++k) { a0[k] -= mean[k]; a1[k] -= mean[k]; v[k] = a0[k] * a0[k] + a1[k] * a1[k]; }
        wave_reduce16(v, lane);
        __syncthreads();
        if ((lane & 3) == 0) red[C.wave * 16 + tsel] = v[0];
        __syncthreads();
#pragma unroll
        for (int k = 0; k < 16; ++k) { float s = 0.f;
#pragma unroll
            for (int wv = 0; wv < NWAVES; ++wv) s += red[wv * 16 + k];
            const float rstd = 1.0f / sqrtf(s * (1.0f / CONV_CH) + EPS);
            const float y0 = a0[k] * rstd * gam.x + bet.x, y1 = a1[k] * rstd * gam.y + bet.y;
            *(unsigned*)(UCV + (size_t)(t0 + k) * CONV_CH + c0) = pk2(siluf_(y0), siluf_(y1)); }
    }
    __syncthreads();
}

typedef short v4i16_t __attribute__((ext_vector_type(4)));
constexpr int VROW = 288;
constexpr int ATT_V_BYTES = 256 * VROW;
constexpr int KROW = 272;
constexpr int ATT_K_OFF = ATT_V_BYTES;
constexpr int ATT_SCR_OFF = ATT_V_BYTES + 256 * KROW;
constexpr int ATT_RK_OFF = ATT_SCR_OFF + NWAVES * 256;
__device__ __forceinline__ void phase_attn(const Args& A, const Ctx& C) {
    const bf16* QKV = (const bf16*)(A.ws + WS_QKV); bf16* ON = (bf16*)(A.ws + WS_ON); float* DEN = (float*)(A.ws + WS_DEN);
    const float* qg = A.in[I_QNG]; const float* kg = A.in[I_KNG];
    LAS unsigned char* Vb = (LAS unsigned char*)C.lds;
    LAS unsigned char* Kb = Vb + ATT_K_OFF;
    LAS float* scr = (LAS float*)(Vb + ATT_SCR_OFF + C.wave * 256);
    LAS float* rkt = (LAS float*)(Vb + ATT_RK_OFF);
    unsigned z0_ = 0u; asm volatile("" : "+v"(z0_));
    const int lane = (int)__builtin_amdgcn_mbcnt_hi(~0u, __builtin_amdgcn_mbcnt_lo(~0u, z0_)), c = lane & 15, kq = lane >> 4, w = C.wave, i0 = 16 * w;
    constexpr float C2 = 0.08838834764831845f * 1.4426950408889634f;
#define ATT_DECODE(U, B_, GI_, HH_, R_, N_, DIL_) const int B_ = (U) / 384, GI_ = ((U) % 384) >> 7; const int DIL_ = (GI_ == 0) ? 1 : (GI_ == 1) ? 4 : 16; \
        const int nbk##B_ = (GI_ == 0) ? 32 : (GI_ == 1) ? 8 : 2; const int rem2##B_ = ((U) % 384) & 127; const int HH_ = rem2##B_ / (DIL_ * nbk##B_), r2##B_ = rem2##B_ % (DIL_ * nbk##B_), R_ = r2##B_ / nbk##B_, N_ = r2##B_ % nbk##B_;
#define ATT_LOAD(KD, VD, QD, RB_, N_, DIL_, HEAD_) do { unsigned zz_ = 0u; asm volatile("" : "+v"(zz_)); const int tid_ = C.wave * 64 + (int)__builtin_amdgcn_mbcnt_hi(~0u, __builtin_amdgcn_mbcnt_lo(~0u, zz_)); const int lb_ = 128 * (N_) - 128; \
        _Pragma("unroll") for (int k_ = 0; k_ < 8; ++k_) { const int idx_ = tid_ + NTHREADS * k_; int l_ = lb_ + (idx_ >> 4); l_ = l_ < 0 ? 0 : l_; \
            const bf16* rp_ = QKV + ((RB_) + (size_t)l_ * (DIL_)) * QKVW + (HEAD_) * HD + (idx_ & 15) * 8; KD[k_] = *(const v4u*)(rp_ + AW); VD[k_] = *(const v4u*)(rp_ + 2 * AW); } \
        { const bf16* qrow_ = QKV + ((RB_) + (size_t)(128 * (N_) + i0 + (tid_ & 15)) * (DIL_)) * QKVW + (HEAD_) * HD + 8 * ((tid_ & 63) >> 4); \
          _Pragma("unroll") for (int ks_ = 0; ks_ < 4; ++ks_) QD[ks_] = *(const v4u*)(qrow_ + 32 * ks_); } } while (0)
#define ATT_STORE(KD, VD) do { unsigned zz_ = 0u; asm volatile("" : "+v"(zz_)); const int tid_ = C.wave * 64 + (int)__builtin_amdgcn_mbcnt_hi(~0u, __builtin_amdgcn_mbcnt_lo(~0u, zz_)); _Pragma("unroll") for (int k_ = 0; k_ < 8; ++k_) { const int idx_ = tid_ + NTHREADS * k_; \
            *(LAS v4u*)(Kb + (idx_ >> 4) * KROW + (idx_ & 15) * 16) = KD[k_]; *(LAS v4u*)(Vb + (idx_ >> 4) * VROW + (idx_ & 15) * 16) = VD[k_]; \
            { const v4u k4 = KD[k_]; const float a0 = bflo(k4.x), a1 = bfhi(k4.x), a2 = bflo(k4.y), a3 = bfhi(k4.y), a4 = bflo(k4.z), a5 = bfhi(k4.z), a6 = bflo(k4.w), a7 = bfhi(k4.w); \
              const float ssr_ = rowsum_f((a0 * a0 + a1 * a1) + (a2 * a2 + a3 * a3) + (a4 * a4 + a5 * a5) + (a6 * a6 + a7 * a7));        \
              rkt[idx_ >> 4] = C2 / sqrtf(ssr_ * (1.0f / HD) + EPS); } } } while (0)
    v4u knext[8], vnext[8], qnext[4], qraw[4];
    if (C.bid < 768) { ATT_DECODE(C.bid, b0_, gi0_, hh0_, r0_, n0_, dil0_); ATT_LOAD(knext, vnext, qraw, (size_t)b0_ * SEQ + r0_, n0_, dil0_, gi0_ * 4 + hh0_); ATT_STORE(knext, vnext); }
    for (int u = C.bid; u < 768; u += C.nb) {
        ATT_DECODE(u, b, gi, hh, r, n, dil);
        const int head = gi * 4 + hh;
        const size_t rowbase = (size_t)b * SEQ + r;
        const int lb = 128 * n - 128;
        __syncthreads();
        const int un = u + C.nb; const bool hasn = un < 768;
        if (hasn) { ATT_DECODE(un, bn_, gin_, hhn_, rn_, nn_, diln_); ATT_LOAD(knext, vnext, qnext, (size_t)bn_ * SEQ + rn_, nn_, diln_, gin_ * 4 + hhn_); }
        pg8::bf16x8 qf[4];
        { float ss = 0.f;
#pragma unroll
          for (int ks = 0; ks < 4; ++ks) { const v4u rw = qraw[ks];
              const float a0 = bflo(rw.x), a1 = bfhi(rw.x), a2 = bflo(rw.y), a3 = bfhi(rw.y), a4 = bflo(rw.z), a5 = bfhi(rw.z), a6 = bflo(rw.w), a7 = bfhi(rw.w);
              ss += (a0 * a0 + a1 * a1) + (a2 * a2 + a3 * a3) + (a4 * a4 + a5 * a5) + (a6 * a6 + a7 * a7); }
          ss += __shfl_xor(ss, 16); ss += __shfl_xor(ss, 32);
          const float rq = 1.0f / sqrtf(ss * (1.0f / HD) + EPS);
#pragma unroll
          for (int ks = 0; ks < 4; ++ks) { const int d0 = head * HD + 32 * ks + 8 * kq; const v4u rw = qraw[ks];
              const f32x4 g0 = *(const f32x4*)(qg + d0) * *(const f32x4*)(kg + d0), g1 = *(const f32x4*)(qg + d0 + 4) * *(const f32x4*)(kg + d0 + 4);
              pg8::u32x4 pk;
              pk.x = pg8::cvt_pk_bf16(bflo(rw.x) * rq * g0.x, bfhi(rw.x) * rq * g0.y); pk.y = pg8::cvt_pk_bf16(bflo(rw.y) * rq * g0.z, bfhi(rw.y) * rq * g0.w);
              pk.z = pg8::cvt_pk_bf16(bflo(rw.z) * rq * g1.x, bfhi(rw.z) * rq * g1.y); pk.w = pg8::cvt_pk_bf16(bflo(rw.w) * rq * g1.z, bfhi(rw.w) * rq * g1.w);
              qf[ks] = __builtin_bit_cast(pg8::bf16x8, pk); } }
        unsigned Pk[10][2]; float dsum = 0.f;
#pragma unroll
        for (int kb = 0; kb < 9; ++kb) {
            const int j0 = i0 + 16 * kb;
            v4u kr[4];
#pragma unroll
            for (int ks = 0; ks < 4; ++ks) kr[ks] = *(const LAS v4u*)(Kb + (j0 + c) * KROW + 64 * ks + 16 * kq);
            const f32x4 rk4 = *(const LAS f32x4*)(rkt + j0 + 4 * kq);
            f32x4 acc = {0.f, 0.f, 0.f, 0.f};
#pragma unroll
            for (int ks = 0; ks < 4; ++ks) acc = __builtin_amdgcn_mfma_f32_16x16x32_bf16(__builtin_bit_cast(pg8::bf16x8, kr[ks]), qf[ks], acc, 0, 0, 0);
#pragma unroll
            for (int e = 0; e < 4; ++e) { const int j = j0 + 4 * kq + e; const int dist = 128 + i0 + c - j;
                const bool valid = (dist >= 0) && (dist <= 128) && (lb + j >= 0);
                const float pv = __builtin_amdgcn_exp2f(acc[e] * rk4[e]);
                acc[e] = valid ? pv : 0.f; dsum += acc[e]; }
            Pk[kb][0] = pg8::cvt_pk_bf16(acc[0], acc[1]); Pk[kb][1] = pg8::cvt_pk_bf16(acc[2], acc[3]);
        }
        Pk[9][0] = 0u; Pk[9][1] = 0u;
        dsum += __shfl_xor(dsum, 16); dsum += __shfl_xor(dsum, 32);
        if (kq == 0) scr[32 + c] = dsum;
        const f32x4 dq = *(const LAS f32x4*)(scr + 32 + 4 * kq);
        f32x4 O[8];
#pragma unroll
        for (int dt = 0; dt < 8; ++dt) O[dt] = (f32x4){0.f, 0.f, 0.f, 0.f};
#pragma unroll
        for (int s = 0; s < 5; ++s) {
            pg8::u32x4 pk; pk.x = Pk[2 * s][0]; pk.y = Pk[2 * s][1]; pk.z = Pk[2 * s + 1][0]; pk.w = Pk[2 * s + 1][1];
            const pg8::bf16x8 pf = __builtin_bit_cast(pg8::bf16x8, pk);
            const int kb1 = (2 * s + 1 < 9) ? 2 * s + 1 : 8;
            const int rowA = i0 + 32 * s + 4 * kq + (c >> 2), rowB = i0 + 16 * kb1 + 4 * kq + (c >> 2);
            LAS unsigned char* pa = Vb + rowA * VROW + (c & 3) * 8; LAS unsigned char* pb = Vb + rowB * VROW + (c & 3) * 8;
#pragma unroll
            for (int dt = 0; dt < 8; ++dt) {
                const v4i16_t lo = __builtin_amdgcn_ds_read_tr16_b64_v4i16((LAS v4i16_t*)(pa + dt * 32));
                const v4i16_t hi = __builtin_amdgcn_ds_read_tr16_b64_v4i16((LAS v4i16_t*)(pb + dt * 32));
                const pg8::bf16x8 vf = {lo[0], lo[1], lo[2], lo[3], hi[0], hi[1], hi[2], hi[3]};
                O[dt] = __builtin_amdgcn_mfma_f32_16x16x32_bf16(pf, vf, O[dt], 0, 0, 0);
            }
        }
        { float inv[4];
#pragma unroll
          for (int e = 0; e < 4; ++e) inv[e] = 1.0f / dq[e];
#pragma unroll
          for (int e = 0; e < 4; ++e) { const size_t trow = rowbase + (size_t)(128 * n + i0 + 4 * kq + e) * dil;
              bf16* op = ON + ((size_t)gi * T + trow) * AOW + hh * HD + c;
#pragma unroll
              for (int dt = 0; dt < 8; ++dt) op[16 * dt] = (bf16)f2bf(O[dt][e] * inv[e]); }
          { unsigned zq_ = 0u; asm volatile("" : "+v"(zq_)); const int l2_ = (int)__builtin_amdgcn_mbcnt_hi(~0u, __builtin_amdgcn_mbcnt_lo(~0u, zq_));
            if ((l2_ >> 4) == 0) DEN[((size_t)gi * T + rowbase + (size_t)(128 * n + 16 * C.wave + (l2_ & 15)) * dil) * 4 + hh] = dsum; } }
        __syncthreads();
        if (hasn) { ATT_STORE(knext, vnext);
#pragma unroll
            for (int ks = 0; ks < 4; ++ks) qraw[ks] = qnext[ks]; }
    }
#undef ATT_DECODE
#undef ATT_LOAD
#undef ATT_STORE
}
__device__ __forceinline__ void phase_attn_combine(const Args& A, const Ctx& C) {
    const bf16* ON = (const bf16*)(A.ws + WS_ON); const float* DEN = (const float*)(A.ws + WS_DEN); bf16* O = (bf16*)(A.ws + WS_O);
    const int gt = C.bid * NTHREADS + C.tid, ngt = C.nb * NTHREADS;
    for (int i = gt; i < T * (AOW / 8); i += ngt) {
        const int t = i >> 6, ch = i & 63, hh = ch >> 4;
        const float d0 = DEN[((size_t)0 * T + t) * 4 + hh], d1 = DEN[((size_t)1 * T + t) * 4 + hh], d2 = DEN[((size_t)2 * T + t) * 4 + hh];
        const float inv = 1.0f / (d0 + d1 + d2); const float w0 = d0 * inv, w1 = d1 * inv, w2 = d2 * inv;
        const v4u a = *(const v4u*)(ON + ((size_t)0 * T + t) * AOW + ch * 8), bq = *(const v4u*)(ON + ((size_t)1 * T + t) * AOW + ch * 8), cq = *(const v4u*)(ON + ((size_t)2 * T + t) * AOW + ch * 8);
        v4u o;
        o.x = pk2(w0 * bflo(a.x) + w1 * bflo(bq.x) + w2 * bflo(cq.x), w0 * bfhi(a.x) + w1 * bfhi(bq.x) + w2 * bfhi(cq.x));
        o.y = pk2(w0 * bflo(a.y) + w1 * bflo(bq.y) + w2 * bflo(cq.y), w0 * bfhi(a.y) + w1 * bfhi(bq.y) + w2 * bfhi(cq.y));
        o.z = pk2(w0 * bflo(a.z) + w1 * bflo(bq.z) + w2 * bflo(cq.z), w0 * bfhi(a.z) + w1 * bfhi(bq.z) + w2 * bfhi(cq.z));
        o.w = pk2(w0 * bflo(a.w) + w1 * bflo(bq.w) + w2 * bflo(cq.w), w0 * bfhi(a.w) + w1 * bfhi(bq.w) + w2 * bfhi(cq.w));
        *(v4u*)(O + (size_t)t * AOW + ch * 8) = o;
    }
}

__device__ __forceinline__ void phase_cvec(const Args& A, const Ctx& C) {
    const bf16* WQ = (const bf16*)(A.ws + WS_WQ); const float* mod = (const float*)(A.ws + WS_MOD); float* cvec = (float*)(A.ws + WS_CVEC);
    for (int n = C.gw; n < D; n += C.ngw) {
        float s0 = 0.f, s1 = 0.f;
#pragma unroll
        for (int j = 0; j < 4; ++j) { const int k = 8 * C.lane + 512 * j; const v4u w = *(const v4u*)(WQ + (size_t)n * D + k);
            const f32x4 a0 = *(const f32x4*)(mod + 3 * 2048 + k), a1 = *(const f32x4*)(mod + 3 * 2048 + k + 4), b0 = *(const f32x4*)(mod + 12288 + 3 * 2048 + k), b1 = *(const f32x4*)(mod + 12288 + 3 * 2048 + k + 4);
            const float w0 = bflo(w.x), w1 = bfhi(w.x), w2 = bflo(w.y), w3 = bfhi(w.y), w4 = bflo(w.z), w5 = bfhi(w.z), w6 = bflo(w.w), w7 = bfhi(w.w);
            s0 += ((w0 * a0.x + w1 * a0.y) + (w2 * a0.z + w3 * a0.w)) + ((w4 * a1.x + w5 * a1.y) + (w6 * a1.z + w7 * a1.w));
            s1 += ((w0 * b0.x + w1 * b0.y) + (w2 * b0.z + w3 * b0.w)) + ((w4 * b1.x + w5 * b1.y) + (w6 * b1.z + w7 * b1.w)); }
#pragma unroll
        for (int o = 1; o < 64; o <<= 1) { s0 += __shfl_xor(s0, o); s1 += __shfl_xor(s1, o); }
        if (C.lane == 0) { cvec[n] = s0; cvec[2048 + n] = s1; }
    }
}

__global__ void __launch_bounds__(NTHREADS, 2) mk_fwd(Args args) {
    extern __shared__ __attribute__((aligned(16))) unsigned char lds[];
    Ctx C;
    C.tid = threadIdx.x; C.lane = C.tid & 63; C.wave = __builtin_amdgcn_readfirstlane(C.tid >> 6);
    C.bid = blockIdx.x; C.nb = gridDim.x; C.gw = C.bid * NWAVES + C.wave; C.ngw = C.nb * NWAVES; C.lds = lds;
    volatile LAS unsigned* MISC = (volatile LAS unsigned*)((LAS unsigned char*)lds + MISC_OFF);
    if (C.tid < 32) MISC[C.tid] = 0u;
    __syncthreads();
    unsigned* ctl = (unsigned*)(args.ws + WS_CTL);
    XcdBarrier bar; bar.bar = ctl + CW_BAR; bar.x = 0; bar.st = nullptr;
    const int lo = args.ph_lo, hi = args.ph_hi;
    if (hi - lo > 1) bar = xcd_barrier_post(ctl + CW_BAR, MISC + 8);
    bar.wave = C.wave;
#define IN(k) (lo <= (k) && (k) < hi)
#define SEAM(k) do { if (IN(k) && IN((k) + 1)) xcd_barrier(bar); } while (0)
    unsigned char* ws = args.ws;
    const float* mod = (const float*)(ws + WS_MOD);
#define REP(k) for (int rep_ = 0; rep_ < ((PROBE_DUP == (k)) ? 2 : 1); ++rep_)
#define FRESH_CTX() do { unsigned z_ = 0u; asm volatile("" : "+v"(z_)); C.lane = (int)__builtin_amdgcn_mbcnt_hi(~0u, __builtin_amdgcn_mbcnt_lo(~0u, z_)); C.tid = C.wave * 64 + C.lane; } while (0)
    if (IN(0)) { FRESH_CTX(); REP(0) phase_prologue(args, C); } SEAM(0);
    if (IN(1)) { FRESH_CTX(); REP(1) phase_norm_mod<true>(args.in[I_X], args.in[I_N1G], mod, 0, 1, (bf16*)(ws + WS_H), C); } SEAM(1);
    LAS unsigned char* ldsl = (LAS unsigned char*)lds;
    if (IN(2)) { FRESH_CTX(); REP(2) { pg8::Gemm g{(const bf16*)(ws + WS_H), (const bf16*)(ws + WS_WIN), T, IN_COLS, D / 2}; pg8::StaticOrder S; S.init(T, IN_COLS, C.nb, C.bid);
                 pg8::EpiIn E{(bf16*)(ws + WS_U), (bf16*)(ws + WS_QKV), (bf16*)(ws + WS_G), 0, 1.0f / WIN_SCALE};
                 pg8::gemm_phase<pg8::EpiIn, pg8::StaticOrder, false, true, true>(ldsl, g, S, E, C.wave); }
                 { constexpr int NT6 = (T / 256) * (IN_COLS / 256) % 256;
                   if (C.nb == 256 && NT6 > 0) { if (C.bid >= NT6) late_transposes(args, C, lds, (C.bid - NT6) * NWAVES + C.wave, (256 - NT6) * NWAVES); }
                   else late_transposes(args, C, lds, C.gw, C.ngw); } } SEAM(2);
    if (IN(3)) { FRESH_CTX(); REP(3) { phase_conv(args, C); phase_attn(args, C); } } SEAM(3);
    if (IN(4)) { FRESH_CTX(); phase_cvec(args, C); phase_attn_combine(args, C);
                 pg8::Gemm g{(const bf16*)(ws + WS_UCV), (const bf16*)(ws + WS_WCO), T, D, CONV_CH}; pg8::StaticOrder S; S.init(T, D, C.nb, C.bid);
                 pg8::EpiYconv E{(const bf16*)(ws + WS_G), (bf16*)(ws + WS_MERGED), args.in[I_BCO]};
                 pg8::gemm_phase<pg8::EpiYconv, pg8::StaticOrder, true, true>(ldsl, g, S, E, C.wave); } SEAM(4);
    if (IN(5)) { FRESH_CTX(); REP(5) { pg8::Gemm g{(const bf16*)(ws + WS_O), (const bf16*)(ws + WS_WAO), T, D, AOW}; pg8::StaticOrder S; S.init(T, D, C.nb, C.bid);
                 pg8::EpiYattn E{(const bf16*)(ws + WS_G), (const bf16*)(ws + WS_MERGED), ws + WS_QP, MG_SCALE};
                 pg8::gemm_phase<pg8::EpiYattn, pg8::StaticOrder, true, true>(ldsl, g, S, E, C.wave); } } SEAM(5);
    if (IN(6)) { FRESH_CTX(); REP(6) { pg8::Gemm g{(const bf16*)(ws + WS_QP), (const bf16*)(ws + WS_WOUT), T, D, D / 2}; pg8::StaticOrder S; S.init(T, D, C.nb, C.bid);
                 pg8::EpiOut E{args.in[I_X], mod, args.in[I_N2G], args.out, (bf16*)(ws + WS_H), (float*)(ws + WS_SSQ), 1.0f / (MG_SCALE * WIN_SCALE)};
                 pg8::gemm_phase<pg8::EpiOut, pg8::StaticOrder, true, true, true>(ldsl, g, S, E, C.wave); } } SEAM(6);
    if (IN(7)) { FRESH_CTX(); REP(7) { pg8::Gemm g{(const bf16*)(ws + WS_H), (const bf16*)(ws + WS_WQ), T, D, D}; pg8::StaticOrder S; S.init(T, D, C.nb, C.bid);
                 pg8::EpiQ E{(bf16*)(ws + WS_QP), (const float*)(ws + WS_SSQ), (const float*)(ws + WS_CVEC)};
                 pg8::gemm_phase<pg8::EpiQ, pg8::StaticOrder, true, true>(ldsl, g, S, E, C.wave); } } SEAM(7);
    if (IN(8)) { FRESH_CTX(); REP(8) phase_topk(args, C); } SEAM(8);
    if (IN(9)) { FRESH_CTX(); for (int rep_ = (PROBE_DUP == 9) ? 0 : 1; rep_ < 2; ++rep_) phase_experts3(args, C, rep_ ? args.out : (float*)(ws + WS_MERGED), rep_ ? 0xFFFFFFFFu : PROBE_EMASK); }
#undef REP
#undef IN
#undef SEAM
}

extern "C" void kernel_launch(void* const* d_in, const int* in_sizes, int n_in, void* d_out, int out_size, void* d_ws, size_t ws_size, hipStream_t stream) {
    static int grid = 0;
    if (grid == 0) {
        if (n_in != 21 || in_sizes[0] != T * D || out_size != T * D || ws_size < WS_END) {
            fprintf(stderr, "kernel_launch: unexpected shapes: n_in %d in0 %d out %d ws %zu (need %zu)\n", n_in, n_in > 0 ? in_sizes[0] : -1, out_size, ws_size, (size_t)WS_END); grid = -1; return; }
        int dev = 0, cus = 0, per_cu = 0;
        if (hipGetDevice(&dev) != hipSuccess || hipDeviceGetAttribute(&cus, hipDeviceAttributeMultiprocessorCount, dev) != hipSuccess) { grid = -1; return; }
        if (hipFuncSetAttribute((const void*)mk_fwd, hipFuncAttributeMaxDynamicSharedMemorySize, LDS_BYTES) != hipSuccess) { fprintf(stderr, "kernel_launch: hipFuncSetAttribute failed\n"); grid = -1; return; }
        if (hipOccupancyMaxActiveBlocksPerMultiprocessor(&per_cu, (const void*)mk_fwd, NTHREADS, LDS_BYTES) != hipSuccess || per_cu < 1)
            fprintf(stderr, "kernel_launch: note: occupancy query reports %d\n", per_cu);
        (void)hipGetLastError();
        grid = cus;
    }
    if (grid < 0) return;
    (void)hipMemsetAsync((char*)d_ws + WS_CTL, 0, CTL_ZERO_BYTES, stream);
    Args a{};
    for (int i = 0; i < 21; ++i) a.in[i] = (const float*)d_in[i];
    a.out = (float*)d_out; a.ws = (unsigned char*)d_ws;
#if N_LAUNCH_MODE == 1
    a.ph_lo = 0; a.ph_hi = NPHASES;
    hipLaunchKernelGGL(mk_fwd, dim3(grid), dim3(NTHREADS), LDS_BYTES, stream, a);
#else
    for (int p = 0; p < NPHASES; ++p) { a.ph_lo = p; a.ph_hi = p + 1; hipLaunchKernelGGL(mk_fwd, dim3(grid), dim3(NTHREADS), LDS_BYTES, stream, a); }
#endif
}
```

```cpp
#include <hip/hip_runtime.h>
#include <cstdio>
#include <cstdint>
#include <cmath>

constexpr int BATCH = 2, SEQ = 4096, D = 2048, T = BATCH * SEQ;
constexpr int CONV_CH = 1024, CONV_K = 31;
constexpr int HD = 128, NHEADS = 12, AW = 1536, AOW = 512;
constexpr int OFF_Q = 2048, OFF_G = OFF_Q + 3 * AW, IN_COLS = OFF_G + 2 * D;
constexpr int QKVW = 3 * AW;
constexpr int PEER_H = 8, PEER_NK = 128, PEER_TOPK = 16, PEER_HK = PEER_H * PEER_TOPK;
constexpr int PEER_E = PEER_NK * PEER_NK;
constexpr int MODW = 6 * D;
constexpr float EPS = 1e-6f;
constexpr int NWAVES = 8, NTHREADS = NWAVES * 64;
#ifndef N_LAUNCH_MODE
#define N_LAUNCH_MODE 1
#endif
constexpr int NPHASES = 10;
#ifndef PROBE_EMASK
#define PROBE_EMASK 0xFFFFFFFFu
#endif
#ifndef PROBE_DUP
#define PROBE_DUP (-1)
#endif
#ifndef MFMA_MASK
#define MFMA_MASK 31
#endif
#ifndef P2_SPLIT
#define P2_SPLIT 0
#endif

constexpr size_t MiB = 1u << 20;
constexpr size_t WS_CTL = 0, CTL_ZERO_BYTES = 64 * 1024;
constexpr size_t WS_MOD = 1 * MiB;
constexpr size_t WS_SK = 1 * MiB + 512 * 1024;
constexpr size_t WS_WIN = 427 * MiB;
constexpr size_t WS_H8 = 459 * MiB;
constexpr size_t WS_WCO = 44 * MiB;
constexpr size_t WS_WAO = 48 * MiB;
constexpr size_t WS_WOUT = 50 * MiB;
constexpr size_t WS_WQ = 58 * MiB;
constexpr size_t WS_WUP = 66 * MiB;
constexpr size_t WS_WDN = 130 * MiB;
constexpr size_t WS_SUP = 98 * MiB, WS_SDN = 98 * MiB + 65536;
constexpr size_t WS_H = 194 * MiB;
constexpr size_t WS_U = 226 * MiB;
constexpr size_t WS_SSQ = WS_U, WS_CVEC = WS_U + 2 * MiB;
constexpr size_t WS_QKV = 242 * MiB;
constexpr size_t WS_G = 314 * MiB;
constexpr size_t WS_UCV = 378 * MiB;
constexpr size_t WS_ON = 394 * MiB;
constexpr size_t WS_DEN = 418 * MiB;
constexpr size_t WS_O = 419 * MiB;
constexpr size_t WS_MERGED = 427 * MiB;
constexpr size_t WS_X1B = WS_MERGED;
constexpr size_t WS_QP = 459 * MiB;
constexpr size_t WS_IDX = 491 * MiB;
constexpr size_t WS_GW = 495 * MiB;
constexpr size_t WS_END = 500 * MiB;
constexpr int CW_BAR = 4096;
constexpr int TK_W = 5;
constexpr int UP_TAIL_ROWS = 4096;
constexpr float UCV_SCALE = 16.0f;
constexpr float O_SCALE = 16.0f;
constexpr float MG_SCALE = 16.0f;
constexpr float WIN_SCALE = 256.0f;

constexpr int LDS_BYTES = 147456 + 512;
constexpr int RING_BYTES = 131072, MISC_OFF = 147456 + 64;

#define GAS __attribute__((address_space(1)))
#define LAS __attribute__((address_space(3)))
typedef unsigned short bf16;
typedef unsigned v4u __attribute__((ext_vector_type(4)));
typedef unsigned v2u __attribute__((ext_vector_type(2)));
typedef float f32x4 __attribute__((ext_vector_type(4)));
#define RLX_AGENT __ATOMIC_RELAXED, __HIP_MEMORY_SCOPE_AGENT

__device__ __forceinline__ unsigned f2bf(float f) { unsigned u = __builtin_bit_cast(unsigned, f); return (u + 0x7fffu + ((u >> 16) & 1u)) >> 16; }
__device__ __forceinline__ unsigned pk2(float lo, float hi) { return f2bf(lo) | (f2bf(hi) << 16); }
__device__ __forceinline__ float bf2f(unsigned b) { return __builtin_bit_cast(float, b << 16); }
__device__ __forceinline__ float bflo(unsigned w) { return __builtin_bit_cast(float, w << 16); }
__device__ __forceinline__ float bfhi(unsigned w) { return __builtin_bit_cast(float, w & 0xffff0000u); }
__device__ __forceinline__ float wave_sum(float v) {
#pragma unroll
    for (int o = 1; o < 64; o <<= 1) v += __shfl_xor(v, o);
    return v;
}
__device__ __forceinline__ float sigmoidf_(float x) { return 1.0f / (1.0f + __expf(-x)); }
__device__ __forceinline__ float siluf_(float x) { return x / (1.0f + __expf(-x)); }
__device__ __forceinline__ float gelu_erf(float x) { return 0.5f * x * (1.0f + erff(x * 0.70710678118654752f)); }

__device__ __forceinline__ int lane_id() { return (int)__builtin_amdgcn_mbcnt_hi(~0u, __builtin_amdgcn_mbcnt_lo(~0u, 0u)); }
#define XB_TMO      128
#define XB_XCNT(j)  (256  + 64 * (j))
#define XB_XSUB(j)  (1280 + 64 * (j))
#define XB_XGEN(j)  (2304 + 64 * (j))
#define XB_TOP      3328
#define XB_TOPGEN   3392
#define XCD_BAR_WORDS 3456
#define XB_SPIN_CAP (1u << 22)
__device__ __forceinline__ unsigned xb_ld(unsigned* p)              { return __hip_atomic_load(p, __ATOMIC_RELAXED, __HIP_MEMORY_SCOPE_AGENT); }
__device__ __forceinline__ unsigned xb_add(unsigned* p, unsigned v) { return __hip_atomic_fetch_add(p, v, __ATOMIC_RELAXED, __HIP_MEMORY_SCOPE_AGENT); }
__device__ __forceinline__ unsigned xb_xcc_id() { return (unsigned)__builtin_amdgcn_s_getreg((3 << 11) | 20) & 0xFu; }
#define XB_SPIN(cond, bar) do { unsigned _sp = 0; while (cond) { __builtin_amdgcn_s_sleep(1); \
    if ((++_sp & 255u) == 0u) { if (xb_ld(&(bar)[XB_TMO])) break; if (_sp > XB_SPIN_CAP) { atomicAdd(&(bar)[XB_TMO], 1u); break; } } } } while (0)
struct XcdBarrier { unsigned* bar; unsigned x; volatile LAS unsigned* st; int wave; };
__device__ __forceinline__ XcdBarrier xcd_barrier_post(unsigned* bar, volatile LAS unsigned* st) {
    XcdBarrier b; b.bar = bar; b.x = xb_xcc_id(); b.st = st; b.wave = 0;
    if (threadIdx.x == 0) (void)xb_add(&bar[XB_XCNT(b.x)], 1u);
    return b;
}
__device__ __forceinline__ void xcd_barrier_complete(unsigned* bar, unsigned x, unsigned& nloc, unsigned& nx) {
    const unsigned G = gridDim.x * gridDim.y * gridDim.z;
    unsigned sum, cnt, mine, sp = 0u;
    for (;;) {
        sum = 0u; cnt = 0u; mine = 0u;
#pragma unroll
        for (unsigned j = 0; j < 16; ++j) { const unsigned c = xb_ld(&bar[XB_XCNT(j)]); sum += c; cnt += (c > 0u) ? 1u : 0u; mine = (j == x) ? c : mine; }
        if (sum == G) break;
        __builtin_amdgcn_s_sleep(1);
        if ((++sp & 255u) == 0u) { if (xb_ld(&bar[XB_TMO])) break; if (sp > XB_SPIN_CAP) { atomicAdd(&bar[XB_TMO], 1u); break; } }
    }
    nloc = mine > 0u ? mine : 1u; nx = cnt > 0u ? cnt : 1u;
}
__device__ __forceinline__ void xcd_barrier(const XcdBarrier& b) {
    asm volatile("s_waitcnt vmcnt(0)" ::: "memory");
    __syncthreads();
    if (b.wave == 0 && lane_id() == 0) {
        unsigned* bar = b.bar;
        __builtin_amdgcn_s_waitcnt(0);
        unsigned nloc = b.st[0], nx = b.st[1];
        if (nloc == 0u) { xcd_barrier_complete(bar, b.x, nloc, nx); b.st[0] = nloc; b.st[1] = nx; }
        const unsigned old = xb_add(&bar[XB_XSUB(b.x)], 1u);
        const unsigned gen = old / nloc;
        if (old + 1u == (gen + 1u) * nloc) {
            __builtin_amdgcn_fence(__ATOMIC_RELEASE, "agent");
            asm volatile("s_waitcnt vmcnt(0)" ::: "memory");
            const unsigned og = xb_add(&bar[XB_TOP], 1u);
            const unsigned tg = og / nx;
            if (og + 1u == (tg + 1u) * nx) xb_add(&bar[XB_TOPGEN], 1u);
            else XB_SPIN(xb_ld(&bar[XB_TOPGEN]) == tg, bar);
            __builtin_amdgcn_fence(__ATOMIC_ACQUIRE, "agent");
            xb_add(&bar[XB_XGEN(b.x)], 1u);
            asm volatile("s_waitcnt vmcnt(0)" ::: "memory");
        } else {
            XB_SPIN(xb_ld(&bar[XB_XGEN(b.x)]) == gen, bar);
            __builtin_amdgcn_fence(__ATOMIC_ACQUIRE, "agent");
            asm volatile("s_waitcnt vmcnt(0)" ::: "memory");
        }
    }
    __syncthreads();
}

namespace pg8 {
#define PG8_LAS __attribute__((address_space(3)))
typedef unsigned short bf16_t;
typedef short bf16x8 __attribute__((ext_vector_type(8)));
typedef float f32x4 __attribute__((ext_vector_type(4)));
typedef unsigned u32x4 __attribute__((ext_vector_type(4)));
constexpr int BM = 256, BK = 64, HALF = 128, HTB = HALF * BK * 2  , STAGE_BYTES = 8 * HTB, NXCD = 8, WGM = 4;

__host__ __device__ __forceinline__ int lds_byte(int r, int c) { const int st = (r >> 4) * 2 + (c >> 5), rr = r & 15, cc = c & 31, ob = rr * 64 + cc * 2; return st * 1024 + (ob ^ (((ob >> 9) & 1) << 5)); }
__host__ __device__ __forceinline__ void stage_rc(int b, int& R, int& C) { const int st = b / 1024, sb = b % 1024, swz = sb ^ (((sb >> 9) & 1) << 5); R = (st >> 1) * 16 + swz / 64; C = (st & 1) * 32 + (swz % 64) / 2; }
__host__ __device__ __forceinline__ int perm32(int rho) { const int n = rho >> 4, i = rho & 15; return 8 * (i >> 2) + 4 * n + (i & 3); }

struct Unit { int pm, pn; };
struct Gemm { const bf16_t* A; const bf16_t* Bt; int M, N, K; };

struct StaticOrder {
    int nM, nN, nwg, G, c;
    __host__ __device__ void init(int M, int N, int G_, int c_) { nM = M / BM; nN = N / BM; nwg = nM * nN; G = G_; c = c_; }
    __host__ __device__ bool next(int i, Unit& u) const {
        const long L = (long)i * G + c; if (L >= nwg) return false;
        int wgid = (int)L; { const int q = nwg / NXCD, r = nwg % NXCD, xcd = wgid % NXCD, off = wgid / NXCD; wgid = (xcd < r ? xcd * (q + 1) : r * (q + 1) + (xcd - r) * q) + off; }
        const int nig = WGM * nN, gid = wgid / nig, fm = gid * WGM, gsz = (nM - fm) < WGM ? (nM - fm) : WGM;
        u.pm = fm + ((wgid % nig) % gsz); u.pn = (wgid % nig) / gsz; return true;
    }
    __device__ __forceinline__ void a_ready(const Unit&) const {}
    __device__ __forceinline__ void done(const Unit&) const {}
};

typedef float f32x2_t __attribute__((ext_vector_type(2))); typedef __bf16 bf16x2_t __attribute__((ext_vector_type(2)));
__device__ __forceinline__ unsigned cvt_pk_bf16(float lo, float hi) { f32x2_t v = {lo, hi}; bf16x2_t b = __builtin_convertvector(v, bf16x2_t); return __builtin_bit_cast(unsigned, b); }
typedef float f32x2 __attribute__((ext_vector_type(2)));
typedef int v8i_t __attribute__((ext_vector_type(8)));
struct Frag32 { bf16x8 lo, hi; };
template <class Epi, class Sched, bool ALIGN_EPI = false, bool SP2 = false, bool FP8 = false>
__device__ __forceinline__ void gemm_phase(PG8_LAS unsigned char* lds, const Gemm g, const Sched& S, const Epi& E, int wave_idx) {
    const int wid = wave_idx, lane = lane_id(), tid = wid * 64 + lane, wr = wid >> 2, wc = wid & 3, fr = lane & 15, fq = lane >> 4;
    const int K = g.K, nt = K / BK;
    unsigned voffA[2], voffB[2];
#pragma unroll
    for (int i = 0; i < 2; ++i) { int R, C; stage_rc(tid * 16 + i * 8192, R, C); const int Rb = Epi::PERM ? ((R & ~31) + perm32(R & 31)) : R;
        voffA[i] = (unsigned)(R * K + C) * 2u; voffB[i] = (unsigned)(Rb * K + C) * 2u; }
    const size_t kstep = (size_t)(BK * 2);
    const size_t hstep = (size_t)HALF * K * 2;
    const size_t tstep = 2 * hstep;
    const unsigned ldsw = (unsigned)wid * 1024u;
    const int aoff = lds_byte(wr * 64 + fr, fq * 8), boff = lds_byte(wc * 32 + fr, fq * 8);
#define PG8_SA(b, h) (((b) * 2 + (h)) * HTB)
#define PG8_SB(b, h) ((4 + (b) * 2 + (h)) * HTB)
#define PG8_STAGE(bufoff, gbase, voff) do { _Pragma("unroll") for (int _i = 0; _i < 2; ++_i) { unsigned vo_ = (voff)[_i]; asm volatile("" : "+v"(vo_));     \
        __builtin_amdgcn_global_load_lds((const unsigned*)((const char*)(gbase) + vo_), (PG8_LAS unsigned*)(lds + (bufoff) + ldsw + _i * 8192), 16, 0, 0); } } while (0)
#define PG8_LDA(dst, b, h) do { _Pragma("unroll") for (int m = 0; m < 4; ++m) { const bf16x8 lo_ = *(const PG8_LAS bf16x8*)(lds + PG8_SA(b, h) + aoff + m * 2048), hi_ = *(const PG8_LAS bf16x8*)(lds + PG8_SA(b, h) + aoff + m * 2048 + 1024); dst[m] = __builtin_bit_cast(v8i_t, (Frag32){lo_, hi_}); } } while (0)
#define PG8_LDB(dst, b, h) do { _Pragma("unroll") for (int n = 0; n < 2; ++n) { const bf16x8 lo_ = *(const PG8_LAS bf16x8*)(lds + PG8_SB(b, h) + boff + n * 2048), hi_ = *(const PG8_LAS bf16x8*)(lds + PG8_SB(b, h) + boff + n * 2048 + 1024); dst[n] = __builtin_bit_cast(v8i_t, (Frag32){lo_, hi_}); } } while (0)
#define PG8_MMA(ai, bj, At, Bt) do { __builtin_amdgcn_s_setprio(1); \
        if constexpr (FP8) { _Pragma("unroll") for (int m = 0; m < 4; ++m) _Pragma("unroll") for (int n = 0; n < 2; ++n) \
            acc[ai][bj][m][n] = __builtin_amdgcn_mfma_scale_f32_16x16x128_f8f6f4(Bt[n], At[m], acc[ai][bj][m][n], 0, 0, 0, 0x7F7F7F7F, 0, 0x7F7F7F7F); } \
        else { _Pragma("unroll") for (int m = 0; m < 4; ++m) _Pragma("unroll") for (int n = 0; n < 2; ++n) { const Frag32 fa_ = __builtin_bit_cast(Frag32, At[m]), fb_ = __builtin_bit_cast(Frag32, Bt[n]); \
            acc[ai][bj][m][n] = __builtin_amdgcn_mfma_f32_16x16x32_bf16(fb_.lo, fa_.lo, acc[ai][bj][m][n], 0, 0, 0); acc[ai][bj][m][n] = __builtin_amdgcn_mfma_f32_16x16x32_bf16(fb_.hi, fa_.hi, acc[ai][bj][m][n], 0, 0, 0); } } \
        __builtin_amdgcn_s_setprio(0); } while (0)
#define PG8_WAIT_V(n) asm volatile("s_waitcnt vmcnt(" #n ")" ::: "memory")
#define PG8_WAIT_L(n) asm volatile("s_waitcnt lgkmcnt(" #n ")" ::: "memory")
#define PG8_BAR __builtin_amdgcn_s_barrier()
#define PG8_SCHED __builtin_amdgcn_sched_barrier(0)
    Unit cur, nxt; int ui = 0;
    if (!S.next(0, cur)) return;
    f32x4 acc[2][2][4][2];
#pragma unroll
    for (int a = 0; a < 2; ++a)
#pragma unroll
        for (int b = 0; b < 2; ++b)
#pragma unroll
            for (int m = 0; m < 4; ++m)
#pragma unroll
                for (int n = 0; n < 2; ++n) acc[a][b][m][n] = (f32x4){0.f, 0.f, 0.f, 0.f};
    v8i_t At[4], B0[2], B1[2];
    const char* cA = (const char*)g.A + (size_t)cur.pm * tstep; const char* cB = (const char*)g.Bt + (size_t)cur.pn * tstep;
    S.a_ready(cur);
    if constexpr (SP2) {
        PG8_STAGE(PG8_SB(0, 0), cB, voffB); PG8_STAGE(PG8_SB(0, 1), cB + hstep, voffB); PG8_STAGE(PG8_SA(0, 0), cA, voffA); PG8_STAGE(PG8_SA(0, 1), cA + hstep, voffA);
        if (wr == 1) PG8_BAR;
        PG8_WAIT_V(2); PG8_BAR;
        PG8_STAGE(PG8_SB(1, 0), cB + kstep, voffB); PG8_STAGE(PG8_SA(1, 0), cA + kstep, voffA); PG8_STAGE(PG8_SB(1, 1), cB + hstep + kstep, voffB);
        PG8_WAIT_V(6); PG8_BAR;
    } else {
        PG8_STAGE(PG8_SB(0, 0), cB, voffB); PG8_STAGE(PG8_SA(0, 0), cA, voffA); PG8_STAGE(PG8_SB(0, 1), cB + hstep, voffB); PG8_STAGE(PG8_SA(0, 1), cA + hstep, voffA);
        if (wr == 1) PG8_BAR;
        PG8_WAIT_V(4); PG8_BAR;
        PG8_STAGE(PG8_SB(1, 0), cB + kstep, voffB); PG8_STAGE(PG8_SA(1, 0), cA + kstep, voffA); PG8_STAGE(PG8_SB(1, 1), cB + hstep + kstep, voffB);
        PG8_WAIT_V(6); PG8_BAR;
    }
    for (;;) {
        const bool has_next = S.next(ui + 1, nxt);
        const char* nA = has_next ? (const char*)g.A + (size_t)nxt.pm * tstep : cA; const char* nB = has_next ? (const char*)g.Bt + (size_t)nxt.pn * tstep : cB;
        for (int t = 0; t < nt; t += 2) {
            const bool last = (t == nt - 2);
            const char* a1 = cA + (size_t)(t + 1) * kstep;
            const char* a2 = last ? nA : cA + (size_t)(t + 2) * kstep; const char* b2 = last ? nB : cB + (size_t)(t + 2) * kstep;
            const char* a3 = a2 + kstep; const char* b3 = b2 + kstep;
            if (last && has_next) S.a_ready(nxt);
            if constexpr (SP2) {
            PG8_LDB(B0, 0, 0); PG8_LDB(B1, 0, 1); PG8_SCHED; PG8_LDA(At, 0, 0); PG8_STAGE(PG8_SA(1, 1), a1 + hstep, voffA);
            PG8_WAIT_V(8); PG8_WAIT_L(0); PG8_BAR; PG8_MMA(0, 0, At, B0); PG8_MMA(0, 1, At, B1); PG8_BAR; PG8_SCHED;
            PG8_LDA(At, 0, 1); PG8_STAGE(PG8_SB(0, 0), b2, voffB); PG8_STAGE(PG8_SB(0, 1), b2 + hstep, voffB); PG8_STAGE(PG8_SA(0, 0), a2, voffA);
            PG8_WAIT_V(8); PG8_WAIT_L(0); PG8_BAR; PG8_MMA(1, 0, At, B0); PG8_MMA(1, 1, At, B1); PG8_BAR; PG8_SCHED;
            PG8_LDB(B0, 1, 0); PG8_LDB(B1, 1, 1); PG8_SCHED; PG8_LDA(At, 1, 0); PG8_STAGE(PG8_SA(0, 1), a2 + hstep, voffA);
            PG8_WAIT_V(8); PG8_WAIT_L(0); PG8_BAR; PG8_MMA(0, 0, At, B0); PG8_MMA(0, 1, At, B1); PG8_BAR; PG8_SCHED;
            PG8_LDA(At, 1, 1); PG8_STAGE(PG8_SB(1, 0), b3, voffB); PG8_STAGE(PG8_SB(1, 1), b3 + hstep, voffB); PG8_STAGE(PG8_SA(1, 0), a3, voffA);
            PG8_WAIT_V(8); PG8_WAIT_L(0); PG8_BAR; PG8_MMA(1, 0, At, B0); PG8_MMA(1, 1, At, B1); PG8_BAR; PG8_SCHED;
            } else {
            PG8_LDB(B0, 0, 0); PG8_SCHED; PG8_LDA(At, 0, 0); PG8_STAGE(PG8_SA(1, 1), a1 + hstep, voffA);
            PG8_WAIT_L(8); PG8_BAR; PG8_WAIT_L(0); PG8_MMA(0, 0, At, B0); PG8_BAR; PG8_SCHED;
            PG8_LDB(B1, 0, 1); PG8_STAGE(PG8_SB(0, 0), b2, voffB);
            PG8_BAR; PG8_WAIT_L(0); PG8_MMA(0, 1, At, B1); PG8_BAR;
            PG8_LDA(At, 0, 1); PG8_STAGE(PG8_SA(0, 0), a2, voffA);
            PG8_BAR; PG8_WAIT_L(0); PG8_MMA(1, 0, At, B0); PG8_BAR; PG8_SCHED;
            PG8_STAGE(PG8_SB(0, 1), b2 + hstep, voffB);
            PG8_WAIT_V(6); PG8_BAR; PG8_MMA(1, 1, At, B1); PG8_BAR;
            PG8_LDB(B0, 1, 0); PG8_SCHED; PG8_LDA(At, 1, 0); PG8_STAGE(PG8_SA(0, 1), a2 + hstep, voffA);
            PG8_WAIT_L(8); PG8_BAR; PG8_WAIT_L(0); PG8_MMA(0, 0, At, B0); PG8_BAR; PG8_SCHED;
            PG8_LDB(B1, 1, 1); PG8_STAGE(PG8_SB(1, 0), b3, voffB);
            PG8_BAR; PG8_WAIT_L(0); PG8_MMA(0, 1, At, B1); PG8_BAR;
            PG8_LDA(At, 1, 1); PG8_STAGE(PG8_SA(1, 0), a3, voffA);
            PG8_BAR; PG8_WAIT_L(0); PG8_MMA(1, 0, At, B0); PG8_BAR; PG8_SCHED;
            PG8_STAGE(PG8_SB(1, 1), b3 + hstep, voffB);
            PG8_WAIT_V(6); PG8_BAR; PG8_MMA(1, 1, At, B1); PG8_BAR;
            }
        }
        if constexpr (ALIGN_EPI) { if (wr == 0) PG8_BAR; }
        if constexpr (!Epi::AFTER_DRAIN) { int l2_ = lane_id(); asm volatile("" : "+v"(l2_)); E(acc, cur, wr, wc, l2_ & 15, l2_ >> 4); S.done(cur); }
        if (!has_next) break;
#pragma unroll
        for (int a = 0; a < 2; ++a)
#pragma unroll
            for (int b = 0; b < 2; ++b)
#pragma unroll
                for (int m = 0; m < 4; ++m)
#pragma unroll
                    for (int n = 0; n < 2; ++n) acc[a][b][m][n] = (f32x4){0.f, 0.f, 0.f, 0.f};
        cur = nxt; cA = nA; cB = nB; ++ui;
        if constexpr (ALIGN_EPI) { if (wr == 1) PG8_BAR; }
    }
    PG8_WAIT_V(0);
    if constexpr (!ALIGN_EPI) { if (wr == 0) PG8_BAR; }
    PG8_BAR;
    if constexpr (Epi::AFTER_DRAIN) { E.fused(acc, cur, wr, wc, fr, fq, lds, wid, lane); S.done(cur); }
#undef PG8_SA
#undef PG8_SB
#undef PG8_STAGE
#undef PG8_LDA
#undef PG8_LDB
#undef PG8_MMA
#undef PG8_WAIT_V
#undef PG8_WAIT_L
#undef PG8_BAR
#undef PG8_SCHED
}
}

namespace pg8 {
__device__ __forceinline__ float fsig(float x) { return __builtin_amdgcn_rcpf(1.0f + __expf(-x)); }
__device__ __forceinline__ u32x4 pack8(const f32x4& v0, const f32x4& v1) { u32x4 w; w.x = cvt_pk_bf16(v0[0], v0[1]); w.y = cvt_pk_bf16(v0[2], v0[3]); w.z = cvt_pk_bf16(v1[0], v1[1]); w.w = cvt_pk_bf16(v1[2], v1[3]); return w; }
__device__ __forceinline__ float blo(unsigned w) { return __builtin_bit_cast(float, w << 16); }
__device__ __forceinline__ float bhi(unsigned w) { return __builtin_bit_cast(float, w & 0xffff0000u); }
struct EpiIn {
    static constexpr bool PERM = true, AFTER_DRAIN = false;
    bf16_t *U, *QKV, *G; int pn0; float osc;
    __device__ __forceinline__ void operator()(const f32x4 (&acc)[2][2][4][2], const Unit& u0, int wr, int wc, int fr, int fq) const {
        Unit u; u.pm = u0.pm; u.pn = u0.pn + pn0;
        const int row0 = u.pm * BM + wr * 64 + fr, cw = wc * 32 + 8 * fq;
        if (u.pn < 8) {
#pragma unroll
            for (int ai = 0; ai < 2; ++ai)
#pragma unroll
                for (int m = 0; m < 4; ++m) { const size_t row = row0 + ai * HALF + m * 16;
                    f32x4 v0 = acc[ai][0][m][0] * osc, v1 = acc[ai][0][m][1] * osc; const f32x4 g0 = acc[ai][1][m][0] * osc, g1 = acc[ai][1][m][1] * osc;
#pragma unroll
                    for (int e = 0; e < 4; ++e) { v0[e] *= fsig(g0[e]); v1[e] *= fsig(g1[e]); }
                    *(u32x4*)(U + row * 1024 + 128 * u.pn + cw) = pack8(v0, v1); }
        } else if (u.pn < 26) {
#pragma unroll
            for (int ai = 0; ai < 2; ++ai)
#pragma unroll
                for (int m = 0; m < 4; ++m) { const size_t row = row0 + ai * HALF + m * 16;
#pragma unroll
                    for (int bj = 0; bj < 2; ++bj) *(u32x4*)(QKV + row * 4608 + (u.pn - 8) * 256 + bj * HALF + cw) = pack8(acc[ai][bj][m][0] * osc, acc[ai][bj][m][1] * osc); }
        } else {
#pragma unroll
            for (int ai = 0; ai < 2; ++ai)
#pragma unroll
                for (int m = 0; m < 4; ++m) { const size_t row = row0 + ai * HALF + m * 16;
#pragma unroll
                    for (int bj = 0; bj < 2; ++bj) { f32x4 v0 = acc[ai][bj][m][0] * osc, v1 = acc[ai][bj][m][1] * osc;
#pragma unroll
                        for (int e = 0; e < 4; ++e) { v0[e] = fsig(v0[e]); v1[e] = fsig(v1[e]); }
                        int p0 = __builtin_amdgcn_cvt_pk_fp8_f32(v0[0], v0[1], 0, false); p0 = __builtin_amdgcn_cvt_pk_fp8_f32(v0[2], v0[3], p0, true);
                        int p1 = __builtin_amdgcn_cvt_pk_fp8_f32(v1[0], v1[1], 0, false); p1 = __builtin_amdgcn_cvt_pk_fp8_f32(v1[2], v1[3], p1, true);
                        typedef unsigned u32x2g_ __attribute__((ext_vector_type(2)));
                        *(u32x2g_*)((unsigned char*)G + row * 4096 + (u.pn - 26) * 256 + bj * HALF + cw) = (u32x2g_){(unsigned)p0, (unsigned)p1}; } }
        }
    }
};
__device__ __forceinline__ void ld_gate8(const bf16_t* G, size_t byteoff, float (&g)[8]) {
    typedef unsigned u32x2h_ __attribute__((ext_vector_type(2))); typedef float f2h_ __attribute__((ext_vector_type(2)));
    const u32x2h_ w = *(const u32x2h_*)((const unsigned char*)G + byteoff);
    const f2h_ a = __builtin_amdgcn_cvt_pk_f32_fp8((int)w.x, false), b = __builtin_amdgcn_cvt_pk_f32_fp8((int)w.x, true), c = __builtin_amdgcn_cvt_pk_f32_fp8((int)w.y, false), d = __builtin_amdgcn_cvt_pk_f32_fp8((int)w.y, true);
    g[0] = a.x; g[1] = a.y; g[2] = b.x; g[3] = b.y; g[4] = c.x; g[5] = c.y; g[6] = d.x; g[7] = d.y;
}
struct EpiYconv {
    static constexpr bool PERM = true, AFTER_DRAIN = false;
    const bf16_t* G; bf16_t* MG; const float* bias; float osc;
    __device__ __forceinline__ void operator()(const f32x4 (&acc)[2][2][4][2], const Unit& u, int wr, int wc, int fr, int fq) const {
        const int row0 = u.pm * BM + wr * 64 + fr, cw = wc * 32 + 8 * fq;
#pragma unroll
        for (int bj = 0; bj < 2; ++bj) { const int col = u.pn * 256 + bj * HALF + cw; const f32x4 b0 = *(const f32x4*)(bias + col), b1 = *(const f32x4*)(bias + col + 4);
#pragma unroll
            for (int ai = 0; ai < 2; ++ai)
#pragma unroll
                for (int m = 0; m < 4; ++m) { const size_t row = row0 + ai * HALF + m * 16;
                    float g[8]; ld_gate8(G, row * 4096 + col, g);
                    f32x4 v0 = acc[ai][bj][m][0] * osc + b0, v1 = acc[ai][bj][m][1] * osc + b1;
                    v0[0] *= g[0]; v0[1] *= g[1]; v0[2] *= g[2]; v0[3] *= g[3]; v1[0] *= g[4]; v1[1] *= g[5]; v1[2] *= g[6]; v1[3] *= g[7];
                    *(u32x4*)(MG + row * 2048 + col) = pack8(v0, v1); } }
    }
};
struct EpiYattn {
    static constexpr bool PERM = true, AFTER_DRAIN = false;
    const bf16_t* G; const bf16_t* MG; unsigned char* MG8; float msc, osc;
    __device__ __forceinline__ void operator()(const f32x4 (&acc)[2][2][4][2], const Unit& u, int wr, int wc, int fr, int fq) const {
        const int row0 = u.pm * BM + wr * 64 + fr, cw = wc * 32 + 8 * fq;
#pragma unroll
        for (int ai = 0; ai < 2; ++ai)
#pragma unroll
            for (int m = 0; m < 4; ++m) { const size_t row = row0 + ai * HALF + m * 16;
#pragma unroll
                for (int bj = 0; bj < 2; ++bj) { const int col = u.pn * 256 + bj * HALF + cw; float g[8]; ld_gate8(G, row * 4096 + 2048 + col, g); const u32x4 p = *(const u32x4*)(MG + row * 2048 + col);
                    f32x4 v0 = acc[ai][bj][m][0] * osc, v1 = acc[ai][bj][m][1] * osc;
                    v0[0] = (blo(p.x) + v0[0] * g[0]) * msc; v0[1] = (bhi(p.x) + v0[1] * g[1]) * msc; v0[2] = (blo(p.y) + v0[2] * g[2]) * msc; v0[3] = (bhi(p.y) + v0[3] * g[3]) * msc;
                    v1[0] = (blo(p.z) + v1[0] * g[4]) * msc; v1[1] = (bhi(p.z) + v1[1] * g[5]) * msc; v1[2] = (blo(p.w) + v1[2] * g[6]) * msc; v1[3] = (bhi(p.w) + v1[3] * g[7]) * msc;
                    int p0 = __builtin_amdgcn_cvt_pk_fp8_f32(v0[0], v0[1], 0, false); p0 = __builtin_amdgcn_cvt_pk_fp8_f32(v0[2], v0[3], p0, true);
                    int p1 = __builtin_amdgcn_cvt_pk_fp8_f32(v1[0], v1[1], 0, false); p1 = __builtin_amdgcn_cvt_pk_fp8_f32(v1[2], v1[3], p1, true);
                    typedef unsigned u32x2_ __attribute__((ext_vector_type(2))); *(u32x2_*)(MG8 + row * 2048 + col) = (u32x2_){(unsigned)p0, (unsigned)p1}; } }
    }
};
struct EpiOut {
    static constexpr bool PERM = true, AFTER_DRAIN = false;
    const float* x; const float* mod; const float* g2; bf16_t* X1B; bf16_t* XA; float* SSQ; float osc;
    __device__ __forceinline__ void operator()(const f32x4 (&acc)[2][2][4][2], const Unit& u, int wr, int wc, int fr, int fq) const {
        const int row0 = u.pm * BM + wr * 64 + fr, cw = wc * 32 + 8 * fq; const int b = (u.pm * BM) / 4096;
        float ss[2][4];
#pragma unroll
        for (int ai = 0; ai < 2; ++ai)
#pragma unroll
            for (int m = 0; m < 4; ++m) ss[ai][m] = 0.f;
#pragma unroll
        for (int bj = 0; bj < 2; ++bj) { const int col = u.pn * 256 + bj * HALF + cw;
            const f32x4 gt0 = *(const f32x4*)(mod + b * 12288 + 2 * 2048 + col) * osc, gt1 = *(const f32x4*)(mod + b * 12288 + 2 * 2048 + col + 4) * osc;
            const f32x4 a0 = *(const f32x4*)(g2 + col) * (*(const f32x4*)(mod + b * 12288 + 4 * 2048 + col) + 1.0f), a1 = *(const f32x4*)(g2 + col + 4) * (*(const f32x4*)(mod + b * 12288 + 4 * 2048 + col + 4) + 1.0f);
#pragma unroll
            for (int ai = 0; ai < 2; ++ai)
#pragma unroll
                for (int m = 0; m < 4; ++m) { const size_t off = (size_t)(row0 + ai * HALF + m * 16) * 2048 + col;
                    const f32x4 y0 = __builtin_nontemporal_load((const f32x4*)(x + off)) + gt0 * acc[ai][bj][m][0], y1 = __builtin_nontemporal_load((const f32x4*)(x + off + 4)) + gt1 * acc[ai][bj][m][1];
                    *(u32x4*)(X1B + off) = pack8(y0, y1);
                    ss[ai][m] += ((y0.x * y0.x + y0.y * y0.y) + (y0.z * y0.z + y0.w * y0.w)) + ((y1.x * y1.x + y1.y * y1.y) + (y1.z * y1.z + y1.w * y1.w));
                    *(u32x4*)(XA + off) = pack8(y0 * a0, y1 * a1); } }
#pragma unroll
        for (int ai = 0; ai < 2; ++ai)
#pragma unroll
            for (int m = 0; m < 4; ++m) { float s_ = ss[ai][m]; s_ += __shfl_xor(s_, 16); s_ += __shfl_xor(s_, 32);
                if (fq == 0) SSQ[(size_t)(row0 + ai * HALF + m * 16) * 32 + u.pn * 4 + wc] = s_; }
    }
};
struct EpiQ {
    static constexpr bool PERM = true, AFTER_DRAIN = false;
    bf16_t* O; const float* SSQ; const float* cvec;
    __device__ __forceinline__ void operator()(const f32x4 (&acc)[2][2][4][2], const Unit& u, int wr, int wc, int fr, int fq) const {
        const int row0 = u.pm * BM + wr * 64 + fr, cw = u.pn * BM + wc * 32 + 8 * fq; const int b = (u.pm * BM) / 4096;
        float rs[2][4];
#pragma unroll
        for (int ai = 0; ai < 2; ++ai)
#pragma unroll
            for (int m = 0; m < 4; ++m) { const float* pp = SSQ + (size_t)(row0 + ai * HALF + m * 16) * 32 + 8 * fq; const f32x4 p0 = *(const f32x4*)pp, p1 = *(const f32x4*)(pp + 4);
                float s_ = ((p0.x + p0.y) + (p0.z + p0.w)) + ((p1.x + p1.y) + (p1.z + p1.w)); s_ += __shfl_xor(s_, 16); s_ += __shfl_xor(s_, 32);
                rs[ai][m] = rsqrtf(s_ * (1.0f / 2048.0f) + 1e-6f); }
#pragma unroll
        for (int bj = 0; bj < 2; ++bj) { const f32x4 c0 = *(const f32x4*)(cvec + b * 2048 + bj * HALF + cw), c1 = *(const f32x4*)(cvec + b * 2048 + bj * HALF + cw + 4);
#pragma unroll
            for (int ai = 0; ai < 2; ++ai)
#pragma unroll
                for (int m = 0; m < 4; ++m) { const size_t row = row0 + ai * HALF + m * 16;
                    *(u32x4*)(O + row * 2048 + bj * HALF + cw) = pack8(acc[ai][bj][m][0] * rs[ai][m] + c0, acc[ai][bj][m][1] * rs[ai][m] + c1); } }
    }
};
struct EpiPlain {
    static constexpr bool PERM = true, AFTER_DRAIN = false;
    bf16_t* O; int ldc;
    __device__ __forceinline__ void operator()(const f32x4 (&acc)[2][2][4][2], const Unit& u, int wr, int wc, int fr, int fq) const {
        const int row0 = u.pm * BM + wr * 64 + fr, cw = u.pn * BM + wc * 32 + 8 * fq;
#pragma unroll
        for (int ai = 0; ai < 2; ++ai)
#pragma unroll
            for (int m = 0; m < 4; ++m) { const size_t row = row0 + ai * HALF + m * 16;
#pragma unroll
                for (int bj = 0; bj < 2; ++bj) *(u32x4*)(O + row * ldc + bj * HALF + cw) = pack8(acc[ai][bj][m][0], acc[ai][bj][m][1]); }
    }
};
}

struct Args { const float* in[21]; float* out; unsigned char* ws; int ph_lo, ph_hi; };
enum { I_X = 0, I_C, I_N1G, I_N2G, I_WADA, I_BADA, I_WIN, I_CDW, I_CDB, I_CLNG, I_CLNB, I_WCO, I_BCO, I_QNG, I_KNG, I_WAO, I_WOUT, I_PWQ, I_PSK, I_PWUP, I_PWDN };

struct Ctx {
    int tid, lane, wave, bid, nb, gw, ngw;
    unsigned char* lds;
};

__device__ __forceinline__ int win_row(int n) {
    if (n < 1024) return (n >> 7) * 256 + (n & 127);
    if (n < 2048) { const int m = n - 1024; return (m >> 7) * 256 + 128 + (m & 127); }
    return n;
}
__device__ __forceinline__ void p0_transpose_item(const float* W, int K, int N, bf16* WT, bool perm, float* scr, int item, int lane) {
    const int nblk = N / 32, kb = item / nblk, nbi = item % nblk, k0 = 64 * kb, n0 = 32 * nbi;
    { f32x4 v_[8];
#pragma unroll
      for (int i = 0; i < 8; ++i) v_[i] = __builtin_nontemporal_load((const f32x4*)(W + (size_t)(k0 + (lane >> 3) + 8 * i) * N + n0 + 4 * (lane & 7)));
#pragma unroll
      for (int i = 0; i < 8; ++i) { float* d_ = scr + ((lane >> 3) + 8 * i) * 33 + 4 * (lane & 7); d_[0] = v_[i].x; d_[1] = v_[i].y; d_[2] = v_[i].z; d_[3] = v_[i].w; } }
    asm volatile("s_waitcnt lgkmcnt(0)" ::: "memory");
    const int c = lane & 7;
    const int r0 = perm ? win_row(n0) : n0;
#pragma unroll
    for (int j = 0; j < 4; ++j) { const int n = (lane >> 3) + 8 * j; const float* s = scr + (8 * c) * 33 + n;
        v4u o; o.x = pk2(s[0 * 33], s[1 * 33]); o.y = pk2(s[2 * 33], s[3 * 33]); o.z = pk2(s[4 * 33], s[5 * 33]); o.w = pk2(s[6 * 33], s[7 * 33]);
        *(v4u*)(WT + (size_t)(r0 + n) * K + k0 + 8 * c) = o; }
    asm volatile("s_waitcnt lgkmcnt(0)" ::: "memory");
}

__device__ __forceinline__ void p0_transpose_item_fp8(const float* W, int K, int N, unsigned char* WT, bool perm, float* scr, int item, int lane, float wsc) {
    const int nblk = N / 32, kb = item / nblk, nbi = item % nblk, k0 = 64 * kb, n0 = 32 * nbi;
    { f32x4 v_[8];
#pragma unroll
      for (int i = 0; i < 8; ++i) v_[i] = __builtin_nontemporal_load((const f32x4*)(W + (size_t)(k0 + (lane >> 3) + 8 * i) * N + n0 + 4 * (lane & 7)));
#pragma unroll
      for (int i = 0; i < 8; ++i) { float* d_ = scr + ((lane >> 3) + 8 * i) * 33 + 4 * (lane & 7); d_[0] = v_[i].x * wsc; d_[1] = v_[i].y * wsc; d_[2] = v_[i].z * wsc; d_[3] = v_[i].w * wsc; } }
    asm volatile("s_waitcnt lgkmcnt(0)" ::: "memory");
    const int c = lane & 3;
    const int r0 = perm ? win_row(n0) : n0;
#pragma unroll
    for (int j = 0; j < 2; ++j) { const int n = (lane >> 2) + 16 * j; const float* s = scr + (16 * c) * 33 + n; v4u o; unsigned* op = (unsigned*)&o;
#pragma unroll
        for (int q = 0; q < 4; ++q) { int p = __builtin_amdgcn_cvt_pk_fp8_f32(s[(4 * q) * 33], s[(4 * q + 1) * 33], 0, false);
            p = __builtin_amdgcn_cvt_pk_fp8_f32(s[(4 * q + 2) * 33], s[(4 * q + 3) * 33], p, true); op[q] = (unsigned)p; }
        *(v4u*)(WT + (size_t)(r0 + n) * K + k0 + 16 * c) = o; }
    asm volatile("s_waitcnt lgkmcnt(0)" ::: "memory");
}
__device__ __forceinline__ void cvt_stream(const float* src, bf16* dst, size_t n, const Ctx& C) {
    const size_t nv = n / 8;
    for (size_t i = (size_t)C.gw * 64 + C.lane; i < nv; i += (size_t)C.ngw * 64) {
        const f32x4 a = *(const f32x4*)(src + i * 8), b = *(const f32x4*)(src + i * 8 + 4);
        v4u o; o.x = pk2(a.x, a.y); o.y = pk2(a.z, a.w); o.z = pk2(b.x, b.y); o.w = pk2(b.z, b.w);
        *(v4u*)(dst + i * 8) = o;
    }
}

typedef float f2v __attribute__((ext_vector_type(2)));

__device__ __forceinline__ unsigned pack_i8x4(float a, float b, float c, float d) {
    const int ia = (int)rintf(a), ib = (int)rintf(b), ic = (int)rintf(c), id = (int)rintf(d);
    return ((unsigned)ia & 255u) | (((unsigned)ib & 255u) << 8) | (((unsigned)ic & 255u) << 16) | ((unsigned)id << 24);
}

struct RowCvt { f32x4 v[2][4]; };
__device__ __forceinline__ void rc_issue(RowCvt& rc, const float* src, int row, int lane) {
    const float* sp = src + (size_t)row * D + 16 * lane;
#pragma unroll
    for (int j = 0; j < 2; ++j)
#pragma unroll
        for (int q = 0; q < 4; ++q) rc.v[j][q] = *(const f32x4*)(sp + 1024 * j + 4 * q);
}
__device__ __forceinline__ float rc_amax(const RowCvt& rc) {
    float am = 0.f;
#pragma unroll
    for (int j = 0; j < 2; ++j)
#pragma unroll
        for (int q = 0; q < 4; ++q) am = fmaxf(am, fmaxf(fmaxf(fabsf(rc.v[j][q].x), fabsf(rc.v[j][q].y)), fmaxf(fabsf(rc.v[j][q].z), fabsf(rc.v[j][q].w))));
#pragma unroll
    for (int o = 1; o < 64; o <<= 1) am = fmaxf(am, __shfl_xor(am, o));
    return am;
}
__device__ __forceinline__ void rc_finish_fp8(const RowCvt& rc, unsigned char* dst, float* inv, int row, int lane) {
    const float am = rc_amax(rc);
    const int ex = (int)((__builtin_bit_cast(unsigned, am) >> 23) & 255u);
    const float sc = (ex == 0) ? 1.0f : __builtin_bit_cast(float, (unsigned)(127 + 7 + 127 - ex) << 23);
    const float isc = (ex == 0) ? 1.0f : __builtin_bit_cast(float, (unsigned)(ex - 7) << 23);
#pragma unroll
    for (int j = 0; j < 2; ++j) { v4u o; unsigned* op = (unsigned*)&o;
#pragma unroll
        for (int q = 0; q < 4; ++q) { int p = __builtin_amdgcn_cvt_pk_fp8_f32(rc.v[j][q].x * sc, rc.v[j][q].y * sc, 0, false);
            p = __builtin_amdgcn_cvt_pk_fp8_f32(rc.v[j][q].z * sc, rc.v[j][q].w * sc, p, true); op[q] = (unsigned)p; }
        *(v4u*)(dst + (size_t)row * D + 16 * lane + 1024 * j) = o; }
    if (lane == 0) inv[row] = isc;
}
__device__ __forceinline__ void rc_finish_i8(const RowCvt& rc, unsigned char* dst, float* inv, int row, int lane) {
    const float am = rc_amax(rc);
    const float sc = (am > 0.f) ? 127.0f / am : 0.f;
#pragma unroll
    for (int j = 0; j < 2; ++j) { v4u o;
        o.x = pack_i8x4(rc.v[j][0].x * sc, rc.v[j][0].y * sc, rc.v[j][0].z * sc, rc.v[j][0].w * sc); o.y = pack_i8x4(rc.v[j][1].x * sc, rc.v[j][1].y * sc, rc.v[j][1].z * sc, rc.v[j][1].w * sc);
        o.z = pack_i8x4(rc.v[j][2].x * sc, rc.v[j][2].y * sc, rc.v[j][2].z * sc, rc.v[j][2].w * sc); o.w = pack_i8x4(rc.v[j][3].x * sc, rc.v[j][3].y * sc, rc.v[j][3].z * sc, rc.v[j][3].w * sc);
        *(v4u*)(dst + (size_t)row * D + 16 * lane + 1024 * j) = o; }
    if (lane == 0) inv[row] = am * (1.0f / 127.0f);
}
__device__ __forceinline__ void phase_prologue(const Args& A, const Ctx& C) {
    unsigned char* ws = A.ws;
    float* mod = (float*)(ws + WS_MOD);
    {
        float* red = (float*)C.lds;
        float* sc = (float*)(C.lds + 16384);
        const float* w_ada = A.in[I_WADA]; const float* cv = A.in[I_C];
        for (int i = C.tid; i < 2 * D; i += NTHREADS) sc[i] = siluf_(cv[i]);
        __syncthreads();
        for (int it = C.bid; it < MODW / 48; it += C.nb) {
            const int c4 = C.tid % 12, kg = C.tid / 12;
            f32x4 a0 = {0.f, 0.f, 0.f, 0.f}, a1 = {0.f, 0.f, 0.f, 0.f};
            if (C.tid < 504) {
                const float* wp = w_ada + 48 * it + 4 * c4;
                for (int k0 = kg; k0 < D; k0 += 42 * 7) {
                    f32x4 w[7];
#pragma unroll
                    for (int u = 0; u < 7; ++u) { const int kk = k0 + 42 * u; w[u] = __builtin_nontemporal_load((const f32x4*)(wp + (size_t)(kk < D ? kk : kg) * MODW)); }
#pragma unroll
                    for (int u = 0; u < 7; ++u) { const int kk = k0 + 42 * u; const bool ok = kk < D; const int kc = ok ? kk : kg;
                        const float s0 = ok ? sc[kc] : 0.f, s1 = ok ? sc[D + kc] : 0.f; a0 += w[u] * s0; a1 += w[u] * s1; }
                }
                float* r = red + kg * 96 + c4 * 4;
                r[0] = a0.x; r[1] = a0.y; r[2] = a0.z; r[3] = a0.w;
                r[48 + 0] = a1.x; r[48 + 1] = a1.y; r[48 + 2] = a1.z; r[48 + 3] = a1.w;
            }
            __syncthreads();
            if (C.tid < 96) {
                float s = 0.f;
                for (int g = 0; g < 42; ++g) s += red[g * 96 + C.tid];
                const int b = C.tid / 48, col = 48 * it + (C.tid % 48);
                mod[b * MODW + col] = s + A.in[I_BADA][col];
            }
            __syncthreads();
        }
    }
    {
        float* scr = (float*)(C.lds + C.wave * 16384);
        constexpr int I_IN = (D / 64) * (IN_COLS / 32);
        for (int it = C.gw; it < I_IN; it += C.ngw) p0_transpose_item_fp8(A.in[I_WIN], D, IN_COLS, ws + WS_WIN, true, scr, it, C.lane, WIN_SCALE);
    }
    cvt_stream(A.in[I_PSK], (bf16*)(ws + WS_SK), (size_t)16 * 128 * 128, C);
}


__device__ __forceinline__ void late_transposes(const Args& A, const Ctx& C, unsigned char* ldsbase, int w0, int nw) {
    unsigned char* ws = A.ws;
    float* scr = (float*)(ldsbase + C.wave * 16384);
    int lane = lane_id(); asm volatile("" : "+v"(lane));
    constexpr int I_CO = (CONV_CH / 64) * (D / 32), I_AO = (AOW / 64) * (D / 32), I_OUT = (D / 64) * (D / 32), I_Q = I_OUT;
    constexpr int NITEMS = I_CO + I_AO + I_OUT + I_Q;
    for (int it = w0; it < NITEMS; it += nw) {
        int r = it;
        if (r < I_CO) { p0_transpose_item_fp8(A.in[I_WCO], CONV_CH, D, ws + WS_WCO, false, scr, r, lane, WIN_SCALE); continue; } r -= I_CO;
        if (r < I_AO) { p0_transpose_item_fp8(A.in[I_WAO], AOW, D, ws + WS_WAO, false, scr, r, lane, WIN_SCALE); continue; } r -= I_AO;
        if (r < I_OUT) { p0_transpose_item_fp8(A.in[I_WOUT], D, D, ws + WS_WOUT, false, scr, r, lane, WIN_SCALE); continue; } r -= I_OUT;
        p0_transpose_item(A.in[I_PWQ], D, D, (bf16*)(ws + WS_WQ), false, scr, r, lane);
    }
    { RowCvt rc; for (int row = w0; row < UP_TAIL_ROWS; row += nw) { rc_issue(rc, A.in[I_PWUP], row, lane); rc_finish_i8(rc, ws + WS_WUP, (float*)(ws + WS_SUP), row, lane); } }
}
template <bool FP8OUT>
__device__ __forceinline__ void norm_mod_store(const f32x4 (&v)[8], float ss, int m, const float* gn, const float* mod, int shift_i, int scale_i, bf16* hout, int lane) {
    const float rstd = 1.0f / sqrtf(ss * (1.0f / D) + EPS);
    const int b = m / SEQ;
    const f32x4* gp = (const f32x4*)gn; const f32x4* sc = (const f32x4*)(mod + b * MODW + scale_i * D); const f32x4* sh = (const f32x4*)(mod + b * MODW + shift_i * D);
    v2u* o = (v2u*)(hout + (size_t)m * D); unsigned* o8 = (unsigned*)((unsigned char*)hout + (size_t)m * D);
#pragma unroll
    for (int j = 0; j < 8; ++j) { const int q = lane + 64 * j; const f32x4 g = gp[q], s = sc[q], h = sh[q];
        const f32x4 y = v[j] * rstd * g * (s + 1.0f) + h;
        if constexpr (FP8OUT) { int p = __builtin_amdgcn_cvt_pk_fp8_f32(y.x, y.y, 0, false); p = __builtin_amdgcn_cvt_pk_fp8_f32(y.z, y.w, p, true); o8[q] = (unsigned)p; }
        else { v2u w; w.x = pk2(y.x, y.y); w.y = pk2(y.z, y.w); o[q] = w; } }
}
template <bool FP8OUT>
__device__ __forceinline__ void phase_norm_mod(const float* xin, const float* gn, const float* mod, int shift_i, int scale_i, bf16* hout, const Ctx& C) {
    for (int m = C.gw; m < T; m += 2 * C.ngw) {
        const int m2 = m + C.ngw; const bool has2 = m2 < T;
        const f32x4* xr = (const f32x4*)(xin + (size_t)m * D); const f32x4* xr2 = (const f32x4*)(xin + (size_t)(has2 ? m2 : m) * D);
        f32x4 v[8], v2[8]; float ss = 0.f, ss2 = 0.f;
#pragma unroll
        for (int j = 0; j < 8; ++j) v[j] = __builtin_nontemporal_load(xr + C.lane + 64 * j);
#pragma unroll
        for (int j = 0; j < 8; ++j) v2[j] = __builtin_nontemporal_load(xr2 + C.lane + 64 * j);
#pragma unroll
        for (int j = 0; j < 8; ++j) { ss += (v[j].x * v[j].x + v[j].y * v[j].y) + (v[j].z * v[j].z + v[j].w * v[j].w); ss2 += (v2[j].x * v2[j].x + v2[j].y * v2[j].y) + (v2[j].z * v2[j].z + v2[j].w * v2[j].w); }
#pragma unroll
        for (int o = 1; o < 64; o <<= 1) { ss += __shfl_xor(ss, o); ss2 += __shfl_xor(ss2, o); }
        norm_mod_store<FP8OUT>(v, ss, m, gn, mod, shift_i, scale_i, hout, C.lane);
        if (has2) norm_mod_store<FP8OUT>(v2, ss2, m2, gn, mod, shift_i, scale_i, hout, C.lane);
    }
}

__device__ __forceinline__ unsigned f2ord(float f) { const unsigned u = __builtin_bit_cast(unsigned, f); return u ^ ((u >> 31) ? 0xFFFFFFFFu : 0x80000000u); }
__device__ __forceinline__ float ord2f(unsigned u) { return __builtin_bit_cast(float, (u & 0x80000000u) ? (u ^ 0x80000000u) : ~u); }
template <int CTRL> __device__ __forceinline__ unsigned dpp_u(unsigned x) { return (unsigned)__builtin_amdgcn_update_dpp(0, (int)x, CTRL, 0xF, 0xF, false); }
__device__ __forceinline__ unsigned rowmax_u(unsigned x) {
    x = max(x, dpp_u<0x128>(x)); x = max(x, dpp_u<0x124>(x)); x = max(x, dpp_u<0x122>(x)); x = max(x, dpp_u<0x121>(x)); return x; }
__device__ __forceinline__ float rowsum_f(float x) {
    x += __builtin_bit_cast(float, dpp_u<0x128>(__builtin_bit_cast(unsigned, x))); x += __builtin_bit_cast(float, dpp_u<0x124>(__builtin_bit_cast(unsigned, x)));
    x += __builtin_bit_cast(float, dpp_u<0x122>(__builtin_bit_cast(unsigned, x))); x += __builtin_bit_cast(float, dpp_u<0x121>(__builtin_bit_cast(unsigned, x))); return x; }
#define CE_DESC(a, b) do { const unsigned _hi = max(a, b), _lo = min(a, b); a = _hi; b = _lo; } while (0)
__device__ __forceinline__ void phase_topk(const Args& A, const Ctx& C) {
    const bf16* QP = (const bf16*)(A.ws + WS_QP); const bf16* SK = (const bf16*)(A.ws + WS_SK);
    int* IDX = (int*)(A.ws + WS_IDX); float* GW = (float*)(A.ws + WS_GW);
    const int lane = C.lane, i = lane & 15, g = lane >> 4;
    constexpr int SKROW = 272;
    const bool sk_lds = (C.nb & 7) == 0;
    LAS unsigned char* skl = (LAS unsigned char*)C.lds;
    if (sk_lds) { const int hh_ = C.bid & 7;
        for (int c_ = C.tid; c_ < 256 * 16; c_ += NTHREADS) { const int row_ = c_ >> 4, ch_ = c_ & 15;
            *(LAS v4u*)(skl + row_ * SKROW + ch_ * 16) = *(const v4u*)(SK + ((size_t)(2 * hh_) * 128 + row_) * 128 + ch_ * 8); }
        __syncthreads(); }
    if (C.wave >= TK_W) {
        const int cw = C.bid * (NWAVES - TK_W) + (C.wave - TK_W), ncw = C.nb * (NWAVES - TK_W); RowCvt ra, rb;
        for (int row = UP_TAIL_ROWS + cw; row < 2 * PEER_E; row += 2 * ncw) {
            const int row2 = row + ncw; const bool has2 = row2 < 2 * PEER_E;
            rc_issue(ra, row < PEER_E ? A.in[I_PWUP] : A.in[I_PWDN], row < PEER_E ? row : row - PEER_E, lane);
            if (has2) rc_issue(rb, row2 < PEER_E ? A.in[I_PWUP] : A.in[I_PWDN], row2 < PEER_E ? row2 : row2 - PEER_E, lane);
            if (row < PEER_E) rc_finish_i8(ra, A.ws + WS_WUP, (float*)(A.ws + WS_SUP), row, lane); else rc_finish_fp8(ra, A.ws + WS_WDN, (float*)(A.ws + WS_SDN), row - PEER_E, lane);
            if (has2) { if (row2 < PEER_E) rc_finish_i8(rb, A.ws + WS_WUP, (float*)(A.ws + WS_SUP), row2, lane); else rc_finish_fp8(rb, A.ws + WS_WDN, (float*)(A.ws + WS_SDN), row2 - PEER_E, lane); }
        }
        return;
    }
    __builtin_amdgcn_s_setprio(2);
    int crow = 2 * PEER_E; RowCvt rc;
#define CV_ISSUE() do { asm volatile("" ::: "memory"); if (crow < 2 * PEER_E) rc_issue(rc, crow < PEER_E ? A.in[I_PWUP] : A.in[I_PWDN], crow < PEER_E ? crow : crow - PEER_E, lane); } while (0)
#define CV_FINISH() do { if (crow < 2 * PEER_E) { if (crow < PEER_E) rc_finish_i8(rc, A.ws + WS_WUP, (float*)(A.ws + WS_SUP), crow, lane); \
        else rc_finish_fp8(rc, A.ws + WS_WDN, (float*)(A.ws + WS_SDN), crow - PEER_E, lane); crow += C.ngw; } asm volatile("" ::: "memory"); } while (0)
    const int it_first = sk_lds ? ((C.bid >> 3) + (C.nb >> 3) * C.wave) * 8 + (C.bid & 7) : C.bid * TK_W + C.wave;
    const int it_step = sk_lds ? (C.nb >> 3) * TK_W * 8 : C.nb * TK_W;
    for (int it = it_first; it < (T / 16) * PEER_H; it += it_step) {
        const int tile = it >> 3, t0 = tile * 16; int h = it & 7; asm volatile("" : "+s"(h));
        unsigned win[2][4];
#pragma unroll
        for (int p = 0; p < 2; ++p) {
            const int slot = 2 * h + p;
            pg8::bf16x8 aq[4];
#pragma unroll
            for (int ks = 0; ks < 4; ++ks) aq[ks] = *(const pg8::bf16x8*)(QP + (size_t)(t0 + i) * D + slot * 128 + 32 * ks + 8 * g);
            unsigned K[4][8];
#pragma unroll
            for (int nt = 0; nt < 8; ++nt) {
                f32x4 acc = {0.f, 0.f, 0.f, 0.f};
                if (sk_lds) { LAS unsigned char* krl = skl + (p * 128 + 16 * nt + i) * SKROW + 16 * g;
#pragma unroll
                    for (int ks = 0; ks < 4; ++ks) acc = __builtin_amdgcn_mfma_f32_16x16x32_bf16(aq[ks], *(const LAS pg8::bf16x8*)(krl + 64 * ks), acc, 0, 0, 0); }
                else { const bf16* kr = SK + ((size_t)slot * 128 + 16 * nt + i) * 128 + 8 * g;
#pragma unroll
                    for (int ks = 0; ks < 4; ++ks) acc = __builtin_amdgcn_mfma_f32_16x16x32_bf16(aq[ks], *(const pg8::bf16x8*)(kr + 32 * ks), acc, 0, 0, 0); }
#pragma unroll
                for (int r = 0; r < 4; ++r) K[r][nt] = (f2ord(acc[r]) & ~127u) | (unsigned)(127 - (16 * nt + i));
            }
#pragma unroll
            for (int r = 0; r < 4; ++r) {
                CV_ISSUE();
                unsigned* k = K[r];
                CE_DESC(k[0], k[1]); CE_DESC(k[2], k[3]); CE_DESC(k[4], k[5]); CE_DESC(k[6], k[7]);
                CE_DESC(k[0], k[2]); CE_DESC(k[1], k[3]); CE_DESC(k[4], k[6]); CE_DESC(k[5], k[7]);
                CE_DESC(k[1], k[2]); CE_DESC(k[5], k[6]);
                CE_DESC(k[0], k[4]); CE_DESC(k[1], k[5]); CE_DESC(k[2], k[6]); CE_DESC(k[3], k[7]);
                CE_DESC(k[2], k[4]); CE_DESC(k[3], k[5]);
                CE_DESC(k[1], k[2]); CE_DESC(k[3], k[4]); CE_DESC(k[5], k[6]);
                unsigned w = 0u;
#pragma unroll
                for (int kk = 0; kk < PEER_TOPK; ++kk) {
                    const unsigned M = rowmax_u(k[0]);
                    const bool pop = (k[0] == M);
#pragma unroll
                    for (int q = 0; q < 7; ++q) k[q] = pop ? k[q + 1] : k[q];
                    k[7] = pop ? 0u : k[7];
                    w = (i == kk) ? M : w;
                }
                win[p][r] = w;
                CV_FINISH();
            }
        }
#pragma unroll
        for (int r = 0; r < 4; ++r) {
            CV_ISSUE();
            const float v1 = ord2f(win[0][r] & ~127u), v2 = ord2f(win[1][r] & ~127u);
            int j = 0;
            float nv = __builtin_bit_cast(float, __builtin_amdgcn_ds_bpermute(4 * (16 * g), __builtin_bit_cast(int, v2)));
            unsigned key = (f2ord(v1 + nv) & ~255u) | (unsigned)(255 - 16 * i);
            unsigned w = 0u; float mx = 0.f;
#pragma unroll
            for (int kk = 0; kk < PEER_TOPK; ++kk) {
                const unsigned M = rowmax_u(key);
                if (kk == 0) mx = ord2f(M & ~255u);
                const bool pop = (key == M);
                j += pop ? 1 : 0;
                const int jj = j < 15 ? j : 15;
                nv = __builtin_bit_cast(float, __builtin_amdgcn_ds_bpermute(4 * (16 * g + jj), __builtin_bit_cast(int, v2)));
                const unsigned nk = (j < 16) ? ((f2ord(v1 + nv) & ~255u) | (unsigned)(255 - (16 * i + jj))) : 0u;
                key = pop ? nk : key;
                w = (i == kk) ? M : w;
            }
            const int ci = 255 - (int)(w & 255u);
            const int n1 = 127 - (int)(win[0][r] & 127u), n2 = 127 - (int)(win[1][r] & 127u);
            const int e1 = __builtin_amdgcn_ds_bpermute(4 * (16 * g + (ci >> 4)), n1), e2 = __builtin_amdgcn_ds_bpermute(4 * (16 * g + (ci & 15)), n2);
            const float ex = __expf(ord2f(w & ~255u) - mx);
            const float sum = rowsum_f(ex);
            const size_t o = (size_t)(t0 + 4 * g + r) * PEER_HK + h * PEER_TOPK + i;
            IDX[o] = e1 * PEER_NK + e2; GW[o] = ex / sum;
            CV_FINISH();
        }
    }
    while (crow < 2 * PEER_E) { CV_ISSUE(); CV_FINISH(); }
    __builtin_amdgcn_s_setprio(0);
#undef CV_ISSUE
#undef CV_FINISH
}

typedef __bf16 bf16x2v __attribute__((ext_vector_type(2)));
__device__ __forceinline__ float dot2bf(unsigned w, unsigned x, float acc) { return __builtin_amdgcn_fdot2_f32_bf16(__builtin_bit_cast(bf16x2v, w), __builtin_bit_cast(bf16x2v, x), acc, false); }
__device__ __forceinline__ f2v fp8lo(unsigned w) { return __builtin_amdgcn_cvt_pk_f32_fp8((int)w, false); }
__device__ __forceinline__ f2v fp8hi(unsigned w) { return __builtin_amdgcn_cvt_pk_f32_fp8((int)w, true); }
constexpr int EXB = 8;


constexpr int EX_LDS_WAVE = 4 * 4096 + 2048;
typedef __bf16 bf16x2w __attribute__((ext_vector_type(2)));
__device__ __forceinline__ float gelu_as(float v) {
    const float av = fabsf(v), t = __builtin_amdgcn_rcpf(av * 0.2316419f + 1.0f);
    float q = t * 0.5307027145f + (-0.7265760135f); q = q * t + 0.7107068705f; q = q * t + (-0.142248368f); q = q * t + 0.127414796f; q = q * t;
    const float e = __builtin_amdgcn_exp2f((v * v) * (-0.72134752044f));
    const float m = v * (q * e);
    return v < 0.f ? m : v - m;
}
__device__ __forceinline__ v4u ldrow16(const unsigned char* sbase, unsigned voff) { return *(const v4u*)(sbase + voff); }
__device__ __forceinline__ v2u ldrow8(const unsigned char* sbase, unsigned voff) { return *(const v2u*)(sbase + voff); }
__device__ __forceinline__ int dot16_i8(const v4u w0, const v4u h0) {
    int s0 = __builtin_amdgcn_sdot4((int)w0.x, (int)h0.x, 0, false), s1 = __builtin_amdgcn_sdot4((int)w0.y, (int)h0.y, 0, false);
    s0 = __builtin_amdgcn_sdot4((int)w0.z, (int)h0.z, s0, false); s1 = __builtin_amdgcn_sdot4((int)w0.w, (int)h0.w, s1, false);
    return s0 + s1;
}
__device__ __forceinline__ int dot32_i8(const v4u w0, const v4u h0, const v4u w1, const v4u h1) {
    int s0 = __builtin_amdgcn_sdot4((int)w0.x, (int)h0.x, 0, false), s1 = __builtin_amdgcn_sdot4((int)w0.y, (int)h0.y, 0, false);
    s0 = __builtin_amdgcn_sdot4((int)w0.z, (int)h0.z, s0, false); s1 = __builtin_amdgcn_sdot4((int)w0.w, (int)h0.w, s1, false);
    s0 = __builtin_amdgcn_sdot4((int)w1.x, (int)h1.x, s0, false); s1 = __builtin_amdgcn_sdot4((int)w1.y, (int)h1.y, s1, false);
    s0 = __builtin_amdgcn_sdot4((int)w1.z, (int)h1.z, s0, false); s1 = __builtin_amdgcn_sdot4((int)w1.w, (int)h1.w, s1, false);
    return s0 + s1;
}
__device__ __forceinline__ float dot2_f2v_bf16(f2v a, unsigned h, float s) { return __builtin_amdgcn_fdot2_f32_bf16(__builtin_convertvector(a, bf16x2w), __builtin_bit_cast(bf16x2w, h), s, false); }
__device__ __forceinline__ float dot16_fp8_bf16(const v4u w, const v4u ha, const v4u hb, float s) {
#define D2(W, HI, H) s = dot2_f2v_bf16((HI) ? fp8hi(W) : fp8lo(W), H, s)
    D2(w.x, 0, ha.x); D2(w.x, 1, ha.y); D2(w.y, 0, ha.z); D2(w.y, 1, ha.w); D2(w.z, 0, hb.x); D2(w.z, 1, hb.y); D2(w.w, 0, hb.z); D2(w.w, 1, hb.w);
#undef D2
    return s;
}
#define EX_AXPY(ACC, W0, W1, CC) do { \
    ACC[0][0] = __builtin_elementwise_fma(fp8lo((W0).x), CC, ACC[0][0]); ACC[0][1] = __builtin_elementwise_fma(fp8hi((W0).x), CC, ACC[0][1]); \
    ACC[0][2] = __builtin_elementwise_fma(fp8lo((W0).y), CC, ACC[0][2]); ACC[0][3] = __builtin_elementwise_fma(fp8hi((W0).y), CC, ACC[0][3]); \
    ACC[0][4] = __builtin_elementwise_fma(fp8lo((W0).z), CC, ACC[0][4]); ACC[0][5] = __builtin_elementwise_fma(fp8hi((W0).z), CC, ACC[0][5]); \
    ACC[0][6] = __builtin_elementwise_fma(fp8lo((W0).w), CC, ACC[0][6]); ACC[0][7] = __builtin_elementwise_fma(fp8hi((W0).w), CC, ACC[0][7]); \
    ACC[1][0] = __builtin_elementwise_fma(fp8lo((W1).x), CC, ACC[1][0]); ACC[1][1] = __builtin_elementwise_fma(fp8hi((W1).x), CC, ACC[1][1]); \
    ACC[1][2] = __builtin_elementwise_fma(fp8lo((W1).y), CC, ACC[1][2]); ACC[1][3] = __builtin_elementwise_fma(fp8hi((W1).y), CC, ACC[1][3]); \
    ACC[1][4] = __builtin_elementwise_fma(fp8lo((W1).z), CC, ACC[1][4]); ACC[1][5] = __builtin_elementwise_fma(fp8hi((W1).z), CC, ACC[1][5]); \
    ACC[1][6] = __builtin_elementwise_fma(fp8lo((W1).w), CC, ACC[1][6]); ACC[1][7] = __builtin_elementwise_fma(fp8hi((W1).w), CC, ACC[1][7]); } while (0)
__device__ __forceinline__ void phase_experts3(const Args& A, const Ctx& C, float* dst, unsigned emask) {
    const bf16* H2 = (const bf16*)(A.ws + WS_H); const bf16* X1B = (const bf16*)(A.ws + WS_X1B); const unsigned char* WUP = A.ws + WS_WUP; const unsigned char* WDN = A.ws + WS_WDN;
    const float* SUP = (const float*)(A.ws + WS_SUP); const float* SDN = (const float*)(A.ws + WS_SDN);
    const int* IDX = (const int*)(A.ws + WS_IDX); const float* GW = (const float*)(A.ws + WS_GW); const float* mod = (const float*)(A.ws + WS_MOD);
    LAS unsigned char* hb = (LAS unsigned char*)C.lds + C.wave * EX_LDS_WAVE;
    LAS unsigned* keys = (LAS unsigned*)(hb + 8192);
    for (int tg = C.gw; tg < T / 4; tg += C.ngw) {
        unsigned z_ = 0u; asm volatile("" : "+v"(z_));
        int lane = (int)__builtin_amdgcn_mbcnt_hi(~0u, __builtin_amdgcn_mbcnt_lo(~0u, z_));
        const int t0 = 4 * tg;
        float hs4[4];
        {
          float rs4[4]; float sv[2][16];
          { const float* SSQ = (const float*)(A.ws + WS_SSQ);
            float sa = SSQ[(size_t)(t0 + (lane >> 5)) * 32 + (lane & 31)], sb = SSQ[(size_t)(t0 + 2 + (lane >> 5)) * 32 + (lane & 31)];
#pragma unroll
            for (int o = 1; o < 32; o <<= 1) { sa += __shfl_xor(sa, o); sb += __shfl_xor(sb, o); }
            const float q0 = __builtin_bit_cast(float, __builtin_amdgcn_readlane(__builtin_bit_cast(int, sa), 0)), q1 = __builtin_bit_cast(float, __builtin_amdgcn_readlane(__builtin_bit_cast(int, sa), 32));
            const float q2 = __builtin_bit_cast(float, __builtin_amdgcn_readlane(__builtin_bit_cast(int, sb), 0)), q3 = __builtin_bit_cast(float, __builtin_amdgcn_readlane(__builtin_bit_cast(int, sb), 32));
            rs4[0] = 1.0f / sqrtf(q0 * (1.0f / D) + EPS); rs4[1] = 1.0f / sqrtf(q1 * (1.0f / D) + EPS); rs4[2] = 1.0f / sqrtf(q2 * (1.0f / D) + EPS); rs4[3] = 1.0f / sqrtf(q3 * (1.0f / D) + EPS);
            const float* sh = mod + (t0 / SEQ) * 12288 + 3 * 2048;
#pragma unroll
            for (int j = 0; j < 2; ++j)
#pragma unroll
                for (int q4 = 0; q4 < 4; ++q4) { const f32x4 v_ = *(const f32x4*)(sh + 16 * lane + 1024 * j + 4 * q4); sv[j][4 * q4] = v_.x; sv[j][4 * q4 + 1] = v_.y; sv[j][4 * q4 + 2] = v_.z; sv[j][4 * q4 + 3] = v_.w; } }
#pragma unroll
          for (int tk = 0; tk < 4; ++tk) {
              float hv[2][16]; float am = 0.f;
#pragma unroll
              for (int j = 0; j < 2; ++j) { const v4u a = *(const v4u*)(H2 + (size_t)(t0 + tk) * D + 16 * lane + 1024 * j), b = *(const v4u*)(H2 + (size_t)(t0 + tk) * D + 16 * lane + 1024 * j + 8);
                  hv[j][0] = bflo(a.x); hv[j][1] = bfhi(a.x); hv[j][2] = bflo(a.y); hv[j][3] = bfhi(a.y); hv[j][4] = bflo(a.z); hv[j][5] = bfhi(a.z); hv[j][6] = bflo(a.w); hv[j][7] = bfhi(a.w);
                  hv[j][8] = bflo(b.x); hv[j][9] = bfhi(b.x); hv[j][10] = bflo(b.y); hv[j][11] = bfhi(b.y); hv[j][12] = bflo(b.z); hv[j][13] = bfhi(b.z); hv[j][14] = bflo(b.w); hv[j][15] = bfhi(b.w);
#pragma unroll
                  for (int q = 0; q < 16; ++q) { hv[j][q] = hv[j][q] * rs4[tk] + sv[j][q]; am = fmaxf(am, fabsf(hv[j][q])); } }
#pragma unroll
              for (int o = 1; o < 64; o <<= 1) am = fmaxf(am, __shfl_xor(am, o));
              const float sc = (am > 0.f) ? 127.0f / am : 0.f; hs4[tk] = am * (1.0f / 127.0f);
#pragma unroll
              for (int j = 0; j < 2; ++j) { v4u o;
                  o.x = pack_i8x4(hv[j][0] * sc, hv[j][1] * sc, hv[j][2] * sc, hv[j][3] * sc); o.y = pack_i8x4(hv[j][4] * sc, hv[j][5] * sc, hv[j][6] * sc, hv[j][7] * sc);
                  o.z = pack_i8x4(hv[j][8] * sc, hv[j][9] * sc, hv[j][10] * sc, hv[j][11] * sc); o.w = pack_i8x4(hv[j][12] * sc, hv[j][13] * sc, hv[j][14] * sc, hv[j][15] * sc);
                  *(LAS v4u*)(hb + tk * 2048 + 16 * lane + 1024 * j) = o; } }
        }
        LAS unsigned* keysM = keys + 512;
        LAS float* cfl = (LAS float*)(keys + 1024);
        unsigned K[8];
#pragma unroll
        for (int s = 0; s < 8; ++s) { const int tk = s >> 1, slot = lane + 64 * (s & 1); const unsigned e = (unsigned)IDX[(size_t)(t0 + tk) * PEER_HK + slot];
            K[s] = (e << 9) | ((unsigned)tk << 7) | (unsigned)slot; }
#define EX_SORT512(KK, KLO, KHI) do { _Pragma("unroll") for (int k = (KLO); k <= (KHI); k <<= 1) { _Pragma("unroll") for (int j = k >> 1; j >= 1; j >>= 1) { \
            if (j >= 64) { const int ds = j >> 6; _Pragma("unroll") for (int s = 0; s < 8; ++s) if ((s & ds) == 0) { const bool up = ((64 * s) & k) == 0; \
                    const unsigned a_ = min(KK[s], KK[s | ds]), b_ = max(KK[s], KK[s | ds]); KK[s] = up ? a_ : b_; KK[s | ds] = up ? b_ : a_; } } \
            else { const bool lower = (lane & j) == 0; _Pragma("unroll") for (int s = 0; s < 8; ++s) { const unsigned o = (j == 1) ? dpp_u<0xB1>(KK[s]) : (j == 2) ? dpp_u<0x4E>(KK[s]) : (j == 8) ? dpp_u<0x128>(KK[s]) : (unsigned)__shfl_xor(KK[s], j);        \
                    const bool up = ((lane + 64 * s) & k) == 0; \
                    KK[s] = (up == lower) ? min(KK[s], o) : max(KK[s], o); } } } } } while (0)
        EX_SORT512(K, 2, 128);
#pragma unroll
        for (int s = 0; s < 8; ++s) { const int p = lane + 64 * s, tok = p >> 7, r_ = p & 127; keys[((tok & 1) ? 127 - r_ : r_) * 4 + tok] = K[s]; }
        asm volatile("" : "+v"(lane));
        EX_SORT512(K, 256, 512);
#pragma unroll
        for (int s = 0; s < 8; ++s) keysM[lane + 64 * s] = K[s];
        { LAS float* tabU = (LAS float*)(keys + 1536); LAS float* tabG = (LAS float*)(keys + 2048); float su8[8], sd8[8], gg8[8];
#pragma unroll
          for (int s = 0; s < 8; ++s) { const unsigned kk_ = K[s]; const unsigned e_ = (kk_ >> 9) & emask; su8[s] = SUP[e_]; sd8[s] = SDN[e_]; gg8[s] = GW[(size_t)(t0 + (int)((kk_ >> 7) & 3u)) * PEER_HK + (kk_ & 127u)]; }
#pragma unroll
          for (int s = 0; s < 8; ++s) { tabU[lane + 64 * s] = su8[s]; tabG[lane + 64 * s] = gg8[s] * sd8[s]; } }
#undef EX_SORT512
        asm volatile("s_waitcnt lgkmcnt(0)" ::: "memory");
        asm volatile("" : "+v"(lane));
        constexpr int EX_NB = 128;
        {
            const int gq_ = lane >> 4, li_ = lane & 15;
            v4u bw[2][8]; unsigned kcur = keysM[gq_];
#define EX_UP_LD(KW, BUF) do { const unsigned char* r_ = WUP + (size_t)(((KW) >> 9) & emask) * D + 16 * li_; \
            _Pragma("unroll") for (int q_ = 0; q_ < 8; ++q_) bw[BUF][q_] = *(const v4u*)(r_ + 256 * q_); } while (0)
#define EX_UP_STEP(B, CUR) do { \
            const unsigned knext = keysM[4 * (((B) + 1 < EX_NB) ? (B) + 1 : (B)) + gq_]; \
            EX_UP_LD(knext, (CUR) ^ 1); \
            const unsigned me = kcur >> 9, mtok = (kcur >> 7) & 3u, mslot = kcur & 127u; \
            const float su = ((LAS float*)(keys + 1536))[4 * (B) + gq_], gs_ = ((LAS float*)(keys + 2048))[4 * (B) + gq_]; \
            LAS unsigned char* hr = hb + mtok * 2048 + 16 * li_; int s0_ = 0, s1_ = 0; \
            _Pragma("unroll") for (int q_ = 0; q_ < 8; q_ += 2) { const v4u h0 = *(LAS v4u*)(hr + 256 * q_), h1 = *(LAS v4u*)(hr + 256 * q_ + 256); \
                s0_ += dot16_i8(bw[CUR][q_], h0); s1_ += dot16_i8(bw[CUR][q_ + 1], h1); } \
            unsigned s_ = (unsigned)(s0_ + s1_); \
            s_ += dpp_u<0x128>(s_); s_ += dpp_u<0x124>(s_); s_ += dpp_u<0x122>(s_); s_ += dpp_u<0x121>(s_);            \
            const float hs_ = (mtok == 0u) ? hs4[0] : (mtok == 1u) ? hs4[1] : (mtok == 2u) ? hs4[2] : hs4[3]; \
            cfl[mtok * 128u + mslot] = gs_ * gelu_as((float)(int)s_ * su * hs_); \
            kcur = knext; } while (0)
            EX_UP_LD(kcur, 0);
            for (int b = 0; b < EX_NB; b += 2) { EX_UP_STEP(b, 0); EX_UP_STEP(b + 1, 1); }
#undef EX_UP_LD
#undef EX_UP_STEP
        }
        asm volatile("s_waitcnt lgkmcnt(0)" ::: "memory");
        asm volatile("" : "+v"(lane));
        const int bb = t0 / SEQ;
        constexpr int EX_DB = 2;
        LAS unsigned* rowT = keys + 1536;
        LAS float* cfT = (LAS float*)(keys + 2048);
#pragma unroll
        for (int s = 0; s < 8; ++s) { const int q_ = lane + 64 * s; const unsigned kk_ = keys[q_]; const unsigned e_ = (kk_ >> 9) & emask;
            rowT[q_] = e_ * (unsigned)D; cfT[q_] = cfl[(q_ & 3) * 128 + (int)(kk_ & 127u)]; }
        asm volatile("s_waitcnt lgkmcnt(0)" ::: "memory");
        const int hl_ = lane >> 5, l5_ = lane & 31;
#define EX_AXPY2(ACC, W0, CC) do { \
    ACC[0] = __builtin_elementwise_fma(fp8lo((W0).x), CC, ACC[0]); ACC[1] = __builtin_elementwise_fma(fp8hi((W0).x), CC, ACC[1]); \
    ACC[2] = __builtin_elementwise_fma(fp8lo((W0).y), CC, ACC[2]); ACC[3] = __builtin_elementwise_fma(fp8hi((W0).y), CC, ACC[3]); \
    ACC[4] = __builtin_elementwise_fma(fp8lo((W0).z), CC, ACC[4]); ACC[5] = __builtin_elementwise_fma(fp8hi((W0).z), CC, ACC[5]); \
    ACC[6] = __builtin_elementwise_fma(fp8lo((W0).w), CC, ACC[6]); ACC[7] = __builtin_elementwise_fma(fp8hi((W0).w), CC, ACC[7]); } while (0)
#define EX_DN_LD(BQ, BUF) do { _Pragma("unroll") for (int bb_ = 0; bb_ < EX_DB; ++bb_) { const v2u rv = *(LAS v2u*)(rowT + 4 * ((BQ) + bb_) + 2 * hl_); \
            bd[BUF][bb_][0] = ldrow16(WDN, rv.x + voff_); bd[BUF][bb_][1] = ldrow16(WDN, rv.y + voff_); } } while (0)
#define EX_DN_STEP(B, CUR) do { \
            EX_DN_LD((((B) + EX_DB < EX_NB) ? (B) + EX_DB : (B)), (CUR) ^ 1); \
            _Pragma("unroll") for (int bb_ = 0; bb_ < EX_DB; ++bb_) { const f2v cv = *(LAS f2v*)(cfT + 4 * ((B) + bb_) + 2 * hl_); \
                { const f2v cc = {cv.x, cv.x}; EX_AXPY2(a0, bd[CUR][bb_][0], cc); } \
                { const f2v cc = {cv.y, cv.y}; EX_AXPY2(a1, bd[CUR][bb_][1], cc); } } } while (0)
#define EX_OUT2(I, ACC) do { _Pragma("unroll") for (int m_ = 0; m_ < 4; ++m_) { const v4u xq_ = xpre[I][m_ >> 1]; const unsigned xa_ = (m_ & 1) ? xq_.z : xq_.x, xb2_ = (m_ & 1) ? xq_.w : xq_.y; \
            const f32x4 g = gpre[m_]; f32x4 x = {bflo(xa_), bfhi(xa_), bflo(xb2_), bfhi(xb2_)}; \
            x.x += g.x * ACC[2 * m_].x; x.y += g.y * ACC[2 * m_].y; x.z += g.z * ACC[2 * m_ + 1].x; x.w += g.w * ACC[2 * m_ + 1].y; \
            *(f32x4*)(dst + (size_t)(t0 + 2 * hl_ + (I)) * D + col_ + 4 * m_) = x; } } while (0)
#define EX_DN_PASS(J) do { v4u bd[2][EX_DB][2]; const int col_ = 512 * (J) + 16 * l5_; const unsigned voff_ = (unsigned)col_; f2v a0[8], a1[8]; \
            v4u xpre[2][2]; f32x4 gpre[4];        \
            _Pragma("unroll") for (int m_ = 0; m_ < 4; ++m_) gpre[m_] = *(const f32x4*)(mod + bb * MODW + 5 * D + col_ + 4 * m_); \
            _Pragma("unroll") for (int i_ = 0; i_ < 2; ++i_) { xpre[i_][0] = *(const v4u*)(X1B + (size_t)(t0 + 2 * hl_ + i_) * D + col_); xpre[i_][1] = *(const v4u*)(X1B + (size_t)(t0 + 2 * hl_ + i_) * D + col_ + 8); } \
            __builtin_amdgcn_sched_barrier(0); \
            _Pragma("unroll") for (int q = 0; q < 8; ++q) { a0[q] = (f2v){0.f, 0.f}; a1[q] = (f2v){0.f, 0.f}; } \
            EX_DN_LD(0, 0); \
            for (int b = 0; b < EX_NB; b += 2 * EX_DB) { EX_DN_STEP(b, 0); EX_DN_STEP(b + EX_DB, 1); } \
            EX_OUT2(0, a0); EX_OUT2(1, a1); } while (0)
        EX_DN_PASS(0);
        asm volatile("" : "+v"(lane));
        EX_DN_PASS(1);
        asm volatile("" : "+v"(lane));
        EX_DN_PASS(2);
        asm volatile("" : "+v"(lane));
        EX_DN_PASS(3);
#undef EX_DN_PASS
#undef EX_DN_LD
#undef EX_DN_STEP
#undef EX_AXPY2
#undef EX_OUT2
        asm volatile("s_waitcnt lgkmcnt(0)" ::: "memory");
    }
}

constexpr int CONV_TT = 16;
__device__ __forceinline__ void wave_reduce16(float (&v)[16], int lane) {
    const bool b5 = lane & 32, b4 = lane & 16, b3 = lane & 8, b2 = lane & 4;
#pragma unroll
    for (int k = 0; k < 8; ++k) { const float keep = b5 ? v[k + 8] : v[k], send = b5 ? v[k] : v[k + 8]; v[k] = keep + __shfl_xor(send, 32); }
#pragma unroll
    for (int k = 0; k < 4; ++k) { const float keep = b4 ? v[k + 4] : v[k], send = b4 ? v[k] : v[k + 4]; v[k] = keep + __shfl_xor(send, 16); }
#pragma unroll
    for (int k = 0; k < 2; ++k) { const float keep = b3 ? v[k + 2] : v[k], send = b3 ? v[k] : v[k + 2]; v[k] = keep + __shfl_xor(send, 8); }
    { const float keep = b2 ? v[1] : v[0], send = b2 ? v[0] : v[1]; v[0] = keep + __shfl_xor(send, 4); }
    v[0] += __shfl_xor(v[0], 2); v[0] += __shfl_xor(v[0], 1);
}
__device__ __forceinline__ void phase_conv(const Args& A, const Ctx& C) {
    const bf16* U = (const bf16*)(A.ws + WS_U); unsigned char* UCV = A.ws + WS_UCV;
    const float* dw = A.in[I_CDW]; const float* db = A.in[I_CDB]; const float* lg = A.in[I_CLNG]; const float* lb = A.in[I_CLNB];
    LAS float* red = (LAS float*)((LAS unsigned char*)C.lds);
    const int c0 = 2 * C.tid, lane = C.lane;
    f2v w2[CONV_K];
#pragma unroll
    for (int j = 0; j < CONV_K; ++j) { const float2 w = *(const float2*)(dw + j * CONV_CH + c0); w2[j] = (f2v){w.x, w.y}; }
    const float2 bias = *(const float2*)(db + c0), gam = *(const float2*)(lg + c0), bet = *(const float2*)(lb + c0);
    const int tsel = ((lane >> 5) & 1) * 8 + ((lane >> 4) & 1) * 4 + ((lane >> 3) & 1) * 2 + ((lane >> 2) & 1);
    for (int it = C.bid; it < T / CONV_TT; it += C.nb) {
        const int t0 = it * CONV_TT, s0 = t0 % SEQ;
        unsigned in[CONV_TT + CONV_K - 1];
#pragma unroll
        for (int q = 0; q < CONV_TT + CONV_K - 1; ++q) { const int sp = s0 - (CONV_K - 1) + q;
            in[q] = (sp >= 0) ? *(const unsigned*)(U + (size_t)(t0 - (CONV_K - 1) + q) * CONV_CH + c0) : 0u; }
        float a0[CONV_TT], a1[CONV_TT];
#pragma unroll
        for (int k = 0; k < CONV_TT; ++k) { f2v xa = {bias.x, bias.y};
#pragma unroll
            for (int j = 0; j < CONV_K; ++j) { const f2v iv = {bflo(in[k + j]), bfhi(in[k + j])}; xa = __builtin_elementwise_fma(w2[j], iv, xa); }
            a0[k] = xa.x; a1[k] = xa.y; }
        float v[16];
#pragma unroll
        for (int k = 0; k < 16; ++k) v[k] = a0[k] + a1[k];
        wave_reduce16(v, lane);
        __syncthreads();
        if ((lane & 3) == 0) red[C.wave * 16 + tsel] = v[0];
        __syncthreads();
        float mean[16];
#pragma unroll
        for (int k = 0; k < 16; ++k) { float s = 0.f;
#pragma unroll
            for (int wv = 0; wv < NWAVES; ++wv) s += red[wv * 16 + k];
            mean[k] = s * (1.0f / CONV_CH); }
#pragma unroll
        for (int k = 0; k < 16; ++k) { a0[k] -= mean[k]; a1[k] -= mean[k]; v[k] = a0[k] * a0[k] + a1[k] * a1[k]; }
        wave_reduce16(v, lane);
        __syncthreads();
        if ((lane & 3) == 0) red[C.wave * 16 + tsel] = v[0];
        __syncthreads();
#pragma unroll
        for (int k = 0; k < 16; ++k) { float s = 0.f;
#pragma unroll
            for (int wv = 0; wv < NWAVES; ++wv) s += red[wv * 16 + k];
            const float rstd = 1.0f / sqrtf(s * (1.0f / CONV_CH) + EPS);
            const float y0 = a0[k] * rstd * gam.x + bet.x, y1 = a1[k] * rstd * gam.y + bet.y;
            *(unsigned short*)(UCV + (size_t)(t0 + k) * CONV_CH + c0) = (unsigned short)__builtin_amdgcn_cvt_pk_fp8_f32(siluf_(y0) * UCV_SCALE, siluf_(y1) * UCV_SCALE, 0, false); }
    }
    __syncthreads();
}

typedef short v4i16_t __attribute__((ext_vector_type(4)));
constexpr int VROW = 288;
constexpr int ATT_V_BYTES = 256 * VROW;
constexpr int KROW = 272;
constexpr int ATT_K_OFF = ATT_V_BYTES;
constexpr int ATT_SCR_OFF = ATT_V_BYTES + 256 * KROW;
constexpr int ATT_RK_OFF = ATT_SCR_OFF + NWAVES * 256;
__device__ __forceinline__ void phase_attn(const Args& A, const Ctx& C) {
    const bf16* QKV = (const bf16*)(A.ws + WS_QKV); bf16* ON = (bf16*)(A.ws + WS_ON); float* DEN = (float*)(A.ws + WS_DEN);
    const float* qg = A.in[I_QNG]; const float* kg = A.in[I_KNG];
    LAS unsigned char* Vb = (LAS unsigned char*)C.lds;
    LAS unsigned char* Kb = Vb + ATT_K_OFF;
    LAS float* scr = (LAS float*)(Vb + ATT_SCR_OFF + C.wave * 256);
    LAS float* rkt = (LAS float*)(Vb + ATT_RK_OFF);
    unsigned z0_ = 0u; asm volatile("" : "+v"(z0_));
    const int lane = (int)__builtin_amdgcn_mbcnt_hi(~0u, __builtin_amdgcn_mbcnt_lo(~0u, z0_)), c = lane & 15, kq = lane >> 4, w = C.wave, i0 = 16 * w;
    constexpr float C2 = 0.08838834764831845f * 1.4426950408889634f;
#define ATT_DECODE(U, B_, GI_, HH_, R_, N_, DIL_) const int B_ = (U) / 384, GI_ = ((U) % 384) >> 7; const int DIL_ = (GI_ == 0) ? 1 : (GI_ == 1) ? 4 : 16; \
        const int nbk##B_ = (GI_ == 0) ? 32 : (GI_ == 1) ? 8 : 2; const int rem2##B_ = ((U) % 384) & 127; const int HH_ = rem2##B_ / (DIL_ * nbk##B_), r2##B_ = rem2##B_ % (DIL_ * nbk##B_), R_ = r2##B_ / nbk##B_, N_ = r2##B_ % nbk##B_;
#define ATT_LOAD(KD, VD, QD, RB_, N_, DIL_, HEAD_, FULL_) do { unsigned zz_ = 0u; asm volatile("" : "+v"(zz_)); const int tid_ = C.wave * 64 + (int)__builtin_amdgcn_mbcnt_hi(~0u, __builtin_amdgcn_mbcnt_lo(~0u, zz_)); const int lb_ = 128 * (N_) - 128; \
        _Pragma("unroll") for (int k_ = 0; k_ < 8; ++k_) { if (k_ < 4 || (FULL_)) { const int idx_ = tid_ + NTHREADS * (k_ & 3); int l_ = lb_ + ((k_ < 4) ? 128 : 0) + (idx_ >> 4); l_ = l_ < 0 ? 0 : l_;        \
            const bf16* rp_ = QKV + ((RB_) + (size_t)l_ * (DIL_)) * QKVW + (HEAD_) * HD + (idx_ & 15) * 8; KD[k_] = *(const v4u*)(rp_ + AW); VD[k_] = *(const v4u*)(rp_ + 2 * AW); } } \
        { const bf16* qrow_ = QKV + ((RB_) + (size_t)(128 * (N_) + i0 + (tid_ & 15)) * (DIL_)) * QKVW + (HEAD_) * HD + 8 * ((tid_ & 63) >> 4); \
          _Pragma("unroll") for (int ks_ = 0; ks_ < 4; ++ks_) QD[ks_] = *(const v4u*)(qrow_ + 32 * ks_); } } while (0)
#define ATT_STORE(KD, VD, FULL_, FLIP_) do { unsigned zz_ = 0u; asm volatile("" : "+v"(zz_)); const int tid_ = C.wave * 64 + (int)__builtin_amdgcn_mbcnt_hi(~0u, __builtin_amdgcn_mbcnt_lo(~0u, zz_)); _Pragma("unroll") for (int k_ = 0; k_ < 8; ++k_) if (k_ < 4 || (FULL_)) { const int idx_ = tid_ + NTHREADS * (k_ & 3); const int pr_ = ((((k_ < 4) ? 128 : 0) + (idx_ >> 4)) ^ (FLIP_));        \
            *(LAS v4u*)(Kb + pr_ * KROW + (idx_ & 15) * 16) = KD[k_]; *(LAS v4u*)(Vb + pr_ * VROW + (idx_ & 15) * 16) = VD[k_]; \
            { const v4u k4 = KD[k_]; const float a0 = bflo(k4.x), a1 = bfhi(k4.x), a2 = bflo(k4.y), a3 = bfhi(k4.y), a4 = bflo(k4.z), a5 = bfhi(k4.z), a6 = bflo(k4.w), a7 = bfhi(k4.w); \
              const float ssr_ = rowsum_f((a0 * a0 + a1 * a1) + (a2 * a2 + a3 * a3) + (a4 * a4 + a5 * a5) + (a6 * a6 + a7 * a7));        \
              rkt[pr_] = C2 / sqrtf(ssr_ * (1.0f / HD) + EPS); } } } while (0)
    v4u knext[8], vnext[8], qnext[4], qraw[4];
    const int upw = (768 + C.nb - 1) / C.nb, ub = C.bid * upw, ue = (ub + upw < 768) ? ub + upw : 768;
    int flip = 0;
    if (ub < ue) { ATT_DECODE(ub, b0_, gi0_, hh0_, r0_, n0_, dil0_); ATT_LOAD(knext, vnext, qraw, (size_t)b0_ * SEQ + r0_, n0_, dil0_, gi0_ * 4 + hh0_, true); ATT_STORE(knext, vnext, true, 0); }
    for (int u = ub; u < ue; ++u) {
        ATT_DECODE(u, b, gi, hh, r, n, dil);
        const int head = gi * 4 + hh;
        const size_t rowbase = (size_t)b * SEQ + r;
        const int lb = 128 * n - 128;
        f32x4 gg[4][2];
#pragma unroll
        for (int ks = 0; ks < 4; ++ks) { const int d0 = head * HD + 32 * ks + 8 * kq; gg[ks][0] = *(const f32x4*)(qg + d0) * *(const f32x4*)(kg + d0); gg[ks][1] = *(const f32x4*)(qg + d0 + 4) * *(const f32x4*)(kg + d0 + 4); }
        __syncthreads();
        const int un = u + 1; const bool hasn = un < ue; const bool reuse = n + 1 < nbkb;
        if (hasn) { ATT_DECODE(un, bn_, gin_, hhn_, rn_, nn_, diln_); ATT_LOAD(knext, vnext, qnext, (size_t)bn_ * SEQ + rn_, nn_, diln_, gin_ * 4 + hhn_, !reuse); }
        pg8::bf16x8 qf[4];
        { float ss = 0.f;
#pragma unroll
          for (int ks = 0; ks < 4; ++ks) { const v4u rw = qraw[ks];
              const float a0 = bflo(rw.x), a1 = bfhi(rw.x), a2 = bflo(rw.y), a3 = bfhi(rw.y), a4 = bflo(rw.z), a5 = bfhi(rw.z), a6 = bflo(rw.w), a7 = bfhi(rw.w);
              ss += (a0 * a0 + a1 * a1) + (a2 * a2 + a3 * a3) + (a4 * a4 + a5 * a5) + (a6 * a6 + a7 * a7); }
          ss += __shfl_xor(ss, 16); ss += __shfl_xor(ss, 32);
          const float rq = 1.0f / sqrtf(ss * (1.0f / HD) + EPS);
#pragma unroll
          for (int ks = 0; ks < 4; ++ks) { const v4u rw = qraw[ks];
              const f32x4 g0 = gg[ks][0], g1 = gg[ks][1];
              pg8::u32x4 pk;
              pk.x = pg8::cvt_pk_bf16(bflo(rw.x) * rq * g0.x, bfhi(rw.x) * rq * g0.y); pk.y = pg8::cvt_pk_bf16(bflo(rw.y) * rq * g0.z, bfhi(rw.y) * rq * g0.w);
              pk.z = pg8::cvt_pk_bf16(bflo(rw.z) * rq * g1.x, bfhi(rw.z) * rq * g1.y); pk.w = pg8::cvt_pk_bf16(bflo(rw.w) * rq * g1.z, bfhi(rw.w) * rq * g1.w);
              qf[ks] = __builtin_bit_cast(pg8::bf16x8, pk); } }
        unsigned Pk[10][2]; float dsum = 0.f;
#pragma unroll
        for (int kb = 0; kb < 9; ++kb) {
            const int j0 = i0 + 16 * kb;
            v4u kr[4];
#pragma unroll
            for (int ks = 0; ks < 4; ++ks) kr[ks] = *(const LAS v4u*)(Kb + ((j0 ^ flip) + c) * KROW + 64 * ks + 16 * kq);
            const f32x4 rk4 = *(const LAS f32x4*)(rkt + (j0 ^ flip) + 4 * kq);
            f32x4 acc = {0.f, 0.f, 0.f, 0.f};
#pragma unroll
            for (int ks = 0; ks < 4; ++ks) acc = __builtin_amdgcn_mfma_f32_16x16x32_bf16(__builtin_bit_cast(pg8::bf16x8, kr[ks]), qf[ks], acc, 0, 0, 0);
#pragma unroll
            for (int e = 0; e < 4; ++e) { const int j = j0 + 4 * kq + e; const int dist = 128 + i0 + c - j;
                const bool valid = (dist >= 0) && (dist <= 128) && (lb + j >= 0);
                const float pv = __builtin_amdgcn_exp2f(acc[e] * rk4[e]);
                acc[e] = valid ? pv : 0.f; dsum += acc[e]; }
            Pk[kb][0] = pg8::cvt_pk_bf16(acc[0], acc[1]); Pk[kb][1] = pg8::cvt_pk_bf16(acc[2], acc[3]);
        }
        Pk[9][0] = 0u; Pk[9][1] = 0u;
        dsum += __shfl_xor(dsum, 16); dsum += __shfl_xor(dsum, 32);
        f32x4 O[8];
#pragma unroll
        for (int dt = 0; dt < 8; ++dt) O[dt] = (f32x4){0.f, 0.f, 0.f, 0.f};
#pragma unroll
        for (int s = 0; s < 5; ++s) {
            pg8::u32x4 pk; pk.x = Pk[2 * s][0]; pk.y = Pk[2 * s][1]; pk.z = Pk[2 * s + 1][0]; pk.w = Pk[2 * s + 1][1];
            const pg8::bf16x8 pf = __builtin_bit_cast(pg8::bf16x8, pk);
            const int kb1 = (2 * s + 1 < 9) ? 2 * s + 1 : 8;
            const int rowA = ((i0 + 32 * s) ^ flip) + 4 * kq + (c >> 2), rowB = ((i0 + 16 * kb1) ^ flip) + 4 * kq + (c >> 2);
            LAS unsigned char* pa = Vb + rowA * VROW + (c & 3) * 8; LAS unsigned char* pb = Vb + rowB * VROW + (c & 3) * 8;
#pragma unroll
            for (int dt = 0; dt < 8; ++dt) {
                const v4i16_t lo = __builtin_amdgcn_ds_read_tr16_b64_v4i16((LAS v4i16_t*)(pa + dt * 32));
                const v4i16_t hi = __builtin_amdgcn_ds_read_tr16_b64_v4i16((LAS v4i16_t*)(pb + dt * 32));
                const pg8::bf16x8 vf = {lo[0], lo[1], lo[2], lo[3], hi[0], hi[1], hi[2], hi[3]};
                O[dt] = __builtin_amdgcn_mfma_f32_16x16x32_bf16(vf, pf, O[dt], 0, 0, 0);
            }
        }
        { const float inv = 1.0f / dsum;
          const size_t trow = rowbase + (size_t)(128 * n + i0 + c) * dil;
          bf16* op = ON + ((size_t)gi * T + trow) * AOW + hh * HD + 4 * kq;
#pragma unroll
          for (int dt = 0; dt < 8; ++dt) { v2u w_; w_.x = pg8::cvt_pk_bf16(O[dt][0] * inv, O[dt][1] * inv); w_.y = pg8::cvt_pk_bf16(O[dt][2] * inv, O[dt][3] * inv); *(v2u*)(op + 16 * dt) = w_; }
          { unsigned zq_ = 0u; asm volatile("" : "+v"(zq_)); const int l2_ = (int)__builtin_amdgcn_mbcnt_hi(~0u, __builtin_amdgcn_mbcnt_lo(~0u, zq_));
            if ((l2_ >> 4) == 0) DEN[((size_t)gi * T + rowbase + (size_t)(128 * n + 16 * C.wave + (l2_ & 15)) * dil) * 4 + hh] = dsum; } }
        __syncthreads();
        if (hasn) { if (reuse) { flip ^= 128; ATT_STORE(knext, vnext, false, flip); } else { flip = 0; ATT_STORE(knext, vnext, true, 0); }
#pragma unroll
            for (int ks = 0; ks < 4; ++ks) qraw[ks] = qnext[ks]; }
    }
#undef ATT_DECODE
#undef ATT_LOAD
#undef ATT_STORE
}
__device__ __forceinline__ void phase_attn_combine(const Args& A, const Ctx& C) {
    const bf16* ON = (const bf16*)(A.ws + WS_ON); const float* DEN = (const float*)(A.ws + WS_DEN); unsigned char* O = A.ws + WS_O;
    const int gt = C.bid * NTHREADS + C.tid, ngt = C.nb * NTHREADS;
    for (int i = gt; i < T * (AOW / 8); i += ngt) {
        const int t = i >> 6, ch = i & 63, hh = ch >> 4;
        const float d0 = DEN[((size_t)0 * T + t) * 4 + hh], d1 = DEN[((size_t)1 * T + t) * 4 + hh], d2 = DEN[((size_t)2 * T + t) * 4 + hh];
        const float inv = O_SCALE / (d0 + d1 + d2); const float w0 = d0 * inv, w1 = d1 * inv, w2 = d2 * inv;
        const v4u a = *(const v4u*)(ON + ((size_t)0 * T + t) * AOW + ch * 8), bq = *(const v4u*)(ON + ((size_t)1 * T + t) * AOW + ch * 8), cq = *(const v4u*)(ON + ((size_t)2 * T + t) * AOW + ch * 8);
        v2u o;
        int p0 = __builtin_amdgcn_cvt_pk_fp8_f32(w0 * bflo(a.x) + w1 * bflo(bq.x) + w2 * bflo(cq.x), w0 * bfhi(a.x) + w1 * bfhi(bq.x) + w2 * bfhi(cq.x), 0, false);
        p0 = __builtin_amdgcn_cvt_pk_fp8_f32(w0 * bflo(a.y) + w1 * bflo(bq.y) + w2 * bflo(cq.y), w0 * bfhi(a.y) + w1 * bfhi(bq.y) + w2 * bfhi(cq.y), p0, true);
        int p1 = __builtin_amdgcn_cvt_pk_fp8_f32(w0 * bflo(a.z) + w1 * bflo(bq.z) + w2 * bflo(cq.z), w0 * bfhi(a.z) + w1 * bfhi(bq.z) + w2 * bfhi(cq.z), 0, false);
        p1 = __builtin_amdgcn_cvt_pk_fp8_f32(w0 * bflo(a.w) + w1 * bflo(bq.w) + w2 * bflo(cq.w), w0 * bfhi(a.w) + w1 * bfhi(bq.w) + w2 * bfhi(cq.w), p1, true);
        o.x = (unsigned)p0; o.y = (unsigned)p1;
        *(v2u*)(O + (size_t)t * AOW + ch * 8) = o;
    }
}

__device__ __forceinline__ void phase_cvec(const Args& A, const Ctx& C) {
    const bf16* WQ = (const bf16*)(A.ws + WS_WQ); const float* mod = (const float*)(A.ws + WS_MOD); float* cvec = (float*)(A.ws + WS_CVEC);
    for (int n = C.gw; n < D; n += C.ngw) {
        float s0 = 0.f, s1 = 0.f;
#pragma unroll
        for (int j = 0; j < 4; ++j) { const int k = 8 * C.lane + 512 * j; const v4u w = *(const v4u*)(WQ + (size_t)n * D + k);
            const f32x4 a0 = *(const f32x4*)(mod + 3 * 2048 + k), a1 = *(const f32x4*)(mod + 3 * 2048 + k + 4), b0 = *(const f32x4*)(mod + 12288 + 3 * 2048 + k), b1 = *(const f32x4*)(mod + 12288 + 3 * 2048 + k + 4);
            const float w0 = bflo(w.x), w1 = bfhi(w.x), w2 = bflo(w.y), w3 = bfhi(w.y), w4 = bflo(w.z), w5 = bfhi(w.z), w6 = bflo(w.w), w7 = bfhi(w.w);
            s0 += ((w0 * a0.x + w1 * a0.y) + (w2 * a0.z + w3 * a0.w)) + ((w4 * a1.x + w5 * a1.y) + (w6 * a1.z + w7 * a1.w));
            s1 += ((w0 * b0.x + w1 * b0.y) + (w2 * b0.z + w3 * b0.w)) + ((w4 * b1.x + w5 * b1.y) + (w6 * b1.z + w7 * b1.w)); }
#pragma unroll
        for (int o = 1; o < 64; o <<= 1) { s0 += __shfl_xor(s0, o); s1 += __shfl_xor(s1, o); }
        if (C.lane == 0) { cvec[n] = s0; cvec[2048 + n] = s1; }
    }
}

__global__ void __launch_bounds__(NTHREADS, 2) mk_fwd(Args args) {
    extern __shared__ __attribute__((aligned(16))) unsigned char lds[];
    Ctx C;
    C.tid = threadIdx.x; C.lane = C.tid & 63; C.wave = __builtin_amdgcn_readfirstlane(C.tid >> 6);
    C.bid = blockIdx.x; C.nb = gridDim.x; C.gw = C.bid * NWAVES + C.wave; C.ngw = C.nb * NWAVES; C.lds = lds;
    volatile LAS unsigned* MISC = (volatile LAS unsigned*)((LAS unsigned char*)lds + MISC_OFF);
    if (C.tid < 32) MISC[C.tid] = 0u;
    __syncthreads();
    unsigned* ctl = (unsigned*)(args.ws + WS_CTL);
    XcdBarrier bar; bar.bar = ctl + CW_BAR; bar.x = 0; bar.st = nullptr;
    const int lo = args.ph_lo, hi = args.ph_hi;
    if (hi - lo > 1) bar = xcd_barrier_post(ctl + CW_BAR, MISC + 8);
    bar.wave = C.wave;
#define IN(k) (lo <= (k) && (k) < hi)
#define SEAM(k) do { if (IN(k) && IN((k) + 1)) xcd_barrier(bar); } while (0)
    unsigned char* ws = args.ws;
    const float* mod = (const float*)(ws + WS_MOD);
#define REP(k) for (int rep_ = 0; rep_ < ((PROBE_DUP == (k)) ? 2 : 1); ++rep_)
#define FRESH_CTX() do { unsigned z_ = 0u; asm volatile("" : "+v"(z_)); C.lane = (int)__builtin_amdgcn_mbcnt_hi(~0u, __builtin_amdgcn_mbcnt_lo(~0u, z_)); C.tid = C.wave * 64 + C.lane; } while (0)
    if (IN(0)) { FRESH_CTX(); REP(0) phase_prologue(args, C); } SEAM(0);
    if (IN(1)) { FRESH_CTX(); REP(1) phase_norm_mod<true>(args.in[I_X], args.in[I_N1G], mod, 0, 1, (bf16*)(ws + WS_H8), C); } SEAM(1);
    LAS unsigned char* ldsl = (LAS unsigned char*)lds;
    if (IN(2)) { FRESH_CTX(); REP(2) { pg8::Gemm g{(const bf16*)(ws + WS_H8), (const bf16*)(ws + WS_WIN), T, IN_COLS, D / 2}; pg8::StaticOrder S; S.init(T, IN_COLS, C.nb, C.bid);
                 pg8::EpiIn E{(bf16*)(ws + WS_U), (bf16*)(ws + WS_QKV), (bf16*)(ws + WS_G), 0, 1.0f / WIN_SCALE};
                 pg8::gemm_phase<pg8::EpiIn, pg8::StaticOrder, false, true, true>(ldsl, g, S, E, C.wave); }
                 { constexpr int NT6 = (T / 256) * (IN_COLS / 256) % 256;
                   if (C.nb == 256 && NT6 > 0) { if (C.bid >= NT6) late_transposes(args, C, lds, (C.bid - NT6) * NWAVES + C.wave, (256 - NT6) * NWAVES); }
                   else late_transposes(args, C, lds, C.gw, C.ngw); } } SEAM(2);
    if (IN(3)) { FRESH_CTX(); REP(3) { phase_conv(args, C); phase_attn(args, C); } } SEAM(3);
    if (IN(4)) { FRESH_CTX(); phase_cvec(args, C); phase_attn_combine(args, C);
                 int kk_ = CONV_CH / 2; asm volatile("" : "+s"(kk_)); pg8::Gemm g{(const bf16*)(ws + WS_UCV), (const bf16*)(ws + WS_WCO), T, D, kk_};   pg8::StaticOrder S; S.init(T, D, C.nb, C.bid);
                 pg8::EpiYconv E{(const bf16*)(ws + WS_G), (bf16*)(ws + WS_MERGED), args.in[I_BCO], 1.0f / (UCV_SCALE * WIN_SCALE)};
                 pg8::gemm_phase<pg8::EpiYconv, pg8::StaticOrder, true, true, true>(ldsl, g, S, E, C.wave); } SEAM(4);
    if (IN(5)) { FRESH_CTX(); REP(5) { int kk_ = AOW / 2; asm volatile("" : "+s"(kk_)); pg8::Gemm g{(const bf16*)(ws + WS_O), (const bf16*)(ws + WS_WAO), T, D, kk_};   pg8::StaticOrder S; S.init(T, D, C.nb, C.bid);
                 pg8::EpiYattn E{(const bf16*)(ws + WS_G), (const bf16*)(ws + WS_MERGED), ws + WS_QP, MG_SCALE, 1.0f / (O_SCALE * WIN_SCALE)};
                 pg8::gemm_phase<pg8::EpiYattn, pg8::StaticOrder, true, true, true>(ldsl, g, S, E, C.wave); } } SEAM(5);
    if (IN(6)) { FRESH_CTX(); REP(6) { pg8::Gemm g{(const bf16*)(ws + WS_QP), (const bf16*)(ws + WS_WOUT), T, D, D / 2}; pg8::StaticOrder S; S.init(T, D, C.nb, C.bid);
                 pg8::EpiOut E{args.in[I_X], mod, args.in[I_N2G], (bf16*)(ws + WS_X1B), (bf16*)(ws + WS_H), (float*)(ws + WS_SSQ), 1.0f / (MG_SCALE * WIN_SCALE)};
                 pg8::gemm_phase<pg8::EpiOut, pg8::StaticOrder, true, true, true>(ldsl, g, S, E, C.wave); } } SEAM(6);
    if (IN(7)) { FRESH_CTX(); REP(7) { pg8::Gemm g{(const bf16*)(ws + WS_H), (const bf16*)(ws + WS_WQ), T, D, D}; pg8::StaticOrder S; S.init(T, D, C.nb, C.bid);
                 pg8::EpiQ E{(bf16*)(ws + WS_QP), (const float*)(ws + WS_SSQ), (const float*)(ws + WS_CVEC)};
                 pg8::gemm_phase<pg8::EpiQ, pg8::StaticOrder, true, true>(ldsl, g, S, E, C.wave); } } SEAM(7);
    if (IN(8)) { FRESH_CTX(); REP(8) phase_topk(args, C); } SEAM(8);
    if (IN(9)) { FRESH_CTX(); phase_experts3(args, C, args.out, 0xFFFFFFFFu); }
#undef REP
#undef IN
#undef SEAM
}

extern "C" void kernel_launch(void* const* d_in, const int* in_sizes, int n_in, void* d_out, int out_size, void* d_ws, size_t ws_size, hipStream_t stream) {
    static int grid = 0;
    if (grid == 0) {
        if (n_in != 21 || in_sizes[0] != T * D || out_size != T * D || ws_size < WS_END) {
            fprintf(stderr, "kernel_launch: unexpected shapes: n_in %d in0 %d out %d ws %zu (need %zu)\n", n_in, n_in > 0 ? in_sizes[0] : -1, out_size, ws_size, (size_t)WS_END); grid = -1; return; }
        int dev = 0, cus = 0, per_cu = 0;
        if (hipGetDevice(&dev) != hipSuccess || hipDeviceGetAttribute(&cus, hipDeviceAttributeMultiprocessorCount, dev) != hipSuccess) { grid = -1; return; }
        if (hipFuncSetAttribute((const void*)mk_fwd, hipFuncAttributeMaxDynamicSharedMemorySize, LDS_BYTES) != hipSuccess) { fprintf(stderr, "kernel_launch: hipFuncSetAttribute failed\n"); grid = -1; return; }
        if (hipOccupancyMaxActiveBlocksPerMultiprocessor(&per_cu, (const void*)mk_fwd, NTHREADS, LDS_BYTES) != hipSuccess || per_cu < 1)
            fprintf(stderr, "kernel_launch: note: occupancy query reports %d\n", per_cu);
        (void)hipGetLastError();
        grid = cus;
    }
    if (grid < 0) return;
    (void)hipMemsetAsync((char*)d_ws + WS_CTL, 0, CTL_ZERO_BYTES, stream);
    Args a{};
    for (int i = 0; i < 21; ++i) a.in[i] = (const float*)d_in[i];
    a.out = (float*)d_out; a.ws = (unsigned char*)d_ws;
#if N_LAUNCH_MODE == 1
    a.ph_lo = 0; a.ph_hi = NPHASES;
    hipLaunchKernelGGL(mk_fwd, dim3(grid), dim3(NTHREADS), LDS_BYTES, stream, a);
#else
    for (int p = 0; p < NPHASES; ++p) { a.ph_lo = p; a.ph_hi = p + 1; hipLaunchKernelGGL(mk_fwd, dim3(grid), dim3(NTHREADS), LDS_BYTES, stream, a); }
#endif
}
```
